# Optimizing an MI355X kernel written in HIP

```python
import math
import jax, jax.numpy as jnp
from jax import lax
import numpy as np

D_MODEL = 1024
BATCH = 2
SEQ = 16384
DEPTH = 4
DEC_BATCH = 16
DEC_SEQ = 32
PAST_LEN = 1024

CHUNK = 64
N_HEADS = 8
HEAD_DIM = 64
ATT_W = N_HEADS * 2 * HEAD_DIM
CONV_W = D_MODEL // 2
CONV_K = 3
POOL_W = D_MODEL // 2
POOL_WINDOWS = (2, 4, 8, 16)
POOL_GROUPS = len(POOL_WINDOWS)
POOL_GW = POOL_W // POOL_GROUPS
POOL_HIST = max(POOL_WINDOWS) - 1
N_BRANCH = 3
IN_COLS = 3 * ATT_W + 3 * CONV_W + POOL_W + N_BRANCH * D_MODEL
BRANCH_ROWS = ATT_W + CONV_W + POOL_W
D_FF = 2816
PLE_DIM = 256
ROPE_THETA = 10000.0
Q_BLOCK = 128
RMS_EPS = 1e-6
N_NORMS = 8

kernel_name = 'hybrid_streaming_encoder_step'


def rms_norm(x, g):
    xf = x.astype(jnp.float32)
    y = xf * lax.rsqrt(jnp.mean(xf * xf, axis=-1, keepdims=True) + RMS_EPS)
    return (y * g.astype(jnp.float32)).astype(x.dtype)


def swiglu(x, w_up, w_down):
    gate, up = jnp.split(x @ w_up, 2, axis=-1)
    return (jax.nn.silu(gate) * up) @ w_down


def rope(x, pos):
    half = HEAD_DIM // 2
    inv = ROPE_THETA ** (-jnp.arange(half, dtype=jnp.float32) / half)
    ang = pos.astype(jnp.float32)[:, None] * inv[None, :]
    cos = jnp.cos(ang)[None, :, None, :]
    sin = jnp.sin(ang)[None, :, None, :]
    xf = x.astype(jnp.float32)
    x1, x2 = xf[..., :half], xf[..., half:]
    return jnp.concatenate([x1 * cos - x2 * sin, x2 * cos + x1 * sin], axis=-1).astype(x.dtype)


def diff_attn_core(q, k, v, lam, mask):
    s = jnp.einsum('bqhd,bkhd->bhqk', q, k).astype(jnp.float32) * (HEAD_DIM ** -0.5)
    if mask is not None:
        s = jnp.where(mask[None, None], s, -jnp.inf)
    p = jax.nn.softmax(s, axis=-1)
    b, _, tq, tk = p.shape
    p = p.reshape(b, N_HEADS, 2, tq, tk)
    a = (p[:, :, 0] - lam * p[:, :, 1]).astype(v.dtype)
    return jnp.einsum('bhqk,bkhe->bqhe', a, v)


def prompt_attention(q, k, v, lam):
    b, s = q.shape[:2]
    nb = s // Q_BLOCK
    qb = q.reshape(b, nb, Q_BLOCK, 2 * N_HEADS, HEAD_DIM).transpose(1, 0, 2, 3, 4)
    qpos = jnp.arange(s, dtype=jnp.int32).reshape(nb, Q_BLOCK)
    kchunk = jnp.arange(s, dtype=jnp.int32) // CHUNK

    def block(args):
        qblk, pos = args
        mask = (pos[:, None] // CHUNK) >= kchunk[None, :]
        return diff_attn_core(qblk, k, v, lam, mask)

    out = lax.map(block, (qb, qpos))
    return out.transpose(1, 0, 2, 3, 4).reshape(b, s, N_HEADS, 2 * HEAD_DIM)


def short_conv(z, hist, conv_w):
    t = z.shape[1]
    zext = jnp.concatenate([hist, z], axis=1)
    y = sum(conv_w[j] * zext[:, j:j + t] for j in range(CONV_K))
    return y, zext[:, -(CONV_K - 1):]


def pool_mixer(z, hist, hist_valid, pool_w, pool_scale):
    b, t, _ = z.shape
    zext = jnp.concatenate([hist, z], axis=1)
    zf = zext.astype(jnp.float32)
    c = jnp.concatenate([jnp.zeros_like(zf[:, :1]), jnp.cumsum(zf, axis=1)], axis=1)
    zcur = zf[:, POOL_HIST:]
    tpos = jnp.arange(t, dtype=jnp.int32)
    outs = []
    for g, w in enumerate(POOL_WINDOWS):
        sl = slice(g * POOL_GW, (g + 1) * POOL_GW)
        wsum = c[:, POOL_HIST + 1:POOL_HIST + 1 + t, sl] - c[:, POOL_HIST + 1 - w:POOL_HIST + 1 - w + t, sl]
        cnt = jnp.minimum(tpos + 1 + hist_valid, w).astype(jnp.float32)[None, :, None]
        outs.append(wsum / cnt - zcur[:, :, sl])
    d = jnp.stack(outs, axis=2).astype(z.dtype)
    y = jnp.einsum('btgc,gcd->btgd', d, pool_w).reshape(b, t, POOL_W) * pool_scale
    return y, zext[:, -POOL_HIST:]


def encoder_layer(li, x, p, pos, k_cache, v_cache, conv_hist, pool_hist, pool_valid,
                  norm_g, w_ffn_up, w_ffn_down, w_in, lam, subln_g, conv_w, pool_w, pool_scale,
                  w_branch, w_out, w_ple_up, w_ple_gate):
    b, t = x.shape[:2]
    h = x + 0.5 * rms_norm(swiglu(rms_norm(x, norm_g[0]), w_ffn_up[0], w_ffn_down[0]), norm_g[1])
    u = rms_norm(h, norm_g[2])
    offs = [ATT_W, 2 * ATT_W, 3 * ATT_W, 3 * ATT_W + CONV_W, 3 * ATT_W + 2 * CONV_W,
            3 * ATT_W + 3 * CONV_W, 3 * ATT_W + 3 * CONV_W + POOL_W]
    q, k, v, bg, cg, xin, zp, gates = jnp.split(u @ w_in, offs, axis=-1)
    q = rope(q.reshape(b, t, 2 * N_HEADS, HEAD_DIM), pos)
    k = rope(k.reshape(b, t, 2 * N_HEADS, HEAD_DIM), pos)
    v = v.reshape(b, t, N_HEADS, 2 * HEAD_DIM)
    lam_init = 0.8 - 0.6 * math.exp(-0.3 * li)
    lamf = lam.astype(jnp.float32)
    lam_full = jnp.exp(jnp.sum(lamf[0] * lamf[1])) - jnp.exp(jnp.sum(lamf[2] * lamf[3])) + lam_init
    if k_cache is None:
        att = prompt_attention(q, k, v, lam_full)
    else:
        att = diff_attn_core(q, jnp.concatenate([k_cache, k], axis=1),
                             jnp.concatenate([v_cache, v], axis=1), lam_full, None)
    att = rms_norm(att, subln_g.reshape(N_HEADS, 2 * HEAD_DIM)) * (1.0 - lam_init)
    att = att.reshape(b, t, ATT_W)
    y_conv, conv_new = short_conv(cg * xin, conv_hist, conv_w)
    y_conv = bg * y_conv
    y_pool, pool_new = pool_mixer(zp, pool_hist, pool_valid, pool_w, pool_scale)
    g = jax.nn.sigmoid(gates).reshape(b, t, N_BRANCH, D_MODEL)
    merged = (g[:, :, 0] * (att @ w_branch[:ATT_W])
              + g[:, :, 1] * (y_conv @ w_branch[ATT_W:ATT_W + CONV_W])
              + g[:, :, 2] * (y_pool @ w_branch[ATT_W + CONV_W:]))
    h = h + rms_norm(merged @ w_out, norm_g[3])
    h = h + 0.5 * rms_norm(swiglu(rms_norm(h, norm_g[4]), w_ffn_up[1], w_ffn_down[1]), norm_g[5])
    gate = jax.nn.sigmoid(rms_norm(h, norm_g[6]) @ w_ple_gate)
    h = h + rms_norm((p @ w_ple_up) * gate, norm_g[7])
    return h, k, v, conv_new, pool_new


def setup_inputs(seed: int = 0) -> dict:
    key = jax.random.key(seed)
    ks = jax.random.split(key, 24)
    f32 = jnp.float32

    def nrm(k, shape, scale):
        return jax.random.normal(k, shape, f32) * scale

    return {
        'x_prompt': nrm(ks[0], (BATCH, SEQ, D_MODEL), 1.0),
        'x_sample': nrm(ks[1], (DEC_BATCH, DEC_SEQ, D_MODEL), 1.0),
        'cache_k': nrm(ks[2], (DEPTH, DEC_BATCH, PAST_LEN, 2 * N_HEADS, HEAD_DIM), 1.0),
        'cache_v': nrm(ks[3], (DEPTH, DEC_BATCH, PAST_LEN, N_HEADS, 2 * HEAD_DIM), 1.0),
        'state_conv': nrm(ks[4], (DEPTH, DEC_BATCH, CONV_K - 1, CONV_W), 1.0),
        'state_pool': nrm(ks[5], (DEPTH, DEC_BATCH, POOL_HIST, POOL_W), 1.0),
        'p_prompt': nrm(ks[6], (DEPTH, BATCH, SEQ, PLE_DIM), 1.0),
        'p_sample': nrm(ks[7], (DEPTH, DEC_BATCH, DEC_SEQ, PLE_DIM), 1.0),
        'norm_g': 1.0 + nrm(ks[8], (DEPTH, N_NORMS, D_MODEL), 0.05),
        'w_ffn_up': nrm(ks[9], (DEPTH, 2, D_MODEL, 2 * D_FF), D_MODEL ** -0.5),
        'w_ffn_down': nrm(ks[10], (DEPTH, 2, D_FF, D_MODEL), D_FF ** -0.5),
        'w_in': nrm(ks[11], (DEPTH, D_MODEL, IN_COLS), D_MODEL ** -0.5),
        'lam': nrm(ks[12], (DEPTH, 4, HEAD_DIM), 0.1),
        'subln_g': 1.0 + nrm(ks[13], (DEPTH, ATT_W), 0.05),
        'conv_w': nrm(ks[14], (DEPTH, CONV_K, CONV_W), CONV_K ** -0.5),
        'pool_w': nrm(ks[15], (DEPTH, POOL_GROUPS, POOL_GW, POOL_GW), POOL_GW ** -0.5),
        'pool_scale': 1.0 + nrm(ks[16], (DEPTH, POOL_W), 0.1),
        'w_branch': nrm(ks[17], (DEPTH, BRANCH_ROWS, D_MODEL), ATT_W ** -0.5),
        'w_out': nrm(ks[18], (DEPTH, D_MODEL, D_MODEL), D_MODEL ** -0.5),
        'w_ple_up': nrm(ks[19], (DEPTH, PLE_DIM, D_MODEL), PLE_DIM ** -0.5),
        'w_ple_gate': nrm(ks[20], (DEPTH, D_MODEL, D_MODEL), D_MODEL ** -0.5),
    }


def reference(x_prompt, x_sample, cache_k, cache_v, state_conv, state_pool, p_prompt, p_sample,
              norm_g, w_ffn_up, w_ffn_down, w_in, lam, subln_g, conv_w, pool_w, pool_scale,
              w_branch, w_out, w_ple_up, w_ple_gate):
    b = x_prompt.shape[0]
    pos_p = jnp.arange(x_prompt.shape[1], dtype=jnp.int32)
    pos_s = PAST_LEN + jnp.arange(x_sample.shape[1], dtype=jnp.int32)
    zero_conv = jnp.zeros((b, CONV_K - 1, CONV_W), x_prompt.dtype)
    zero_pool = jnp.zeros((b, POOL_HIST, POOL_W), x_prompt.dtype)
    sample_pool_valid = min(PAST_LEN, POOL_HIST)
    hp, hs = x_prompt, x_sample
    kp_l, vp_l, cp_l, pp_l = [], [], [], []
    ks_l, vs_l, cs_l, ps_l = [], [], [], []
    for li in range(DEPTH):
        wl = (norm_g[li], w_ffn_up[li], w_ffn_down[li], w_in[li], lam[li], subln_g[li], conv_w[li],
              pool_w[li], pool_scale[li], w_branch[li], w_out[li], w_ple_up[li], w_ple_gate[li])
        hp, kp, vp, cp, pp = encoder_layer(li, hp, p_prompt[li], pos_p, None, None,
                                           zero_conv, zero_pool, 0, *wl)
        hs, ks_, vs_, cs_, ps_ = encoder_layer(li, hs, p_sample[li], pos_s, cache_k[li], cache_v[li],
                                               state_conv[li], state_pool[li], sample_pool_valid, *wl)
        kp_l.append(kp); vp_l.append(vp); cp_l.append(cp); pp_l.append(pp)
        ks_l.append(ks_); vs_l.append(vs_); cs_l.append(cs_); ps_l.append(ps_)
    return (hp, hs,
            jnp.stack(kp_l), jnp.stack(vp_l), jnp.stack(cp_l), jnp.stack(pp_l),
            jnp.stack(ks_l), jnp.stack(vs_l), jnp.stack(cs_l), jnp.stack(ps_l))
```

```cpp
#include <hip/hip_runtime.h>
#include <cstdio>
#include <cstdint>

namespace pg8 {
#define PG8_LAS __attribute__((address_space(3)))
typedef unsigned short bf16_t;
typedef short bf16x8 __attribute__((ext_vector_type(8)));
typedef float f32x4 __attribute__((ext_vector_type(4)));
typedef unsigned u32x4 __attribute__((ext_vector_type(4)));
constexpr int BM = 256, BK = 64, HALF = 128, HTB = HALF * BK * 2  , STAGE_BYTES = 8 * HTB, NXCD = 8, WGM = 8;

__host__ __device__ __forceinline__ int lds_byte(int r, int c) { const int st = (r >> 4) * 2 + (c >> 5), rr = r & 15, cc = c & 31, ob = rr * 64 + cc * 2; return st * 1024 + (ob ^ (((ob >> 9) & 1) << 5)); }
__host__ __device__ __forceinline__ void stage_rc(int b, int& R, int& C) { const int st = b / 1024, sb = b % 1024, swz = sb ^ (((sb >> 9) & 1) << 5); R = (st >> 1) * 16 + swz / 64; C = (st & 1) * 32 + (swz % 64) / 2; }
__host__ __device__ __forceinline__ int perm32(int rho) { const int n = rho >> 4, i = rho & 15; return 8 * (i >> 2) + 4 * n + (i & 3); }

struct Unit { int pm, pn, seg; };
struct Gemm { const bf16_t* A; const bf16_t* Bt; int M, N, K; };

struct StaticOrder {
    int nM, nN, nwg, G, c;
    __host__ __device__ void init(int M, int N, int G_, int c_) { nM = M / BM; nN = N / BM; nwg = nM * nN; G = G_; c = c_; }
    __host__ __device__ bool next(int i, Unit& u) const {
        const long L = (long)i * G + c; if (L >= nwg) return false;
        int wgid = (int)L; { const int q = nwg / NXCD, r = nwg % NXCD, xcd = wgid % NXCD, off = wgid / NXCD; wgid = (xcd < r ? xcd * (q + 1) : r * (q + 1) + (xcd - r) * q) + off; }
        const int nig = WGM * nN, gid = wgid / nig, fm = gid * WGM, gsz = (nM - fm) < WGM ? (nM - fm) : WGM;
        u.pm = fm + ((wgid % nig) % gsz); u.pn = (wgid % nig) / gsz; u.seg = 0; return true;
    }
    __device__ __forceinline__ size_t koff_bytes(const Unit&) const { return 0; }
    __device__ __forceinline__ int ntiles(const Unit&, int K) const { return K / BK; }
    __device__ __forceinline__ void a_ready(const Unit&) const {}
    __device__ __forceinline__ void done(const Unit&) const {}
};
struct SegOrder : StaticOrder {
    __host__ __device__ bool next(int i, Unit& u) const { const int r = i / 3; if (!StaticOrder::next(r, u)) return false; u.seg = i - 3 * r; return true; }
    __device__ __forceinline__ size_t koff_bytes(const Unit& u) const { return u.seg == 0 ? 0 : (u.seg == 1 ? 2048 : 3072); }
    __device__ __forceinline__ int ntiles(const Unit& u, int) const { return u.seg == 0 ? 16 : 8; }
};

typedef float cvt_f32x2_t __attribute__((ext_vector_type(2))); typedef __bf16 cvt_bf16x2_t __attribute__((ext_vector_type(2)));
__device__ __forceinline__ unsigned cvt_pk_bf16(float lo, float hi) { const cvt_f32x2_t v = {lo, hi}; const cvt_bf16x2_t b = __builtin_convertvector(v, cvt_bf16x2_t); return __builtin_bit_cast(unsigned, b); }
typedef float f32x2 __attribute__((ext_vector_type(2)));
constexpr int MPROMPT = 32768;
constexpr float QSCALE = 0.125f * 1.4426950408889634f;
__device__ __forceinline__ float sigm(float x) { return __builtin_amdgcn_rcpf(1.0f + __builtin_amdgcn_exp2f(-1.4426950408889634f * x)); }
__device__ __forceinline__ u32x4 pack8(const f32x4 a, const f32x4 b) { u32x4 w; w.x = cvt_pk_bf16(a[0], a[1]); w.y = cvt_pk_bf16(a[2], a[3]); w.z = cvt_pk_bf16(b[0], b[1]); w.w = cvt_pk_bf16(b[2], b[3]); return w; }
__device__ __forceinline__ void unpack8(const u32x4 w, f32x4& a, f32x4& b) {
    a[0] = __uint_as_float(w.x << 16); a[1] = __uint_as_float(w.x & 0xffff0000u); a[2] = __uint_as_float(w.y << 16); a[3] = __uint_as_float(w.y & 0xffff0000u);
    b[0] = __uint_as_float(w.z << 16); b[1] = __uint_as_float(w.z & 0xffff0000u); b[2] = __uint_as_float(w.w << 16); b[3] = __uint_as_float(w.w & 0xffff0000u); }

struct EpiSwiGLU {
    static constexpr bool PERM = true, AFTER_DRAIN = false;
    bf16_t* O; int ldc;
    __device__ __forceinline__ void operator()(const f32x4 (&acc)[2][2][4][2], const Unit& u, int wr, int wc, int fr, int fq) const {
        const int row0 = u.pm * BM + wr * 64 + fr, col0 = u.pn * HALF + wc * 32 + 8 * fq;
#pragma unroll
        for (int ai = 0; ai < 2; ++ai)
#pragma unroll
            for (int m = 0; m < 4; ++m) { bf16_t* p = O + (size_t)(row0 + ai * HALF + m * 16) * ldc + col0; f32x4 h[2];
#pragma unroll
                for (int n = 0; n < 2; ++n)
#pragma unroll
                    for (int j = 0; j < 4; ++j) { const float g = acc[ai][0][m][n][j]; h[n][j] = g * sigm(g) * acc[ai][1][m][n][j]; }
                *(u32x4*)p = pack8(h[0], h[1]); }
    }
};
struct EpiF32 {
    static constexpr bool PERM = false, AFTER_DRAIN = false;
    float* Y; int ldc;
    __device__ __forceinline__ void operator()(const f32x4 (&acc)[2][2][4][2], const Unit& u, int wr, int wc, int fr, int fq) const {
        float* yb = Y + (size_t)(u.pm * BM) * ldc + u.pn * BM;
        int lrow = wr * 64 + fr, lcol = wc * 32 + 4 * fq; asm volatile("" : "+v"(lrow), "+v"(lcol));
#pragma unroll
        for (int ai = 0; ai < 2; ++ai)
#pragma unroll
            for (int m = 0; m < 4; ++m) { const int o = (lrow + ai * HALF + m * 16) * ldc + lcol;
#pragma unroll
                for (int bj = 0; bj < 2; ++bj)
#pragma unroll
                    for (int n = 0; n < 2; ++n) *(f32x4*)(yb + o + bj * HALF + n * 16) = acc[ai][bj][m][n]; }
    }
};
struct EpiPle {
    static constexpr bool PERM = false, AFTER_DRAIN = false;
    float* Y; const bf16_t* PU; int ldc;
    __device__ __forceinline__ void operator()(const f32x4 (&acc)[2][2][4][2], const Unit& u, int wr, int wc, int fr, int fq) const {
        const int row0 = u.pm * BM + wr * 64 + fr, col0 = u.pn * BM + wc * 32 + 4 * fq;
        typedef unsigned u32x2v __attribute__((ext_vector_type(2)));
#pragma unroll
        for (int ai = 0; ai < 2; ++ai)
#pragma unroll
            for (int m = 0; m < 4; ++m) { const size_t off = (size_t)(row0 + ai * HALF + m * 16) * ldc + col0;
#pragma unroll
                for (int bj = 0; bj < 2; ++bj)
#pragma unroll
                    for (int n = 0; n < 2; ++n) { const u32x2v w = *(const u32x2v*)(PU + off + bj * HALF + n * 16); const f32x4 a = acc[ai][bj][m][n]; f32x4 o;
                        o[0] = __uint_as_float(w.x << 16) * sigm(a[0]); o[1] = __uint_as_float(w.x & 0xffff0000u) * sigm(a[1]);
                        o[2] = __uint_as_float(w.y << 16) * sigm(a[2]); o[3] = __uint_as_float(w.y & 0xffff0000u) * sigm(a[3]);
                        *(f32x4*)(Y + off + bj * HALF + n * 16) = o; } }
    }
};
struct EpiBf {
    static constexpr bool PERM = true, AFTER_DRAIN = false;
    bf16_t* O; int ldc;
    __device__ __forceinline__ void operator()(const f32x4 (&acc)[2][2][4][2], const Unit& u, int wr, int wc, int fr, int fq) const {
        bf16_t* ob = O + (size_t)(u.pm * BM) * ldc + u.pn * BM;
        int lrow = wr * 64 + fr, lcol = wc * 32 + 8 * fq; asm volatile("" : "+v"(lrow), "+v"(lcol));
#pragma unroll
        for (int ai = 0; ai < 2; ++ai)
#pragma unroll
            for (int m = 0; m < 4; ++m) { const int o = (lrow + ai * HALF + m * 16) * ldc + lcol;
#pragma unroll
                for (int bj = 0; bj < 2; ++bj) *(u32x4*)(ob + o + bj * HALF) = pack8(acc[ai][bj][m][0], acc[ai][bj][m][1]); }
    }
};
struct EpiSeg {
    static constexpr bool PERM = true, AFTER_DRAIN = false;
    const bf16_t* S; float* T; bf16_t* O;
    __device__ __forceinline__ void operator()(const f32x4 (&acc)[2][2][4][2], const Unit& u, int wr, int wc, int fr, int fq) const {
        const int seg = u.seg;
        const bf16_t* sb = S + (size_t)(u.pm * BM) * 3072 + u.pn * BM + seg * 1024; float* tb = T + (size_t)(u.pm * BM) * 1024 + u.pn * BM; bf16_t* ob = O + (size_t)(u.pm * BM) * 1024 + u.pn * BM;
        int lrow = wr * 64 + fr, lcol = wc * 32 + 8 * fq; asm volatile("" : "+v"(lrow), "+v"(lcol));
#pragma unroll
        for (int ai = 0; ai < 2; ++ai)
#pragma unroll
            for (int m = 0; m < 4; ++m) { const int r = lrow + ai * HALF + m * 16;
#pragma unroll
                for (int bj = 0; bj < 2; ++bj) { const u32x4 ws = *(const u32x4*)(sb + r * 3072 + lcol + bj * HALF); f32x4 s0, s1; unpack8(ws, s0, s1);
                    f32x4 o0 = acc[ai][bj][m][0] * s0, o1 = acc[ai][bj][m][1] * s1; float* tp = tb + r * 1024 + lcol + bj * HALF;
                    if (seg != 0) { o0 = o0 + *(const f32x4*)tp; o1 = o1 + *(const f32x4*)(tp + 4); }
                    if (seg != 2) { *(f32x4*)tp = o0; *(f32x4*)(tp + 4) = o1; }
                    else *(u32x4*)(ob + r * 1024 + lcol + bj * HALF) = pack8(o0, o1); } }
    }
};
struct EpiWin {
    static constexpr bool PERM = true, AFTER_DRAIN = false;
    bf16_t *Q, *K, *V, *BG, *C, *ZP, *GS; const float *ropec, *ropes; float *kp, *vp, *ks, *vs;
    __device__ __forceinline__ void operator()(const f32x4 (&acc)[2][2][4][2], const Unit& u, int wr, int wc, int fr, int fq) const {
        const int pn = u.pn; const bool samp = u.pm >= MPROMPT / BM; const int row0 = u.pm * BM + wr * 64 + fr;
        if (pn < 8) {
            const bool isq = pn < 4; const int map = (pn & 3) * 4 + wc; bf16_t* dst = isq ? Q : K; const float sc = isq ? QSCALE : 1.0f;
            float* ko = samp ? ks - (size_t)MPROMPT * 1024 : kp;
#pragma unroll
            for (int ai = 0; ai < 2; ++ai)
#pragma unroll
                for (int m = 0; m < 4; ++m) { const int row = row0 + ai * HALF + m * 16; const int pos = samp ? 1024 + ((row - MPROMPT) & 31) : (row & 16383);
                    const float* cp = ropec + (size_t)pos * 32 + 8 * fq; const float* sp = ropes + (size_t)pos * 32 + 8 * fq;
                    f32x4 o1[2], o2[2];
#pragma unroll
                    for (int n = 0; n < 2; ++n) { const f32x4 c = *(const f32x4*)(cp + 4 * n), s = *(const f32x4*)(sp + 4 * n), x1 = acc[ai][0][m][n], x2 = acc[ai][1][m][n]; o1[n] = x1 * c - x2 * s; o2[n] = x2 * c + x1 * s; }
                    const size_t off = (size_t)row * 1024 + map * 64 + 8 * fq;
                    if (!isq) { float* kf = ko + off; *(f32x4*)kf = o1[0]; *(f32x4*)(kf + 4) = o1[1]; *(f32x4*)(kf + 32) = o2[0]; *(f32x4*)(kf + 36) = o2[1]; }
                    *(u32x4*)(dst + off) = pack8(o1[0] * sc, o1[1] * sc); *(u32x4*)(dst + off + 32) = pack8(o2[0] * sc, o2[1] * sc); }
        } else if (pn < 12) {
            float* vo = samp ? vs - (size_t)MPROMPT * 1024 : vp; const int col0 = (pn - 8) * BM + wc * 32 + 8 * fq;
#pragma unroll
            for (int ai = 0; ai < 2; ++ai)
#pragma unroll
                for (int m = 0; m < 4; ++m) { const size_t off = (size_t)(row0 + ai * HALF + m * 16) * 1024 + col0;
#pragma unroll
                    for (int bj = 0; bj < 2; ++bj) { float* vf = vo + off + bj * HALF; *(f32x4*)vf = acc[ai][bj][m][0]; *(f32x4*)(vf + 4) = acc[ai][bj][m][1]; *(u32x4*)(V + off + bj * HALF) = pack8(acc[ai][bj][m][0], acc[ai][bj][m][1]); } }
        } else if (pn < 14 || (pn >= 18 && pn < 20)) {
            bf16_t* dst = pn < 14 ? BG : ZP; const int col0 = (pn < 14 ? pn - 12 : pn - 18) * BM + wc * 32 + 8 * fq;
#pragma unroll
            for (int ai = 0; ai < 2; ++ai)
#pragma unroll
                for (int m = 0; m < 4; ++m) { bf16_t* p = dst + (size_t)(row0 + ai * HALF + m * 16) * 512 + col0;
#pragma unroll
                    for (int bj = 0; bj < 2; ++bj) *(u32x4*)(p + bj * HALF) = pack8(acc[ai][bj][m][0], acc[ai][bj][m][1]); }
        } else if (pn < 18) {
            const int col0 = (pn - 14) * HALF + wc * 32 + 8 * fq;
#pragma unroll
            for (int ai = 0; ai < 2; ++ai)
#pragma unroll
                for (int m = 0; m < 4; ++m) *(u32x4*)(C + (size_t)(row0 + ai * HALF + m * 16) * 512 + col0) = pack8(acc[ai][0][m][0] * acc[ai][1][m][0], acc[ai][0][m][1] * acc[ai][1][m][1]);
        } else {
            const int col0 = (pn - 20) * BM + wc * 32 + 8 * fq;
#pragma unroll
            for (int ai = 0; ai < 2; ++ai)
#pragma unroll
                for (int m = 0; m < 4; ++m) { bf16_t* p = GS + (size_t)(row0 + ai * HALF + m * 16) * 3072 + col0;
#pragma unroll
                    for (int bj = 0; bj < 2; ++bj) { f32x4 g0, g1;
#pragma unroll
                        for (int j = 0; j < 4; ++j) { g0[j] = sigm(acc[ai][bj][m][0][j]); g1[j] = sigm(acc[ai][bj][m][1][j]); }
                        *(u32x4*)(p + bj * HALF) = pack8(g0, g1); } }
        }
    }
};
template <class Epi, class Sched, bool ALIGN_EPI = false, bool SP2 = false>
__device__ __forceinline__ void gemm_phase(PG8_LAS unsigned char* lds, const Gemm g, const Sched& S, const Epi& E, const int wave) {
    int lane_; asm volatile("v_mbcnt_lo_u32_b32 %0, -1, 0\n\tv_mbcnt_hi_u32_b32 %0, -1, %0" : "=v"(lane_));
    const int wid = wave, lane = lane_, tid = wid * 64 + lane, wr = wid >> 2, wc = wid & 3, fr = lane & 15, fq = lane >> 4;
    const int K = g.K;
    unsigned voffA[2], voffB[2];
#pragma unroll
    for (int i = 0; i < 2; ++i) { int R, C; stage_rc(tid * 16 + i * 8192, R, C); const int Rb = Epi::PERM ? ((R & ~31) + perm32(R & 31)) : R;
        voffA[i] = (unsigned)(R * K + C) * 2u; voffB[i] = (unsigned)(Rb * K + C) * 2u; }
    const size_t kstep = (size_t)(BK * 2);
    const size_t hstep = (size_t)HALF * K * 2;
    const size_t tstep = 2 * hstep;
    const unsigned ldsw = (unsigned)wid * 1024u;
    const int aoff = lds_byte(wr * 64 + fr, fq * 8), boff = lds_byte(wc * 32 + fr, fq * 8);
#define PG8_SA(b, h) (((b) * 2 + (h)) * HTB)
#define PG8_SB(b, h) ((4 + (b) * 2 + (h)) * HTB)
#define PG8_STAGE(bufoff, gbase, voff) do { _Pragma("unroll") for (int _i = 0; _i < 2; ++_i) \
        __builtin_amdgcn_global_load_lds((const unsigned*)((const char*)(gbase) + (voff)[_i]), (PG8_LAS unsigned*)(lds + (bufoff) + ldsw + _i * 8192), 16, 0, 0); } while (0)
#define PG8_LDA(dst, b, h) do { _Pragma("unroll") for (int m = 0; m < 4; ++m) _Pragma("unroll") for (int k = 0; k < 2; ++k) dst[m][k] = *(const PG8_LAS bf16x8*)(lds + PG8_SA(b, h) + aoff + m * 2048 + k * 1024); } while (0)
#define PG8_LDB(dst, b, h) do { _Pragma("unroll") for (int n = 0; n < 2; ++n) _Pragma("unroll") for (int k = 0; k < 2; ++k) dst[n][k] = *(const PG8_LAS bf16x8*)(lds + PG8_SB(b, h) + boff + n * 2048 + k * 1024); } while (0)
#define PG8_MMA(ai, bj, At, Bt) do { __builtin_amdgcn_s_setprio(1); _Pragma("unroll") for (int m = 0; m < 4; ++m) _Pragma("unroll") for (int n = 0; n < 2; ++n) _Pragma("unroll") for (int k = 0; k < 2; ++k) \
        acc[ai][bj][m][n] = __builtin_amdgcn_mfma_f32_16x16x32_bf16(Bt[n][k], At[m][k], acc[ai][bj][m][n], 0, 0, 0); __builtin_amdgcn_s_setprio(0); } while (0)
#define PG8_WAIT_V(n) asm volatile("s_waitcnt vmcnt(" #n ")" ::: "memory")
#define PG8_WAIT_L(n) asm volatile("s_waitcnt lgkmcnt(" #n ")" ::: "memory")
#define PG8_BAR __builtin_amdgcn_s_barrier()
#define PG8_SCHED __builtin_amdgcn_sched_barrier(0)
    Unit cur, nxt; int ui = 0;
    if (!S.next(0, cur)) return;
    f32x4 acc[2][2][4][2];
#pragma unroll
    for (int a = 0; a < 2; ++a)
#pragma unroll
        for (int b = 0; b < 2; ++b)
#pragma unroll
            for (int m = 0; m < 4; ++m)
#pragma unroll
                for (int n = 0; n < 2; ++n) acc[a][b][m][n] = (f32x4){0.f, 0.f, 0.f, 0.f};
    bf16x8 At[4][2], B0[2][2], B1[2][2];
    const char* cA = (const char*)g.A + (size_t)cur.pm * tstep + S.koff_bytes(cur); const char* cB = (const char*)g.Bt + (size_t)cur.pn * tstep + S.koff_bytes(cur);
    S.a_ready(cur);
    if constexpr (SP2) {
        PG8_STAGE(PG8_SB(0, 0), cB, voffB); PG8_STAGE(PG8_SB(0, 1), cB + hstep, voffB); PG8_STAGE(PG8_SA(0, 0), cA, voffA); PG8_STAGE(PG8_SA(0, 1), cA + hstep, voffA);
        if (wr == 1) PG8_BAR;
        PG8_WAIT_V(2); PG8_BAR;
        PG8_STAGE(PG8_SB(1, 0), cB + kstep, voffB); PG8_STAGE(PG8_SA(1, 0), cA + kstep, voffA); PG8_STAGE(PG8_SB(1, 1), cB + hstep + kstep, voffB);
        PG8_WAIT_V(6); PG8_BAR;
    } else {
        PG8_STAGE(PG8_SB(0, 0), cB, voffB); PG8_STAGE(PG8_SA(0, 0), cA, voffA); PG8_STAGE(PG8_SB(0, 1), cB + hstep, voffB); PG8_STAGE(PG8_SA(0, 1), cA + hstep, voffA);
        if (wr == 1) PG8_BAR;
        PG8_WAIT_V(4); PG8_BAR;
        PG8_STAGE(PG8_SB(1, 0), cB + kstep, voffB); PG8_STAGE(PG8_SA(1, 0), cA + kstep, voffA); PG8_STAGE(PG8_SB(1, 1), cB + hstep + kstep, voffB);
        PG8_WAIT_V(6); PG8_BAR;
    }
    for (;;) {
        const bool has_next = S.next(ui + 1, nxt);
        const char* nA = has_next ? (const char*)g.A + (size_t)nxt.pm * tstep + S.koff_bytes(nxt) : cA; const char* nB = has_next ? (const char*)g.Bt + (size_t)nxt.pn * tstep + S.koff_bytes(nxt) : cB;
        const int nt = S.ntiles(cur, K);
        for (int t = 0; t < nt; t += 2) {
            const bool last = (t == nt - 2);
            const char* a1 = cA + (size_t)(t + 1) * kstep;
            const char* a2 = last ? nA : cA + (size_t)(t + 2) * kstep; const char* b2 = last ? nB : cB + (size_t)(t + 2) * kstep;
            const char* a3 = a2 + kstep; const char* b3 = b2 + kstep;
            if (last && has_next) S.a_ready(nxt);
            if constexpr (SP2) {
            PG8_LDB(B0, 0, 0); PG8_LDB(B1, 0, 1); PG8_SCHED; PG8_LDA(At, 0, 0); PG8_STAGE(PG8_SA(1, 1), a1 + hstep, voffA);
            PG8_WAIT_V(8); PG8_WAIT_L(0); PG8_BAR; PG8_MMA(0, 0, At, B0); PG8_MMA(0, 1, At, B1); PG8_BAR; PG8_SCHED;
            PG8_LDA(At, 0, 1); PG8_STAGE(PG8_SB(0, 0), b2, voffB); PG8_STAGE(PG8_SB(0, 1), b2 + hstep, voffB); PG8_STAGE(PG8_SA(0, 0), a2, voffA);
            PG8_WAIT_V(8); PG8_WAIT_L(0); PG8_BAR; PG8_MMA(1, 0, At, B0); PG8_MMA(1, 1, At, B1); PG8_BAR; PG8_SCHED;
            PG8_LDB(B0, 1, 0); PG8_LDB(B1, 1, 1); PG8_SCHED; PG8_LDA(At, 1, 0); PG8_STAGE(PG8_SA(0, 1), a2 + hstep, voffA);
            PG8_WAIT_V(8); PG8_WAIT_L(0); PG8_BAR; PG8_MMA(0, 0, At, B0); PG8_MMA(0, 1, At, B1); PG8_BAR; PG8_SCHED;
            PG8_LDA(At, 1, 1); PG8_STAGE(PG8_SB(1, 0), b3, voffB); PG8_STAGE(PG8_SB(1, 1), b3 + hstep, voffB); PG8_STAGE(PG8_SA(1, 0), a3, voffA);
            PG8_WAIT_V(8); PG8_WAIT_L(0); PG8_BAR; PG8_MMA(1, 0, At, B0); PG8_MMA(1, 1, At, B1); PG8_BAR; PG8_SCHED;
            } else {
            PG8_LDB(B0, 0, 0); PG8_SCHED; PG8_LDA(At, 0, 0); PG8_STAGE(PG8_SA(1, 1), a1 + hstep, voffA);
            PG8_WAIT_L(8); PG8_BAR; PG8_WAIT_L(0); PG8_MMA(0, 0, At, B0); PG8_BAR; PG8_SCHED;
            PG8_LDB(B1, 0, 1); PG8_STAGE(PG8_SB(0, 0), b2, voffB);
            PG8_BAR; PG8_WAIT_L(0); PG8_MMA(0, 1, At, B1); PG8_BAR;
            PG8_LDA(At, 0, 1); PG8_STAGE(PG8_SA(0, 0), a2, voffA);
            PG8_BAR; PG8_WAIT_L(0); PG8_MMA(1, 0, At, B0); PG8_BAR; PG8_SCHED;
            PG8_STAGE(PG8_SB(0, 1), b2 + hstep, voffB);
            PG8_WAIT_V(6); PG8_BAR; PG8_MMA(1, 1, At, B1); PG8_BAR;
            PG8_LDB(B0, 1, 0); PG8_SCHED; PG8_LDA(At, 1, 0); PG8_STAGE(PG8_SA(0, 1), a2 + hstep, voffA);
            PG8_WAIT_L(8); PG8_BAR; PG8_WAIT_L(0); PG8_MMA(0, 0, At, B0); PG8_BAR; PG8_SCHED;
            PG8_LDB(B1, 1, 1); PG8_STAGE(PG8_SB(1, 0), b3, voffB);
            PG8_BAR; PG8_WAIT_L(0); PG8_MMA(0, 1, At, B1); PG8_BAR;
            PG8_LDA(At, 1, 1); PG8_STAGE(PG8_SA(1, 0), a3, voffA);
            PG8_BAR; PG8_WAIT_L(0); PG8_MMA(1, 0, At, B0); PG8_BAR; PG8_SCHED;
            PG8_STAGE(PG8_SB(1, 1), b3 + hstep, voffB);
            PG8_WAIT_V(6); PG8_BAR; PG8_MMA(1, 1, At, B1); PG8_BAR;
            }
        }
        if constexpr (ALIGN_EPI) { if (wr == 0) PG8_BAR; }
        if constexpr (!Epi::AFTER_DRAIN) { E(acc, cur, wr, wc, fr, fq); S.done(cur); }
        if (!has_next) break;
#pragma unroll
        for (int a = 0; a < 2; ++a)
#pragma unroll
            for (int b = 0; b < 2; ++b)
#pragma unroll
                for (int m = 0; m < 4; ++m)
#pragma unroll
                    for (int n = 0; n < 2; ++n) acc[a][b][m][n] = (f32x4){0.f, 0.f, 0.f, 0.f};
        cur = nxt; cA = nA; cB = nB; ++ui;
        if constexpr (ALIGN_EPI) { if (wr == 1) PG8_BAR; }
    }
    PG8_WAIT_V(0);
    if constexpr (!ALIGN_EPI) { if (wr == 0) PG8_BAR; }
    PG8_BAR;
    if constexpr (Epi::AFTER_DRAIN) { E.fused(acc, cur, wr, wc, fr, fq, lds, wid, lane); S.done(cur); }
#undef PG8_SA
#undef PG8_SB
#undef PG8_STAGE
#undef PG8_LDA
#undef PG8_LDB
#undef PG8_MMA
#undef PG8_WAIT_V
#undef PG8_WAIT_L
#undef PG8_BAR
#undef PG8_SCHED
}
}
#include <hip/hip_bf16.h>
#include <cmath>
namespace attn_body {
using bf16=__hip_bfloat16;
using bf16x8=__attribute__((ext_vector_type(8)))short;
using s16x4=__attribute__((ext_vector_type(4)))short;
using f32x16=__attribute__((ext_vector_type(16)))float;
using u32x4=__attribute__((ext_vector_type(4)))unsigned;
constexpr int SEQ=16384,D=64,DM=1024,OP=2048;
constexpr int NW=8,QBLK=32,QB=QBLK*NW,KVBLK=64,NQB=SEQ/QB;
constexpr int ATTN_PITCH=DM, ATTN_UNIT_ROWS=QB;
__device__ __forceinline__ int crow(int r,int hi){return (r&3)+8*(r>>2)+4*hi;}
#define SBAR() __builtin_amdgcn_sched_barrier(0)
__device__ __forceinline__ void cmask(f32x16&p0,f32x16&p1,int jb,int qrel,int hi){
  const float NEG=-INFINITY; (void)hi;
  if(jb>(qrel>>6)){
  #pragma unroll
  for(int r=0;r<16;++r){p0[r]=NEG;p1[r]=NEG;} }
}

constexpr int NSLOT=3, SLOTB=8192;
constexpr int LDS_K=0, LDS_V=NSLOT*SLOTB, LDS_WS=2*NSLOT*SLOTB, LDS_OST=LDS_WS+NW*64*4, LDS_BYTES=LDS_OST+NW*4096;
constexpr float C2=0.125f*1.4426950408889634f;
__device__ __forceinline__ void glds16(const void*gsrc,unsigned lds_dst){unsigned keep;
  asm volatile("s_mov_b32 %0, m0\n\ts_mov_b32 m0, %2\n\ts_nop 0\n\tglobal_load_lds_dwordx4 %1, off\n\ts_mov_b32 m0, %0":"=&s"(keep):"v"(gsrc),"s"(lds_dst):"memory");}
__device__ __forceinline__ float max3f(float a,float b,float c){float r;asm("v_max3_f32 %0, %1, %2, %3":"=v"(r):"v"(a),"v"(b),"v"(c));return r;}
__device__ __forceinline__ float max2f(float a,float b){float r;asm("v_max_f32_e32 %0, %1, %2":"=v"(r):"v"(a),"v"(b));return r;}
__device__ __forceinline__ float fadd_s(float a,float b){float r;asm("v_add_f32_e32 %0, %1, %2":"=v"(r):"v"(a),"v"(b));return r;}
__device__ __forceinline__ float fsub_s(float a,float b){float r;asm("v_sub_f32_e32 %0, %1, %2":"=v"(r):"v"(a),"v"(b));return r;}
typedef float f32x2_t __attribute__((ext_vector_type(2))); typedef __bf16 bf16x2_t __attribute__((ext_vector_type(2)));
__device__ __forceinline__ unsigned cvtpk_s(float lo,float hi){f32x2_t v={lo,hi};bf16x2_t b=__builtin_convertvector(v,bf16x2_t);return __builtin_bit_cast(unsigned,b);}
#define WAIT_BAR(N) asm volatile("s_waitcnt vmcnt(" #N ") lgkmcnt(0)\n\ts_barrier":::"memory")

__device__ __forceinline__ void qkt(f32x16&p0,f32x16&p1,const char*Kslot,const bf16x8*qr,const f32x16&negm,int r32,int hi){
  const char*kb=Kslot+hi*1024+r32*16;
  #pragma unroll
  for(int d0=0;d0<4;++d0){
    const bf16x8 b0=*reinterpret_cast<const bf16x8*>(kb+d0*2048);
    const bf16x8 b1=*reinterpret_cast<const bf16x8*>(kb+d0*2048+512);
    if(d0==0){p0=__builtin_amdgcn_mfma_f32_32x32x16_bf16(b0,qr[0],negm,0,0,0);p1=__builtin_amdgcn_mfma_f32_32x32x16_bf16(b1,qr[0],negm,0,0,0);}
    else{p0=__builtin_amdgcn_mfma_f32_32x32x16_bf16(b0,qr[d0],p0,0,0,0);p1=__builtin_amdgcn_mfma_f32_32x32x16_bf16(b1,qr[d0],p1,0,0,0);}}
}
typedef __attribute__((address_space(3))) const char* lds_cptr;
typedef short v4i16_t __attribute__((ext_vector_type(4)));
__device__ __forceinline__ void kload8(bf16x8*kf,lds_cptr kp){
  kf[0]=*(const __attribute__((address_space(3))) bf16x8*)(kp);      kf[1]=*(const __attribute__((address_space(3))) bf16x8*)(kp+512);
  kf[2]=*(const __attribute__((address_space(3))) bf16x8*)(kp+2048); kf[3]=*(const __attribute__((address_space(3))) bf16x8*)(kp+2560);
  kf[4]=*(const __attribute__((address_space(3))) bf16x8*)(kp+4096); kf[5]=*(const __attribute__((address_space(3))) bf16x8*)(kp+4608);
  kf[6]=*(const __attribute__((address_space(3))) bf16x8*)(kp+6144); kf[7]=*(const __attribute__((address_space(3))) bf16x8*)(kp+6656);
}
__device__ __forceinline__ void kload2(bf16x8*kf,lds_cptr kp,int j){ kf[2*j]=*(const __attribute__((address_space(3))) bf16x8*)(kp+j*2048); kf[2*j+1]=*(const __attribute__((address_space(3))) bf16x8*)(kp+j*2048+512); }
__device__ __forceinline__ s16x4 vtr(lds_cptr p){ return __builtin_bit_cast(s16x4,__builtin_amdgcn_ds_read_tr16_b64_v4i16((__attribute__((address_space(3))) v4i16_t*)p)); }
__device__ __forceinline__ float rowmax(const f32x16&p0,const f32x16&p1){
  float a=max3f(p0[0],p0[1],p1[0]),b=max3f(p0[2],p0[3],p1[1]);a=max3f(a,p1[2],p1[3]);
  #pragma unroll
  for(int r=4;r<16;r+=4){a=max3f(a,p0[r],p0[r+1]);b=max3f(b,p0[r+2],p0[r+3]);a=max3f(a,p1[r],p1[r+1]);b=max3f(b,p1[r+2],p1[r+3]);}
  const float m=max2f(a,b);
  auto rr=__builtin_amdgcn_permlane32_swap(__float_as_uint(m),__float_as_uint(m),false,false);
  return max2f(__uint_as_float(rr[0]),__uint_as_float(rr[1]));
}
__device__ __forceinline__ void pv(f32x16*o,int vb,bf16x8 pa0,bf16x8 pa1,bf16x8 pa2,bf16x8 pa3){
  #pragma unroll
  for(int d0=0;d0<2;++d0){s16x4 lo[4],hi[4];
    #pragma unroll
    for(int ks=0;ks<4;++ks){
      asm volatile("ds_read_b64_tr_b16 %0,%1 offset:%c2":"=&v"(lo[ks]):"v"(vb),"i"(d0*4096+ks*1024):"memory");
      asm volatile("ds_read_b64_tr_b16 %0,%1 offset:%c2":"=&v"(hi[ks]):"v"(vb),"i"(d0*4096+ks*1024+512):"memory");}
    asm volatile("s_waitcnt lgkmcnt(0)":::"memory");SBAR();
    #define PK(k) (bf16x8){lo[k][0],lo[k][1],lo[k][2],lo[k][3],hi[k][0],hi[k][1],hi[k][2],hi[k][3]}
    o[d0]=__builtin_amdgcn_mfma_f32_32x32x16_bf16(pa0,PK(0),o[d0],0,0,0);
    o[d0]=__builtin_amdgcn_mfma_f32_32x32x16_bf16(pa1,PK(1),o[d0],0,0,0);
    o[d0]=__builtin_amdgcn_mfma_f32_32x32x16_bf16(pa2,PK(2),o[d0],0,0,0);
    o[d0]=__builtin_amdgcn_mfma_f32_32x32x16_bf16(pa3,PK(3),o[d0],0,0,0);
    #undef PK
  }
}

#ifndef ATTN_STORE16
#define ATTN_STORE16(p,v) (*(u32x4*)(p)=(v))
#endif
template<int THRL> __device__ __forceinline__ void attn_unit(int b,int map,int vh,int qb,const bf16*Q,const bf16*__restrict__ K,const bf16*__restrict__ V,bf16*O,char*shm,const int wave){
  int lane_; asm volatile("v_mbcnt_lo_u32_b32 %0, -1, 0\n\tv_mbcnt_hi_u32_b32 %0, -1, %0":"=v"(lane_)); const int lane=lane_,r32=lane&31,hi=lane>>5; const int wid=wave;
  const long rowbase=(long)b*SEQ; const int q0=qb*QB;
  const bf16*Qw=Q+(rowbase+q0+wid*QBLK)*DM+map*D;
  const bf16*Kh=K+rowbase*DM+map*D,*Vh=V+rowbase*DM+(map>>1)*128+vh*64;
  const unsigned lds0=(unsigned)(uintptr_t)shm;
  float*wsf=(float*)(shm+LDS_WS)+wid*64;
  const bf16*ksrc=Kh+(long)lane*DM+wid*8;
  const bf16*vsrc=Vh+(long)(16*(wid&3)+(lane>>2))*DM+(wid>>2)*32+(lane&3)*8;
  const unsigned kdst=lds0+LDS_K+wid*1024, vdst=lds0+LDS_V+wid*1024;
  #define DMA_K(t,slot) glds16(ksrc+(long)(t)*KVBLK*DM,(unsigned)__builtin_amdgcn_readfirstlane(kdst+(slot)))
  #define DMA_V(t,slot) glds16(vsrc+(long)(t)*KVBLK*DM,(unsigned)__builtin_amdgcn_readfirstlane(vdst+(slot)))
  const int vb0=(int)(lds0+LDS_V)+((lane>>4)&1)*32+(lane&3)*8+(4*hi+((lane&15)>>2))*64;
  const char*Kbase=shm+LDS_K; bf16x8 kf[8];
  const lds_cptr shm3=(lds_cptr)shm; const lds_cptr kp0=shm3+LDS_K+hi*1024+r32*16; const lds_cptr vp0=shm3+LDS_V+((lane>>4)&1)*32+(lane&3)*8+(4*hi+((lane&15)>>2))*64;
  const int NT=(q0+QB)/KVBLK;
  DMA_K(0,0);DMA_V(0,0);DMA_K(1,SLOTB);
  bf16x8 qr[4];
  #pragma unroll
  for(int d0=0;d0<4;++d0)qr[d0]=*reinterpret_cast<const bf16x8*>(&Qw[(long)r32*DM+d0*16+hi*8]);
  float mhat=0.f,l_reg=0.f;f32x16 o[2];o[0]=f32x16{};o[1]=f32x16{};f32x16 negm=f32x16{};asm volatile("":"+v"(negm));
  const int qrel=wid*QBLK+r32;
  #define CMASK(P0,P1,t) do{int jb_=(t)-(NT-4); if(jb_>=0)cmask(P0,P1,jb_,qrel,hi);}while(0)
  bool resc=false;
  #define START(P0,P1) do{ const float rm=rowmax(P0,P1); resc=false; \
    { const float dl=rm; mhat=fadd_s(mhat,dl); \
      _Pragma("unroll") for(int r=0;r<16;++r){P0[r]=fsub_s(P0[r],dl);P1[r]=fsub_s(P1[r],dl);} \
      _Pragma("unroll") for(int r=0;r<16;++r)negm[r]=-mhat; asm volatile("":"+v"(negm)); } \
    _Pragma("unroll") for(int r=0;r<16;++r)P0[r]=__builtin_amdgcn_exp2f(P0[r]); }while(0)
  #define RESC() do{ if(resc){ asm volatile("s_waitcnt lgkmcnt(0)":::"memory"); \
      _Pragma("unroll") for(int d_=0;d_<2;++d_) _Pragma("unroll") for(int r=0;r<16;++r)o[d_][r]*=wsf[crow(r,hi)]; } }while(0)
  f32x16 pA0,pA1,pB0,pB1;
  int sl_prev=0,sl_cur=0,sl_next=SLOTB;
  #define ROT() do{sl_prev=sl_cur;sl_cur=sl_next;sl_next=(sl_next==(NSLOT-1)*SLOTB)?0:sl_next+SLOTB;}while(0)
  DMA_K(2,2*SLOTB);
  WAIT_BAR(3);
  qkt(pA0,pA1,Kbase,qr,negm,r32,hi);asm volatile("s_nop 15\n\ts_nop 7":"+v"(pA0),"+v"(pA1));CMASK(pA0,pA1,0);
  START(pA0,pA1);
  _Pragma("unroll") for(int r=0;r<16;++r)pA1[r]=__builtin_amdgcn_exp2f(pA1[r]);
  WAIT_BAR(0);
  DMA_K(3,0);DMA_V(1,SLOTB);
  ROT();
  kload8(kf,kp0+sl_cur);
  WAIT_BAR(2);
  s16x4 vlo[8],vhi[8]; u32x4 pw0,pw1,pw2,pw3;
  #define PKW(P,B) cvtpk_s(P[B],P[B+1])
  #define PAF(k) __builtin_bit_cast(bf16x8,pw##k)
  #define VFR(i) (bf16x8){vlo[i][0],vlo[i][1],vlo[i][2],vlo[i][3],vhi[i][0],vhi[i][1],vhi[i][2],vhi[i][3]}
  #define PIN(x) asm volatile("":"+v"(x))
  #define MX3(a,b,c) __builtin_fmaxf(__builtin_fmaxf((a),(b)),(c))
  #define GAPA(MF,A0,A1,A2,A3,W0,W1,PW) do{ MF; sacc+=A0; sacc+=A1; sacc+=A2; sacc+=A3; PIN(sacc); W0; W1; PIN(PW); SBAR(); }while(0)
  #define EX(v) __builtin_amdgcn_exp2f(v)
  #define GAPB(MF,X,B) do{ MF; X[B]=EX(X[B]); X[B+1]=EX(X[B+1]); X[B+2]=EX(X[B+2]); X[B+3]=EX(X[B+3]); PIN(X); SBAR(); }while(0)
  #define VRD(i) do{ vlo[i]=vtr(vp_+(((i)>>2)*4096+((i)&3)*1024)); vhi[i]=vtr(vp_+(((i)>>2)*4096+((i)&3)*1024+512)); }while(0)
  #define KRD(G,j) do{ if(G){ kload2(kf,kp0+sl_next,j); SBAR(); } }while(0)
  #define STEP(C0,C1,P0,P1,t,GK,GV,GL) do{ SBAR(); \
    const lds_cptr vp_=vp0+sl_prev; \
    VRD(0); SBAR(); float sacc=(P0[0]+P0[1]); \
    GAPA(C0=__builtin_amdgcn_mfma_f32_32x32x16_bf16(kf[0],qr[0],negm,0,0,0), P0[2],P0[3],P0[4],P0[5],     pw0[0]=PKW(P0,0), pw0[1]=PKW(P0,2), pw0); \
    VRD(4); SBAR(); GAPA(C1=__builtin_amdgcn_mfma_f32_32x32x16_bf16(kf[1],qr[0],negm,0,0,0), P0[6],P0[7],P0[8],P0[9],     pw0[2]=PKW(P0,4), pw0[3]=PKW(P0,6), pw0); \
    VRD(1); SBAR(); GAPA(C0=__builtin_amdgcn_mfma_f32_32x32x16_bf16(kf[2],qr[1],C0,0,0,0),   P0[10],P0[11],P0[12],P0[13], pw1[0]=PKW(P0,8), pw1[1]=PKW(P0,10), pw1); \
    VRD(5); SBAR(); GAPA(C1=__builtin_amdgcn_mfma_f32_32x32x16_bf16(kf[3],qr[1],C1,0,0,0),   P0[14],P0[15],P1[0],P1[1],   pw1[2]=PKW(P0,12),pw1[3]=PKW(P0,14), pw1); \
    VRD(2); SBAR(); GAPA(C0=__builtin_amdgcn_mfma_f32_32x32x16_bf16(kf[4],qr[2],C0,0,0,0),   P1[2],P1[3],P1[4],P1[5],     pw2[0]=PKW(P1,0), pw2[1]=PKW(P1,2), pw2); \
    VRD(6); SBAR(); GAPA(C1=__builtin_amdgcn_mfma_f32_32x32x16_bf16(kf[5],qr[2],C1,0,0,0),   P1[6],P1[7],P1[8],P1[9],     pw2[2]=PKW(P1,4), pw2[3]=PKW(P1,6), pw2); \
    VRD(3); SBAR(); GAPA(C0=__builtin_amdgcn_mfma_f32_32x32x16_bf16(kf[6],qr[3],C0,0,0,0),   P1[10],P1[11],P1[12],P1[13], pw3[0]=PKW(P1,8), pw3[1]=PKW(P1,10), pw3); \
    VRD(7); SBAR(); GAPA(C1=__builtin_amdgcn_mfma_f32_32x32x16_bf16(kf[7],qr[3],C1,0,0,0),   P1[14],P1[15],0.f,0.f,       pw3[2]=PKW(P1,12),pw3[3]=PKW(P1,14), pw3); \
    l_reg+=sacc; \
    if(GK){DMA_K((t)+3,sl_cur);} if(GV){DMA_V((t)+1,sl_next);} \
    CMASK(C0,C1,t); \
    { float a=MX3(C0[0],C0[1],C1[0]),b=MX3(C0[2],C0[3],C1[1]); a=MX3(a,C1[2],C1[3]); \
      _Pragma("unroll") for(int r=4;r<16;r+=4){a=MX3(a,C0[r],C0[r+1]);b=MX3(b,C0[r+2],C0[r+3]);a=MX3(a,C1[r],C1[r+1]);b=MX3(b,C1[r+2],C1[r+3]);} \
      float rm=__builtin_fmaxf(a,b); { auto rr=__builtin_amdgcn_permlane32_swap(__float_as_uint(rm),__float_as_uint(rm),false,false); rm=__builtin_fmaxf(__uint_as_float(rr[0]),__uint_as_float(rr[1])); } \
      resc=false; \
      if(__builtin_expect(__any(rm>(float)THRL),0)){ const float dl=__builtin_fmaxf(rm,0.f); mhat+=dl; \
        _Pragma("unroll") for(int r=0;r<16;++r){C0[r]-=dl;C1[r]-=dl;} \
        _Pragma("unroll") for(int r=0;r<16;++r)negm[r]=-mhat; asm volatile("":"+v"(negm)); \
        const float f=__builtin_amdgcn_exp2f(-dl); l_reg*=f; if(hi==0)wsf[r32]=f; resc=true; } } \
    SBAR(); \
    GAPB(o[0]=__builtin_amdgcn_mfma_f32_32x32x16_bf16(PAF(0),VFR(0),o[0],0,0,0), C0,0); \
    GAPB(o[1]=__builtin_amdgcn_mfma_f32_32x32x16_bf16(PAF(0),VFR(4),o[1],0,0,0), C0,4); \
    KRD(GL,0); GAPB(o[0]=__builtin_amdgcn_mfma_f32_32x32x16_bf16(PAF(1),VFR(1),o[0],0,0,0), C0,8); \
    KRD(GL,1); GAPB(o[1]=__builtin_amdgcn_mfma_f32_32x32x16_bf16(PAF(1),VFR(5),o[1],0,0,0), C0,12); \
    KRD(GL,2); GAPB(o[0]=__builtin_amdgcn_mfma_f32_32x32x16_bf16(PAF(2),VFR(2),o[0],0,0,0), C1,0); \
    KRD(GL,3); GAPB(o[1]=__builtin_amdgcn_mfma_f32_32x32x16_bf16(PAF(2),VFR(6),o[1],0,0,0), C1,4); \
    GAPB(o[0]=__builtin_amdgcn_mfma_f32_32x32x16_bf16(PAF(3),VFR(3),o[0],0,0,0), C1,8); \
    GAPB(o[1]=__builtin_amdgcn_mfma_f32_32x32x16_bf16(PAF(3),VFR(7),o[1],0,0,0), C1,12); \
    }while(0)
  int t=1;
  #undef CMASK
  #define CMASK(P0,P1,t) do{}while(0)
  for(;t+5<NT;t+=2){
    STEP(pB0,pB1,pA0,pA1,t,true,true,true);     WAIT_BAR(2); RESC(); ROT();
    STEP(pA0,pA1,pB0,pB1,t+1,true,true,true);   WAIT_BAR(2); RESC(); ROT();
  }
  #undef CMASK
  #define CMASK(P0,P1,t) do{int jb_=(t)-(NT-4); if(jb_>=0)cmask(P0,P1,jb_,qrel,hi);}while(0)
  #define ENDW(tt) do{ if((tt)+3<NT){WAIT_BAR(2);} else if((tt)+2<NT){WAIT_BAR(1);} else {WAIT_BAR(0);} }while(0)
  for(;t+1<NT;t+=2){
    STEP(pB0,pB1,pA0,pA1,t,(t+3<NT),(t+1<NT),(t+1<NT));       ENDW(t);   RESC(); ROT();
    STEP(pA0,pA1,pB0,pB1,t+1,(t+4<NT),(t+2<NT),(t+2<NT));     ENDW(t+1); RESC(); ROT();
  }
  STEP(pB0,pB1,pA0,pA1,NT-1,false,false,false); RESC();
  { float sacc=pB0[0]+pB0[1]; _Pragma("unroll") for(int r=2;r<16;++r)sacc+=pB0[r]; _Pragma("unroll") for(int r=0;r<16;++r)sacc+=pB1[r]; l_reg+=sacc;
    pw0=(u32x4){PKW(pB0,0),PKW(pB0,2),PKW(pB0,4),PKW(pB0,6)};pw1=(u32x4){PKW(pB0,8),PKW(pB0,10),PKW(pB0,12),PKW(pB0,14)};pw2=(u32x4){PKW(pB1,0),PKW(pB1,2),PKW(pB1,4),PKW(pB1,6)};pw3=(u32x4){PKW(pB1,8),PKW(pB1,10),PKW(pB1,12),PKW(pB1,14)};
    SBAR(); pv(o,vb0+sl_cur,PAF(0),PAF(1),PAF(2),PAF(3)); }
  #undef PKW
  #undef PAF
  #undef VFR
  #undef PIN
  #undef MX3
  #undef GAPA
  #undef GAPB
  #undef EX
  #undef VRD
  #undef KRD
  #undef STEP
  #undef ENDW
  {auto rr=__builtin_amdgcn_permlane32_swap(__float_as_uint(l_reg),__float_as_uint(l_reg),false,false);l_reg=__uint_as_float(rr[0])+__uint_as_float(rr[1]);}
  if(hi==0)wsf[32+r32]=l_reg;asm volatile("s_waitcnt lgkmcnt(0)":::"memory");
  float rli[16];
  #pragma unroll
  for(int r=0;r<16;++r)rli[r]=__builtin_amdgcn_rcpf(wsf[32+crow(r,hi)]);
  bf16*Ow=O+(rowbase+q0+wid*QBLK)*OP+map*128+vh*64;
  { bf16*stg=(bf16*)(shm+LDS_OST)+wid*2048;
    #pragma unroll
    for(int r=0;r<16;++r){const int orow=crow(r,hi);
      #pragma unroll
      for(int d0=0;d0<2;++d0)stg[orow*64+d0*32+r32]=__float2bfloat16(o[d0][r]*rli[r]);}
    asm volatile("s_waitcnt lgkmcnt(0)":::"memory");
    #pragma unroll
    for(int i=0;i<4;++i){const int row=i*8+(lane>>3),ch=lane&7; const u32x4 v=*(const u32x4*)(stg+row*64+ch*8); ATTN_STORE16(Ow+(long)row*OP+ch*8,v);} }
  asm volatile("s_waitcnt lgkmcnt(0)\n\ts_barrier":::"memory");
  #undef DMA_K
  #undef DMA_V
  #undef CMASK
  #undef START
  #undef RESC
  #undef ROT
}
constexpr int ATTN_LDS_BYTES=LDS_BYTES;
struct AttnTensors { const bf16* Q; const bf16* K; const bf16* V; bf16* O; };
template<int THRL=8> __device__ __forceinline__ void attn_phase(char*lds,const AttnTensors&T,int vcu,const int wave){
  const int combo=vcu>>2, s=vcu&3, xcd=combo>>3, within=combo&7;
  const int b=xcd>>2, head=2*(xcd&3)+(within>>2), map=2*head+((within>>1)&1), vh=within&1;
  for(int i=0;i<16;++i){ const int p=s+4*(i>>1); const int qb=(i&1)?(63-p):p; attn_unit<THRL>(b,map,vh,qb,T.Q,T.K,T.V,T.O,lds,wave); }
}
#undef SBAR
#undef WAIT_BAR
}
constexpr int NWAVES = 8;
constexpr int D = 1024, MP = 32768, MS = 512, M = MP + MS, SEQ = 16384, DEPTH = 4, DFF = 2816, NUP = 2 * DFF, NIN = 8192, KBR = 2048, PLE = 256;
constexpr int DSEQ = 32, PAST = 1024, DB = 16;
constexpr float RMS_EPS = 1e-6f;
constexpr int PH_PER_LAYER = 14, NPH = 1 + DEPTH * PH_PER_LAYER;
#ifndef MK_PER_PHASE
#define MK_PER_PHASE 0
#endif

constexpr size_t MiB = 1u << 20;
constexpr size_t WS_CTL = 0, CTL_ZERO_BYTES = 1 * MiB;
constexpr size_t WS_ROPEC = 2 * MiB, WS_ROPES = 4 * MiB;
constexpr size_t WS_W = 8 * MiB, W_LAYER = 64 * MiB;
constexpr size_t W_UP1 = 0, W_UP2 = 11 * MiB, W_DN1 = 22 * MiB, W_DN2 = 22 * MiB + 5632 * 1024, W_IN = 33 * MiB, W_BR = 49 * MiB, W_OUT = 53 * MiB, W_PG = 55 * MiB, W_PU = 57 * MiB;
constexpr size_t WS_PB = 272 * MiB, PB_LAYER = 17 * MiB;
constexpr size_t WS_XN = 344 * MiB, WS_HFF = 416 * MiB, WS_Q = 600 * MiB, WS_K = 672 * MiB, WS_V = 744 * MiB, WS_BG = 816 * MiB, WS_C = 852 * MiB, WS_ZP = 888 * MiB;
constexpr size_t WS_GS = 924 * MiB, WS_O = 1120 * MiB, WS_A2 = 1256 * MiB, WS_MG = 1392 * MiB, WS_Y = 1464 * MiB, WS_PU = 1600 * MiB, WS_END = 1672 * MiB;
static_assert(WS_XN + (size_t)M * D * 2 <= WS_HFF && WS_HFF + (size_t)M * DFF * 2 <= WS_Q && WS_GS + (size_t)M * 3072 * 2 <= WS_O && WS_O + (size_t)M * 2048 * 2 <= WS_A2 && WS_Y + (size_t)M * D * 4 <= WS_PU && WS_PU + (size_t)M * D * 2 <= WS_END, "d_ws map");
static_assert(W_PU + (size_t)D * PLE * 2 <= W_LAYER && (size_t)M * PLE * 2 <= PB_LAYER && WS_W + DEPTH * W_LAYER <= WS_PB && WS_PB + DEPTH * PB_LAYER <= WS_XN, "d_ws map 2");
constexpr int CW_TMO = 0, CW_CODE = 1, CW_BAR = 4096;
constexpr size_t O_Y = 0, O_KP = (size_t)M * D, O_VP = O_KP + (size_t)DEPTH * MP * D, O_CP = O_VP + (size_t)DEPTH * MP * D, O_PP = O_CP + (size_t)DEPTH * 2 * 2 * 512, O_KS = O_PP + (size_t)DEPTH * 2 * 15 * 512,
                 O_VS = O_KS + (size_t)DEPTH * MS * D, O_CS = O_VS + (size_t)DEPTH * MS * D, O_PS = O_CS + (size_t)DEPTH * DB * 2 * 512, O_END = O_PS + (size_t)DEPTH * DB * 15 * 512;

constexpr int RING_OFF = 0, RING_BYTES = 131072;
constexpr int LDSCTL_OFF = RING_BYTES, MISC_OFF = LDSCTL_OFF + 320;
constexpr int LDS_BYTES = 147456;
static_assert(MISC_OFF + 128 <= LDS_BYTES, "LDS map");
#define GAS __attribute__((address_space(1)))
#define LAS __attribute__((address_space(3)))
typedef unsigned short bf16;
typedef unsigned v4u __attribute__((ext_vector_type(4)));
typedef float f32x4 __attribute__((ext_vector_type(4)));
typedef short bf16x8 __attribute__((ext_vector_type(8)));
typedef GAS unsigned gu32;
typedef GAS unsigned long long gu64;
#define RLX_AGENT __ATOMIC_RELAXED, __HIP_MEMORY_SCOPE_AGENT
#define LDS_WAIT() asm volatile("s_waitcnt lgkmcnt(0)" ::: "memory")
#define VM_WAIT() asm volatile("s_waitcnt vmcnt(0)" ::: "memory")
__device__ __forceinline__ unsigned long long rt() { return __builtin_amdgcn_s_memrealtime(); }
__device__ __forceinline__ unsigned f2bf(float f) { unsigned u = __builtin_bit_cast(unsigned, f); return (u + 0x7fffu + ((u >> 16) & 1u)) >> 16; }
__device__ __forceinline__ unsigned pk2(float lo, float hi) { return f2bf(lo) | (f2bf(hi) << 16); }

#define XB_TMO      128
#define XB_XCNT(j)  (256  + 64 * (j))
#define XB_XSUB(j)  (1280 + 64 * (j))
#define XB_XGEN(j)  (2304 + 64 * (j))
#define XB_TOP      3328
#define XB_TOPGEN   3392
#define XCD_BAR_WORDS 3456
#define XB_SPIN_CAP (1u << 18)

__device__ __forceinline__ unsigned xb_ld(unsigned* p)              { return __hip_atomic_load(p, __ATOMIC_RELAXED, __HIP_MEMORY_SCOPE_AGENT); }
__device__ __forceinline__ unsigned xb_add(unsigned* p, unsigned v) { return __hip_atomic_fetch_add(p, v, __ATOMIC_RELAXED, __HIP_MEMORY_SCOPE_AGENT); }
__device__ __forceinline__ unsigned xb_xcc_id() { return (unsigned)__builtin_amdgcn_s_getreg((3 << 11) | 20) & 0xFu; }
#define XB_SPIN(cond, bar) do { unsigned _sp = 0; while (cond) { __builtin_amdgcn_s_sleep(1); \
    if ((++_sp & 255u) == 0u) { if (xb_ld(&(bar)[XB_TMO])) break; if (_sp > XB_SPIN_CAP) { atomicAdd(&(bar)[XB_TMO], 1u); break; } } } } while (0)

__device__ __forceinline__ int lane_now() { int l; asm volatile("v_mbcnt_lo_u32_b32 %0, -1, 0\n\tv_mbcnt_hi_u32_b32 %0, -1, %0" : "=v"(l)); return l; }
struct XcdBarrier {
    int wave;
    unsigned* bar; unsigned x;
    volatile LAS unsigned* st;
};

__device__ __forceinline__ XcdBarrier xcd_barrier_post(unsigned* bar, volatile LAS unsigned* st) {
    XcdBarrier b; b.wave = (int)__builtin_amdgcn_readfirstlane(threadIdx.x >> 6); b.bar = bar; b.x = xb_xcc_id(); b.st = st;
    if (threadIdx.x == 0) (void)xb_add(&bar[XB_XCNT(b.x)], 1u);
    return b;
}
__device__ __forceinline__ void xcd_barrier_complete(unsigned* bar, unsigned x, unsigned& nloc, unsigned& nx) {
    const unsigned G = gridDim.x * gridDim.y * gridDim.z;
    unsigned sum, cnt, mine, sp = 0u;
    for (;;) {
        sum = 0u; cnt = 0u; mine = 0u;
#pragma unroll
        for (unsigned j = 0; j < 16; ++j) { const unsigned c = xb_ld(&bar[XB_XCNT(j)]); sum += c; cnt += (c > 0u) ? 1u : 0u; mine = (j == x) ? c : mine; }
        if (sum == G) break;
        __builtin_amdgcn_s_sleep(1);
        if ((++sp & 255u) == 0u) { if (xb_ld(&bar[XB_TMO])) break; if (sp > XB_SPIN_CAP) { atomicAdd(&bar[XB_TMO], 1u); break; } }
    }
    nloc = mine > 0u ? mine : 1u; nx = cnt > 0u ? cnt : 1u;
}

__device__ __forceinline__ void xcd_barrier(const XcdBarrier& b) {
    asm volatile("s_waitcnt vmcnt(0)" ::: "memory");
    __syncthreads();
    if (b.wave == 0 && lane_now() == 0) {
        unsigned* bar = b.bar;
        __builtin_amdgcn_s_waitcnt(0);
        unsigned nloc = b.st[0], nx = b.st[1];
        if (nloc == 0u) { xcd_barrier_complete(bar, b.x, nloc, nx); b.st[0] = nloc; b.st[1] = nx; }
        const unsigned old = xb_add(&bar[XB_XSUB(b.x)], 1u);
        const unsigned gen = old / nloc;
        if (old + 1u == (gen + 1u) * nloc) {
            __builtin_amdgcn_fence(__ATOMIC_RELEASE, "agent");
            asm volatile("s_waitcnt vmcnt(0)" ::: "memory");
            const unsigned og = xb_add(&bar[XB_TOP], 1u);
            const unsigned tg = og / nx;
            if (og + 1u == (tg + 1u) * nx) xb_add(&bar[XB_TOPGEN], 1u);
            else XB_SPIN(xb_ld(&bar[XB_TOPGEN]) == tg, bar);
            __builtin_amdgcn_fence(__ATOMIC_ACQUIRE, "agent");
            xb_add(&bar[XB_XGEN(b.x)], 1u);
            asm volatile("s_waitcnt vmcnt(0)" ::: "memory");
        } else {
            XB_SPIN(xb_ld(&bar[XB_XGEN(b.x)]) == gen, bar);
            __builtin_amdgcn_fence(__ATOMIC_ACQUIRE, "agent");
            asm volatile("s_waitcnt vmcnt(0)" ::: "memory");
        }
    }
    __syncthreads();
}
struct Frame {
    LAS unsigned char* lds;
    volatile LAS unsigned* MISC;
    gu32* ctl;
    int wave;
    int vcu, G;
    const float* in[21]; float* out; unsigned char* ws;
};
__device__ __forceinline__ float wave_sum(float v) {
#pragma unroll
    for (int o = 1; o < 64; o <<= 1) v += __shfl_xor(v, o);
    return v;
}
__device__ __forceinline__ bf16* wsb(Frame& F, size_t off) { return (bf16*)(F.ws + off); }
__device__ __forceinline__ bf16* wlayer(Frame& F, int li, size_t off) { return (bf16*)(F.ws + WS_W + (size_t)li * W_LAYER + off); }

__device__ __forceinline__ int map_row(int kind, int n0) {
    if (kind == 1) { const int bj = n0 / DFF, rem = n0 - bj * DFF; return (rem >> 7) * 256 + bj * 128 + (rem & 127); }
    if (kind == 2) {
        if (n0 < 2048) return (n0 & ~255) + ((n0 >> 5) & 1) * 128 + ((n0 >> 6) & 3) * 32;
        if (n0 >= 3584 && n0 < 4608) { const int x = n0 >= 4096, j = n0 - (x ? 4096 : 3584); return 3584 + (j >> 7) * 256 + x * 128 + (j & 127); }
        return n0; }
    return n0;
}
__device__ __forceinline__ void p0_transpose_item(const float* W, int N, bf16* WT, int ldk, int kind, LAS float* scr, int item, int lane) {
    const int nblk = N / 32, kb = item / nblk, nb = item % nblk, k0 = 64 * kb, n0 = 32 * nb;
#pragma unroll 8
    for (int i = 0; i < 32; ++i) { const int kk = 2 * i + (lane >> 5); scr[kk * 33 + (lane & 31)] = W[(size_t)(k0 + kk) * N + n0 + (lane & 31)]; }
    LDS_WAIT(); asm volatile("" ::: "memory");
    const int c = lane & 7; const int r0 = map_row(kind, n0);
#pragma unroll
    for (int j = 0; j < 4; ++j) { const int n = (lane >> 3) + 8 * j; const LAS float* s = scr + (8 * c) * 33 + n;
        v4u o; o.x = pk2(s[0 * 33], s[1 * 33]); o.y = pk2(s[2 * 33], s[3 * 33]); o.z = pk2(s[4 * 33], s[5 * 33]); o.w = pk2(s[6 * 33], s[7 * 33]);
        *(GAS v4u*)(WT + (size_t)(r0 + n) * ldk + k0 + 8 * c) = o; }
    LDS_WAIT(); asm volatile("" ::: "memory");
}
__device__ __forceinline__ void p0_weff_item(const float* pool_w, const float* pool_scale, const float* wbr, bf16* WT, int item, int lane) {
    const int kb = item >> 4, nb = item & 15, k0 = kb * 8, g = k0 >> 7, c0 = k0 & 127, n = nb * 64 + lane;
    float acc[8];
#pragma unroll
    for (int i = 0; i < 8; ++i) acc[i] = 0.f;
    const float* pw = pool_w + ((size_t)g * 128 + c0) * 128; const float* ps = pool_scale + g * 128; const float* wb = wbr + (size_t)(1536 + g * 128) * D + n;
    for (int dd = 0; dd < 128; ++dd) { const float w = wb[(size_t)dd * D] * ps[dd];
#pragma unroll
        for (int i = 0; i < 8; ++i) acc[i] += pw[i * 128 + dd] * w; }
    v4u o; o.x = pk2(acc[0], acc[1]); o.y = pk2(acc[2], acc[3]); o.z = pk2(acc[4], acc[5]); o.w = pk2(acc[6], acc[7]);
    *(GAS v4u*)(WT + (size_t)n * KBR + 1536 + k0) = o;
}
__device__ __forceinline__ void norm_row(int lane, const float* yrow, const float* hin, float coef, const float* ga, float* hout, const float* gb, bf16* xnrow) {
    const GAS f32x4* hr = (const GAS f32x4*)hin + lane;
    f32x4 h[4];
#pragma unroll
    for (int j = 0; j < 4; ++j) h[j] = hr[64 * j];
    if (yrow) {
        const GAS f32x4* yr = (const GAS f32x4*)yrow + lane; f32x4 y[4]; float s = 0.f;
#pragma unroll
        for (int j = 0; j < 4; ++j) { y[j] = yr[64 * j]; s += (y[j].x * y[j].x + y[j].y * y[j].y) + (y[j].z * y[j].z + y[j].w * y[j].w); }
        const float r = coef * __builtin_amdgcn_rsqf(wave_sum(s) * (1.f / D) + RMS_EPS);
#pragma unroll
        for (int j = 0; j < 4; ++j) { const f32x4 g = ((const GAS f32x4*)ga + lane)[64 * j]; h[j] = h[j] + y[j] * r * g; }
    }
    GAS f32x4* ho = (GAS f32x4*)hout + lane;
#pragma unroll
    for (int j = 0; j < 4; ++j) ho[64 * j] = h[j];
    if (xnrow) {
        float s2 = 0.f;
#pragma unroll
        for (int j = 0; j < 4; ++j) s2 += (h[j].x * h[j].x + h[j].y * h[j].y) + (h[j].z * h[j].z + h[j].w * h[j].w);
        const float r2 = __builtin_amdgcn_rsqf(wave_sum(s2) * (1.f / D) + RMS_EPS);
        GAS unsigned long long* o8 = (GAS unsigned long long*)xnrow + lane;
#pragma unroll
        for (int j = 0; j < 4; ++j) { const f32x4 g = ((const GAS f32x4*)gb + lane)[64 * j]; const f32x4 v = h[j] * r2 * g;
            o8[64 * j] = (unsigned long long)pk2(v.x, v.y) | ((unsigned long long)pk2(v.z, v.w) << 32); }
    }
}
__device__ __forceinline__ void rope_entry(int pos, int d, float& c, float& s) {
    double inv = 1.0; for (int i = 0; i < d; ++i) inv *= 0.7498942093324559;
    const float ang = (float)pos * (float)inv; const double a = (double)ang;
    const double q = __builtin_rint(a * 0.6366197723675814);
    double y = __builtin_fma(-q, 1.5707963267948966, a); y = __builtin_fma(-q, 6.123233995736766e-17, y);
    const double y2 = y * y;
    const double sp = y * (1.0 + y2 * (-1.0 / 6.0 + y2 * (1.0 / 120.0 + y2 * (-1.0 / 5040.0 + y2 * (1.0 / 362880.0 + y2 * (-1.0 / 39916800.0 + y2 * (1.0 / 6227020800.0)))))));
    const double cp = 1.0 + y2 * (-0.5 + y2 * (1.0 / 24.0 + y2 * (-1.0 / 720.0 + y2 * (1.0 / 40320.0 + y2 * (-1.0 / 3628800.0 + y2 * (1.0 / 479001600.0 + y2 * (-1.0 / 87178291200.0)))))));
    const int qi = ((int)q) & 3;
    const double sv = (qi == 0) ? sp : (qi == 1) ? cp : (qi == 2) ? -sp : -cp;
    const double cv = (qi == 0) ? cp : (qi == 1) ? -sp : (qi == 2) ? -cp : sp;
    c = (float)cv; s = (float)sv;
}
__device__ __forceinline__ void norm_phase(Frame& F, float coef, const float* ga, const float* gb, bool write_xn) {
    const int gw = F.vcu * NWAVES + F.wave, NGW = F.G * NWAVES;
    const float* Y = (const float*)(F.ws + WS_Y); bf16* XN = wsb(F, WS_XN);
    const int lane = lane_now();
    for (int m = gw; m < M; m += NGW) norm_row(lane, Y + (size_t)m * D, F.out + (size_t)m * D, coef, ga, F.out + (size_t)m * D, gb, write_xn ? XN + (size_t)m * D : nullptr);
}
__device__ __forceinline__ void p0_prologue(Frame& F) {
    LAS float* scr = (LAS float*)(F.lds + RING_OFF + F.wave * 16384);
    const int gw = F.vcu * NWAVES + F.wave, NGW = F.G * NWAVES; const int lane = lane_now();
    for (int li = 0; li < DEPTH; ++li) {
        for (int f = 0; f < 2; ++f) {
            const float* wu = F.in[9] + (size_t)(li * 2 + f) * D * NUP; bf16* du = wlayer(F, li, f ? W_UP2 : W_UP1);
            for (int it = gw; it < (D / 64) * (NUP / 32); it += NGW) p0_transpose_item(wu, NUP, du, D, 1, scr, it, lane);
            const float* wd = F.in[10] + (size_t)(li * 2 + f) * DFF * D; bf16* dd = wlayer(F, li, f ? W_DN2 : W_DN1);
            for (int it = gw; it < (DFF / 64) * (D / 32); it += NGW) p0_transpose_item(wd, D, dd, DFF, 0, scr, it, lane);
        }
        for (int it = gw; it < (D / 64) * (NIN / 32); it += NGW) p0_transpose_item(F.in[11] + (size_t)li * D * NIN, NIN, wlayer(F, li, W_IN), D, 2, scr, it, lane);
        for (int it = gw; it < (1536 / 64) * (D / 32); it += NGW) p0_transpose_item(F.in[17] + (size_t)li * KBR * D, D, wlayer(F, li, W_BR), KBR, 0, scr, it, lane);
        for (int it = gw; it < (D / 64) * (D / 32); it += NGW) p0_transpose_item(F.in[18] + (size_t)li * D * D, D, wlayer(F, li, W_OUT), D, 0, scr, it, lane);
        for (int it = gw; it < (D / 64) * (D / 32); it += NGW) p0_transpose_item(F.in[20] + (size_t)li * D * D, D, wlayer(F, li, W_PG), D, 0, scr, it, lane);
        for (int it = gw; it < (PLE / 64) * (D / 32); it += NGW) p0_transpose_item(F.in[19] + (size_t)li * PLE * D, D, wlayer(F, li, W_PU), PLE, 0, scr, it, lane);
        for (int it = gw; it < 64 * 16; it += NGW) p0_weff_item(F.in[15] + (size_t)li * 4 * 128 * 128, F.in[16] + (size_t)li * 512, F.in[17] + (size_t)li * KBR * D, wlayer(F, li, W_BR), it, lane);
        bf16* pb = (bf16*)(F.ws + WS_PB + (size_t)li * PB_LAYER);
        for (int m = gw; m < M; m += NGW) { const float* src = m < MP ? F.in[6] + ((size_t)li * MP + m) * PLE : F.in[7] + ((size_t)li * MS + (m - MP)) * PLE;
            const f32x4 v = ((const GAS f32x4*)src)[lane]; ((GAS unsigned long long*)(pb + (size_t)m * PLE))[lane] = (unsigned long long)pk2(v.x, v.y) | ((unsigned long long)pk2(v.z, v.w) << 32); }
    }
    { float* rc = (float*)(F.ws + WS_ROPEC); float* rs = (float*)(F.ws + WS_ROPES);
      for (int i = gw * 64 + lane; i < SEQ * 32; i += NGW * 64) { float c, s; rope_entry(i >> 5, i & 31, c, s); rc[i] = c; rs[i] = s; } }
    bf16* XN = wsb(F, WS_XN);
    for (int m = gw; m < M; m += NGW) { const float* xr = m < MP ? F.in[0] + (size_t)m * D : F.in[1] + (size_t)(m - MP) * D;
        norm_row(lane, nullptr, xr, 0.f, nullptr, F.out + (size_t)m * D, F.in[8], XN + (size_t)m * D); }
}
__device__ __forceinline__ void unpack8f(const v4u w, float (&f)[8]) {
    f[0] = __uint_as_float(w.x << 16); f[1] = __uint_as_float(w.x & 0xffff0000u); f[2] = __uint_as_float(w.y << 16); f[3] = __uint_as_float(w.y & 0xffff0000u);
    f[4] = __uint_as_float(w.z << 16); f[5] = __uint_as_float(w.z & 0xffff0000u); f[6] = __uint_as_float(w.w << 16); f[7] = __uint_as_float(w.w & 0xffff0000u); }
__device__ __forceinline__ v4u pack8f(const float (&f)[8]) { v4u o; o.x = pk2(f[0], f[1]); o.y = pk2(f[2], f[3]); o.z = pk2(f[4], f[5]); o.w = pk2(f[6], f[7]); return o; }
__device__ __forceinline__ void e2_phase(Frame& F, int li) {
    const int gw = F.vcu * NWAVES + F.wave, NGW = F.G * NWAVES, lane = lane_now();
    const float* lam = F.in[12] + li * 256;
    const float s1 = wave_sum(lam[lane] * lam[64 + lane]), s2 = wave_sum(lam[128 + lane] * lam[192 + lane]);
    const float lam_init = 0.8f - 0.6f * __expf(-0.3f * (float)li);
    const float lam_full = __expf(s1) - __expf(s2) + lam_init, osc = 1.0f - lam_init;
    const bf16* O = wsb(F, WS_O); const bf16* BG = wsb(F, WS_BG); const bf16* C = wsb(F, WS_C); const bf16* ZP = wsb(F, WS_ZP); bf16* A2 = wsb(F, WS_A2);
    const int hh = lane >> 3, e0 = (lane & 7) * 16, c0 = lane * 8, grp = lane >> 4, win = 2 << grp;
    float sg[16];
#pragma unroll
    for (int i = 0; i < 16; ++i) sg[i] = F.in[13][li * 1024 + hh * 128 + e0 + i];
    float cw[3][8];
#pragma unroll
    for (int j = 0; j < 3; ++j)
#pragma unroll
        for (int i = 0; i < 8; ++i) cw[j][i] = F.in[14][(li * 3 + j) * 512 + c0 + i];
    for (int m = gw; m < M; m += NGW) {
        const bool samp = m >= MP; const int t = samp ? ((m - MP) & 31) : (m & (SEQ - 1)); const int b = samp ? ((m - MP) >> 5) : (m >> 14); const int T = samp ? DSEQ : SEQ;
        { const bf16* orow = O + (size_t)m * 2048 + hh * 256 + e0;
          float o1[16], o2[16]; { float t8[8]; unpack8f(*(const GAS v4u*)orow, t8); for (int i = 0; i < 8; ++i) o1[i] = t8[i]; unpack8f(*(const GAS v4u*)(orow + 8), t8); for (int i = 0; i < 8; ++i) o1[8 + i] = t8[i];
              unpack8f(*(const GAS v4u*)(orow + 128), t8); for (int i = 0; i < 8; ++i) o2[i] = t8[i]; unpack8f(*(const GAS v4u*)(orow + 136), t8); for (int i = 0; i < 8; ++i) o2[8 + i] = t8[i]; }
          float ss = 0.f;
#pragma unroll
          for (int i = 0; i < 16; ++i) { o1[i] = o1[i] - lam_full * o2[i]; ss += o1[i] * o1[i]; }
          ss += __shfl_xor(ss, 1); ss += __shfl_xor(ss, 2); ss += __shfl_xor(ss, 4);
          const float r = __builtin_amdgcn_rsqf(ss * (1.f / 128.f) + RMS_EPS) * osc;
          float a0[8], a1[8];
#pragma unroll
          for (int i = 0; i < 8; ++i) { a0[i] = o1[i] * r * sg[i]; a1[i] = o1[8 + i] * r * sg[8 + i]; }
          bf16* arow = A2 + (size_t)m * KBR + hh * 128 + e0; *(GAS v4u*)arow = pack8f(a0); *(GAS v4u*)(arow + 8) = pack8f(a1); }
        { float z0[8], z1[8], z2[8], bgv[8];
          unpack8f(*(const GAS v4u*)(C + (size_t)m * 512 + c0), z0); unpack8f(*(const GAS v4u*)(BG + (size_t)m * 512 + c0), bgv);
          const float* hist = F.in[4] + ((size_t)(li * DB + b) * 2) * 512 + c0;
          if (t >= 1) unpack8f(*(const GAS v4u*)(C + (size_t)(m - 1) * 512 + c0), z1);
          else { for (int i = 0; i < 8; ++i) z1[i] = samp ? hist[512 + i] : 0.f; }
          if (t >= 2) unpack8f(*(const GAS v4u*)(C + (size_t)(m - 2) * 512 + c0), z2);
          else { for (int i = 0; i < 8; ++i) z2[i] = samp ? hist[t * 512 + i] : 0.f; }
          float y[8];
#pragma unroll
          for (int i = 0; i < 8; ++i) y[i] = bgv[i] * (cw[0][i] * z2[i] + cw[1][i] * z1[i] + cw[2][i] * z0[i]);
          *(GAS v4u*)(A2 + (size_t)m * KBR + 1024 + c0) = pack8f(y);
          if (t >= T - 2) { float* dst = samp ? F.out + O_CS + ((size_t)(li * DB + b) * 2 + (t - (T - 2))) * 512 + c0 : F.out + O_CP + ((size_t)(li * 2 + b) * 2 + (t - (T - 2))) * 512 + c0;
              *(GAS f32x4*)dst = (f32x4){z0[0], z0[1], z0[2], z0[3]}; *(GAS f32x4*)(dst + 4) = (f32x4){z0[4], z0[5], z0[6], z0[7]}; } }
        { float zc[8], ws8[8]; unpack8f(*(const GAS v4u*)(ZP + (size_t)m * 512 + c0), zc);
#pragma unroll
          for (int i = 0; i < 8; ++i) ws8[i] = zc[i];
          const float* phist = F.in[5] + ((size_t)(li * DB + b) * 15) * 512 + c0;
          for (int j = 1; j < 16; ++j) { if (j < win) { const int i = t - j;
                  if (i >= 0) { float zz[8]; unpack8f(*(const GAS v4u*)(ZP + (size_t)(m - j) * 512 + c0), zz);
#pragma unroll
                      for (int q = 0; q < 8; ++q) ws8[q] += zz[q]; }
                  else if (samp) { const float* hp = phist + (size_t)(15 + i) * 512;
#pragma unroll
                      for (int q = 0; q < 8; ++q) ws8[q] += hp[q]; } } }
          const int cnt = min(t + 1 + (samp ? 15 : 0), win); const float rc = 1.0f / (float)cnt;
          float dv[8];
#pragma unroll
          for (int i = 0; i < 8; ++i) dv[i] = ws8[i] * rc - zc[i];
          *(GAS v4u*)(A2 + (size_t)m * KBR + 1536 + c0) = pack8f(dv);
          if (t >= T - 15) { float* dst = samp ? F.out + O_PS + ((size_t)(li * DB + b) * 15 + (t - (T - 15))) * 512 + c0 : F.out + O_PP + ((size_t)(li * 2 + b) * 15 + (t - (T - 15))) * 512 + c0;
              *(GAS f32x4*)dst = (f32x4){zc[0], zc[1], zc[2], zc[3]}; *(GAS f32x4*)(dst + 4) = (f32x4){zc[4], zc[5], zc[6], zc[7]}; } }
    }
}
typedef float f32x16 __attribute__((ext_vector_type(16)));
__device__ __forceinline__ bf16x8 cvt8(const f32x4 a, const f32x4 b) { v4u w; w.x = pk2(a.x, a.y); w.y = pk2(a.z, a.w); w.z = pk2(b.x, b.y); w.w = pk2(b.z, b.w); return __builtin_bit_cast(bf16x8, w); }
__device__ __forceinline__ int crow16(int r, int hi) { return (r & 3) + 8 * (r >> 2) + 4 * hi; }
__device__ __forceinline__ void sattn_unit(Frame& F, int li, int b, int head) {
    const int lane = lane_now(), wid = F.wave, r32 = lane & 31, hi = lane >> 5;
    LAS float* Lmx = (LAS float*)(F.lds + RING_OFF);
    LAS float* Lsum = (LAS float*)(F.lds + RING_OFF + 2048);
    LAS float* Lo = (LAS float*)(F.lds + RING_OFF + 4096);
    const bf16* Qs = wsb(F, WS_Q) + (size_t)(MP + b * DSEQ) * D;
    const float* kc = F.in[2] + ((size_t)(li * DB + b) * PAST) * D; const float* vc = F.in[3] + ((size_t)(li * DB + b) * PAST) * D;
    const float* kn = F.out + O_KS + ((size_t)li * MS + b * DSEQ) * D; const float* vn = F.out + O_VS + ((size_t)li * MS + b * DSEQ) * D;
    bf16x8 qr[2][4];
#pragma unroll
    for (int mm = 0; mm < 2; ++mm)
#pragma unroll
        for (int d0 = 0; d0 < 4; ++d0) qr[mm][d0] = *(const GAS bf16x8*)(Qs + (size_t)r32 * D + (2 * head + mm) * 64 + d0 * 16 + hi * 8);
    const int nblk = (wid == 0) ? 5 : 4;
    float mx[2] = {-INFINITY, -INFINITY};
    for (int i = 0; i < nblk; ++i) { const int blk = (i < 4) ? wid + 8 * i : 32; const float* kb = (blk < 32) ? kc + (size_t)(blk * 32) * D : kn;
#pragma unroll
        for (int mm = 0; mm < 2; ++mm) { f32x16 s = {};
#pragma unroll
            for (int d0 = 0; d0 < 4; ++d0) { const float* kp = kb + (size_t)r32 * D + (2 * head + mm) * 64 + d0 * 16 + hi * 8; const bf16x8 kf = cvt8(*(const GAS f32x4*)kp, *(const GAS f32x4*)(kp + 4));
                s = __builtin_amdgcn_mfma_f32_32x32x16_bf16(kf, qr[mm][d0], s, 0, 0, 0); }
            float mloc = s[0];
#pragma unroll
            for (int r = 1; r < 16; ++r) mloc = fmaxf(mloc, s[r]);
            mx[mm] = fmaxf(mx[mm], mloc); } }
#pragma unroll
    for (int mm = 0; mm < 2; ++mm) { mx[mm] = fmaxf(mx[mm], __shfl_xor(mx[mm], 32)); if (hi == 0) Lmx[(mm * 8 + wid) * 32 + r32] = mx[mm]; }
    __syncthreads();
    float Mx[2];
#pragma unroll
    for (int mm = 0; mm < 2; ++mm) { float v = Lmx[(mm * 8) * 32 + r32];
#pragma unroll
        for (int w = 1; w < 8; ++w) v = fmaxf(v, Lmx[(mm * 8 + w) * 32 + r32]);
        Mx[mm] = v; }
    f32x16 o[2][4];
#pragma unroll
    for (int mm = 0; mm < 2; ++mm)
#pragma unroll
        for (int eb = 0; eb < 4; ++eb) o[mm][eb] = (f32x16){};
    float lsum[2] = {0.f, 0.f};
    for (int i = 0; i < nblk; ++i) { const int blk = (i < 4) ? wid + 8 * i : 32; const float* kb = (blk < 32) ? kc + (size_t)(blk * 32) * D : kn; const float* vb = (blk < 32) ? vc + (size_t)(blk * 32) * D : vn;
        bf16x8 pf[2][2];
#pragma unroll
        for (int mm = 0; mm < 2; ++mm) { f32x16 s = {};
#pragma unroll
            for (int d0 = 0; d0 < 4; ++d0) { const float* kp = kb + (size_t)r32 * D + (2 * head + mm) * 64 + d0 * 16 + hi * 8; const bf16x8 kf = cvt8(*(const GAS f32x4*)kp, *(const GAS f32x4*)(kp + 4));
                s = __builtin_amdgcn_mfma_f32_32x32x16_bf16(kf, qr[mm][d0], s, 0, 0, 0); }
            float acc = 0.f;
#pragma unroll
            for (int r = 0; r < 16; ++r) { s[r] = __builtin_amdgcn_exp2f(s[r] - Mx[mm]); acc += s[r]; }
            lsum[mm] += acc;
#pragma unroll
            for (int k2 = 0; k2 < 2; ++k2) pf[mm][k2] = cvt8((f32x4){s[8 * k2], s[8 * k2 + 1], s[8 * k2 + 2], s[8 * k2 + 3]}, (f32x4){s[8 * k2 + 4], s[8 * k2 + 5], s[8 * k2 + 6], s[8 * k2 + 7]}); }
#pragma unroll
        for (int eb = 0; eb < 4; ++eb)
#pragma unroll
            for (int k2 = 0; k2 < 2; ++k2) { const float* vp = vb + (size_t)(16 * k2 + 4 * hi) * D + head * 128 + eb * 32 + r32;
                const f32x4 va = {vp[0], vp[D], vp[2 * D], vp[3 * D]}, vb4 = {vp[8 * D], vp[9 * D], vp[10 * D], vp[11 * D]}; const bf16x8 vf = cvt8(va, vb4);
                o[0][eb] = __builtin_amdgcn_mfma_f32_32x32x16_bf16(vf, pf[0][k2], o[0][eb], 0, 0, 0); o[1][eb] = __builtin_amdgcn_mfma_f32_32x32x16_bf16(vf, pf[1][k2], o[1][eb], 0, 0, 0); } }
#pragma unroll
    for (int mm = 0; mm < 2; ++mm) { lsum[mm] += __shfl_xor(lsum[mm], 32); if (hi == 0) Lsum[(mm * 8 + wid) * 32 + r32] = lsum[mm]; }
    for (int w = 0; w < 8; ++w) { __syncthreads();
        if (wid == w) {
#pragma unroll
            for (int mm = 0; mm < 2; ++mm)
#pragma unroll
                for (int eb = 0; eb < 4; ++eb)
#pragma unroll
                    for (int r = 0; r < 16; ++r) { const int idx = (mm * 128 + eb * 32 + crow16(r, hi)) * 32 + r32; if (w == 0) Lo[idx] = o[mm][eb][r]; else Lo[idx] += o[mm][eb][r]; } } }
    __syncthreads();
    { const int tid = wid * 64 + lane, mm = tid >> 8, q = (tid >> 3) & 31, e0 = (tid & 7) * 16; float L = 0.f;
#pragma unroll
      for (int w = 0; w < 8; ++w) L += Lsum[(mm * 8 + w) * 32 + q];
      const float inv = 1.0f / L; float v0[8], v1[8];
#pragma unroll
      for (int i = 0; i < 8; ++i) { v0[i] = Lo[(mm * 128 + e0 + i) * 32 + q] * inv; v1[i] = Lo[(mm * 128 + e0 + 8 + i) * 32 + q] * inv; }
      bf16* orow = wsb(F, WS_O) + (size_t)(MP + b * DSEQ + q) * 2048 + (2 * head + mm) * 128 + e0; *(GAS v4u*)orow = pack8f(v0); *(GAS v4u*)(orow + 8) = pack8f(v1); }
    __syncthreads();
}
#ifndef KEEP_UP
#define KEEP_UP 1
#endif
#ifndef KEEP_DOWN
#define KEEP_DOWN 1
#endif
#ifndef KEEP_N1
#define KEEP_N1 1
#endif
#ifndef KEEP_WIN
#define KEEP_WIN 1
#endif
#ifndef KEEP_ATT
#define KEEP_ATT 1
#endif
#ifndef KEEP_E2
#define KEEP_E2 1
#endif
#ifndef KEEP_BR
#define KEEP_BR 1
#endif
#ifndef KEEP_WOUT
#define KEEP_WOUT 1
#endif
#ifndef KEEP_N3
#define KEEP_N3 1
#endif
#ifndef KEEP_PG
#define KEEP_PG 1
#endif
#ifndef KEEP_N5
#define KEEP_N5 1
#endif
#ifndef KEEP_PRO
#define KEEP_PRO 1
#endif
struct Args { const float* in[21]; float* out; unsigned char* ws; int ph_lo, ph_hi; };
#if !MK_PER_PHASE
#define GRID_BAR() xcd_barrier(bar)
#else
#define GRID_BAR() do { if (F.wave == 0 && lane_now() == 0) __hip_atomic_store(F.ctl + CW_TMO, 0xBADBA0u, RLX_AGENT); } while (0)
#endif
#define IN(k) (lo <= (k) && (k) < hi)
#define SEAM(k) do { if (IN(k) && IN((k) + 1)) GRID_BAR(); } while (0)
__device__ __forceinline__ unsigned long long uni64_opaque(unsigned long long v) { unsigned lo = __builtin_amdgcn_readfirstlane((unsigned)v), hi = __builtin_amdgcn_readfirstlane((unsigned)(v >> 32)); asm volatile("" : "+s"(lo), "+s"(hi)); return ((unsigned long long)hi << 32) | lo; }
#define FRESH() do { F.ws = (unsigned char*)(GAS unsigned char*)uni64_opaque((unsigned long long)F.ws); F.out = (float*)(GAS float*)uni64_opaque((unsigned long long)F.out); } while (0)
#define RING (F.lds + RING_OFF)
template <int LI, int HALF> __device__ __forceinline__ void ffn_part(Frame& F, const XcdBarrier& bar, const int lo, const int hi) {
    constexpr int pb = 1 + LI * PH_PER_LAYER, p0 = pb + HALF * 9;
    if (KEEP_UP && IN(p0)) { FRESH(); pg8::Gemm g{wsb(F, WS_XN), wlayer(F, LI, HALF ? W_UP2 : W_UP1), M, NUP, D}; pg8::StaticOrder S; S.init(M, NUP, F.G, (int)blockIdx.x);
        pg8::EpiSwiGLU E{wsb(F, WS_HFF), DFF};
        pg8::gemm_phase<pg8::EpiSwiGLU, pg8::StaticOrder, true, true>(RING, g, S, E, F.wave); SEAM(p0); }
    if (KEEP_DOWN && IN(p0 + 1)) { FRESH(); { pg8::Gemm g{wsb(F, WS_HFF), wlayer(F, LI, HALF ? W_DN2 : W_DN1), M, D, DFF}; pg8::StaticOrder S; S.init(M, D, F.G, (int)blockIdx.x);
        pg8::EpiF32 E{(float*)(F.ws + WS_Y), D};
        pg8::gemm_phase<pg8::EpiF32, pg8::StaticOrder, true, true>(RING, g, S, E, F.wave); } }
    if (KEEP_DOWN && IN(p0 + 1)) {
        if (HALF == 1) { FRESH(); int kple = PLE; asm volatile("" : "+s"(kple));
            pg8::Gemm g2{(const bf16*)(F.ws + WS_PB + (size_t)LI * PB_LAYER), wlayer(F, LI, W_PU), M, D, kple}; pg8::StaticOrder S2; S2.init(M, D, F.G, (int)blockIdx.x);
            pg8::EpiBf E2{wsb(F, WS_PU), D};
            pg8::gemm_phase<pg8::EpiBf, pg8::StaticOrder, true, true>(RING, g2, S2, E2, F.wave); }
        SEAM(p0 + 1); }
    if (KEEP_N1 && IN(p0 + 2)) { FRESH(); const float* ng = F.in[8] + (size_t)LI * 8 * D; norm_phase(F, 0.5f, ng + (HALF ? 5 : 1) * D, ng + (HALF ? 6 : 2) * D, true); SEAM(p0 + 2); }
}
template <int LI> __device__ __forceinline__ void mixer_part(Frame& F, const XcdBarrier& bar, const int lo, const int hi) {
    constexpr int pb = 1 + LI * PH_PER_LAYER;
    if (KEEP_WIN && IN(pb + 3)) { FRESH(); pg8::Gemm g{wsb(F, WS_XN), wlayer(F, LI, W_IN), M, NIN, D}; pg8::StaticOrder S; S.init(M, NIN, F.G, (int)blockIdx.x);
        pg8::EpiWin E{wsb(F, WS_Q), wsb(F, WS_K), wsb(F, WS_V), wsb(F, WS_BG), wsb(F, WS_C), wsb(F, WS_ZP), wsb(F, WS_GS), (const float*)(F.ws + WS_ROPEC), (const float*)(F.ws + WS_ROPES),
                      F.out + O_KP + (size_t)LI * MP * D, F.out + O_VP + (size_t)LI * MP * D, F.out + O_KS + (size_t)LI * MS * D, F.out + O_VS + (size_t)LI * MS * D};
        pg8::gemm_phase<pg8::EpiWin, pg8::StaticOrder, true, true>(RING, g, S, E, F.wave); SEAM(pb + 3); }
    if (KEEP_ATT && IN(pb + 4)) { FRESH();
        const attn_body::AttnTensors AT{(const attn_body::bf16*)wsb(F, WS_Q), (const attn_body::bf16*)wsb(F, WS_K), (const attn_body::bf16*)wsb(F, WS_V), (attn_body::bf16*)wsb(F, WS_O)};
        for (int v = F.vcu; v < 256; v += F.G) attn_body::attn_phase<8>((char*)RING, AT, v, F.wave);
        for (int su = F.vcu; su < DB * 8; su += F.G) sattn_unit(F, LI, su >> 3, su & 7);
        SEAM(pb + 4); }
    if (KEEP_E2 && IN(pb + 5)) { FRESH(); e2_phase(F, LI); SEAM(pb + 5); }
    if (KEEP_BR && IN(pb + 6)) { FRESH(); pg8::Gemm g{wsb(F, WS_A2), wlayer(F, LI, W_BR), M, D, KBR}; pg8::SegOrder S; S.init(M, D, F.G, (int)blockIdx.x);
        pg8::EpiSeg E{wsb(F, WS_GS), (float*)(F.ws + WS_Y), wsb(F, WS_MG)};
        pg8::gemm_phase<pg8::EpiSeg, pg8::SegOrder, true, true>(RING, g, S, E, F.wave); SEAM(pb + 6); }
    if (KEEP_WOUT && IN(pb + 7)) { FRESH(); pg8::Gemm g{wsb(F, WS_MG), wlayer(F, LI, W_OUT), M, D, D}; pg8::StaticOrder S; S.init(M, D, F.G, (int)blockIdx.x);
        pg8::EpiF32 E{(float*)(F.ws + WS_Y), D};
        pg8::gemm_phase<pg8::EpiF32, pg8::StaticOrder, true, true>(RING, g, S, E, F.wave); SEAM(pb + 7); }
    if (KEEP_N3 && IN(pb + 8)) { FRESH(); const float* ng = F.in[8] + (size_t)LI * 8 * D; norm_phase(F, 1.0f, ng + 3 * D, ng + 4 * D, true); SEAM(pb + 8); }
}
template <int LI> __device__ __forceinline__ void ple_part(Frame& F, const XcdBarrier& bar, const int lo, const int hi) {
    constexpr int pb = 1 + LI * PH_PER_LAYER;
    if (KEEP_PG && IN(pb + 12)) { FRESH(); pg8::Gemm g{wsb(F, WS_XN), wlayer(F, LI, W_PG), M, D, D}; pg8::StaticOrder S; S.init(M, D, F.G, (int)blockIdx.x);
        pg8::EpiPle E{(float*)(F.ws + WS_Y), wsb(F, WS_PU), D};
        pg8::gemm_phase<pg8::EpiPle, pg8::StaticOrder, true, true>(RING, g, S, E, F.wave); SEAM(pb + 12); }
    if (KEEP_N5 && IN(pb + 13)) { FRESH(); const float* ng = F.in[8] + (size_t)LI * 8 * D; norm_phase(F, 1.0f, ng + 7 * D, ng + 8 * D, LI + 1 < DEPTH); SEAM(pb + 13); }
}
template <int LI> __device__ __forceinline__ void layer_part(Frame& F, const XcdBarrier& bar, const int lo, const int hi) {
    ffn_part<LI, 0>(F, bar, lo, hi); mixer_part<LI>(F, bar, lo, hi); ffn_part<LI, 1>(F, bar, lo, hi); ple_part<LI>(F, bar, lo, hi);
}
__global__ void __launch_bounds__(NWAVES * 64, 2) enc_fwd(Args args) {
    extern __shared__ __attribute__((aligned(16))) unsigned char lds[];
    Frame F;
    F.lds = (LAS unsigned char*)lds;
    F.MISC = (volatile LAS unsigned*)(F.lds + MISC_OFF);
    F.wave = __builtin_amdgcn_readfirstlane(threadIdx.x >> 6);
    F.G = gridDim.x; { const int bx = blockIdx.x; F.vcu = (F.G % 8 == 0) ? (bx % 8) * (F.G / 8) + bx / 8 : bx; }
#pragma unroll
    for (int i = 0; i < 21; ++i) F.in[i] = args.in[i];
    F.out = args.out; F.ws = args.ws;
    F.ctl = (gu32*)(F.ws + WS_CTL);
    for (int u = threadIdx.x; u < (LDS_BYTES - LDSCTL_OFF) / 4; u += NWAVES * 64) ((LAS unsigned*)(F.lds + LDSCTL_OFF))[u] = 0u;
    __syncthreads();
    XcdBarrier bar; bar.wave = F.wave; bar.bar = (unsigned*)(F.ctl + CW_BAR); bar.x = 0; bar.st = nullptr;
#if !MK_PER_PHASE
    bar = xcd_barrier_post((unsigned*)(F.ctl + CW_BAR), F.MISC + 8);
#endif
    const int lo = args.ph_lo, hi = args.ph_hi;
    if (KEEP_PRO && IN(0)) { FRESH(); p0_prologue(F); SEAM(0); }
    layer_part<0>(F, bar, lo, hi); layer_part<1>(F, bar, lo, hi); layer_part<2>(F, bar, lo, hi); layer_part<3>(F, bar, lo, hi);
}
#undef IN
#undef SEAM
#undef FRESH
#undef RING

#ifndef DBG_DUMP
#define DBG_DUMP 0
#endif
#if DBG_DUMP
__global__ void dbg_dump_bf16(const unsigned short* src, float* dst, size_t n) { size_t i = (size_t)blockIdx.x * blockDim.x + threadIdx.x; const size_t st = (size_t)gridDim.x * blockDim.x; for (; i < n; i += st) dst[i] = __uint_as_float((unsigned)src[i] << 16); }
#endif
#ifndef PH_STOP
#define PH_STOP 1000
#endif
extern "C" void kernel_launch(void* const* d_in, const int* in_sizes, int n_in, void* d_out, int out_size, void* d_ws, size_t ws_size, hipStream_t stream) {
    static int grid = 0;
    if (grid == 0) {
        if (n_in != 21 || (size_t)(unsigned)out_size != O_END || ws_size < WS_END) { fprintf(stderr, "kernel_launch: unexpected shapes (n_in %d, out %d, ws %zu); nothing launched\n", n_in, out_size, ws_size); grid = -1; return; }
        int dev = 0, cus = 0, per_cu = 0;
        if (hipGetDevice(&dev) != hipSuccess || hipDeviceGetAttribute(&cus, hipDeviceAttributeMultiprocessorCount, dev) != hipSuccess) { grid = -1; return; }
        if (hipFuncSetAttribute((const void*)enc_fwd, hipFuncAttributeMaxDynamicSharedMemorySize, LDS_BYTES) != hipSuccess) { fprintf(stderr, "kernel_launch: hipFuncSetAttribute failed\n"); grid = -1; return; }
        if (hipOccupancyMaxActiveBlocksPerMultiprocessor(&per_cu, (const void*)enc_fwd, NWAVES * 64, LDS_BYTES) != hipSuccess || per_cu < 1)
            fprintf(stderr, "kernel_launch: note: occupancy query reports %d workgroups per CU\n", per_cu);
        (void)hipGetLastError();
        grid = cus;
    }
    if (grid < 0) return;
    if (hipMemsetAsync((char*)d_ws + WS_CTL, 0, CTL_ZERO_BYTES, stream) != hipSuccess) return;
    Args a{};
    for (int i = 0; i < 21; ++i) a.in[i] = (const float*)d_in[i];
    a.out = (float*)d_out; a.ws = (unsigned char*)d_ws;
#if MK_PER_PHASE
    for (int ph = 0; ph < (NPH < PH_STOP ? NPH : PH_STOP); ++ph) { a.ph_lo = ph; a.ph_hi = ph + 1; hipLaunchKernelGGL(enc_fwd, dim3(grid), dim3(NWAVES * 64), LDS_BYTES, stream, a); }
#if DBG_DUMP
    { const unsigned char* ws = (const unsigned char*)d_ws; float* out = (float*)d_out;
      if (DBG_DUMP & 1) { hipLaunchKernelGGL(dbg_dump_bf16, dim3(2048), dim3(256), 0, stream, (const unsigned short*)(ws + WS_O), out + O_KP + (size_t)1 * MP * D, (size_t)MP * 2048);
                          hipLaunchKernelGGL(dbg_dump_bf16, dim3(256), dim3(256), 0, stream, (const unsigned short*)(ws + WS_O) + (size_t)MP * 2048, out + O_KS + (size_t)1 * MS * D, (size_t)MS * 2048); }
      if (DBG_DUMP & 2) { hipLaunchKernelGGL(dbg_dump_bf16, dim3(2048), dim3(256), 0, stream, (const unsigned short*)(ws + WS_A2), out + O_VP + (size_t)1 * MP * D, (size_t)MP * 2048);
                          hipLaunchKernelGGL(dbg_dump_bf16, dim3(256), dim3(256), 0, stream, (const unsigned short*)(ws + WS_A2) + (size_t)MP * 2048, out + O_VS + (size_t)1 * MS * D, (size_t)MS * 2048); }
      if (DBG_DUMP & 8) { hipLaunchKernelGGL(dbg_dump_bf16, dim3(2048), dim3(256), 0, stream, (const unsigned short*)(ws + WS_GS), out + O_KP + (size_t)1 * MP * D, (size_t)MP * 3072); }
      if (DBG_DUMP & 16) { hipLaunchKernelGGL(dbg_dump_bf16, dim3(2048), dim3(256), 0, stream, (const unsigned short*)(ws + WS_W + W_BR), out + O_VP + (size_t)1 * MP * D, (size_t)1024 * 2048); }
      if (DBG_DUMP & 4) { hipLaunchKernelGGL(dbg_dump_bf16, dim3(2048), dim3(256), 0, stream, (const unsigned short*)(ws + WS_MG), out + O_KP + (size_t)3 * MP * D, (size_t)MP * 1024);
                          hipLaunchKernelGGL(dbg_dump_bf16, dim3(256), dim3(256), 0, stream, (const unsigned short*)(ws + WS_MG) + (size_t)MP * 1024, out + O_KS + (size_t)3 * MS * D, (size_t)MS * 1024); } }
#endif
#else
    a.ph_lo = 0; a.ph_hi = (NPH < PH_STOP ? NPH : PH_STOP);
    hipLaunchKernelGGL(enc_fwd, dim3(grid), dim3(NWAVES * 64), LDS_BYTES, stream, a);
#endif
}
```

```cpp
#include <hip/hip_runtime.h>
#include <cstdio>
#include <cstdint>

namespace pg8 {
#define PG8_LAS __attribute__((address_space(3)))
typedef unsigned short bf16_t;
typedef short bf16x8 __attribute__((ext_vector_type(8)));
typedef float f32x4 __attribute__((ext_vector_type(4)));
typedef unsigned u32x4 __attribute__((ext_vector_type(4)));
constexpr int BM = 256, BK = 64, HALF = 128, HTB = HALF * BK * 2  , STAGE_BYTES = 8 * HTB, NXCD = 8, WGM = 8;

__host__ __device__ __forceinline__ int lds_byte(int r, int c) { const int st = (r >> 4) * 2 + (c >> 5), rr = r & 15, cc = c & 31, ob = rr * 64 + cc * 2; return st * 1024 + (ob ^ (((ob >> 9) & 1) << 5)); }
__host__ __device__ __forceinline__ void stage_rc(int b, int& R, int& C) { const int st = b / 1024, sb = b % 1024, swz = sb ^ (((sb >> 9) & 1) << 5); R = (st >> 1) * 16 + swz / 64; C = (st & 1) * 32 + (swz % 64) / 2; }
__host__ __device__ __forceinline__ int perm32(int rho) { const int n = rho >> 4, i = rho & 15; return 8 * (i >> 2) + 4 * n + (i & 3); }

struct Unit { int pm, pn, seg; };
constexpr int MPROMPT_TILES = 128;
struct Gemm { const bf16_t* A; const bf16_t* Bt; int M, N, K; };

struct StaticOrder {
    int nM, nN, nwg, G, c;
    __host__ __device__ void init(int M, int N, int G_, int c_) { nM = M / BM; nN = N / BM; nwg = nM * nN; G = G_; c = c_; }
    __host__ __device__ bool next(int i, Unit& u) const {
        const long L = (long)i * G + c; if (L >= nwg) return false;
        int wgid = (int)L; { const int q = nwg / NXCD, r = nwg % NXCD, xcd = wgid % NXCD, off = wgid / NXCD; wgid = (xcd < r ? xcd * (q + 1) : r * (q + 1) + (xcd - r) * q) + off; }
        const int nig = WGM * nN, gid = wgid / nig, fm = gid * WGM, gsz = (nM - fm) < WGM ? (nM - fm) : WGM;
        u.pm = fm + ((wgid % nig) % gsz); u.pn = (wgid % nig) / gsz; u.seg = 0; return true;
    }
    __device__ __forceinline__ size_t koff_bytes(const Unit&) const { return 0; }
    __device__ __forceinline__ int ntiles(const Unit&, int K) const { return K / BK; }
    __device__ __forceinline__ void a_ready(const Unit&) const {}
    __device__ __forceinline__ void done(const Unit&) const {}
};
struct SampleOrder {
    int nN, G, c;
    __host__ __device__ void init(int N, int G_, int c_) { nN = N / BM; G = G_; c = c_; }
    __host__ __device__ bool next(int i, Unit& u) const { const int L = i * G + c; if (L >= 2 * nN) return false; u.pm = MPROMPT_TILES + L / nN; u.pn = L % nN; u.seg = 0; return true; }
    __device__ __forceinline__ size_t koff_bytes(const Unit&) const { return 0; }
    __device__ __forceinline__ int ntiles(const Unit&, int K) const { return K / BK; }
    __device__ __forceinline__ void a_ready(const Unit&) const {}
    __device__ __forceinline__ void done(const Unit&) const {}
};
struct SampleSplitOrder : SampleOrder {
    __host__ __device__ bool next(int i, Unit& u) const { const int L = i * G + c; if (L >= 32) return false; const int tile = L >> 2; u.pm = MPROMPT_TILES + (tile >> 2); u.pn = tile & 3; u.seg = L & 3; return true; }
    __device__ __forceinline__ size_t koff_bytes(const Unit& u) const { return (size_t)(u.seg == 0 ? 0 : (u.seg == 1 ? 12 : (u.seg == 2 ? 24 : 34))) * BK * 2; }
    __device__ __forceinline__ int ntiles(const Unit& u, int) const { return u.seg < 2 ? 12 : 10; }
};
struct SampleSegOrder : SampleOrder {
    __host__ __device__ bool next(int i, Unit& u) const { const int r = i / 3; if (!SampleOrder::next(r, u)) return false; u.seg = i - 3 * r; return true; }
    __device__ __forceinline__ size_t koff_bytes(const Unit& u) const { return u.seg == 0 ? 0 : (u.seg == 1 ? 2048 : 3072); }
    __device__ __forceinline__ int ntiles(const Unit& u, int) const { return u.seg == 0 ? 16 : 8; }
};
struct SegOrder : StaticOrder {
    __host__ __device__ bool next(int i, Unit& u) const { const int r = i / 3; if (!StaticOrder::next(r, u)) return false; u.seg = i - 3 * r; return true; }
    __device__ __forceinline__ size_t koff_bytes(const Unit& u) const { return u.seg == 0 ? 0 : (u.seg == 1 ? 2048 : 3072); }
    __device__ __forceinline__ int ntiles(const Unit& u, int) const { return u.seg == 0 ? 16 : 8; }
};

typedef float cvt_f32x2_t __attribute__((ext_vector_type(2))); typedef __bf16 cvt_bf16x2_t __attribute__((ext_vector_type(2)));
__device__ __forceinline__ unsigned cvt_pk_bf16(float lo, float hi) { const cvt_f32x2_t v = {lo, hi}; const cvt_bf16x2_t b = __builtin_convertvector(v, cvt_bf16x2_t); return __builtin_bit_cast(unsigned, b); }
typedef float f32x2 __attribute__((ext_vector_type(2)));
constexpr int MPROMPT = 32768;
constexpr float QSCALE = 0.125f * 1.4426950408889634f;
__device__ __forceinline__ float sigm(float x) { return __builtin_amdgcn_rcpf(1.0f + __builtin_amdgcn_exp2f(-1.4426950408889634f * x)); }
__device__ __forceinline__ u32x4 pack8(const f32x4 a, const f32x4 b) { u32x4 w; w.x = cvt_pk_bf16(a[0], a[1]); w.y = cvt_pk_bf16(a[2], a[3]); w.z = cvt_pk_bf16(b[0], b[1]); w.w = cvt_pk_bf16(b[2], b[3]); return w; }
__device__ __forceinline__ void unpack8(const u32x4 w, f32x4& a, f32x4& b) {
    a[0] = __uint_as_float(w.x << 16); a[1] = __uint_as_float(w.x & 0xffff0000u); a[2] = __uint_as_float(w.y << 16); a[3] = __uint_as_float(w.y & 0xffff0000u);
    b[0] = __uint_as_float(w.z << 16); b[1] = __uint_as_float(w.z & 0xffff0000u); b[2] = __uint_as_float(w.w << 16); b[3] = __uint_as_float(w.w & 0xffff0000u); }

struct EpiSwiGLU {
    static constexpr bool PERM = true, AFTER_DRAIN = false;
    bf16_t* O; int ldc;
    __device__ __forceinline__ void operator()(const f32x4 (&acc)[2][2][4][2], const Unit& u, int wr, int wc, int fr, int fq) const {
        const int row0 = u.pm * BM + wr * 64 + fr, col0 = u.pn * HALF + wc * 32 + 8 * fq;
#pragma unroll
        for (int ai = 0; ai < 2; ++ai)
#pragma unroll
            for (int m = 0; m < 4; ++m) { bf16_t* p = O + (size_t)(row0 + ai * HALF + m * 16) * ldc + col0; f32x4 h[2];
#pragma unroll
                for (int n = 0; n < 2; ++n)
#pragma unroll
                    for (int j = 0; j < 4; ++j) { const float g = acc[ai][0][m][n][j]; h[n][j] = g * sigm(g) * acc[ai][1][m][n][j]; }
                *(u32x4*)p = pack8(h[0], h[1]); }
    }
};
struct EpiF32 {
    static constexpr bool PERM = false, AFTER_DRAIN = false;
    float* Y; int ldc;
    __device__ __forceinline__ void operator()(const f32x4 (&acc)[2][2][4][2], const Unit& u, int wr, int wc, int fr, int fq) const {
        float* yb = Y + (size_t)(u.pm * BM) * ldc + u.pn * BM;
        int lrow = wr * 64 + fr, lcol = wc * 32 + 4 * fq; asm volatile("" : "+v"(lrow), "+v"(lcol));
#pragma unroll
        for (int ai = 0; ai < 2; ++ai)
#pragma unroll
            for (int m = 0; m < 4; ++m) { const int o = (lrow + ai * HALF + m * 16) * ldc + lcol;
#pragma unroll
                for (int bj = 0; bj < 2; ++bj)
#pragma unroll
                    for (int n = 0; n < 2; ++n) *(f32x4*)(yb + o + bj * HALF + n * 16) = acc[ai][bj][m][n]; }
    }
};
struct EpiF32Slab {
    static constexpr bool PERM = false, AFTER_DRAIN = false;
    float* YS;
    __device__ __forceinline__ void operator()(const f32x4 (&acc)[2][2][4][2], const Unit& u, int wr, int wc, int fr, int fq) const {
        float* yb = YS + (size_t)u.seg * 512 * 1024 + (size_t)((u.pm - MPROMPT_TILES) * BM) * 1024 + u.pn * BM;
        int lrow = wr * 64 + fr, lcol = wc * 32 + 4 * fq; asm volatile("" : "+v"(lrow), "+v"(lcol));
#pragma unroll
        for (int ai = 0; ai < 2; ++ai)
#pragma unroll
            for (int m = 0; m < 4; ++m) { const int o = (lrow + ai * HALF + m * 16) * 1024 + lcol;
#pragma unroll
                for (int bj = 0; bj < 2; ++bj)
#pragma unroll
                    for (int n = 0; n < 2; ++n) *(f32x4*)(yb + o + bj * HALF + n * 16) = acc[ai][bj][m][n]; }
    }
};
struct EpiPle {
    static constexpr bool PERM = true, AFTER_DRAIN = false;
    bf16_t* Y; const bf16_t* PU; int ldc;
    __device__ __forceinline__ void operator()(const f32x4 (&acc)[2][2][4][2], const Unit& u, int wr, int wc, int fr, int fq) const {
        const size_t tb = (size_t)(u.pm * BM) * ldc + u.pn * BM;
        int lrow = wr * 64 + fr, lcol = wc * 32 + 8 * fq; asm volatile("" : "+v"(lrow), "+v"(lcol));
#pragma unroll
        for (int ai = 0; ai < 2; ++ai)
#pragma unroll
            for (int m = 0; m < 4; ++m) { const int o = (lrow + ai * HALF + m * 16) * ldc + lcol;
#pragma unroll
                for (int bj = 0; bj < 2; ++bj) { const u32x4 w = *(const u32x4*)(PU + tb + o + bj * HALF); f32x4 p0, p1; unpack8(w, p0, p1); f32x4 o0, o1;
#pragma unroll
                    for (int j = 0; j < 4; ++j) { o0[j] = p0[j] * sigm(acc[ai][bj][m][0][j]); o1[j] = p1[j] * sigm(acc[ai][bj][m][1][j]); }
                    *(u32x4*)(Y + tb + o + bj * HALF) = pack8(o0, o1); } }
    }
};
struct EpiBf {
    static constexpr bool PERM = true, AFTER_DRAIN = false;
    bf16_t* O; int ldc;
    __device__ __forceinline__ void operator()(const f32x4 (&acc)[2][2][4][2], const Unit& u, int wr, int wc, int fr, int fq) const {
        bf16_t* ob = O + (size_t)(u.pm * BM) * ldc + u.pn * BM;
        int lrow = wr * 64 + fr, lcol = wc * 32 + 8 * fq; asm volatile("" : "+v"(lrow), "+v"(lcol));
#pragma unroll
        for (int ai = 0; ai < 2; ++ai)
#pragma unroll
            for (int m = 0; m < 4; ++m) { const int o = (lrow + ai * HALF + m * 16) * ldc + lcol;
#pragma unroll
                for (int bj = 0; bj < 2; ++bj) *(u32x4*)(ob + o + bj * HALF) = pack8(acc[ai][bj][m][0], acc[ai][bj][m][1]); }
    }
};
struct EpiSeg {
    static constexpr bool PERM = true, AFTER_DRAIN = false;
    const bf16_t* S; float* T; bf16_t* O;
    __device__ __forceinline__ void operator()(const f32x4 (&acc)[2][2][4][2], const Unit& u, int wr, int wc, int fr, int fq) const {
        const int seg = u.seg;
        const bf16_t* sb = S + (size_t)(u.pm * BM) * 3072 + u.pn * BM + seg * 1024; float* tb = T + (size_t)(u.pm * BM) * 1024 + u.pn * BM; bf16_t* ob = O + (size_t)(u.pm * BM) * 1024 + u.pn * BM;
        int lrow = wr * 64 + fr, lcol = wc * 32 + 8 * fq; asm volatile("" : "+v"(lrow), "+v"(lcol));
#pragma unroll
        for (int ai = 0; ai < 2; ++ai)
#pragma unroll
            for (int m = 0; m < 4; ++m) { const int r = lrow + ai * HALF + m * 16;
#pragma unroll
                for (int bj = 0; bj < 2; ++bj) { const u32x4 ws = *(const u32x4*)(sb + r * 3072 + lcol + bj * HALF); f32x4 s0, s1; unpack8(ws, s0, s1);
                    f32x4 o0 = acc[ai][bj][m][0] * s0, o1 = acc[ai][bj][m][1] * s1; float* tp = tb + r * 1024 + lcol + bj * HALF;
                    if (seg != 0) { o0 = o0 + *(const f32x4*)tp; o1 = o1 + *(const f32x4*)(tp + 4); }
                    if (seg != 2) { *(f32x4*)tp = o0; *(f32x4*)(tp + 4) = o1; }
                    else *(u32x4*)(ob + r * 1024 + lcol + bj * HALF) = pack8(o0, o1); } }
    }
};
struct EpiWin {
    static constexpr bool PERM = true, AFTER_DRAIN = false;
    bf16_t *Q, *K, *V, *BG, *C, *ZP, *GS; const float *ropec, *ropes; float *kp, *vp, *ks, *vs;
    __device__ __forceinline__ void operator()(const f32x4 (&acc)[2][2][4][2], const Unit& u, int wr, int wc, int fr, int fq) const {
        const int pn = u.pn; const bool samp = u.pm >= MPROMPT / BM; const int row0 = u.pm * BM + wr * 64 + fr;
        if (pn < 8) {
            const bool isq = pn < 4; const int map = (pn & 3) * 4 + wc; bf16_t* dst = isq ? Q : K; const float sc = isq ? QSCALE : 1.0f;
            float* ko = samp ? ks - (size_t)MPROMPT * 1024 : kp;
#pragma unroll
            for (int ai = 0; ai < 2; ++ai)
#pragma unroll
                for (int m = 0; m < 4; ++m) { const int row = row0 + ai * HALF + m * 16; const int pos = samp ? 1024 + ((row - MPROMPT) & 31) : (row & 16383);
                    const float* cp = ropec + (size_t)pos * 32 + 8 * fq; const float* sp = ropes + (size_t)pos * 32 + 8 * fq;
                    f32x4 o1[2], o2[2];
#pragma unroll
                    for (int n = 0; n < 2; ++n) { const f32x4 c = *(const f32x4*)(cp + 4 * n), s = *(const f32x4*)(sp + 4 * n), x1 = acc[ai][0][m][n], x2 = acc[ai][1][m][n]; o1[n] = x1 * c - x2 * s; o2[n] = x2 * c + x1 * s; }
                    const size_t off = (size_t)row * 1024 + map * 64 + 8 * fq;
                    if (!isq) { float* kf = ko + off; __builtin_nontemporal_store(o1[0], (f32x4*)kf); __builtin_nontemporal_store(o1[1], (f32x4*)(kf + 4)); __builtin_nontemporal_store(o2[0], (f32x4*)(kf + 32)); __builtin_nontemporal_store(o2[1], (f32x4*)(kf + 36)); }
                    *(u32x4*)(dst + off) = pack8(o1[0] * sc, o1[1] * sc); *(u32x4*)(dst + off + 32) = pack8(o2[0] * sc, o2[1] * sc); }
        } else if (pn < 12) {
            float* vo = samp ? vs - (size_t)MPROMPT * 1024 : vp; const int col0 = (pn - 8) * BM + wc * 32 + 8 * fq;
#pragma unroll
            for (int ai = 0; ai < 2; ++ai)
#pragma unroll
                for (int m = 0; m < 4; ++m) { const size_t off = (size_t)(row0 + ai * HALF + m * 16) * 1024 + col0;
#pragma unroll
                    for (int bj = 0; bj < 2; ++bj) { float* vf = vo + off + bj * HALF; __builtin_nontemporal_store(acc[ai][bj][m][0], (f32x4*)vf); __builtin_nontemporal_store(acc[ai][bj][m][1], (f32x4*)(vf + 4)); *(u32x4*)(V + off + bj * HALF) = pack8(acc[ai][bj][m][0], acc[ai][bj][m][1]); } }
        } else if (pn < 14 || (pn >= 18 && pn < 20)) {
            bf16_t* dst = pn < 14 ? BG : ZP; const int col0 = (pn < 14 ? pn - 12 : pn - 18) * BM + wc * 32 + 8 * fq;
#pragma unroll
            for (int ai = 0; ai < 2; ++ai)
#pragma unroll
                for (int m = 0; m < 4; ++m) { bf16_t* p = dst + (size_t)(row0 + ai * HALF + m * 16) * 512 + col0;
#pragma unroll
                    for (int bj = 0; bj < 2; ++bj) *(u32x4*)(p + bj * HALF) = pack8(acc[ai][bj][m][0], acc[ai][bj][m][1]); }
        } else if (pn < 18) {
            const int col0 = (pn - 14) * HALF + wc * 32 + 8 * fq;
#pragma unroll
            for (int ai = 0; ai < 2; ++ai)
#pragma unroll
                for (int m = 0; m < 4; ++m) *(u32x4*)(C + (size_t)(row0 + ai * HALF + m * 16) * 512 + col0) = pack8(acc[ai][0][m][0] * acc[ai][1][m][0], acc[ai][0][m][1] * acc[ai][1][m][1]);
        } else {
            const int col0 = (pn - 20) * BM + wc * 32 + 8 * fq;
#pragma unroll
            for (int ai = 0; ai < 2; ++ai)
#pragma unroll
                for (int m = 0; m < 4; ++m) { bf16_t* p = GS + (size_t)(row0 + ai * HALF + m * 16) * 3072 + col0;
#pragma unroll
                    for (int bj = 0; bj < 2; ++bj) { f32x4 g0, g1;
#pragma unroll
                        for (int j = 0; j < 4; ++j) { g0[j] = sigm(acc[ai][bj][m][0][j]); g1[j] = sigm(acc[ai][bj][m][1][j]); }
                        *(u32x4*)(p + bj * HALF) = pack8(g0, g1); } }
        }
    }
};
template <class Epi, class Sched, bool ALIGN_EPI = false, bool SP2 = false>
__device__ __forceinline__ void gemm_phase(PG8_LAS unsigned char* lds, const Gemm g, const Sched& S, const Epi& E, const int wave) {
    int lane_; asm volatile("v_mbcnt_lo_u32_b32 %0, -1, 0\n\tv_mbcnt_hi_u32_b32 %0, -1, %0" : "=v"(lane_));
    const int wid = wave, lane = lane_, tid = wid * 64 + lane, wr = wid >> 2, wc = wid & 3, fr = lane & 15, fq = lane >> 4;
    const int K = g.K;
    unsigned voffA[2], voffB[2];
#pragma unroll
    for (int i = 0; i < 2; ++i) { int R, C; stage_rc(tid * 16 + i * 8192, R, C); const int Rb = Epi::PERM ? ((R & ~31) + perm32(R & 31)) : R;
        voffA[i] = (unsigned)(R * K + C) * 2u; voffB[i] = (unsigned)(Rb * K + C) * 2u; }
    const size_t kstep = (size_t)(BK * 2);
    const size_t hstep = (size_t)HALF * K * 2;
    const size_t tstep = 2 * hstep;
    const unsigned ldsw = (unsigned)wid * 1024u;
    const int aoff = lds_byte(wr * 64 + fr, fq * 8), boff = lds_byte(wc * 32 + fr, fq * 8);
#define PG8_SA(b, h) (((b) * 2 + (h)) * HTB)
#define PG8_SB(b, h) ((4 + (b) * 2 + (h)) * HTB)
#define PG8_STAGE(bufoff, gbase, voff) do { _Pragma("unroll") for (int _i = 0; _i < 2; ++_i) \
        __builtin_amdgcn_global_load_lds((const unsigned*)((const char*)(gbase) + (voff)[_i]), (PG8_LAS unsigned*)(lds + (bufoff) + ldsw + _i * 8192), 16, 0, 0); } while (0)
#define PG8_LDA(dst, b, h) do { _Pragma("unroll") for (int m = 0; m < 4; ++m) _Pragma("unroll") for (int k = 0; k < 2; ++k) dst[m][k] = *(const PG8_LAS bf16x8*)(lds + PG8_SA(b, h) + aoff + m * 2048 + k * 1024); } while (0)
#define PG8_LDB(dst, b, h) do { _Pragma("unroll") for (int n = 0; n < 2; ++n) _Pragma("unroll") for (int k = 0; k < 2; ++k) dst[n][k] = *(const PG8_LAS bf16x8*)(lds + PG8_SB(b, h) + boff + n * 2048 + k * 1024); } while (0)
#define PG8_MMA(ai, bj, At, Bt) do { __builtin_amdgcn_s_setprio(1); _Pragma("unroll") for (int m = 0; m < 4; ++m) _Pragma("unroll") for (int n = 0; n < 2; ++n) _Pragma("unroll") for (int k = 0; k < 2; ++k) \
        acc[ai][bj][m][n] = __builtin_amdgcn_mfma_f32_16x16x32_bf16(Bt[n][k], At[m][k], acc[ai][bj][m][n], 0, 0, 0); __builtin_amdgcn_s_setprio(0); } while (0)
#define PG8_WAIT_V(n) asm volatile("s_waitcnt vmcnt(" #n ")" ::: "memory")
#define PG8_WAIT_L(n) asm volatile("s_waitcnt lgkmcnt(" #n ")" ::: "memory")
#define PG8_BAR __builtin_amdgcn_s_barrier()
#define PG8_SCHED __builtin_amdgcn_sched_barrier(0)
    Unit cur, nxt; int ui = 0;
    if (!S.next(0, cur)) return;
    f32x4 acc[2][2][4][2];
#pragma unroll
    for (int a = 0; a < 2; ++a)
#pragma unroll
        for (int b = 0; b < 2; ++b)
#pragma unroll
            for (int m = 0; m < 4; ++m)
#pragma unroll
                for (int n = 0; n < 2; ++n) acc[a][b][m][n] = (f32x4){0.f, 0.f, 0.f, 0.f};
    bf16x8 At[4][2], B0[2][2], B1[2][2];
    const char* cA = (const char*)g.A + (size_t)cur.pm * tstep + S.koff_bytes(cur); const char* cB = (const char*)g.Bt + (size_t)cur.pn * tstep + S.koff_bytes(cur);
    S.a_ready(cur);
    if constexpr (SP2) {
        PG8_STAGE(PG8_SB(0, 0), cB, voffB); PG8_STAGE(PG8_SB(0, 1), cB + hstep, voffB); PG8_STAGE(PG8_SA(0, 0), cA, voffA); PG8_STAGE(PG8_SA(0, 1), cA + hstep, voffA);
        if (wr == 1) PG8_BAR;
        PG8_WAIT_V(2); PG8_BAR;
        PG8_STAGE(PG8_SB(1, 0), cB + kstep, voffB); PG8_STAGE(PG8_SA(1, 0), cA + kstep, voffA); PG8_STAGE(PG8_SB(1, 1), cB + hstep + kstep, voffB);
        PG8_WAIT_V(6); PG8_BAR;
    } else {
        PG8_STAGE(PG8_SB(0, 0), cB, voffB); PG8_STAGE(PG8_SA(0, 0), cA, voffA); PG8_STAGE(PG8_SB(0, 1), cB + hstep, voffB); PG8_STAGE(PG8_SA(0, 1), cA + hstep, voffA);
        if (wr == 1) PG8_BAR;
        PG8_WAIT_V(4); PG8_BAR;
        PG8_STAGE(PG8_SB(1, 0), cB + kstep, voffB); PG8_STAGE(PG8_SA(1, 0), cA + kstep, voffA); PG8_STAGE(PG8_SB(1, 1), cB + hstep + kstep, voffB);
        PG8_WAIT_V(6); PG8_BAR;
    }
    for (;;) {
        const bool has_next = S.next(ui + 1, nxt);
        const char* nA = has_next ? (const char*)g.A + (size_t)nxt.pm * tstep + S.koff_bytes(nxt) : cA; const char* nB = has_next ? (const char*)g.Bt + (size_t)nxt.pn * tstep + S.koff_bytes(nxt) : cB;
        const int nt = S.ntiles(cur, K);
        for (int t = 0; t < nt; t += 2) {
            const bool last = (t == nt - 2);
            const char* a1 = cA + (size_t)(t + 1) * kstep;
            const char* a2 = last ? nA : cA + (size_t)(t + 2) * kstep; const char* b2 = last ? nB : cB + (size_t)(t + 2) * kstep;
            const char* a3 = a2 + kstep; const char* b3 = b2 + kstep;
            if (last && has_next) S.a_ready(nxt);
            if constexpr (SP2) {
            PG8_LDB(B0, 0, 0); PG8_LDB(B1, 0, 1); PG8_SCHED; PG8_LDA(At, 0, 0); PG8_STAGE(PG8_SA(1, 1), a1 + hstep, voffA);
            PG8_WAIT_V(8); PG8_WAIT_L(0); PG8_BAR; PG8_MMA(0, 0, At, B0); PG8_MMA(0, 1, At, B1); PG8_BAR; PG8_SCHED;
            PG8_LDA(At, 0, 1); PG8_STAGE(PG8_SB(0, 0), b2, voffB); PG8_STAGE(PG8_SB(0, 1), b2 + hstep, voffB); PG8_STAGE(PG8_SA(0, 0), a2, voffA);
            PG8_WAIT_V(8); PG8_WAIT_L(0); PG8_BAR; PG8_MMA(1, 0, At, B0); PG8_MMA(1, 1, At, B1); PG8_BAR; PG8_SCHED;
            PG8_LDB(B0, 1, 0); PG8_LDB(B1, 1, 1); PG8_SCHED; PG8_LDA(At, 1, 0); PG8_STAGE(PG8_SA(0, 1), a2 + hstep, voffA);
            PG8_WAIT_V(8); PG8_WAIT_L(0); PG8_BAR; PG8_MMA(0, 0, At, B0); PG8_MMA(0, 1, At, B1); PG8_BAR; PG8_SCHED;
            PG8_LDA(At, 1, 1); PG8_STAGE(PG8_SB(1, 0), b3, voffB); PG8_STAGE(PG8_SB(1, 1), b3 + hstep, voffB); PG8_STAGE(PG8_SA(1, 0), a3, voffA);
            PG8_WAIT_V(8); PG8_WAIT_L(0); PG8_BAR; PG8_MMA(1, 0, At, B0); PG8_MMA(1, 1, At, B1); PG8_BAR; PG8_SCHED;
            } else {
            PG8_LDB(B0, 0, 0); PG8_SCHED; PG8_LDA(At, 0, 0); PG8_STAGE(PG8_SA(1, 1), a1 + hstep, voffA);
            PG8_WAIT_L(8); PG8_BAR; PG8_WAIT_L(0); PG8_MMA(0, 0, At, B0); PG8_BAR; PG8_SCHED;
            PG8_LDB(B1, 0, 1); PG8_STAGE(PG8_SB(0, 0), b2, voffB);
            PG8_BAR; PG8_WAIT_L(0); PG8_MMA(0, 1, At, B1); PG8_BAR;
            PG8_LDA(At, 0, 1); PG8_STAGE(PG8_SA(0, 0), a2, voffA);
            PG8_BAR; PG8_WAIT_L(0); PG8_MMA(1, 0, At, B0); PG8_BAR; PG8_SCHED;
            PG8_STAGE(PG8_SB(0, 1), b2 + hstep, voffB);
            PG8_WAIT_V(6); PG8_BAR; PG8_MMA(1, 1, At, B1); PG8_BAR;
            PG8_LDB(B0, 1, 0); PG8_SCHED; PG8_LDA(At, 1, 0); PG8_STAGE(PG8_SA(0, 1), a2 + hstep, voffA);
            PG8_WAIT_L(8); PG8_BAR; PG8_WAIT_L(0); PG8_MMA(0, 0, At, B0); PG8_BAR; PG8_SCHED;
            PG8_LDB(B1, 1, 1); PG8_STAGE(PG8_SB(1, 0), b3, voffB);
            PG8_BAR; PG8_WAIT_L(0); PG8_MMA(0, 1, At, B1); PG8_BAR;
            PG8_LDA(At, 1, 1); PG8_STAGE(PG8_SA(1, 0), a3, voffA);
            PG8_BAR; PG8_WAIT_L(0); PG8_MMA(1, 0, At, B0); PG8_BAR; PG8_SCHED;
            PG8_STAGE(PG8_SB(1, 1), b3 + hstep, voffB);
            PG8_WAIT_V(6); PG8_BAR; PG8_MMA(1, 1, At, B1); PG8_BAR;
            }
        }
        if constexpr (ALIGN_EPI) { if (wr == 0) PG8_BAR; }
        if constexpr (!Epi::AFTER_DRAIN) { E(acc, cur, wr, wc, fr, fq); S.done(cur); }
        if (!has_next) break;
#pragma unroll
        for (int a = 0; a < 2; ++a)
#pragma unroll
            for (int b = 0; b < 2; ++b)
#pragma unroll
                for (int m = 0; m < 4; ++m)
#pragma unroll
                    for (int n = 0; n < 2; ++n) acc[a][b][m][n] = (f32x4){0.f, 0.f, 0.f, 0.f};
        cur = nxt; cA = nA; cB = nB; ++ui;
        if constexpr (ALIGN_EPI) { if (wr == 1) PG8_BAR; }
    }
    PG8_WAIT_V(0);
    if constexpr (!ALIGN_EPI) { if (wr == 0) PG8_BAR; }
    PG8_BAR;
    if constexpr (Epi::AFTER_DRAIN) { E.fused(acc, cur, wr, wc, fr, fq, lds, wid, lane); S.done(cur); }
#undef PG8_SA
#undef PG8_SB
#undef PG8_STAGE
#undef PG8_LDA
#undef PG8_LDB
#undef PG8_MMA
#undef PG8_WAIT_V
#undef PG8_WAIT_L
#undef PG8_BAR
#undef PG8_SCHED
}
}
#include <hip/hip_bf16.h>
#include <cmath>
namespace attn_body {
using bf16=__hip_bfloat16;
using bf16x8=__attribute__((ext_vector_type(8)))short;
using s16x4=__attribute__((ext_vector_type(4)))short;
using f32x16=__attribute__((ext_vector_type(16)))float;
using u32x4=__attribute__((ext_vector_type(4)))unsigned;
constexpr int SEQ=16384,D=64,DM=1024,OP=2048;
constexpr int NW=8,QBLK=32,QB=QBLK*NW,KVBLK=64,NQB=SEQ/QB;
constexpr int ATTN_PITCH=DM, ATTN_UNIT_ROWS=QB;
__device__ __forceinline__ int crow(int r,int hi){return (r&3)+8*(r>>2)+4*hi;}
__device__ __forceinline__ f32x16 zero16(){ float z; asm volatile("v_mov_b32 %0, 0":"=v"(z)); f32x16 r; _Pragma("unroll") for(int i=0;i<16;++i)r[i]=z; return r; }
#define SBAR() __builtin_amdgcn_sched_barrier(0)
__device__ __forceinline__ void cmask(f32x16&p0,f32x16&p1,int jb,int qrel,int hi){
  const float NEG=-INFINITY; (void)hi;
  if(jb>(qrel>>6)){
  #pragma unroll
  for(int r=0;r<16;++r){p0[r]=NEG;p1[r]=NEG;} }
}

constexpr int NSLOT=3, SLOTB=8192;
constexpr int LDS_K=0, LDS_V=NSLOT*SLOTB, LDS_WS=3*NSLOT*SLOTB, LDS_OST=LDS_WS+NW*64*4, LDS_BYTES=LDS_OST+NW*4096;
constexpr float C2=0.125f*1.4426950408889634f;
__device__ __forceinline__ void glds16(const void*gsrc,unsigned lds_dst){unsigned keep;
  asm volatile("s_mov_b32 %0, m0\n\ts_mov_b32 m0, %2\n\ts_nop 0\n\tglobal_load_lds_dwordx4 %1, off\n\ts_mov_b32 m0, %0":"=&s"(keep):"v"(gsrc),"s"(lds_dst):"memory");}
__device__ __forceinline__ float max3f(float a,float b,float c){float r;asm("v_max3_f32 %0, %1, %2, %3":"=v"(r):"v"(a),"v"(b),"v"(c));return r;}
__device__ __forceinline__ float max2f(float a,float b){float r;asm("v_max_f32_e32 %0, %1, %2":"=v"(r):"v"(a),"v"(b));return r;}
__device__ __forceinline__ float fadd_s(float a,float b){float r;asm("v_add_f32_e32 %0, %1, %2":"=v"(r):"v"(a),"v"(b));return r;}
__device__ __forceinline__ float fsub_s(float a,float b){float r;asm("v_sub_f32_e32 %0, %1, %2":"=v"(r):"v"(a),"v"(b));return r;}
typedef float f32x2_t __attribute__((ext_vector_type(2))); typedef __bf16 bf16x2_t __attribute__((ext_vector_type(2)));
__device__ __forceinline__ unsigned cvtpk_s(float lo,float hi){f32x2_t v={lo,hi};bf16x2_t b=__builtin_convertvector(v,bf16x2_t);return __builtin_bit_cast(unsigned,b);}
#define WAIT_BAR(N) asm volatile("s_waitcnt vmcnt(" #N ") lgkmcnt(0)\n\ts_barrier":::"memory")

__device__ __forceinline__ void qkt(f32x16&p0,f32x16&p1,const char*Kslot,const bf16x8*qr,const f32x16&negm,int r32,int hi){
  const char*kb=Kslot+hi*1024+r32*16;
  #pragma unroll
  for(int d0=0;d0<4;++d0){
    const bf16x8 b0=*reinterpret_cast<const bf16x8*>(kb+d0*2048);
    const bf16x8 b1=*reinterpret_cast<const bf16x8*>(kb+d0*2048+512);
    if(d0==0){p0=__builtin_amdgcn_mfma_f32_32x32x16_bf16(b0,qr[0],negm,0,0,0);p1=__builtin_amdgcn_mfma_f32_32x32x16_bf16(b1,qr[0],negm,0,0,0);}
    else{p0=__builtin_amdgcn_mfma_f32_32x32x16_bf16(b0,qr[d0],p0,0,0,0);p1=__builtin_amdgcn_mfma_f32_32x32x16_bf16(b1,qr[d0],p1,0,0,0);}}
}
typedef __attribute__((address_space(3))) const char* lds_cptr;
typedef short v4i16_t __attribute__((ext_vector_type(4)));
__device__ __forceinline__ void kload8(bf16x8*kf,lds_cptr kp){
  kf[0]=*(const __attribute__((address_space(3))) bf16x8*)(kp);      kf[1]=*(const __attribute__((address_space(3))) bf16x8*)(kp+512);
  kf[2]=*(const __attribute__((address_space(3))) bf16x8*)(kp+2048); kf[3]=*(const __attribute__((address_space(3))) bf16x8*)(kp+2560);
  kf[4]=*(const __attribute__((address_space(3))) bf16x8*)(kp+4096); kf[5]=*(const __attribute__((address_space(3))) bf16x8*)(kp+4608);
  kf[6]=*(const __attribute__((address_space(3))) bf16x8*)(kp+6144); kf[7]=*(const __attribute__((address_space(3))) bf16x8*)(kp+6656);
}
__device__ __forceinline__ void kload2(bf16x8*kf,lds_cptr kp,int j){ kf[2*j]=*(const __attribute__((address_space(3))) bf16x8*)(kp+j*2048); kf[2*j+1]=*(const __attribute__((address_space(3))) bf16x8*)(kp+j*2048+512); }
__device__ __forceinline__ s16x4 vtr(lds_cptr p){ return __builtin_bit_cast(s16x4,__builtin_amdgcn_ds_read_tr16_b64_v4i16((__attribute__((address_space(3))) v4i16_t*)p)); }
__device__ __forceinline__ float rowmax(const f32x16&p0,const f32x16&p1){
  float a=max3f(p0[0],p0[1],p1[0]),b=max3f(p0[2],p0[3],p1[1]);a=max3f(a,p1[2],p1[3]);
  #pragma unroll
  for(int r=4;r<16;r+=4){a=max3f(a,p0[r],p0[r+1]);b=max3f(b,p0[r+2],p0[r+3]);a=max3f(a,p1[r],p1[r+1]);b=max3f(b,p1[r+2],p1[r+3]);}
  const float m=max2f(a,b);
  auto rr=__builtin_amdgcn_permlane32_swap(__float_as_uint(m),__float_as_uint(m),false,false);
  return max2f(__uint_as_float(rr[0]),__uint_as_float(rr[1]));
}
__device__ __forceinline__ void pv(f32x16*o,int vb,bf16x8 pa0,bf16x8 pa1,bf16x8 pa2,bf16x8 pa3){
  #pragma unroll
  for(int d0=0;d0<4;++d0){s16x4 lo[4],hi[4];
    #pragma unroll
    for(int ks=0;ks<4;++ks){
      asm volatile("ds_read_b64_tr_b16 %0,%1 offset:%c2":"=&v"(lo[ks]):"v"(vb),"i"(d0*4096+ks*1024):"memory");
      asm volatile("ds_read_b64_tr_b16 %0,%1 offset:%c2":"=&v"(hi[ks]):"v"(vb),"i"(d0*4096+ks*1024+512):"memory");}
    asm volatile("s_waitcnt lgkmcnt(0)":::"memory");SBAR();
    #define PK(k) (bf16x8){lo[k][0],lo[k][1],lo[k][2],lo[k][3],hi[k][0],hi[k][1],hi[k][2],hi[k][3]}
    o[d0]=__builtin_amdgcn_mfma_f32_32x32x16_bf16(pa0,PK(0),o[d0],0,0,0);
    o[d0]=__builtin_amdgcn_mfma_f32_32x32x16_bf16(pa1,PK(1),o[d0],0,0,0);
    o[d0]=__builtin_amdgcn_mfma_f32_32x32x16_bf16(pa2,PK(2),o[d0],0,0,0);
    o[d0]=__builtin_amdgcn_mfma_f32_32x32x16_bf16(pa3,PK(3),o[d0],0,0,0);
    #undef PK
  }
}

#ifndef ATTN_STORE16
#define ATTN_STORE16(p,v) (*(u32x4*)(p)=(v))
#endif
template<int THRL> __device__ __forceinline__ void attn_unit(int b,int map,int qb,const bf16*Q,const bf16*__restrict__ K,const bf16*__restrict__ V,bf16*O,char*shm,const int wave){
  int lane_; asm volatile("v_mbcnt_lo_u32_b32 %0, -1, 0\n\tv_mbcnt_hi_u32_b32 %0, -1, %0":"=v"(lane_)); const int lane=lane_,r32=lane&31,hi=lane>>5; const int wid=wave;
  const long rowbase=(long)b*SEQ; const int q0=qb*QB;
  const bf16*Qw=Q+(rowbase+q0+wid*QBLK)*DM+map*D;
  const bf16*Kh=K+rowbase*DM+map*D,*Vh=V+rowbase*DM+(map>>1)*128;
  const unsigned lds0=(unsigned)(uintptr_t)shm;
  float*wsf=(float*)(shm+LDS_WS)+wid*64;
  const bf16*ksrc=Kh+(long)lane*DM+wid*8;
  const bf16*vsrc=Vh+(long)(16*(wid&3)+(lane>>2))*DM+(wid>>2)*32+(lane&3)*8;
  const unsigned kdst=lds0+LDS_K+wid*1024, vdst=lds0+LDS_V+wid*1024;
  #define DMA_K(t,slot) glds16(ksrc+(long)(t)*KVBLK*DM,(unsigned)__builtin_amdgcn_readfirstlane(kdst+(slot)))
  #define DMA_V(t,slot) do{ glds16(vsrc+(long)(t)*KVBLK*DM,(unsigned)__builtin_amdgcn_readfirstlane(vdst+2*(slot))); glds16(vsrc+(long)(t)*KVBLK*DM+64,(unsigned)__builtin_amdgcn_readfirstlane(vdst+2*(slot)+8192)); }while(0)
  const int vb0=(int)(lds0+LDS_V)+((lane>>4)&1)*32+(lane&3)*8+(4*hi+((lane&15)>>2))*64;
  const char*Kbase=shm+LDS_K; bf16x8 kf[8];
  const lds_cptr shm3=(lds_cptr)shm; const lds_cptr kp0=shm3+LDS_K+hi*1024+r32*16; const lds_cptr vp0=shm3+LDS_V+((lane>>4)&1)*32+(lane&3)*8+(4*hi+((lane&15)>>2))*64;
  const int NT=(q0+QB)/KVBLK;
  DMA_K(0,0);DMA_V(0,0);DMA_K(1,SLOTB);
  bf16x8 qr[4];
  #pragma unroll
  for(int d0=0;d0<4;++d0)qr[d0]=*reinterpret_cast<const bf16x8*>(&Qw[(long)r32*DM+d0*16+hi*8]);
  float mhat=0.f,l_reg=0.f;f32x16 o[4];o[0]=zero16();o[1]=zero16();o[2]=zero16();o[3]=zero16();f32x16 negm=zero16();asm volatile("":"+v"(negm));
  const int qrel=wid*QBLK+r32;
  #define CMASK(P0,P1,t) do{int jb_=(t)-(NT-4); if(jb_>=0)cmask(P0,P1,jb_,qrel,hi);}while(0)
  bool resc=false;
  #define START(P0,P1) do{ const float rm=rowmax(P0,P1); resc=false; \
    { const float dl=rm; mhat=fadd_s(mhat,dl); \
      _Pragma("unroll") for(int r=0;r<16;++r){P0[r]=fsub_s(P0[r],dl);P1[r]=fsub_s(P1[r],dl);} \
      _Pragma("unroll") for(int r=0;r<16;++r)negm[r]=-mhat; asm volatile("":"+v"(negm)); } \
    _Pragma("unroll") for(int r=0;r<16;++r)P0[r]=__builtin_amdgcn_exp2f(P0[r]); }while(0)
  #define RESC() do{ if(resc){ asm volatile("s_waitcnt lgkmcnt(0)":::"memory"); \
      _Pragma("unroll") for(int d_=0;d_<4;++d_) _Pragma("unroll") for(int r=0;r<16;++r)o[d_][r]*=wsf[crow(r,hi)]; } }while(0)
  f32x16 pA0,pA1,pB0,pB1;
  int sl_prev=0,sl_cur=0,sl_next=SLOTB;
  #define ROT() do{sl_prev=sl_cur;sl_cur=sl_next;sl_next=(sl_next==(NSLOT-1)*SLOTB)?0:sl_next+SLOTB;}while(0)
  DMA_K(2,2*SLOTB);
  WAIT_BAR(3);
  qkt(pA0,pA1,Kbase,qr,negm,r32,hi);asm volatile("s_nop 15\n\ts_nop 7":"+v"(pA0),"+v"(pA1));CMASK(pA0,pA1,0);
  START(pA0,pA1);
  _Pragma("unroll") for(int r=0;r<16;++r)pA1[r]=__builtin_amdgcn_exp2f(pA1[r]);
  WAIT_BAR(0);
  DMA_K(3,0);DMA_V(1,SLOTB);
  ROT();
  kload8(kf,kp0+sl_cur);
  WAIT_BAR(3);
  s16x4 vlo[16],vhi[16]; u32x4 pw0,pw1,pw2,pw3;
  #define PKW(P,B) cvtpk_s(P[B],P[B+1])
  #define PAF(k) __builtin_bit_cast(bf16x8,pw##k)
  #define VFR(i) (bf16x8){vlo[i][0],vlo[i][1],vlo[i][2],vlo[i][3],vhi[i][0],vhi[i][1],vhi[i][2],vhi[i][3]}
  #define PIN(x) asm volatile("":"+v"(x))
  #define MX3(a,b,c) __builtin_fmaxf(__builtin_fmaxf((a),(b)),(c))
  #define GAPA(MF,A0,A1,A2,A3,W0,W1,PW) do{ MF; sacc+=A0; sacc+=A1; sacc+=A2; sacc+=A3; PIN(sacc); W0; W1; PIN(PW); SBAR(); }while(0)
  #define EX(v) __builtin_amdgcn_exp2f(v)
  #define GAPB2(MF,X,B) do{ MF; X[B]=EX(X[B]); X[B+1]=EX(X[B+1]); PIN(X); SBAR(); }while(0)
  #define GAPB(MF,X,B) do{ MF; X[B]=EX(X[B]); X[B+1]=EX(X[B+1]); X[B+2]=EX(X[B+2]); X[B+3]=EX(X[B+3]); PIN(X); SBAR(); }while(0)
  #define VRD(i) do{ vlo[i]=vtr(vp_+(((i)>>2)*4096+((i)&3)*1024)); vhi[i]=vtr(vp_+(((i)>>2)*4096+((i)&3)*1024+512)); }while(0)
  #define KRD(G,j) do{ if(G){ kload2(kf,kp0+sl_next,j); SBAR(); } }while(0)
  #define STEP(C0,C1,P0,P1,t,GK,GV,GL) do{ SBAR(); \
    const lds_cptr vp_=vp0+2*sl_prev; \
    VRD(0); SBAR(); float sacc=(P0[0]+P0[1]); \
    GAPA(C0=__builtin_amdgcn_mfma_f32_32x32x16_bf16(kf[0],qr[0],negm,0,0,0), P0[2],P0[3],P0[4],P0[5],     pw0[0]=PKW(P0,0), pw0[1]=PKW(P0,2), pw0); \
    VRD(4); SBAR(); GAPA(C1=__builtin_amdgcn_mfma_f32_32x32x16_bf16(kf[1],qr[0],negm,0,0,0), P0[6],P0[7],P0[8],P0[9],     pw0[2]=PKW(P0,4), pw0[3]=PKW(P0,6), pw0); \
    VRD(1); SBAR(); GAPA(C0=__builtin_amdgcn_mfma_f32_32x32x16_bf16(kf[2],qr[1],C0,0,0,0),   P0[10],P0[11],P0[12],P0[13], pw1[0]=PKW(P0,8), pw1[1]=PKW(P0,10), pw1); \
    VRD(5); SBAR(); GAPA(C1=__builtin_amdgcn_mfma_f32_32x32x16_bf16(kf[3],qr[1],C1,0,0,0),   P0[14],P0[15],P1[0],P1[1],   pw1[2]=PKW(P0,12),pw1[3]=PKW(P0,14), pw1); \
    VRD(2); SBAR(); GAPA(C0=__builtin_amdgcn_mfma_f32_32x32x16_bf16(kf[4],qr[2],C0,0,0,0),   P1[2],P1[3],P1[4],P1[5],     pw2[0]=PKW(P1,0), pw2[1]=PKW(P1,2), pw2); \
    VRD(6); SBAR(); GAPA(C1=__builtin_amdgcn_mfma_f32_32x32x16_bf16(kf[5],qr[2],C1,0,0,0),   P1[6],P1[7],P1[8],P1[9],     pw2[2]=PKW(P1,4), pw2[3]=PKW(P1,6), pw2); \
    VRD(3); SBAR(); GAPA(C0=__builtin_amdgcn_mfma_f32_32x32x16_bf16(kf[6],qr[3],C0,0,0,0),   P1[10],P1[11],P1[12],P1[13], pw3[0]=PKW(P1,8), pw3[1]=PKW(P1,10), pw3); \
    VRD(7); SBAR(); GAPA(C1=__builtin_amdgcn_mfma_f32_32x32x16_bf16(kf[7],qr[3],C1,0,0,0),   P1[14],P1[15],0.f,0.f,       pw3[2]=PKW(P1,12),pw3[3]=PKW(P1,14), pw3); \
    l_reg+=sacc; \
    if(GK){DMA_K((t)+3,sl_cur);} if(GV){DMA_V((t)+1,sl_next);} \
    CMASK(C0,C1,t); \
    { float a=MX3(C0[0],C0[1],C1[0]),b=MX3(C0[2],C0[3],C1[1]); a=MX3(a,C1[2],C1[3]); \
      _Pragma("unroll") for(int r=4;r<16;r+=4){a=MX3(a,C0[r],C0[r+1]);b=MX3(b,C0[r+2],C0[r+3]);a=MX3(a,C1[r],C1[r+1]);b=MX3(b,C1[r+2],C1[r+3]);} \
      float rm=__builtin_fmaxf(a,b); { auto rr=__builtin_amdgcn_permlane32_swap(__float_as_uint(rm),__float_as_uint(rm),false,false); rm=__builtin_fmaxf(__uint_as_float(rr[0]),__uint_as_float(rr[1])); } \
      resc=false; \
      if(__builtin_expect(__any(rm>(float)THRL),0)){ const float dl=__builtin_fmaxf(rm,0.f); mhat+=dl; \
        _Pragma("unroll") for(int r=0;r<16;++r){C0[r]-=dl;C1[r]-=dl;} \
        _Pragma("unroll") for(int r=0;r<16;++r)negm[r]=-mhat; asm volatile("":"+v"(negm)); \
        const float f=__builtin_amdgcn_exp2f(-dl); l_reg*=f; if(hi==0)wsf[r32]=f; resc=true; } } \
    SBAR(); \
    VRD(8); SBAR();  GAPB2(o[0]=__builtin_amdgcn_mfma_f32_32x32x16_bf16(PAF(0),VFR(0),o[0],0,0,0), C0,0); \
    VRD(12); SBAR(); GAPB2(o[1]=__builtin_amdgcn_mfma_f32_32x32x16_bf16(PAF(0),VFR(4),o[1],0,0,0), C0,2); \
    KRD(GL,0); GAPB2(o[0]=__builtin_amdgcn_mfma_f32_32x32x16_bf16(PAF(1),VFR(1),o[0],0,0,0), C0,4); \
    KRD(GL,1); GAPB2(o[1]=__builtin_amdgcn_mfma_f32_32x32x16_bf16(PAF(1),VFR(5),o[1],0,0,0), C0,6); \
    KRD(GL,2); GAPB2(o[0]=__builtin_amdgcn_mfma_f32_32x32x16_bf16(PAF(2),VFR(2),o[0],0,0,0), C0,8); \
    KRD(GL,3); GAPB2(o[1]=__builtin_amdgcn_mfma_f32_32x32x16_bf16(PAF(2),VFR(6),o[1],0,0,0), C0,10); \
    VRD(9); SBAR();  GAPB2(o[0]=__builtin_amdgcn_mfma_f32_32x32x16_bf16(PAF(3),VFR(3),o[0],0,0,0), C0,12); \
    VRD(13); SBAR(); GAPB2(o[1]=__builtin_amdgcn_mfma_f32_32x32x16_bf16(PAF(3),VFR(7),o[1],0,0,0), C0,14); \
    VRD(10); SBAR(); GAPB2(o[2]=__builtin_amdgcn_mfma_f32_32x32x16_bf16(PAF(0),VFR(8),o[2],0,0,0), C1,0); \
    VRD(14); SBAR(); GAPB2(o[3]=__builtin_amdgcn_mfma_f32_32x32x16_bf16(PAF(0),VFR(12),o[3],0,0,0), C1,2); \
    VRD(11); SBAR(); GAPB2(o[2]=__builtin_amdgcn_mfma_f32_32x32x16_bf16(PAF(1),VFR(9),o[2],0,0,0), C1,4); \
    VRD(15); SBAR(); GAPB2(o[3]=__builtin_amdgcn_mfma_f32_32x32x16_bf16(PAF(1),VFR(13),o[3],0,0,0), C1,6); \
    GAPB2(o[2]=__builtin_amdgcn_mfma_f32_32x32x16_bf16(PAF(2),VFR(10),o[2],0,0,0), C1,8); \
    GAPB2(o[3]=__builtin_amdgcn_mfma_f32_32x32x16_bf16(PAF(2),VFR(14),o[3],0,0,0), C1,10); \
    GAPB2(o[2]=__builtin_amdgcn_mfma_f32_32x32x16_bf16(PAF(3),VFR(11),o[2],0,0,0), C1,12); \
    GAPB2(o[3]=__builtin_amdgcn_mfma_f32_32x32x16_bf16(PAF(3),VFR(15),o[3],0,0,0), C1,14); \
    }while(0)
  int t=1;
  #undef CMASK
  #define CMASK(P0,P1,t) do{}while(0)
  for(;t+5<NT;t+=2){
    STEP(pB0,pB1,pA0,pA1,t,true,true,true);     WAIT_BAR(3); RESC(); ROT();
    STEP(pA0,pA1,pB0,pB1,t+1,true,true,true);   WAIT_BAR(3); RESC(); ROT();
  }
  #undef CMASK
  #define CMASK(P0,P1,t) do{int jb_=(t)-(NT-4); if(jb_>=0)cmask(P0,P1,jb_,qrel,hi);}while(0)
  #define ENDW(tt) do{ if((tt)+3<NT){WAIT_BAR(3);} else if((tt)+2<NT){WAIT_BAR(2);} else {WAIT_BAR(0);} }while(0)
  for(;t+1<NT;t+=2){
    STEP(pB0,pB1,pA0,pA1,t,(t+3<NT),(t+1<NT),(t+1<NT));       ENDW(t);   RESC(); ROT();
    STEP(pA0,pA1,pB0,pB1,t+1,(t+4<NT),(t+2<NT),(t+2<NT));     ENDW(t+1); RESC(); ROT();
  }
  STEP(pB0,pB1,pA0,pA1,NT-1,false,false,false); RESC();
  { float sacc=pB0[0]+pB0[1]; _Pragma("unroll") for(int r=2;r<16;++r)sacc+=pB0[r]; _Pragma("unroll") for(int r=0;r<16;++r)sacc+=pB1[r]; l_reg+=sacc;
    pw0=(u32x4){PKW(pB0,0),PKW(pB0,2),PKW(pB0,4),PKW(pB0,6)};pw1=(u32x4){PKW(pB0,8),PKW(pB0,10),PKW(pB0,12),PKW(pB0,14)};pw2=(u32x4){PKW(pB1,0),PKW(pB1,2),PKW(pB1,4),PKW(pB1,6)};pw3=(u32x4){PKW(pB1,8),PKW(pB1,10),PKW(pB1,12),PKW(pB1,14)};
    SBAR(); pv(o,vb0+2*sl_cur,PAF(0),PAF(1),PAF(2),PAF(3)); }
  #undef PKW
  #undef PAF
  #undef VFR
  #undef PIN
  #undef MX3
  #undef GAPA
  #undef GAPB
  #undef GAPB2
  #undef EX
  #undef VRD
  #undef KRD
  #undef STEP
  #undef ENDW
  {auto rr=__builtin_amdgcn_permlane32_swap(__float_as_uint(l_reg),__float_as_uint(l_reg),false,false);l_reg=__uint_as_float(rr[0])+__uint_as_float(rr[1]);}
  if(hi==0)wsf[32+r32]=l_reg;asm volatile("s_waitcnt lgkmcnt(0)":::"memory");
  float rli[16];
  #pragma unroll
  for(int r=0;r<16;++r)rli[r]=__builtin_amdgcn_rcpf(wsf[32+crow(r,hi)]);
  bf16*Ow=O+(rowbase+q0+wid*QBLK)*OP+map*128;
  { bf16*stg=(bf16*)(shm+LDS_OST)+wid*2048;
    #pragma unroll
    for(int hp=0;hp<2;++hp){
    #pragma unroll
    for(int r=0;r<16;++r){const int orow=crow(r,hi);
      #pragma unroll
      for(int d0=0;d0<2;++d0)stg[orow*64+d0*32+r32]=__float2bfloat16(o[2*hp+d0][r]*rli[r]);}
    asm volatile("s_waitcnt lgkmcnt(0)":::"memory");
    #pragma unroll
    for(int i=0;i<4;++i){const int row=i*8+(lane>>3),ch=lane&7; const u32x4 v=*(const u32x4*)(stg+row*64+ch*8); ATTN_STORE16(Ow+(long)row*OP+hp*64+ch*8,v);}
    asm volatile("s_waitcnt lgkmcnt(0)":::"memory"); } }
  asm volatile("s_waitcnt lgkmcnt(0)\n\ts_barrier":::"memory");
  #undef DMA_K
  #undef DMA_V
  #undef CMASK
  #undef START
  #undef RESC
  #undef ROT
}
constexpr int ATTN_LDS_BYTES=LDS_BYTES;
struct AttnTensors { const bf16* Q; const bf16* K; const bf16* V; bf16* O; };
template<int THRL=8> __device__ __forceinline__ void attn_phase(char*lds,const AttnTensors&T,int vcu,const int wave){
  const int xcd=vcu>>5, s=vcu&31, b=xcd>>2;
  for(int c=0;c<4;++c){ const int map=4*(xcd&3)+c;
    attn_unit<THRL>(b,map,s,T.Q,T.K,T.V,T.O,lds,wave); attn_unit<THRL>(b,map,63-s,T.Q,T.K,T.V,T.O,lds,wave); }
}
#undef SBAR
#undef WAIT_BAR
}
constexpr int NWAVES = 8;
constexpr int D = 1024, MP = 32768, MS = 512, M = MP + MS, SEQ = 16384, DEPTH = 4, DFF = 2816, NUP = 2 * DFF, NIN = 8192, KBR = 2048, PLE = 256;
constexpr int DSEQ = 32, PAST = 1024, DB = 16;
constexpr float RMS_EPS = 1e-6f;
constexpr int PH_PER_LAYER = 14, NPH = 1 + DEPTH * PH_PER_LAYER;
#ifndef REP_ATT
#define REP_ATT 1
#endif
#ifndef REP_PRO
#define REP_PRO 1
#endif
#ifndef REP_ROW
#define REP_ROW 1
#endif
#ifndef REP_E2
#define REP_E2 1
#endif
#ifndef REP_LB
#define REP_LB 1
#endif
#ifndef REP_BAR
#define REP_BAR 1
#endif
#ifndef REP_SG
#define REP_SG 1
#endif
#ifndef REP_SA
#define REP_SA 1
#endif
#ifndef REP_SE2
#define REP_SE2 1
#endif
#ifndef REP_GEMM_BAR
#define REP_GEMM_BAR 0
#endif
#ifndef REP_GEMM
#define REP_GEMM 1
#endif
#ifndef MK_PER_PHASE
#define MK_PER_PHASE 0
#endif

constexpr size_t MiB = 1u << 20;
constexpr size_t WS_CTL = 0, CTL_ZERO_BYTES = 1 * MiB;
constexpr size_t WS_ROPEC = 2 * MiB, WS_ROPES = 4 * MiB;
constexpr size_t WS_W = 8 * MiB, W_LAYER = 64 * MiB;
constexpr size_t W_UP1 = 0, W_UP2 = 11 * MiB, W_DN1 = 22 * MiB, W_DN2 = 22 * MiB + 5632 * 1024, W_IN = 33 * MiB, W_BR = 49 * MiB, W_OUT = 53 * MiB, W_PG = 55 * MiB, W_PU = 57 * MiB;
constexpr size_t WS_PB = 272 * MiB, PB_LAYER = 17 * MiB;
constexpr size_t WS_XN = 344 * MiB, WS_HFF = 416 * MiB, WS_Q = 600 * MiB, WS_K = 672 * MiB, WS_V = 744 * MiB, WS_BG = 816 * MiB, WS_C = 852 * MiB, WS_ZP = 888 * MiB;
constexpr size_t WS_GS = 924 * MiB, WS_O = 1120 * MiB, WS_A2 = 1256 * MiB, WS_MG = 1392 * MiB, WS_Y = 1464 * MiB, WS_PU = 1600 * MiB, WS_YS = 1672 * MiB  , WS_END = 1680 * MiB, WS_YB = 1688 * MiB  , WS_HB = 1760 * MiB  , WS_TOP = 1828 * MiB, WS_DUMMY = 1832 * MiB  ;
static_assert(WS_XN + (size_t)M * D * 2 <= WS_HFF && WS_HFF + (size_t)M * DFF * 2 <= WS_Q && WS_GS + (size_t)M * 3072 * 2 <= WS_O && WS_O + (size_t)M * 2048 * 2 <= WS_A2 && WS_Y + (size_t)M * D * 4 <= WS_PU && WS_PU + (size_t)M * D * 2 <= WS_END, "d_ws map");
static_assert(W_PU + (size_t)D * PLE * 2 <= W_LAYER && (size_t)M * PLE * 2 <= PB_LAYER && WS_W + DEPTH * W_LAYER <= WS_PB && WS_PB + DEPTH * PB_LAYER <= WS_XN, "d_ws map 2");
constexpr int CW_TMO = 0, CW_CODE = 1, CW_BAR = 4096;
constexpr size_t O_Y = 0, O_KP = (size_t)M * D, O_VP = O_KP + (size_t)DEPTH * MP * D, O_CP = O_VP + (size_t)DEPTH * MP * D, O_PP = O_CP + (size_t)DEPTH * 2 * 2 * 512, O_KS = O_PP + (size_t)DEPTH * 2 * 15 * 512,
                 O_VS = O_KS + (size_t)DEPTH * MS * D, O_CS = O_VS + (size_t)DEPTH * MS * D, O_PS = O_CS + (size_t)DEPTH * DB * 2 * 512, O_END = O_PS + (size_t)DEPTH * DB * 15 * 512;

constexpr int RING_OFF = 0, RING_BYTES = 131072;
constexpr int LDSCTL_OFF = RING_BYTES, MISC_OFF = LDSCTL_OFF + 320;
constexpr int LDS_BYTES = 147456;
static_assert(MISC_OFF + 128 <= LDS_BYTES, "LDS map");
#define GAS __attribute__((address_space(1)))
#define LAS __attribute__((address_space(3)))
typedef unsigned short bf16;
typedef unsigned v4u __attribute__((ext_vector_type(4)));
typedef float f32x4 __attribute__((ext_vector_type(4)));
typedef short bf16x8 __attribute__((ext_vector_type(8)));
typedef GAS unsigned gu32;
typedef GAS unsigned long long gu64;
#define RLX_AGENT __ATOMIC_RELAXED, __HIP_MEMORY_SCOPE_AGENT
#define LDS_WAIT() asm volatile("s_waitcnt lgkmcnt(0)" ::: "memory")
#define VM_WAIT() asm volatile("s_waitcnt vmcnt(0)" ::: "memory")
__device__ __forceinline__ unsigned long long rt() { return __builtin_amdgcn_s_memrealtime(); }
__device__ __forceinline__ unsigned f2bf(float f) { unsigned u = __builtin_bit_cast(unsigned, f); return (u + 0x7fffu + ((u >> 16) & 1u)) >> 16; }
__device__ __forceinline__ unsigned pk2(float lo, float hi) { return f2bf(lo) | (f2bf(hi) << 16); }

#define XB_TMO      128
#define XB_XCNT(j)  (256  + 64 * (j))
#define XB_XSUB(j)  (1280 + 64 * (j))
#define XB_XGEN(j)  (2304 + 64 * (j))
#define XB_TOP      3328
#define XB_TOPGEN   3392
#define XCD_BAR_WORDS 3456
#define XB_SPIN_CAP (1u << 18)

__device__ __forceinline__ unsigned xb_ld(unsigned* p)              { return __hip_atomic_load(p, __ATOMIC_RELAXED, __HIP_MEMORY_SCOPE_AGENT); }
__device__ __forceinline__ unsigned xb_add(unsigned* p, unsigned v) { return __hip_atomic_fetch_add(p, v, __ATOMIC_RELAXED, __HIP_MEMORY_SCOPE_AGENT); }
__device__ __forceinline__ unsigned xb_xcc_id() { return (unsigned)__builtin_amdgcn_s_getreg((3 << 11) | 20) & 0xFu; }
#define XB_SPIN(cond, bar) do { unsigned _sp = 0; while (cond) { __builtin_amdgcn_s_sleep(1); \
    if ((++_sp & 255u) == 0u) { if (xb_ld(&(bar)[XB_TMO])) break; if (_sp > XB_SPIN_CAP) { atomicAdd(&(bar)[XB_TMO], 1u); break; } } } } while (0)

__device__ __forceinline__ int lane_now() { int l; asm volatile("v_mbcnt_lo_u32_b32 %0, -1, 0\n\tv_mbcnt_hi_u32_b32 %0, -1, %0" : "=v"(l)); return l; }
struct XcdBarrier {
    int wave;
    unsigned* bar; unsigned x;
    volatile LAS unsigned* st;
};

__device__ __forceinline__ XcdBarrier xcd_barrier_post(unsigned* bar, volatile LAS unsigned* st) {
    XcdBarrier b; b.wave = (int)__builtin_amdgcn_readfirstlane(threadIdx.x >> 6); b.bar = bar; b.x = xb_xcc_id(); b.st = st;
    if (threadIdx.x == 0) (void)xb_add(&bar[XB_XCNT(b.x)], 1u);
    return b;
}
__device__ __forceinline__ void xcd_barrier_complete(unsigned* bar, unsigned x, unsigned& nloc, unsigned& nx) {
    const unsigned G = gridDim.x * gridDim.y * gridDim.z;
    unsigned sum, cnt, mine, sp = 0u;
    for (;;) {
        sum = 0u; cnt = 0u; mine = 0u;
#pragma unroll
        for (unsigned j = 0; j < 16; ++j) { const unsigned c = xb_ld(&bar[XB_XCNT(j)]); sum += c; cnt += (c > 0u) ? 1u : 0u; mine = (j == x) ? c : mine; }
        if (sum == G) break;
        __builtin_amdgcn_s_sleep(1);
        if ((++sp & 255u) == 0u) { if (xb_ld(&bar[XB_TMO])) break; if (sp > XB_SPIN_CAP) { atomicAdd(&bar[XB_TMO], 1u); break; } }
    }
    nloc = mine > 0u ? mine : 1u; nx = cnt > 0u ? cnt : 1u;
}

__device__ __forceinline__ void xcd_barrier(const XcdBarrier& b) {
    asm volatile("s_waitcnt vmcnt(0)" ::: "memory");
    __syncthreads();
    if (b.wave == 0 && lane_now() == 0) {
        unsigned* bar = b.bar;
        __builtin_amdgcn_s_waitcnt(0);
        unsigned nloc = b.st[0], nx = b.st[1];
        if (nloc == 0u) { xcd_barrier_complete(bar, b.x, nloc, nx); b.st[0] = nloc; b.st[1] = nx; }
        const unsigned old = xb_add(&bar[XB_XSUB(b.x)], 1u);
        const unsigned gen = old / nloc;
        if (old + 1u == (gen + 1u) * nloc) {
            __builtin_amdgcn_fence(__ATOMIC_RELEASE, "agent");
            asm volatile("s_waitcnt vmcnt(0)" ::: "memory");
            const unsigned og = xb_add(&bar[XB_TOP], 1u);
            const unsigned tg = og / nx;
            if (og + 1u == (tg + 1u) * nx) xb_add(&bar[XB_TOPGEN], 1u);
            else XB_SPIN(xb_ld(&bar[XB_TOPGEN]) == tg, bar);
            __builtin_amdgcn_fence(__ATOMIC_ACQUIRE, "agent");
            xb_add(&bar[XB_XGEN(b.x)], 1u);
            asm volatile("s_waitcnt vmcnt(0)" ::: "memory");
        } else {
            XB_SPIN(xb_ld(&bar[XB_XGEN(b.x)]) == gen, bar);
            __builtin_amdgcn_fence(__ATOMIC_ACQUIRE, "agent");
            asm volatile("s_waitcnt vmcnt(0)" ::: "memory");
        }
    }
    __syncthreads();
}
constexpr int NSG_C = 64;
struct Frame {
    LAS unsigned char* lds;
    volatile LAS unsigned* MISC;
    gu32* ctl;
    int wave;
    int vcu, G;
    unsigned lbn;
    int sidx, pidx;
    const float* in[21]; float* out; unsigned char* ws;
};
__device__ __forceinline__ float wave_sum(float v) {
#pragma unroll
    for (int o = 1; o < 64; o <<= 1) v += __shfl_xor(v, o);
    return v;
}
__device__ __forceinline__ bf16* wsb(Frame& F, size_t off) { return (bf16*)(F.ws + off); }
__device__ __forceinline__ bf16* wlayer(Frame& F, int li, size_t off) { return (bf16*)(F.ws + WS_W + (size_t)li * W_LAYER + off); }

__device__ __forceinline__ int map_row(int kind, int n0) {
    if (kind == 1) { const int bj = n0 / DFF, rem = n0 - bj * DFF; return (rem >> 7) * 256 + bj * 128 + (rem & 127); }
    if (kind == 2) {
        if (n0 < 2048) return (n0 & ~255) + ((n0 >> 5) & 1) * 128 + ((n0 >> 6) & 3) * 32;
        if (n0 >= 3584 && n0 < 4608) { const int x = n0 >= 4096, j = n0 - (x ? 4096 : 3584); return 3584 + (j >> 7) * 256 + x * 128 + (j & 127); }
        return n0; }
    return n0;
}
__device__ __forceinline__ void p0_transpose_item(const float* W, int N, bf16* WT, int ldk, int kind, LAS float* scr, int item, int lane) {
    const int nblk = N / 32, kb = item / nblk, nb = item % nblk, k0 = 64 * kb, n0 = 32 * nb;
#pragma unroll 8
    for (int i = 0; i < 32; ++i) { const int kk = 2 * i + (lane >> 5); scr[kk * 33 + (lane & 31)] = __builtin_nontemporal_load(&W[(size_t)(k0 + kk) * N + n0 + (lane & 31)]); }
    LDS_WAIT(); asm volatile("" ::: "memory");
    const int c = lane & 7; const int r0 = map_row(kind, n0);
#pragma unroll
    for (int j = 0; j < 4; ++j) { const int n = (lane >> 3) + 8 * j; const LAS float* s = scr + (8 * c) * 33 + n;
        v4u o; o.x = pk2(s[0 * 33], s[1 * 33]); o.y = pk2(s[2 * 33], s[3 * 33]); o.z = pk2(s[4 * 33], s[5 * 33]); o.w = pk2(s[6 * 33], s[7 * 33]);
        *(GAS v4u*)(WT + (size_t)(r0 + n) * ldk + k0 + 8 * c) = o; }
    LDS_WAIT(); asm volatile("" ::: "memory");
}
__device__ __forceinline__ void p0_weff_item(const float* pool_w, const float* pool_scale, const float* wbr, bf16* WT, int item, int lane) {
    const int kb = item >> 4, nb = item & 15, k0 = kb * 8, g = k0 >> 7, c0 = k0 & 127, n = nb * 64 + lane;
    float acc[8];
#pragma unroll
    for (int i = 0; i < 8; ++i) acc[i] = 0.f;
    const float* pw = pool_w + ((size_t)g * 128 + c0) * 128; const float* ps = pool_scale + g * 128; const float* wb = wbr + (size_t)(1536 + g * 128) * D + n;
    for (int dd = 0; dd < 128; ++dd) { const float w = wb[(size_t)dd * D] * ps[dd];
#pragma unroll
        for (int i = 0; i < 8; ++i) acc[i] += pw[i * 128 + dd] * w; }
    v4u o; o.x = pk2(acc[0], acc[1]); o.y = pk2(acc[2], acc[3]); o.z = pk2(acc[4], acc[5]); o.w = pk2(acc[6], acc[7]);
    *(GAS v4u*)(WT + (size_t)n * KBR + 1536 + k0) = o;
}
__device__ __forceinline__ void norm_row(int lane, const float* yrow, const float* hin, float coef, const float* ga, float* hout, const float* gb, bf16* xnrow) {
    const GAS f32x4* hr = (const GAS f32x4*)hin + lane;
    f32x4 h[4];
#pragma unroll
    for (int j = 0; j < 4; ++j) h[j] = hr[64 * j];
    if (yrow) {
        const GAS f32x4* yr = (const GAS f32x4*)yrow + lane; f32x4 y[4]; float s = 0.f;
#pragma unroll
        for (int j = 0; j < 4; ++j) { y[j] = yr[64 * j]; s += (y[j].x * y[j].x + y[j].y * y[j].y) + (y[j].z * y[j].z + y[j].w * y[j].w); }
        const float r = coef * __builtin_amdgcn_rsqf(wave_sum(s) * (1.f / D) + RMS_EPS);
#pragma unroll
        for (int j = 0; j < 4; ++j) { const f32x4 g = ((const GAS f32x4*)ga + lane)[64 * j]; h[j] = h[j] + y[j] * r * g; }
    }
    GAS f32x4* ho = (GAS f32x4*)hout + lane;
#pragma unroll
    for (int j = 0; j < 4; ++j) ho[64 * j] = h[j];
    if (xnrow) {
        float s2 = 0.f;
#pragma unroll
        for (int j = 0; j < 4; ++j) s2 += (h[j].x * h[j].x + h[j].y * h[j].y) + (h[j].z * h[j].z + h[j].w * h[j].w);
        const float r2 = __builtin_amdgcn_rsqf(wave_sum(s2) * (1.f / D) + RMS_EPS);
        GAS unsigned long long* o8 = (GAS unsigned long long*)xnrow + lane;
#pragma unroll
        for (int j = 0; j < 4; ++j) { const f32x4 g = ((const GAS f32x4*)gb + lane)[64 * j]; const f32x4 v = h[j] * r2 * g;
            o8[64 * j] = (unsigned long long)pk2(v.x, v.y) | ((unsigned long long)pk2(v.z, v.w) << 32); }
    }
}
__device__ __forceinline__ void rope_entry(int pos, int d, float& c, float& s) {
    double inv = 1.0; for (int i = 0; i < d; ++i) inv *= 0.7498942093324559;
    const float ang = (float)pos * (float)inv; const double a = (double)ang;
    const double q = __builtin_rint(a * 0.6366197723675814);
    double y = __builtin_fma(-q, 1.5707963267948966, a); y = __builtin_fma(-q, 6.123233995736766e-17, y);
    const double y2 = y * y;
    const double sp = y * (1.0 + y2 * (-1.0 / 6.0 + y2 * (1.0 / 120.0 + y2 * (-1.0 / 5040.0 + y2 * (1.0 / 362880.0 + y2 * (-1.0 / 39916800.0 + y2 * (1.0 / 6227020800.0)))))));
    const double cp = 1.0 + y2 * (-0.5 + y2 * (1.0 / 24.0 + y2 * (-1.0 / 720.0 + y2 * (1.0 / 40320.0 + y2 * (-1.0 / 3628800.0 + y2 * (1.0 / 479001600.0 + y2 * (-1.0 / 87178291200.0)))))));
    const int qi = ((int)q) & 3;
    const double sv = (qi == 0) ? sp : (qi == 1) ? cp : (qi == 2) ? -sp : -cp;
    const double cv = (qi == 0) ? cp : (qi == 1) ? -sp : (qi == 2) ? -cp : sp;
    c = (float)cv; s = (float)sv;
}
struct RowRegs { f32x4 y[4], h[4]; };
typedef unsigned u32x2r __attribute__((ext_vector_type(2)));
__device__ __forceinline__ f32x4 bf4_to_f32(const u32x2r w) { return (f32x4){__uint_as_float(w.x << 16), __uint_as_float(w.x & 0xffff0000u), __uint_as_float(w.y << 16), __uint_as_float(w.y & 0xffff0000u)}; }
__device__ __forceinline__ void row_load(int lane, const bf16* Y, const bf16* H, int m, RowRegs& R) {
    const GAS u32x2r* yr = (const GAS u32x2r*)(Y + (size_t)m * D) + lane; const GAS u32x2r* hr = (const GAS u32x2r*)(H + (size_t)m * D) + lane;
    u32x2r yw[4], hw[4];
#pragma unroll
    for (int j = 0; j < 4; ++j) { yw[j] = yr[64 * j]; hw[j] = hr[64 * j]; }
#pragma unroll
    for (int j = 0; j < 4; ++j) { R.y[j] = bf4_to_f32(yw[j]); R.h[j] = bf4_to_f32(hw[j]); }
}
__device__ __forceinline__ void row_finish(int lane, RowRegs& R, float coef, const f32x4 (&ga)[4], const f32x4 (&gb)[4], bf16* H, bf16* XN, int m, bool write_xn, float* fin) {
    float s = 0.f;
#pragma unroll
    for (int j = 0; j < 4; ++j) s += (R.y[j].x * R.y[j].x + R.y[j].y * R.y[j].y) + (R.y[j].z * R.y[j].z + R.y[j].w * R.y[j].w);
    const float r = coef * __builtin_amdgcn_rsqf(wave_sum(s) * (1.f / D) + RMS_EPS);
    GAS unsigned long long* hb = (GAS unsigned long long*)(H + (size_t)m * D) + lane; GAS f32x4* ho = (GAS f32x4*)(fin + (size_t)m * D) + lane; float s2 = 0.f;
#pragma unroll
    for (int j = 0; j < 4; ++j) { R.h[j] = R.h[j] + R.y[j] * r * ga[j]; if (fin) ho[64 * j] = R.h[j]; else hb[64 * j] = (unsigned long long)pk2(R.h[j].x, R.h[j].y) | ((unsigned long long)pk2(R.h[j].z, R.h[j].w) << 32); s2 += (R.h[j].x * R.h[j].x + R.h[j].y * R.h[j].y) + (R.h[j].z * R.h[j].z + R.h[j].w * R.h[j].w); }
    if (write_xn) {
        const float r2 = __builtin_amdgcn_rsqf(wave_sum(s2) * (1.f / D) + RMS_EPS);
        GAS unsigned long long* o8 = (GAS unsigned long long*)(XN + (size_t)m * D) + lane;
#pragma unroll
        for (int j = 0; j < 4; ++j) { const f32x4 v = R.h[j] * r2 * gb[j]; o8[64 * j] = (unsigned long long)pk2(v.x, v.y) | ((unsigned long long)pk2(v.z, v.w) << 32); }
    }
}
__device__ __forceinline__ void norm_phase(Frame& F, float coef, const float* ga_, const float* gb_, bool write_xn, int m0, int m1, int gw, int NGW, bool dry = false, bool final_ = false) {
    const bf16* Y = (const bf16*)(F.ws + WS_YB); bf16* XN = dry ? (bf16*)(F.ws + WS_DUMMY + 160 * MiB) : wsb(F, WS_XN); const bf16* H = wsb(F, WS_HB); bf16* HO = dry ? (bf16*)(F.ws + WS_DUMMY) : wsb(F, WS_HB);
    float* fin = (final_ && !dry) ? F.out : nullptr;
    const int lane = lane_now();
    f32x4 ga[4], gb[4];
#pragma unroll
    for (int j = 0; j < 4; ++j) { ga[j] = ((const GAS f32x4*)ga_ + lane)[64 * j]; gb[j] = write_xn ? ((const GAS f32x4*)gb_ + lane)[64 * j] : (f32x4){0.f, 0.f, 0.f, 0.f}; }
    for (int m = m0 + gw; m < m1; m += 4 * NGW) {
        const int mb = m + NGW, mc = m + 2 * NGW, md = m + 3 * NGW; const bool hasb = mb < m1, hasc = mc < m1, hasd = md < m1;
        RowRegs A, B, C, E; row_load(lane, Y, H, m, A); if (hasb) row_load(lane, Y, H, mb, B); if (hasc) row_load(lane, Y, H, mc, C); if (hasd) row_load(lane, Y, H, md, E);
        row_finish(lane, A, coef, ga, gb, HO, XN, m, write_xn, fin);
        if (hasb) row_finish(lane, B, coef, ga, gb, HO, XN, mb, write_xn, fin);
        if (hasc) row_finish(lane, C, coef, ga, gb, HO, XN, mc, write_xn, fin);
        if (hasd) row_finish(lane, E, coef, ga, gb, HO, XN, md, write_xn, fin);
    }
}
__device__ __forceinline__ void norm_phase_sample(Frame& F, float coef, const float* ga_, const float* gb_, bool write_xn, const float* ysrc, int nslab, bool final_ = false) {
    const int lane = lane_now(); bf16* XN = wsb(F, WS_XN); bf16* H = wsb(F, WS_HB); float* fin = final_ ? F.out : nullptr;
    f32x4 ga[4], gb[4];
#pragma unroll
    for (int j = 0; j < 4; ++j) { ga[j] = ((const GAS f32x4*)ga_ + lane)[64 * j]; gb[j] = write_xn ? ((const GAS f32x4*)gb_ + lane)[64 * j] : (f32x4){0.f, 0.f, 0.f, 0.f}; }
    for (int r = F.sidx * NWAVES + F.wave; r < MS; r += NSG_C * NWAVES) {
        RowRegs A; const int m = MP + r;
        const GAS u32x2r* hr = (const GAS u32x2r*)(H + (size_t)m * D) + lane;
#pragma unroll
        for (int j = 0; j < 4; ++j) { A.h[j] = bf4_to_f32(hr[64 * j]); A.y[j] = (f32x4){0.f, 0.f, 0.f, 0.f}; }
        for (int sl = 0; sl < nslab; ++sl) { const GAS f32x4* yr = (const GAS f32x4*)(ysrc + (size_t)sl * MS * D + (size_t)r * D) + lane;
#pragma unroll
            for (int j = 0; j < 4; ++j) A.y[j] = A.y[j] + yr[64 * j]; }
        if (nslab == 0) { const GAS u32x2r* yr = (const GAS u32x2r*)((const bf16*)(F.ws + WS_YB) + (size_t)m * D) + lane;
#pragma unroll
            for (int j = 0; j < 4; ++j) A.y[j] = bf4_to_f32(yr[64 * j]); }
        row_finish(lane, A, coef, ga, gb, H, XN, m, write_xn, fin);
    }
}
__device__ __forceinline__ void p0_layer(Frame& F, const int li, const int gw, const int NGW, const int parts = 31) {
    LAS float* scr = (LAS float*)(F.lds + RING_OFF + F.wave * 16384);
    const int lane = lane_now();
    for (int f = 0; f < 2; ++f) {
        if (parts & 1) { const float* wu = F.in[9] + (size_t)(li * 2 + f) * D * NUP; bf16* du = wlayer(F, li, f ? W_UP2 : W_UP1);
            for (int it = gw; it < (D / 64) * (NUP / 32); it += NGW) p0_transpose_item(wu, NUP, du, D, 1, scr, it, lane); }
        if (parts & 2) { const float* wd = F.in[10] + (size_t)(li * 2 + f) * DFF * D; bf16* dd = wlayer(F, li, f ? W_DN2 : W_DN1);
            for (int it = gw; it < (DFF / 64) * (D / 32); it += NGW) p0_transpose_item(wd, D, dd, DFF, 0, scr, it, lane); }
    }
    if (parts & 4) for (int it = gw; it < (D / 64) * (NIN / 32); it += NGW) p0_transpose_item(F.in[11] + (size_t)li * D * NIN, NIN, wlayer(F, li, W_IN), D, 2, scr, it, lane);
    if (parts & 8) {
        for (int it = gw; it < (1536 / 64) * (D / 32); it += NGW) p0_transpose_item(F.in[17] + (size_t)li * KBR * D, D, wlayer(F, li, W_BR), KBR, 0, scr, it, lane);
        for (int it = gw; it < (D / 64) * (D / 32); it += NGW) p0_transpose_item(F.in[18] + (size_t)li * D * D, D, wlayer(F, li, W_OUT), D, 0, scr, it, lane);
        for (int it = gw; it < (D / 64) * (D / 32); it += NGW) p0_transpose_item(F.in[20] + (size_t)li * D * D, D, wlayer(F, li, W_PG), D, 0, scr, it, lane);
        for (int it = gw; it < (PLE / 64) * (D / 32); it += NGW) p0_transpose_item(F.in[19] + (size_t)li * PLE * D, D, wlayer(F, li, W_PU), PLE, 0, scr, it, lane);
        for (int it = gw; it < 64 * 16; it += NGW) p0_weff_item(F.in[15] + (size_t)li * 4 * 128 * 128, F.in[16] + (size_t)li * 512, F.in[17] + (size_t)li * KBR * D, wlayer(F, li, W_BR), it, lane);
    }
    if (parts & 16) { bf16* pb = (bf16*)(F.ws + WS_PB + (size_t)li * PB_LAYER);
        for (int m = gw; m < M; m += NGW) { const float* src = m < MP ? F.in[6] + ((size_t)li * MP + m) * PLE : F.in[7] + ((size_t)li * MS + (m - MP)) * PLE;
            const f32x4 v = __builtin_nontemporal_load((const GAS f32x4*)src + lane); ((GAS unsigned long long*)(pb + (size_t)m * PLE))[lane] = (unsigned long long)pk2(v.x, v.y) | ((unsigned long long)pk2(v.z, v.w) << 32); } }
}
__device__ __forceinline__ void p0_prologue(Frame& F) {
    const int gw = F.vcu * NWAVES + F.wave, NGW = F.G * NWAVES; const int lane = lane_now();
    p0_layer(F, 0, gw, NGW);
    { float* rc = (float*)(F.ws + WS_ROPEC); float* rs = (float*)(F.ws + WS_ROPES);
      for (int i = gw * 64 + lane; i < SEQ * 32; i += NGW * 64) { float c, s; rope_entry(i >> 5, i & 31, c, s); rc[i] = c; rs[i] = s; } }
    bf16* XN = wsb(F, WS_XN); bf16* HB = wsb(F, WS_HB);
    for (int m = gw; m < M; m += NGW) { const float* xr = m < MP ? F.in[0] + (size_t)m * D : F.in[1] + (size_t)(m - MP) * D;
        const GAS f32x4* xp = (const GAS f32x4*)xr + lane; f32x4 h[4]; float s2 = 0.f;
#pragma unroll
        for (int j = 0; j < 4; ++j) { h[j] = xp[64 * j]; s2 += (h[j].x * h[j].x + h[j].y * h[j].y) + (h[j].z * h[j].z + h[j].w * h[j].w); }
        const float r2 = __builtin_amdgcn_rsqf(wave_sum(s2) * (1.f / D) + RMS_EPS);
        GAS unsigned long long* hb = (GAS unsigned long long*)(HB + (size_t)m * D) + lane; GAS unsigned long long* o8 = (GAS unsigned long long*)(XN + (size_t)m * D) + lane;
#pragma unroll
        for (int j = 0; j < 4; ++j) { hb[64 * j] = (unsigned long long)pk2(h[j].x, h[j].y) | ((unsigned long long)pk2(h[j].z, h[j].w) << 32);
            const f32x4 g = ((const GAS f32x4*)F.in[8] + lane)[64 * j]; const f32x4 v = h[j] * r2 * g; o8[64 * j] = (unsigned long long)pk2(v.x, v.y) | ((unsigned long long)pk2(v.z, v.w) << 32); } }
}
__device__ __forceinline__ void unpack8f(const v4u w, float (&f)[8]) {
    f[0] = __uint_as_float(w.x << 16); f[1] = __uint_as_float(w.x & 0xffff0000u); f[2] = __uint_as_float(w.y << 16); f[3] = __uint_as_float(w.y & 0xffff0000u);
    f[4] = __uint_as_float(w.z << 16); f[5] = __uint_as_float(w.z & 0xffff0000u); f[6] = __uint_as_float(w.w << 16); f[7] = __uint_as_float(w.w & 0xffff0000u); }
__device__ __forceinline__ v4u pack8f(const float (&f)[8]) { v4u o; o.x = pk2(f[0], f[1]); o.y = pk2(f[2], f[3]); o.z = pk2(f[4], f[5]); o.w = pk2(f[6], f[7]); return o; }
__device__ __forceinline__ void e2_phase(Frame& F, int li, int m0, int m1, int gw, int NGW) {
    const int lane = lane_now();
    const float* lam = F.in[12] + li * 256;
    const float s1 = wave_sum(lam[lane] * lam[64 + lane]), s2 = wave_sum(lam[128 + lane] * lam[192 + lane]);
    const float lam_init = 0.8f - 0.6f * __expf(-0.3f * (float)li);
    const float lam_full = __expf(s1) - __expf(s2) + lam_init, osc = 1.0f - lam_init;
    const bf16* O = wsb(F, WS_O); const bf16* BG = wsb(F, WS_BG); const bf16* C = wsb(F, WS_C); const bf16* ZP = wsb(F, WS_ZP); bf16* A2 = wsb(F, WS_A2);
    const int hh = lane >> 3, e0 = (lane & 7) * 16, c0 = lane * 8, grp = lane >> 4, win = 2 << grp;
    float sg[16];
#pragma unroll
    for (int i = 0; i < 16; ++i) sg[i] = F.in[13][li * 1024 + hh * 128 + e0 + i];
    float cw[3][8];
#pragma unroll
    for (int j = 0; j < 3; ++j)
#pragma unroll
        for (int i = 0; i < 8; ++i) cw[j][i] = F.in[14][(li * 3 + j) * 512 + c0 + i];
    for (int m = m0 + gw; m < m1; m += NGW) {
        const bool samp = m >= MP; const int t = samp ? ((m - MP) & 31) : (m & (SEQ - 1)); const int b = samp ? ((m - MP) >> 5) : (m >> 14); const int T = samp ? DSEQ : SEQ;
        { const bf16* orow = O + (size_t)m * 2048 + hh * 256 + e0;
          float o1[16], o2[16]; { float t8[8]; unpack8f(*(const GAS v4u*)orow, t8); for (int i = 0; i < 8; ++i) o1[i] = t8[i]; unpack8f(*(const GAS v4u*)(orow + 8), t8); for (int i = 0; i < 8; ++i) o1[8 + i] = t8[i];
              unpack8f(*(const GAS v4u*)(orow + 128), t8); for (int i = 0; i < 8; ++i) o2[i] = t8[i]; unpack8f(*(const GAS v4u*)(orow + 136), t8); for (int i = 0; i < 8; ++i) o2[8 + i] = t8[i]; }
          float ss = 0.f;
#pragma unroll
          for (int i = 0; i < 16; ++i) { o1[i] = o1[i] - lam_full * o2[i]; ss += o1[i] * o1[i]; }
          ss += __shfl_xor(ss, 1); ss += __shfl_xor(ss, 2); ss += __shfl_xor(ss, 4);
          const float r = __builtin_amdgcn_rsqf(ss * (1.f / 128.f) + RMS_EPS) * osc;
          float a0[8], a1[8];
#pragma unroll
          for (int i = 0; i < 8; ++i) { a0[i] = o1[i] * r * sg[i]; a1[i] = o1[8 + i] * r * sg[8 + i]; }
          bf16* arow = A2 + (size_t)m * KBR + hh * 128 + e0; *(GAS v4u*)arow = pack8f(a0); *(GAS v4u*)(arow + 8) = pack8f(a1); }
        { float z0[8], z1[8], z2[8], bgv[8];
          unpack8f(*(const GAS v4u*)(C + (size_t)m * 512 + c0), z0); unpack8f(*(const GAS v4u*)(BG + (size_t)m * 512 + c0), bgv);
          const float* hist = F.in[4] + ((size_t)(li * DB + b) * 2) * 512 + c0;
          if (t >= 1) unpack8f(*(const GAS v4u*)(C + (size_t)(m - 1) * 512 + c0), z1);
          else { for (int i = 0; i < 8; ++i) z1[i] = samp ? hist[512 + i] : 0.f; }
          if (t >= 2) unpack8f(*(const GAS v4u*)(C + (size_t)(m - 2) * 512 + c0), z2);
          else { for (int i = 0; i < 8; ++i) z2[i] = samp ? hist[t * 512 + i] : 0.f; }
          float y[8];
#pragma unroll
          for (int i = 0; i < 8; ++i) y[i] = bgv[i] * (cw[0][i] * z2[i] + cw[1][i] * z1[i] + cw[2][i] * z0[i]);
          *(GAS v4u*)(A2 + (size_t)m * KBR + 1024 + c0) = pack8f(y);
          if (t >= T - 2) { float* dst = samp ? F.out + O_CS + ((size_t)(li * DB + b) * 2 + (t - (T - 2))) * 512 + c0 : F.out + O_CP + ((size_t)(li * 2 + b) * 2 + (t - (T - 2))) * 512 + c0;
              *(GAS f32x4*)dst = (f32x4){z0[0], z0[1], z0[2], z0[3]}; *(GAS f32x4*)(dst + 4) = (f32x4){z0[4], z0[5], z0[6], z0[7]}; } }
        { float zc[8], ws8[8]; unpack8f(*(const GAS v4u*)(ZP + (size_t)m * 512 + c0), zc);
#pragma unroll
          for (int i = 0; i < 8; ++i) ws8[i] = zc[i];
          if (t >= 15) {
              v4u zr[15];
#pragma unroll
              for (int j = 1; j < 16; ++j) { const int jj = j < win ? j : win - 1; zr[j - 1] = *(const GAS v4u*)(ZP + (size_t)(m - jj) * 512 + c0); }
#pragma unroll
              for (int j = 1; j < 16; ++j) { float zz[8]; unpack8f(zr[j - 1], zz); const float wj = j < win ? 1.f : 0.f;
#pragma unroll
                  for (int q = 0; q < 8; ++q) ws8[q] += wj * zz[q]; }
          } else {
          const float* phist = F.in[5] + ((size_t)(li * DB + b) * 15) * 512 + c0;
          for (int j = 1; j < 16; ++j) { if (j < win) { const int i = t - j;
                  if (i >= 0) { float zz[8]; unpack8f(*(const GAS v4u*)(ZP + (size_t)(m - j) * 512 + c0), zz);
#pragma unroll
                      for (int q = 0; q < 8; ++q) ws8[q] += zz[q]; }
                  else if (samp) { const float* hp = phist + (size_t)(15 + i) * 512;
#pragma unroll
                      for (int q = 0; q < 8; ++q) ws8[q] += hp[q]; } } }
          }
          const int cnt = min(t + 1 + (samp ? 15 : 0), win); const float rc = 1.0f / (float)cnt;
          float dv[8];
#pragma unroll
          for (int i = 0; i < 8; ++i) dv[i] = ws8[i] * rc - zc[i];
          *(GAS v4u*)(A2 + (size_t)m * KBR + 1536 + c0) = pack8f(dv);
          if (t >= T - 15) { float* dst = samp ? F.out + O_PS + ((size_t)(li * DB + b) * 15 + (t - (T - 15))) * 512 + c0 : F.out + O_PP + ((size_t)(li * 2 + b) * 15 + (t - (T - 15))) * 512 + c0;
              *(GAS f32x4*)dst = (f32x4){zc[0], zc[1], zc[2], zc[3]}; *(GAS f32x4*)(dst + 4) = (f32x4){zc[4], zc[5], zc[6], zc[7]}; } }
    }
}
typedef float f32x16 __attribute__((ext_vector_type(16)));
__device__ __forceinline__ bf16x8 cvt8(const f32x4 a, const f32x4 b) { v4u w; w.x = pk2(a.x, a.y); w.y = pk2(a.z, a.w); w.z = pk2(b.x, b.y); w.w = pk2(b.z, b.w); return __builtin_bit_cast(bf16x8, w); }
__device__ __forceinline__ int crow16(int r, int hi) { return (r & 3) + 8 * (r >> 2) + 4 * hi; }
__device__ __forceinline__ void sattn_unit(Frame& F, int li, int b, int head) {
    const int lane = lane_now(), wid = F.wave, r32 = lane & 31, hi = lane >> 5;
    LAS float* Lmx = (LAS float*)(F.lds + LDSCTL_OFF + 1024);
    LAS float* Lsum = (LAS float*)(F.lds + LDSCTL_OFF + 3072);
    const bf16* Qs = wsb(F, WS_Q) + (size_t)(MP + b * DSEQ) * D;
    const float* kc = F.in[2] + ((size_t)(li * DB + b) * PAST) * D; const float* vc = F.in[3] + ((size_t)(li * DB + b) * PAST) * D;
    const float* kn = F.out + O_KS + ((size_t)li * MS + b * DSEQ) * D; const float* vn = F.out + O_VS + ((size_t)li * MS + b * DSEQ) * D;
    bf16x8 qr[2][4];
#pragma unroll
    for (int mm = 0; mm < 2; ++mm)
#pragma unroll
        for (int d0 = 0; d0 < 4; ++d0) qr[mm][d0] = *(const GAS bf16x8*)(Qs + (size_t)r32 * D + (2 * head + mm) * 64 + d0 * 16 + hi * 8);
    const int nblk = (wid == 0) ? 5 : 4;
    f32x16 o[2][4];
#pragma unroll
    for (int mm = 0; mm < 2; ++mm)
#pragma unroll
        for (int eb = 0; eb < 4; ++eb) o[mm][eb] = (f32x16){};
    float lsum[2] = {0.f, 0.f}, mrun[2] = {-1e30f, -1e30f};
    for (int i = 0; i < nblk; ++i) { const int blk = (i < 4) ? wid + 8 * i : 32; const float* kb = (blk < 32) ? kc + (size_t)(blk * 32) * D : kn; const float* vb = (blk < 32) ? vc + (size_t)(blk * 32) * D : vn;
        f32x16 s[2];
#pragma unroll
        for (int mm = 0; mm < 2; ++mm) { s[mm] = (f32x16){};
#pragma unroll
            for (int d0 = 0; d0 < 4; ++d0) { const float* kp = kb + (size_t)r32 * D + (2 * head + mm) * 64 + d0 * 16 + hi * 8; const bf16x8 kf = cvt8(__builtin_nontemporal_load((const GAS f32x4*)kp), __builtin_nontemporal_load((const GAS f32x4*)(kp + 4)));
                s[mm] = __builtin_amdgcn_mfma_f32_32x32x16_bf16(kf, qr[mm][d0], s[mm], 0, 0, 0); } }
        bf16x8 pf[2][2];
#pragma unroll
        for (int mm = 0; mm < 2; ++mm) {
            float mloc = s[mm][0];
#pragma unroll
            for (int r = 1; r < 16; ++r) mloc = fmaxf(mloc, s[mm][r]);
            mloc = fmaxf(mloc, __shfl_xor(mloc, 32));
            const float mnew = fmaxf(mrun[mm], mloc), sc = __builtin_amdgcn_exp2f(mrun[mm] - mnew); mrun[mm] = mnew;
            lsum[mm] *= sc;
#pragma unroll
            for (int eb = 0; eb < 4; ++eb)
#pragma unroll
                for (int r = 0; r < 16; ++r) o[mm][eb][r] *= sc;
            float acc = 0.f;
#pragma unroll
            for (int r = 0; r < 16; ++r) { s[mm][r] = __builtin_amdgcn_exp2f(s[mm][r] - mnew); acc += s[mm][r]; }
            lsum[mm] += acc;
#pragma unroll
            for (int k2 = 0; k2 < 2; ++k2) pf[mm][k2] = cvt8((f32x4){s[mm][8 * k2], s[mm][8 * k2 + 1], s[mm][8 * k2 + 2], s[mm][8 * k2 + 3]}, (f32x4){s[mm][8 * k2 + 4], s[mm][8 * k2 + 5], s[mm][8 * k2 + 6], s[mm][8 * k2 + 7]}); }
#pragma unroll
        for (int eb = 0; eb < 4; ++eb)
#pragma unroll
            for (int k2 = 0; k2 < 2; ++k2) { const float* vp = vb + (size_t)(16 * k2 + 4 * hi) * D + head * 128 + eb * 32 + r32;
                const GAS float* vq = (const GAS float*)vp; const f32x4 va = {__builtin_nontemporal_load(vq), __builtin_nontemporal_load(vq + D), __builtin_nontemporal_load(vq + 2 * D), __builtin_nontemporal_load(vq + 3 * D)}, vb4 = {__builtin_nontemporal_load(vq + 8 * D), __builtin_nontemporal_load(vq + 9 * D), __builtin_nontemporal_load(vq + 10 * D), __builtin_nontemporal_load(vq + 11 * D)}; const bf16x8 vf = cvt8(va, vb4);
                o[0][eb] = __builtin_amdgcn_mfma_f32_32x32x16_bf16(vf, pf[0][k2], o[0][eb], 0, 0, 0); o[1][eb] = __builtin_amdgcn_mfma_f32_32x32x16_bf16(vf, pf[1][k2], o[1][eb], 0, 0, 0); } }
#pragma unroll
    for (int mm = 0; mm < 2; ++mm) { lsum[mm] += __shfl_xor(lsum[mm], 32); if (hi == 0) { Lmx[(mm * 8 + wid) * 32 + r32] = mrun[mm]; Lsum[(mm * 8 + wid) * 32 + r32] = lsum[mm]; } }
    __syncthreads();
#pragma unroll
    for (int mm = 0; mm < 2; ++mm) { float M = Lmx[(mm * 8) * 32 + r32];
#pragma unroll
        for (int w = 1; w < 8; ++w) M = fmaxf(M, Lmx[(mm * 8 + w) * 32 + r32]);
        const float f = __builtin_amdgcn_exp2f(mrun[mm] - M);
#pragma unroll
        for (int eb = 0; eb < 4; ++eb)
#pragma unroll
            for (int r = 0; r < 16; ++r) o[mm][eb][r] *= f; }
    LAS float* Lw = (LAS float*)(F.lds + RING_OFF) + wid * 4096;
#pragma unroll
    for (int mm = 0; mm < 2; ++mm) {
        __syncthreads();
#pragma unroll
        for (int eb = 0; eb < 4; ++eb)
#pragma unroll
            for (int r = 0; r < 16; ++r) Lw[(eb * 32 + crow16(r, hi)) * 32 + r32] = o[mm][eb][r];
        __syncthreads();
        { const int q = lane & 31, e0 = (wid * 2 + (lane >> 5)) * 8; float L = 0.f;
          float Mq = Lmx[(mm * 8) * 32 + q];
#pragma unroll
          for (int w = 1; w < 8; ++w) Mq = fmaxf(Mq, Lmx[(mm * 8 + w) * 32 + q]);
#pragma unroll
          for (int w = 0; w < 8; ++w) L += Lsum[(mm * 8 + w) * 32 + q] * __builtin_amdgcn_exp2f(Lmx[(mm * 8 + w) * 32 + q] - Mq);
          const float inv = 1.0f / L; float v[8];
#pragma unroll
          for (int i = 0; i < 8; ++i) { float a = 0.f;
#pragma unroll
              for (int w = 0; w < 8; ++w) a += ((LAS float*)(F.lds + RING_OFF))[w * 4096 + (e0 + i) * 32 + q];
              v[i] = a * inv; }
          bf16* orow = wsb(F, WS_O) + (size_t)(MP + b * DSEQ + q) * 2048 + (2 * head + mm) * 128 + e0; *(GAS v4u*)orow = pack8f(v); }
    }
    __syncthreads();
}
#ifndef KEEP_UP
#define KEEP_UP 1
#endif
#ifndef KEEP_DOWN
#define KEEP_DOWN 1
#endif
#ifndef KEEP_N1
#define KEEP_N1 1
#endif
#ifndef KEEP_WIN
#define KEEP_WIN 1
#endif
#ifndef KEEP_ATT
#define KEEP_ATT 1
#endif
#ifndef KEEP_E2
#define KEEP_E2 1
#endif
#ifndef KEEP_BR
#define KEEP_BR 1
#endif
#ifndef KEEP_WOUT
#define KEEP_WOUT 1
#endif
#ifndef KEEP_N3
#define KEEP_N3 1
#endif
#ifndef KEEP_PG
#define KEEP_PG 1
#endif
#ifndef KEEP_N5
#define KEEP_N5 1
#endif
#ifndef KEEP_PRO
#define KEEP_PRO 1
#endif
struct Args { const float* in[21]; float* out; unsigned char* ws; int ph_lo, ph_hi; };
#if !MK_PER_PHASE
#define GRID_BAR() do { for (int rb_ = 0; rb_ < REP_BAR; ++rb_) xcd_barrier(bar); } while (0)
#else
#define GRID_BAR() do { if (F.wave == 0 && lane_now() == 0) __hip_atomic_store(F.ctl + CW_TMO, 0xBADBA0u, RLX_AGENT); } while (0)
#endif
#define IN(k) (lo <= (k) && (k) < hi)
#define SEAM(k) do { if (IN(k) && IN((k) + 1)) GRID_BAR(); } while (0)
__device__ __forceinline__ unsigned long long uni64_opaque(unsigned long long v) { unsigned lo = __builtin_amdgcn_readfirstlane((unsigned)v), hi = __builtin_amdgcn_readfirstlane((unsigned)(v >> 32)); asm volatile("" : "+s"(lo), "+s"(hi)); return ((unsigned long long)hi << 32) | lo; }
#define FRESH() do { F.ws = (unsigned char*)(GAS unsigned char*)uni64_opaque((unsigned long long)F.ws); F.out = (float*)(GAS float*)uni64_opaque((unsigned long long)F.out); } while (0)
#define RING (F.lds + RING_OFF)
constexpr int NSG = 64, NPG = 192;
constexpr int CW_GRP = 8192, CW_GRP_TMO = 8256;
constexpr int LB_PER_LAYER = 9;
__device__ __forceinline__ void group_barrier1(Frame& F, const unsigned n) {
    asm volatile("s_waitcnt vmcnt(0)" ::: "memory");
    __syncthreads();
    if (F.wave == 0 && lane_now() == 0) {
        __builtin_amdgcn_s_waitcnt(0);
        __builtin_amdgcn_fence(__ATOMIC_RELEASE, "agent");
        asm volatile("s_waitcnt vmcnt(0)" ::: "memory");
        gu32* c = F.ctl + CW_GRP; const unsigned target = (unsigned)NSG * (n + 1u);
        (void)__hip_atomic_fetch_add(c, 1u, RLX_AGENT);
        unsigned sp = 0u;
        while (__hip_atomic_load(c, RLX_AGENT) < target) { __builtin_amdgcn_s_sleep(1);
            if ((++sp & 255u) == 0u) { if (__hip_atomic_load(F.ctl + CW_GRP_TMO, RLX_AGENT)) break; if (sp > (1u << 20)) { __hip_atomic_store(F.ctl + CW_GRP_TMO, 1u, RLX_AGENT); break; } } }
        __builtin_amdgcn_fence(__ATOMIC_ACQUIRE, "agent");
        asm volatile("s_waitcnt vmcnt(0)" ::: "memory");
    }
    __syncthreads();
}
__device__ __forceinline__ void group_barrier(Frame& F) { for (unsigned r = 0; r < REP_LB; ++r) group_barrier1(F, F.lbn++); }
#define OPAQUE_K(name, val) int name = (val); asm volatile("" : "+s"(name))
#define SAMPLE (F.sidx >= 0)
template <int LI, int HALF> __device__ __forceinline__ void ffn_part(Frame& F, const XcdBarrier& bar, const int lo, const int hi) {
    constexpr int pb = 1 + LI * PH_PER_LAYER, p0 = pb + HALF * 9;
    if (KEEP_UP && IN(p0)) { FRESH(); pg8::Gemm g{wsb(F, WS_XN), wlayer(F, LI, HALF ? W_UP2 : W_UP1), MP, NUP, D}; pg8::StaticOrder S; S.init(MP, NUP, F.G, (int)blockIdx.x);
        pg8::EpiSwiGLU E{wsb(F, WS_HFF), DFF};
        for (int rep = 0; rep < REP_GEMM; ++rep) { if (rep && REP_GEMM_BAR) GRID_BAR(); pg8::gemm_phase<pg8::EpiSwiGLU, pg8::StaticOrder, true, true>(RING, g, S, E, F.wave); } SEAM(p0); }
    if (KEEP_DOWN && IN(p0 + 1)) { FRESH(); { pg8::Gemm g{wsb(F, WS_HFF), wlayer(F, LI, HALF ? W_DN2 : W_DN1), MP, D, DFF}; pg8::StaticOrder S; S.init(MP, D, F.G, (int)blockIdx.x);
        pg8::EpiBf E{wsb(F, WS_YB), D};
        for (int rep = 0; rep < REP_GEMM; ++rep) { if (rep && REP_GEMM_BAR) GRID_BAR(); pg8::gemm_phase<pg8::EpiBf, pg8::StaticOrder, true, true>(RING, g, S, E, F.wave); } } }
    if (KEEP_DOWN && IN(p0 + 1)) {
        if (HALF == 1) { FRESH(); OPAQUE_K(kple, PLE);
            pg8::Gemm g2{(const bf16*)(F.ws + WS_PB + (size_t)LI * PB_LAYER), wlayer(F, LI, W_PU), MP, D, kple}; pg8::StaticOrder S2; S2.init(MP, D, F.G, (int)blockIdx.x);
            pg8::EpiBf E2{wsb(F, WS_PU), D};
            for (int rep = 0; rep < REP_GEMM; ++rep) { if (rep && REP_GEMM_BAR) GRID_BAR(); pg8::gemm_phase<pg8::EpiBf, pg8::StaticOrder, true, true>(RING, g2, S2, E2, F.wave); } }
        SEAM(p0 + 1); }
    if (KEEP_N1 && IN(p0 + 2) && !SAMPLE) { FRESH(); const float* ng = F.in[8] + (size_t)LI * 8 * D; for (int rep = 0; rep < REP_ROW; ++rep) norm_phase(F, 0.5f, ng + (HALF ? 5 : 1) * D, ng + (HALF ? 6 : 2) * D, true, 0, MP, F.pidx * NWAVES + F.wave, NPG * NWAVES, rep + 1 < REP_ROW);
        if (HALF == 0 && LI + 1 < DEPTH) p0_layer(F, LI + 1 < DEPTH ? LI + 1 : LI, F.pidx * NWAVES + F.wave, NPG * NWAVES, 16); }
    if (KEEP_N1 && IN(p0 + 2) && SAMPLE && (HALF == 1 || LI == 0)) { FRESH(); OPAQUE_K(kd, D); pg8::Gemm g{wsb(F, WS_XN), wlayer(F, LI, HALF ? W_UP2 : W_UP1), M, NUP, kd}; pg8::SampleOrder S; S.init(NUP, NSG, F.sidx);
        pg8::EpiSwiGLU E{wsb(F, WS_HFF), DFF};
        for (int rs_ = 0; rs_ < REP_SG; ++rs_) pg8::gemm_phase<pg8::EpiSwiGLU, pg8::SampleOrder, true, true>(RING, g, S, E, F.wave); group_barrier(F); }
    if (KEEP_N1 && IN(p0 + 2) && SAMPLE) { FRESH(); OPAQUE_K(kf, DFF); pg8::Gemm g{wsb(F, WS_HFF), wlayer(F, LI, HALF ? W_DN2 : W_DN1), M, D, kf}; pg8::SampleSplitOrder S; S.init(D, NSG, F.sidx);
        pg8::EpiF32Slab E{(float*)(F.ws + WS_YS)};
        for (int rs_ = 0; rs_ < REP_SG; ++rs_) pg8::gemm_phase<pg8::EpiF32Slab, pg8::SampleSplitOrder, true, true>(RING, g, S, E, F.wave); }
    if (KEEP_N1 && IN(p0 + 2) && SAMPLE && HALF == 1) { FRESH(); OPAQUE_K(kple, PLE);
        pg8::Gemm g2{(const bf16*)(F.ws + WS_PB + (size_t)LI * PB_LAYER), wlayer(F, LI, W_PU), M, D, kple}; pg8::SampleOrder S2; S2.init(D, NSG, (F.sidx + NSG - 32) % NSG);
        pg8::EpiBf E2{wsb(F, WS_PU), D};
        for (int rs_ = 0; rs_ < REP_SG; ++rs_) pg8::gemm_phase<pg8::EpiBf, pg8::SampleOrder, true, true>(RING, g2, S2, E2, F.wave); }
    if (KEEP_N1 && IN(p0 + 2) && SAMPLE) { FRESH(); group_barrier(F); const float* ng = F.in[8] + (size_t)LI * 8 * D;
        norm_phase_sample(F, 0.5f, ng + (HALF ? 5 : 1) * D, ng + (HALF ? 6 : 2) * D, true, (const float*)(F.ws + WS_YS), 4); }
    if (KEEP_N1 && IN(p0 + 2) && SAMPLE && HALF == 0) { FRESH(); group_barrier(F); OPAQUE_K(kd, D); pg8::Gemm g{wsb(F, WS_XN), wlayer(F, LI, W_IN), M, NIN, kd}; pg8::SampleOrder S; S.init(NIN, NSG, F.sidx);
        pg8::EpiWin E{wsb(F, WS_Q), wsb(F, WS_K), wsb(F, WS_V), wsb(F, WS_BG), wsb(F, WS_C), wsb(F, WS_ZP), wsb(F, WS_GS), (const float*)(F.ws + WS_ROPEC), (const float*)(F.ws + WS_ROPES),
                      F.out + O_KP + (size_t)LI * MP * D, F.out + O_VP + (size_t)LI * MP * D, F.out + O_KS + (size_t)LI * MS * D, F.out + O_VS + (size_t)LI * MS * D};
        for (int rs_ = 0; rs_ < REP_SG; ++rs_) pg8::gemm_phase<pg8::EpiWin, pg8::SampleOrder, true, true>(RING, g, S, E, F.wave); }
    if (IN(p0 + 2)) SEAM(p0 + 2);
}
template <int LI> __device__ __forceinline__ void mixer_part(Frame& F, const XcdBarrier& bar, const int lo, const int hi) {
    constexpr int pb = 1 + LI * PH_PER_LAYER;
    if (KEEP_WIN && IN(pb + 3)) { FRESH(); pg8::Gemm g{wsb(F, WS_XN), wlayer(F, LI, W_IN), MP, NIN, D}; pg8::StaticOrder S; S.init(MP, NIN, F.G, (int)blockIdx.x);
        pg8::EpiWin E{wsb(F, WS_Q), wsb(F, WS_K), wsb(F, WS_V), wsb(F, WS_BG), wsb(F, WS_C), wsb(F, WS_ZP), wsb(F, WS_GS), (const float*)(F.ws + WS_ROPEC), (const float*)(F.ws + WS_ROPES),
                      F.out + O_KP + (size_t)LI * MP * D, F.out + O_VP + (size_t)LI * MP * D, F.out + O_KS + (size_t)LI * MS * D, F.out + O_VS + (size_t)LI * MS * D};
        for (int rep = 0; rep < REP_GEMM; ++rep) { if (rep && REP_GEMM_BAR) GRID_BAR(); pg8::gemm_phase<pg8::EpiWin, pg8::StaticOrder, true, true>(RING, g, S, E, F.wave); } SEAM(pb + 3); }
    if (KEEP_ATT && IN(pb + 4)) { FRESH();
        const attn_body::AttnTensors AT{(const attn_body::bf16*)wsb(F, WS_Q), (const attn_body::bf16*)wsb(F, WS_K), (const attn_body::bf16*)wsb(F, WS_V), (attn_body::bf16*)wsb(F, WS_O)};
        for (int rep = 0; rep < REP_ATT; ++rep)
        for (int v = F.vcu; v < 256; v += F.G) attn_body::attn_phase<8>((char*)RING, AT, v, F.wave);
        SEAM(pb + 4); }
    if (KEEP_E2 && IN(pb + 5) && !SAMPLE) { FRESH(); for (int rep = 0; rep < REP_E2; ++rep) e2_phase(F, LI, 0, MP, F.pidx * NWAVES + F.wave, NPG * NWAVES);
        if (LI + 1 < DEPTH) p0_layer(F, LI + 1 < DEPTH ? LI + 1 : LI, F.pidx * NWAVES + F.wave, NPG * NWAVES, 1); }
    if (KEEP_E2 && IN(pb + 5) && SAMPLE) { FRESH(); for (int rs_ = 0; rs_ < REP_SA; ++rs_) for (int su = F.sidx; su < DB * 8; su += NSG) sattn_unit(F, LI, su >> 3, su & 7); group_barrier(F); }
    if (KEEP_E2 && IN(pb + 5) && SAMPLE) { FRESH(); for (int rs_ = 0; rs_ < REP_SE2; ++rs_) e2_phase(F, LI, MP, M, F.sidx * NWAVES + F.wave, NSG * NWAVES); }
    if (IN(pb + 5)) SEAM(pb + 5);
    if (KEEP_BR && IN(pb + 6)) { FRESH(); pg8::Gemm g{wsb(F, WS_A2), wlayer(F, LI, W_BR), MP, D, KBR}; pg8::SegOrder S; S.init(MP, D, F.G, (int)blockIdx.x);
        pg8::EpiSeg E{wsb(F, WS_GS), (float*)(F.ws + WS_Y), wsb(F, WS_MG)};
        for (int rep = 0; rep < REP_GEMM; ++rep) { if (rep && REP_GEMM_BAR) GRID_BAR(); pg8::gemm_phase<pg8::EpiSeg, pg8::SegOrder, true, true>(RING, g, S, E, F.wave); } SEAM(pb + 6); }
    if (KEEP_WOUT && IN(pb + 7)) { FRESH(); pg8::Gemm g{wsb(F, WS_MG), wlayer(F, LI, W_OUT), MP, D, D}; pg8::StaticOrder S; S.init(MP, D, F.G, (int)blockIdx.x);
        pg8::EpiBf E{wsb(F, WS_YB), D};
        for (int rep = 0; rep < REP_GEMM; ++rep) { if (rep && REP_GEMM_BAR) GRID_BAR(); pg8::gemm_phase<pg8::EpiBf, pg8::StaticOrder, true, true>(RING, g, S, E, F.wave); } SEAM(pb + 7); }
    if (KEEP_N3 && IN(pb + 8) && !SAMPLE) { FRESH(); const float* ng = F.in[8] + (size_t)LI * 8 * D; for (int rep = 0; rep < REP_ROW; ++rep) norm_phase(F, 1.0f, ng + 3 * D, ng + 4 * D, true, 0, MP, F.pidx * NWAVES + F.wave, NPG * NWAVES, rep + 1 < REP_ROW);
        if (LI + 1 < DEPTH) p0_layer(F, LI + 1 < DEPTH ? LI + 1 : LI, F.pidx * NWAVES + F.wave, NPG * NWAVES, 4 | 8); }
    if (KEEP_N3 && IN(pb + 8) && SAMPLE) { FRESH(); pg8::Gemm g{wsb(F, WS_A2), wlayer(F, LI, W_BR), M, D, KBR}; pg8::SampleSegOrder S; S.init(D, NSG, F.sidx);
        pg8::EpiSeg E{wsb(F, WS_GS), (float*)(F.ws + WS_Y), wsb(F, WS_MG)};
        for (int rs_ = 0; rs_ < REP_SG; ++rs_) pg8::gemm_phase<pg8::EpiSeg, pg8::SampleSegOrder, true, true>(RING, g, S, E, F.wave); group_barrier(F); }
    if (KEEP_N3 && IN(pb + 8) && SAMPLE) { FRESH(); OPAQUE_K(kd, D); pg8::Gemm g{wsb(F, WS_MG), wlayer(F, LI, W_OUT), M, D, kd}; pg8::SampleOrder S; S.init(D, NSG, F.sidx);
        pg8::EpiBf E{wsb(F, WS_YB), D};
        for (int rs_ = 0; rs_ < REP_SG; ++rs_) pg8::gemm_phase<pg8::EpiBf, pg8::SampleOrder, true, true>(RING, g, S, E, F.wave); group_barrier(F); }
    if (KEEP_N3 && IN(pb + 8) && SAMPLE) { FRESH(); const float* ng = F.in[8] + (size_t)LI * 8 * D; norm_phase_sample(F, 1.0f, ng + 3 * D, ng + 4 * D, true, nullptr, 0); }
    if (IN(pb + 8)) SEAM(pb + 8);
}
template <int LI> __device__ __forceinline__ void ple_part(Frame& F, const XcdBarrier& bar, const int lo, const int hi) {
    constexpr int pb = 1 + LI * PH_PER_LAYER;
    if (KEEP_PG && IN(pb + 12)) { FRESH(); pg8::Gemm g{wsb(F, WS_XN), wlayer(F, LI, W_PG), MP, D, D}; pg8::StaticOrder S; S.init(MP, D, F.G, (int)blockIdx.x);
        pg8::EpiPle E{wsb(F, WS_YB), wsb(F, WS_PU), D};
        for (int rep = 0; rep < REP_GEMM; ++rep) { if (rep && REP_GEMM_BAR) GRID_BAR(); pg8::gemm_phase<pg8::EpiPle, pg8::StaticOrder, true, true>(RING, g, S, E, F.wave); } SEAM(pb + 12); }
    if (KEEP_N5 && IN(pb + 13) && !SAMPLE) { FRESH(); const float* ng = F.in[8] + (size_t)LI * 8 * D; for (int rep = 0; rep < REP_ROW; ++rep) norm_phase(F, 1.0f, ng + 7 * D, ng + 8 * D, LI + 1 < DEPTH, 0, MP, F.pidx * NWAVES + F.wave, NPG * NWAVES, rep + 1 < REP_ROW, LI + 1 == DEPTH);
        if (LI + 1 < DEPTH) p0_layer(F, LI + 1 < DEPTH ? LI + 1 : LI, F.pidx * NWAVES + F.wave, NPG * NWAVES, 2); }
    if (KEEP_N5 && IN(pb + 13) && SAMPLE) { FRESH(); OPAQUE_K(kd, D); pg8::Gemm g{wsb(F, WS_XN), wlayer(F, LI, W_PG), M, D, kd}; pg8::SampleOrder S; S.init(D, NSG, F.sidx);
        pg8::EpiPle E{wsb(F, WS_YB), wsb(F, WS_PU), D};
        for (int rs_ = 0; rs_ < REP_SG; ++rs_) pg8::gemm_phase<pg8::EpiPle, pg8::SampleOrder, true, true>(RING, g, S, E, F.wave); group_barrier(F); }
    if (KEEP_N5 && IN(pb + 13) && SAMPLE) { FRESH(); const float* ng = F.in[8] + (size_t)LI * 8 * D; norm_phase_sample(F, 1.0f, ng + 7 * D, ng + 8 * D, LI + 1 < DEPTH, nullptr, 0, LI + 1 == DEPTH); }
    if (KEEP_N5 && IN(pb + 13) && SAMPLE && LI + 1 < DEPTH) { FRESH(); group_barrier(F); OPAQUE_K(kd, D); pg8::Gemm g{wsb(F, WS_XN), wlayer(F, LI + 1 < DEPTH ? LI + 1 : LI, W_UP1), M, NUP, kd}; pg8::SampleOrder S; S.init(NUP, NSG, F.sidx);
        pg8::EpiSwiGLU E{wsb(F, WS_HFF), DFF};
        for (int rs_ = 0; rs_ < REP_SG; ++rs_) pg8::gemm_phase<pg8::EpiSwiGLU, pg8::SampleOrder, true, true>(RING, g, S, E, F.wave); }
    if (IN(pb + 13)) SEAM(pb + 13);
}
template <int LI> __device__ __forceinline__ void layer_part(Frame& F, const XcdBarrier& bar, const int lo, const int hi) {
    ffn_part<LI, 0>(F, bar, lo, hi); mixer_part<LI>(F, bar, lo, hi); ffn_part<LI, 1>(F, bar, lo, hi); ple_part<LI>(F, bar, lo, hi);
}
__global__ void __launch_bounds__(NWAVES * 64, 2) enc_fwd(Args args) {
    extern __shared__ __attribute__((aligned(16))) unsigned char lds[];
    Frame F;
    F.lds = (LAS unsigned char*)lds;
    F.MISC = (volatile LAS unsigned*)(F.lds + MISC_OFF);
    F.wave = __builtin_amdgcn_readfirstlane(threadIdx.x >> 6);
    F.G = gridDim.x; { const int bx = blockIdx.x; F.vcu = (F.G % 8 == 0) ? (bx % 8) * (F.G / 8) + bx / 8 : bx; }
    { const int w = F.vcu & 31, x = F.vcu >> 5; F.sidx = (w < 8) ? x * 8 + w : -1; F.pidx = (w >= 8) ? x * 24 + (w - 8) : -1; } F.lbn = 0u;
#pragma unroll
    for (int i = 0; i < 21; ++i) F.in[i] = args.in[i];
    F.out = args.out; F.ws = args.ws;
    F.ctl = (gu32*)(F.ws + WS_CTL);
    for (int u = threadIdx.x; u < (LDS_BYTES - LDSCTL_OFF) / 4; u += NWAVES * 64) ((LAS unsigned*)(F.lds + LDSCTL_OFF))[u] = 0u;
    __syncthreads();
    XcdBarrier bar; bar.wave = F.wave; bar.bar = (unsigned*)(F.ctl + CW_BAR); bar.x = 0; bar.st = nullptr;
#if !MK_PER_PHASE
    bar = xcd_barrier_post((unsigned*)(F.ctl + CW_BAR), F.MISC + 8);
#endif
    const int lo = args.ph_lo, hi = args.ph_hi;
    if (KEEP_PRO && IN(0)) { FRESH(); for (int rep = 0; rep < REP_PRO; ++rep) p0_prologue(F); SEAM(0); }
    layer_part<0>(F, bar, lo, hi); layer_part<1>(F, bar, lo, hi); layer_part<2>(F, bar, lo, hi); layer_part<3>(F, bar, lo, hi);
}
#undef IN
#undef SEAM
#undef FRESH
#undef RING
#undef SAMPLE

#ifndef DBG_DUMP
#define DBG_DUMP 0
#endif
#if DBG_DUMP
__global__ void dbg_dump_bf16(const unsigned short* src, float* dst, size_t n) { size_t i = (size_t)blockIdx.x * blockDim.x + threadIdx.x; const size_t st = (size_t)gridDim.x * blockDim.x; for (; i < n; i += st) dst[i] = __uint_as_float((unsigned)src[i] << 16); }
#endif
#ifndef PH_STOP
#define PH_STOP 1000
#endif
extern "C" void kernel_launch(void* const* d_in, const int* in_sizes, int n_in, void* d_out, int out_size, void* d_ws, size_t ws_size, hipStream_t stream) {
    static int grid = 0;
    if (grid == 0) {
        if (n_in != 21 || (size_t)(unsigned)out_size != O_END || ws_size < WS_TOP) { fprintf(stderr, "kernel_launch: unexpected shapes (n_in %d, out %d, ws %zu); nothing launched\n", n_in, out_size, ws_size); grid = -1; return; }
        int dev = 0, cus = 0, per_cu = 0;
        if (hipGetDevice(&dev) != hipSuccess || hipDeviceGetAttribute(&cus, hipDeviceAttributeMultiprocessorCount, dev) != hipSuccess) { grid = -1; return; }
        if (hipFuncSetAttribute((const void*)enc_fwd, hipFuncAttributeMaxDynamicSharedMemorySize, LDS_BYTES) != hipSuccess) { fprintf(stderr, "kernel_launch: hipFuncSetAttribute failed\n"); grid = -1; return; }
        if (hipOccupancyMaxActiveBlocksPerMultiprocessor(&per_cu, (const void*)enc_fwd, NWAVES * 64, LDS_BYTES) != hipSuccess || per_cu < 1)
            fprintf(stderr, "kernel_launch: note: occupancy query reports %d workgroups per CU\n", per_cu);
        (void)hipGetLastError();
        grid = cus;
    }
    if (grid < 0) return;
    if (hipMemsetAsync((char*)d_ws + WS_CTL, 0, CTL_ZERO_BYTES, stream) != hipSuccess) return;
    Args a{};
    for (int i = 0; i < 21; ++i) a.in[i] = (const float*)d_in[i];
    a.out = (float*)d_out; a.ws = (unsigned char*)d_ws;
#if MK_PER_PHASE
    for (int ph = 0; ph < (NPH < PH_STOP ? NPH : PH_STOP); ++ph) { a.ph_lo = ph; a.ph_hi = ph + 1; hipLaunchKernelGGL(enc_fwd, dim3(grid), dim3(NWAVES * 64), LDS_BYTES, stream, a); }
#if DBG_DUMP
    { const unsigned char* ws = (const unsigned char*)d_ws; float* out = (float*)d_out;
      if (DBG_DUMP & 1) { hipLaunchKernelGGL(dbg_dump_bf16, dim3(2048), dim3(256), 0, stream, (const unsigned short*)(ws + WS_O), out + O_KP + (size_t)1 * MP * D, (size_t)MP * 2048);
                          hipLaunchKernelGGL(dbg_dump_bf16, dim3(256), dim3(256), 0, stream, (const unsigned short*)(ws + WS_O) + (size_t)MP * 2048, out + O_KS + (size_t)1 * MS * D, (size_t)MS * 2048); }
      if (DBG_DUMP & 2) { hipLaunchKernelGGL(dbg_dump_bf16, dim3(2048), dim3(256), 0, stream, (const unsigned short*)(ws + WS_A2), out + O_VP + (size_t)1 * MP * D, (size_t)MP * 2048);
                          hipLaunchKernelGGL(dbg_dump_bf16, dim3(256), dim3(256), 0, stream, (const unsigned short*)(ws + WS_A2) + (size_t)MP * 2048, out + O_VS + (size_t)1 * MS * D, (size_t)MS * 2048); }
      if (DBG_DUMP & 8) { hipLaunchKernelGGL(dbg_dump_bf16, dim3(2048), dim3(256), 0, stream, (const unsigned short*)(ws + WS_GS), out + O_KP + (size_t)1 * MP * D, (size_t)MP * 3072); }
      if (DBG_DUMP & 16) { hipLaunchKernelGGL(dbg_dump_bf16, dim3(2048), dim3(256), 0, stream, (const unsigned short*)(ws + WS_W + W_BR), out + O_VP + (size_t)1 * MP * D, (size_t)1024 * 2048); }
      if (DBG_DUMP & 4) { hipLaunchKernelGGL(dbg_dump_bf16, dim3(2048), dim3(256), 0, stream, (const unsigned short*)(ws + WS_MG), out + O_KP + (size_t)3 * MP * D, (size_t)MP * 1024);
                          hipLaunchKernelGGL(dbg_dump_bf16, dim3(256), dim3(256), 0, stream, (const unsigned short*)(ws + WS_MG) + (size_t)MP * 1024, out + O_KS + (size_t)3 * MS * D, (size_t)MS * 1024); } }
#endif
#else
    a.ph_lo = 0; a.ph_hi = (NPH < PH_STOP ? NPH : PH_STOP);
    hipLaunchKernelGGL(enc_fwd, dim3(grid), dim3(NWAVES * 64), LDS_BYTES, stream, a);
#endif
}
```

```cpp
#include <hip/hip_runtime.h>
#include <cstdio>
#include <cstdint>

namespace pg8 {
#define PG8_LAS __attribute__((address_space(3)))
typedef unsigned short bf16_t;
typedef short bf16x8 __attribute__((ext_vector_type(8)));
typedef float f32x4 __attribute__((ext_vector_type(4)));
typedef unsigned u32x4 __attribute__((ext_vector_type(4)));
constexpr int BM = 256, BK = 64, HALF = 128, HTB = HALF * BK * 2  , STAGE_BYTES = 8 * HTB, NXCD = 8, WGM = 4;

__host__ __device__ __forceinline__ int lds_byte(int r, int c) { const int st = (r >> 4) * 2 + (c >> 5), rr = r & 15, cc = c & 31, ob = rr * 64 + cc * 2; return st * 1024 + (ob ^ (((ob >> 9) & 1) << 5)); }
__host__ __device__ __forceinline__ void stage_rc(int b, int& R, int& C) { const int st = b / 1024, sb = b % 1024, swz = sb ^ (((sb >> 9) & 1) << 5); R = (st >> 1) * 16 + swz / 64; C = (st & 1) * 32 + (swz % 64) / 2; }
__host__ __device__ __forceinline__ int perm32(int rho) { const int n = rho >> 4, i = rho & 15; return 8 * (i >> 2) + 4 * n + (i & 3); }

struct Unit { int pm, pn, seg; };
constexpr int MPROMPT_TILES = 128;
struct Gemm { const bf16_t* A; const bf16_t* Bt; int M, N, K; };

struct StaticOrder {
    int nM, nN, nwg, G, c;
    __host__ __device__ void init(int M, int N, int G_, int c_) { nM = M / BM; nN = N / BM; nwg = nM * nN; G = G_; c = c_; }
    __host__ __device__ bool next(int i, Unit& u) const {
        const long L = (long)i * G + c; if (L >= nwg) return false;
        int wgid = (int)L; { const int q = nwg / NXCD, r = nwg % NXCD, xcd = wgid % NXCD, off = wgid / NXCD; wgid = (xcd < r ? xcd * (q + 1) : r * (q + 1) + (xcd - r) * q) + off; }
        const int nig = WGM * nN, gid = wgid / nig, fm = gid * WGM, gsz = (nM - fm) < WGM ? (nM - fm) : WGM;
        u.pm = fm + ((wgid % nig) % gsz); u.pn = (wgid % nig) / gsz; u.seg = 0; return true;
    }
    __device__ __forceinline__ size_t koff_bytes(const Unit&) const { return 0; }
    __device__ __forceinline__ int ntiles(const Unit&, int K) const { return K / BK; }
    __device__ __forceinline__ void a_ready(const Unit&) const {}
    __device__ __forceinline__ void done(const Unit&) const {}
};
struct SampleOrder {
    int nN, G, c;
    __host__ __device__ void init(int N, int G_, int c_) { nN = N / BM; G = G_; c = c_; }
    __host__ __device__ bool next(int i, Unit& u) const { const int L = i * G + c; if (L >= 2 * nN) return false; u.pm = MPROMPT_TILES + L / nN; u.pn = L % nN; u.seg = 0; return true; }
    __device__ __forceinline__ size_t koff_bytes(const Unit&) const { return 0; }
    __device__ __forceinline__ int ntiles(const Unit&, int K) const { return K / BK; }
    __device__ __forceinline__ void a_ready(const Unit&) const {}
    __device__ __forceinline__ void done(const Unit&) const {}
};
struct SampleSplitOrder : SampleOrder {
    __host__ __device__ bool next(int i, Unit& u) const { const int L = i * G + c; if (L >= 32) return false; const int tile = L >> 2; u.pm = MPROMPT_TILES + (tile >> 2); u.pn = tile & 3; u.seg = L & 3; return true; }
    __device__ __forceinline__ size_t koff_bytes(const Unit& u) const { return (size_t)(u.seg == 0 ? 0 : (u.seg == 1 ? 12 : (u.seg == 2 ? 24 : 34))) * BK * 2; }
    __device__ __forceinline__ int ntiles(const Unit& u, int) const { return u.seg < 2 ? 12 : 10; }
};
struct SampleSegOrder : SampleOrder {
    __host__ __device__ bool next(int i, Unit& u) const { const int r = i / 3; if (!SampleOrder::next(r, u)) return false; u.seg = i - 3 * r; return true; }
    __device__ __forceinline__ size_t koff_bytes(const Unit& u) const { return u.seg == 0 ? 0 : (u.seg == 1 ? 2048 : 3072); }
    __device__ __forceinline__ int ntiles(const Unit& u, int) const { return u.seg == 0 ? 16 : 8; }
};
struct SegOrder : StaticOrder {
    __host__ __device__ bool next(int i, Unit& u) const { const int r = i / 3; if (!StaticOrder::next(r, u)) return false; u.seg = i - 3 * r; return true; }
    __device__ __forceinline__ size_t koff_bytes(const Unit& u) const { return u.seg == 0 ? 0 : (u.seg == 1 ? 2048 : 3072); }
    __device__ __forceinline__ int ntiles(const Unit& u, int) const { return u.seg == 0 ? 16 : 8; }
};

typedef float cvt_f32x2_t __attribute__((ext_vector_type(2))); typedef __bf16 cvt_bf16x2_t __attribute__((ext_vector_type(2)));
__device__ __forceinline__ unsigned cvt_pk_bf16(float lo, float hi) { const cvt_f32x2_t v = {lo, hi}; const cvt_bf16x2_t b = __builtin_convertvector(v, cvt_bf16x2_t); return __builtin_bit_cast(unsigned, b); }
typedef float f32x2 __attribute__((ext_vector_type(2)));
constexpr int MPROMPT = 32768;
constexpr float QSCALE = 0.125f * 1.4426950408889634f;
__device__ __forceinline__ float sigm(float x) { return __builtin_amdgcn_rcpf(1.0f + __builtin_amdgcn_exp2f(-1.4426950408889634f * x)); }
__device__ __forceinline__ u32x4 pack8(const f32x4 a, const f32x4 b) { u32x4 w; w.x = cvt_pk_bf16(a[0], a[1]); w.y = cvt_pk_bf16(a[2], a[3]); w.z = cvt_pk_bf16(b[0], b[1]); w.w = cvt_pk_bf16(b[2], b[3]); return w; }
__device__ __forceinline__ void unpack8(const u32x4 w, f32x4& a, f32x4& b) {
    a[0] = __uint_as_float(w.x << 16); a[1] = __uint_as_float(w.x & 0xffff0000u); a[2] = __uint_as_float(w.y << 16); a[3] = __uint_as_float(w.y & 0xffff0000u);
    b[0] = __uint_as_float(w.z << 16); b[1] = __uint_as_float(w.z & 0xffff0000u); b[2] = __uint_as_float(w.w << 16); b[3] = __uint_as_float(w.w & 0xffff0000u); }

struct EpiSwiGLU {
    static constexpr bool PERM = true, AFTER_DRAIN = false;
    bf16_t* O; int ldc;
    __device__ __forceinline__ void operator()(const f32x4 (&acc)[2][2][4][2], const Unit& u, int wr, int wc, int fr, int fq) const {
        const int row0 = u.pm * BM + wr * 64 + fr, col0 = u.pn * HALF + wc * 32 + 8 * fq;
#pragma unroll
        for (int ai = 0; ai < 2; ++ai)
#pragma unroll
            for (int m = 0; m < 4; ++m) { bf16_t* p = O + (size_t)(row0 + ai * HALF + m * 16) * ldc + col0; f32x4 h[2];
#pragma unroll
                for (int n = 0; n < 2; ++n)
#pragma unroll
                    for (int j = 0; j < 4; ++j) { const float g = acc[ai][0][m][n][j]; h[n][j] = g * sigm(g) * acc[ai][1][m][n][j]; }
                *(u32x4*)p = pack8(h[0], h[1]); }
    }
};
struct EpiF32 {
    static constexpr bool PERM = false, AFTER_DRAIN = false;
    float* Y; int ldc;
    __device__ __forceinline__ void operator()(const f32x4 (&acc)[2][2][4][2], const Unit& u, int wr, int wc, int fr, int fq) const {
        float* yb = Y + (size_t)(u.pm * BM) * ldc + u.pn * BM;
        int lrow = wr * 64 + fr, lcol = wc * 32 + 4 * fq; asm volatile("" : "+v"(lrow), "+v"(lcol));
#pragma unroll
        for (int ai = 0; ai < 2; ++ai)
#pragma unroll
            for (int m = 0; m < 4; ++m) { const int o = (lrow + ai * HALF + m * 16) * ldc + lcol;
#pragma unroll
                for (int bj = 0; bj < 2; ++bj)
#pragma unroll
                    for (int n = 0; n < 2; ++n) *(f32x4*)(yb + o + bj * HALF + n * 16) = acc[ai][bj][m][n]; }
    }
};
struct EpiF32Slab {
    static constexpr bool PERM = false, AFTER_DRAIN = false;
    float* YS;
    __device__ __forceinline__ void operator()(const f32x4 (&acc)[2][2][4][2], const Unit& u, int wr, int wc, int fr, int fq) const {
        float* yb = YS + (size_t)u.seg * 512 * 1024 + (size_t)((u.pm - MPROMPT_TILES) * BM) * 1024 + u.pn * BM;
        int lrow = wr * 64 + fr, lcol = wc * 32 + 4 * fq; asm volatile("" : "+v"(lrow), "+v"(lcol));
#pragma unroll
        for (int ai = 0; ai < 2; ++ai)
#pragma unroll
            for (int m = 0; m < 4; ++m) { const int o = (lrow + ai * HALF + m * 16) * 1024 + lcol;
#pragma unroll
                for (int bj = 0; bj < 2; ++bj)
#pragma unroll
                    for (int n = 0; n < 2; ++n) *(f32x4*)(yb + o + bj * HALF + n * 16) = acc[ai][bj][m][n]; }
    }
};
struct EpiPle {
    static constexpr bool PERM = true, AFTER_DRAIN = false;
    bf16_t* Y; const bf16_t* PU; int ldc;
    __device__ __forceinline__ void operator()(const f32x4 (&acc)[2][2][4][2], const Unit& u, int wr, int wc, int fr, int fq) const {
        const size_t tb = (size_t)(u.pm * BM) * ldc + u.pn * BM;
        int lrow = wr * 64 + fr, lcol = wc * 32 + 8 * fq; asm volatile("" : "+v"(lrow), "+v"(lcol));
#pragma unroll
        for (int ai = 0; ai < 2; ++ai)
#pragma unroll
            for (int m = 0; m < 4; ++m) { const int o = (lrow + ai * HALF + m * 16) * ldc + lcol;
#pragma unroll
                for (int bj = 0; bj < 2; ++bj) { const u32x4 w = *(const u32x4*)(PU + tb + o + bj * HALF); f32x4 p0, p1; unpack8(w, p0, p1); f32x4 o0, o1;
#pragma unroll
                    for (int j = 0; j < 4; ++j) { o0[j] = p0[j] * sigm(acc[ai][bj][m][0][j]); o1[j] = p1[j] * sigm(acc[ai][bj][m][1][j]); }
                    *(u32x4*)(Y + tb + o + bj * HALF) = pack8(o0, o1); } }
    }
};
struct EpiBf {
    static constexpr bool PERM = true, AFTER_DRAIN = false;
    bf16_t* O; int ldc;
    __device__ __forceinline__ void operator()(const f32x4 (&acc)[2][2][4][2], const Unit& u, int wr, int wc, int fr, int fq) const {
        bf16_t* ob = O + (size_t)(u.pm * BM) * ldc + u.pn * BM;
        int lrow = wr * 64 + fr, lcol = wc * 32 + 8 * fq; asm volatile("" : "+v"(lrow), "+v"(lcol));
#pragma unroll
        for (int ai = 0; ai < 2; ++ai)
#pragma unroll
            for (int m = 0; m < 4; ++m) { const int o = (lrow + ai * HALF + m * 16) * ldc + lcol;
#pragma unroll
                for (int bj = 0; bj < 2; ++bj) *(u32x4*)(ob + o + bj * HALF) = pack8(acc[ai][bj][m][0], acc[ai][bj][m][1]); }
    }
};
struct EpiSeg {
    static constexpr bool PERM = true, AFTER_DRAIN = false;
    const bf16_t* S; float* T; bf16_t* O;
    __device__ __forceinline__ void operator()(const f32x4 (&acc)[2][2][4][2], const Unit& u, int wr, int wc, int fr, int fq) const {
        const int seg = u.seg;
        const bf16_t* sb = S + (size_t)(u.pm * BM) * 3072 + u.pn * BM + seg * 1024; float* tb = T + (size_t)(u.pm * BM) * 1024 + u.pn * BM; bf16_t* ob = O + (size_t)(u.pm * BM) * 1024 + u.pn * BM;
        int lrow = wr * 64 + fr, lcol = wc * 32 + 8 * fq; asm volatile("" : "+v"(lrow), "+v"(lcol));
#pragma unroll
        for (int ai = 0; ai < 2; ++ai)
#pragma unroll
            for (int m = 0; m < 4; ++m) { const int r = lrow + ai * HALF + m * 16;
#pragma unroll
                for (int bj = 0; bj < 2; ++bj) { const u32x4 ws = *(const u32x4*)(sb + r * 3072 + lcol + bj * HALF); f32x4 s0, s1; unpack8(ws, s0, s1);
                    f32x4 o0 = acc[ai][bj][m][0] * s0, o1 = acc[ai][bj][m][1] * s1; float* tp = tb + r * 1024 + lcol + bj * HALF;
                    if (seg != 0) { o0 = o0 + *(const f32x4*)tp; o1 = o1 + *(const f32x4*)(tp + 4); }
                    if (seg != 2) { *(f32x4*)tp = o0; *(f32x4*)(tp + 4) = o1; }
                    else *(u32x4*)(ob + r * 1024 + lcol + bj * HALF) = pack8(o0, o1); } }
    }
};
struct EpiWin {
    static constexpr bool PERM = true, AFTER_DRAIN = false;
    bf16_t *Q, *K, *V, *BG, *C, *ZP, *GS; const float *ropec, *ropes; float *kp, *vp, *ks, *vs;
    __device__ __forceinline__ void operator()(const f32x4 (&acc)[2][2][4][2], const Unit& u, int wr, int wc, int fr, int fq) const {
        const int pn = u.pn; const bool samp = u.pm >= MPROMPT / BM; const int row0 = u.pm * BM + wr * 64 + fr;
        if (pn < 8) {
            const bool isq = pn < 4; const int map = (pn & 3) * 4 + wc; bf16_t* dst = isq ? Q : K; const float sc = isq ? QSCALE : 1.0f;
            float* ko = samp ? ks - (size_t)MPROMPT * 1024 : kp;
#pragma unroll
            for (int ai = 0; ai < 2; ++ai)
#pragma unroll
                for (int m = 0; m < 4; ++m) { const int row = row0 + ai * HALF + m * 16; const int pos = samp ? 1024 + ((row - MPROMPT) & 31) : (row & 16383);
                    const float* cp = ropec + (size_t)pos * 32 + 8 * fq; const float* sp = ropes + (size_t)pos * 32 + 8 * fq;
                    f32x4 o1[2], o2[2];
#pragma unroll
                    for (int n = 0; n < 2; ++n) { const f32x4 c = *(const f32x4*)(cp + 4 * n), s = *(const f32x4*)(sp + 4 * n), x1 = acc[ai][0][m][n], x2 = acc[ai][1][m][n]; o1[n] = x1 * c - x2 * s; o2[n] = x2 * c + x1 * s; }
                    const size_t off = (size_t)row * 1024 + map * 64 + 8 * fq;
                    if (!isq) { float* kf = ko + off; __builtin_nontemporal_store(o1[0], (f32x4*)kf); __builtin_nontemporal_store(o1[1], (f32x4*)(kf + 4)); __builtin_nontemporal_store(o2[0], (f32x4*)(kf + 32)); __builtin_nontemporal_store(o2[1], (f32x4*)(kf + 36)); }
                    *(u32x4*)(dst + off) = pack8(o1[0] * sc, o1[1] * sc); *(u32x4*)(dst + off + 32) = pack8(o2[0] * sc, o2[1] * sc); }
        } else if (pn < 12) {
            float* vo = samp ? vs - (size_t)MPROMPT * 1024 : vp; const int col0 = (pn - 8) * BM + wc * 32 + 8 * fq;
#pragma unroll
            for (int ai = 0; ai < 2; ++ai)
#pragma unroll
                for (int m = 0; m < 4; ++m) { const size_t off = (size_t)(row0 + ai * HALF + m * 16) * 1024 + col0;
#pragma unroll
                    for (int bj = 0; bj < 2; ++bj) { float* vf = vo + off + bj * HALF; __builtin_nontemporal_store(acc[ai][bj][m][0], (f32x4*)vf); __builtin_nontemporal_store(acc[ai][bj][m][1], (f32x4*)(vf + 4)); *(u32x4*)(V + off + bj * HALF) = pack8(acc[ai][bj][m][0], acc[ai][bj][m][1]); } }
        } else if (pn < 14 || (pn >= 18 && pn < 20)) {
            bf16_t* dst = pn < 14 ? BG : ZP; const int col0 = (pn < 14 ? pn - 12 : pn - 18) * BM + wc * 32 + 8 * fq;
#pragma unroll
            for (int ai = 0; ai < 2; ++ai)
#pragma unroll
                for (int m = 0; m < 4; ++m) { bf16_t* p = dst + (size_t)(row0 + ai * HALF + m * 16) * 512 + col0;
#pragma unroll
                    for (int bj = 0; bj < 2; ++bj) *(u32x4*)(p + bj * HALF) = pack8(acc[ai][bj][m][0], acc[ai][bj][m][1]); }
        } else if (pn < 18) {
            const int col0 = (pn - 14) * HALF + wc * 32 + 8 * fq;
#pragma unroll
            for (int ai = 0; ai < 2; ++ai)
#pragma unroll
                for (int m = 0; m < 4; ++m) *(u32x4*)(C + (size_t)(row0 + ai * HALF + m * 16) * 512 + col0) = pack8(acc[ai][0][m][0] * acc[ai][1][m][0], acc[ai][0][m][1] * acc[ai][1][m][1]);
        } else {
            const int col0 = (pn - 20) * BM + wc * 32 + 8 * fq;
#pragma unroll
            for (int ai = 0; ai < 2; ++ai)
#pragma unroll
                for (int m = 0; m < 4; ++m) { bf16_t* p = GS + (size_t)(row0 + ai * HALF + m * 16) * 3072 + col0;
#pragma unroll
                    for (int bj = 0; bj < 2; ++bj) { f32x4 g0, g1;
#pragma unroll
                        for (int j = 0; j < 4; ++j) { g0[j] = sigm(acc[ai][bj][m][0][j]); g1[j] = sigm(acc[ai][bj][m][1][j]); }
                        *(u32x4*)(p + bj * HALF) = pack8(g0, g1); } }
        }
    }
};
template <class Epi, class Sched, bool ALIGN_EPI = false, bool SP2 = false>
__device__ __forceinline__ void gemm_phase(PG8_LAS unsigned char* lds, const Gemm g, const Sched& S, const Epi& E, const int wave) {
    int lane_; asm volatile("v_mbcnt_lo_u32_b32 %0, -1, 0\n\tv_mbcnt_hi_u32_b32 %0, -1, %0" : "=v"(lane_));
    const int wid = wave, lane = lane_, tid = wid * 64 + lane, wr = wid >> 2, wc = wid & 3, fr = lane & 15, fq = lane >> 4;
    const int K = g.K;
    unsigned voffA[2], voffB[2];
#pragma unroll
    for (int i = 0; i < 2; ++i) { int R, C; stage_rc(tid * 16 + i * 8192, R, C); const int Rb = Epi::PERM ? ((R & ~31) + perm32(R & 31)) : R;
        voffA[i] = (unsigned)(R * K + C) * 2u; voffB[i] = (unsigned)(Rb * K + C) * 2u; }
    const size_t kstep = (size_t)(BK * 2);
    const size_t hstep = (size_t)HALF * K * 2;
    const size_t tstep = 2 * hstep;
    const unsigned ldsw = (unsigned)wid * 1024u;
    const int aoff = lds_byte(wr * 64 + fr, fq * 8), boff = lds_byte(wc * 32 + fr, fq * 8);
#define PG8_SA(b, h) (((b) * 2 + (h)) * HTB)
#define PG8_SB(b, h) ((4 + (b) * 2 + (h)) * HTB)
#define PG8_STAGE(bufoff, gbase, voff) do { _Pragma("unroll") for (int _i = 0; _i < 2; ++_i) \
        __builtin_amdgcn_global_load_lds((const unsigned*)((const char*)(gbase) + (voff)[_i]), (PG8_LAS unsigned*)(lds + (bufoff) + ldsw + _i * 8192), 16, 0, 0); } while (0)
#define PG8_LDA(dst, b, h) do { _Pragma("unroll") for (int m = 0; m < 4; ++m) _Pragma("unroll") for (int k = 0; k < 2; ++k) dst[m][k] = *(const PG8_LAS bf16x8*)(lds + PG8_SA(b, h) + aoff + m * 2048 + k * 1024); } while (0)
#define PG8_LDB(dst, b, h) do { _Pragma("unroll") for (int n = 0; n < 2; ++n) _Pragma("unroll") for (int k = 0; k < 2; ++k) dst[n][k] = *(const PG8_LAS bf16x8*)(lds + PG8_SB(b, h) + boff + n * 2048 + k * 1024); } while (0)
#define PG8_MMA(ai, bj, At, Bt) do { __builtin_amdgcn_s_setprio(1); _Pragma("unroll") for (int m = 0; m < 4; ++m) _Pragma("unroll") for (int n = 0; n < 2; ++n) _Pragma("unroll") for (int k = 0; k < 2; ++k) \
        acc[ai][bj][m][n] = __builtin_amdgcn_mfma_f32_16x16x32_bf16(Bt[n][k], At[m][k], acc[ai][bj][m][n], 0, 0, 0); __builtin_amdgcn_s_setprio(0); } while (0)
#define PG8_WAIT_V(n) asm volatile("s_waitcnt vmcnt(" #n ")" ::: "memory")
#define PG8_WAIT_L(n) asm volatile("s_waitcnt lgkmcnt(" #n ")" ::: "memory")
#define PG8_BAR __builtin_amdgcn_s_barrier()
#define PG8_SCHED __builtin_amdgcn_sched_barrier(0)
    Unit cur, nxt; int ui = 0;
    if (!S.next(0, cur)) return;
    f32x4 acc[2][2][4][2];
#pragma unroll
    for (int a = 0; a < 2; ++a)
#pragma unroll
        for (int b = 0; b < 2; ++b)
#pragma unroll
            for (int m = 0; m < 4; ++m)
#pragma unroll
                for (int n = 0; n < 2; ++n) acc[a][b][m][n] = (f32x4){0.f, 0.f, 0.f, 0.f};
    bf16x8 At[4][2], B0[2][2], B1[2][2];
    const char* cA = (const char*)g.A + (size_t)cur.pm * tstep + S.koff_bytes(cur); const char* cB = (const char*)g.Bt + (size_t)cur.pn * tstep + S.koff_bytes(cur);
    S.a_ready(cur);
    if constexpr (SP2) {
        PG8_STAGE(PG8_SB(0, 0), cB, voffB); PG8_STAGE(PG8_SB(0, 1), cB + hstep, voffB); PG8_STAGE(PG8_SA(0, 0), cA, voffA); PG8_STAGE(PG8_SA(0, 1), cA + hstep, voffA);
        if (wr == 1) PG8_BAR;
        PG8_WAIT_V(2); PG8_BAR;
        PG8_STAGE(PG8_SB(1, 0), cB + kstep, voffB); PG8_STAGE(PG8_SA(1, 0), cA + kstep, voffA); PG8_STAGE(PG8_SB(1, 1), cB + hstep + kstep, voffB);
        PG8_WAIT_V(6); PG8_BAR;
    } else {
        PG8_STAGE(PG8_SB(0, 0), cB, voffB); PG8_STAGE(PG8_SA(0, 0), cA, voffA); PG8_STAGE(PG8_SB(0, 1), cB + hstep, voffB); PG8_STAGE(PG8_SA(0, 1), cA + hstep, voffA);
        if (wr == 1) PG8_BAR;
        PG8_WAIT_V(4); PG8_BAR;
        PG8_STAGE(PG8_SB(1, 0), cB + kstep, voffB); PG8_STAGE(PG8_SA(1, 0), cA + kstep, voffA); PG8_STAGE(PG8_SB(1, 1), cB + hstep + kstep, voffB);
        PG8_WAIT_V(6); PG8_BAR;
    }
    for (;;) {
        const bool has_next = S.next(ui + 1, nxt);
        const char* nA = has_next ? (const char*)g.A + (size_t)nxt.pm * tstep + S.koff_bytes(nxt) : cA; const char* nB = has_next ? (const char*)g.Bt + (size_t)nxt.pn * tstep + S.koff_bytes(nxt) : cB;
        const int nt = S.ntiles(cur, K);
        for (int t = 0; t < nt; t += 2) {
            const bool last = (t == nt - 2);
            const char* a1 = cA + (size_t)(t + 1) * kstep;
            const char* a2 = last ? nA : cA + (size_t)(t + 2) * kstep; const char* b2 = last ? nB : cB + (size_t)(t + 2) * kstep;
            const char* a3 = a2 + kstep; const char* b3 = b2 + kstep;
            if (last && has_next) S.a_ready(nxt);
            if constexpr (SP2) {
            PG8_LDB(B0, 0, 0); PG8_LDB(B1, 0, 1); PG8_SCHED; PG8_LDA(At, 0, 0); PG8_STAGE(PG8_SA(1, 1), a1 + hstep, voffA);
            PG8_WAIT_V(8); PG8_WAIT_L(0); PG8_BAR; PG8_MMA(0, 0, At, B0); PG8_MMA(0, 1, At, B1); PG8_BAR; PG8_SCHED;
            PG8_LDA(At, 0, 1); PG8_STAGE(PG8_SB(0, 0), b2, voffB); PG8_STAGE(PG8_SB(0, 1), b2 + hstep, voffB); PG8_STAGE(PG8_SA(0, 0), a2, voffA);
            PG8_WAIT_V(8); PG8_WAIT_L(0); PG8_BAR; PG8_MMA(1, 0, At, B0); PG8_MMA(1, 1, At, B1); PG8_BAR; PG8_SCHED;
            PG8_LDB(B0, 1, 0); PG8_LDB(B1, 1, 1); PG8_SCHED; PG8_LDA(At, 1, 0); PG8_STAGE(PG8_SA(0, 1), a2 + hstep, voffA);
            PG8_WAIT_V(8); PG8_WAIT_L(0); PG8_BAR; PG8_MMA(0, 0, At, B0); PG8_MMA(0, 1, At, B1); PG8_BAR; PG8_SCHED;
            PG8_LDA(At, 1, 1); PG8_STAGE(PG8_SB(1, 0), b3, voffB); PG8_STAGE(PG8_SB(1, 1), b3 + hstep, voffB); PG8_STAGE(PG8_SA(1, 0), a3, voffA);
            PG8_WAIT_V(8); PG8_WAIT_L(0); PG8_BAR; PG8_MMA(1, 0, At, B0); PG8_MMA(1, 1, At, B1); PG8_BAR; PG8_SCHED;
            } else {
            PG8_LDB(B0, 0, 0); PG8_SCHED; PG8_LDA(At, 0, 0); PG8_STAGE(PG8_SA(1, 1), a1 + hstep, voffA);
            PG8_WAIT_L(8); PG8_BAR; PG8_WAIT_L(0); PG8_MMA(0, 0, At, B0); PG8_BAR; PG8_SCHED;
            PG8_LDB(B1, 0, 1); PG8_STAGE(PG8_SB(0, 0), b2, voffB);
            PG8_BAR; PG8_WAIT_L(0); PG8_MMA(0, 1, At, B1); PG8_BAR;
            PG8_LDA(At, 0, 1); PG8_STAGE(PG8_SA(0, 0), a2, voffA);
            PG8_BAR; PG8_WAIT_L(0); PG8_MMA(1, 0, At, B0); PG8_BAR; PG8_SCHED;
            PG8_STAGE(PG8_SB(0, 1), b2 + hstep, voffB);
            PG8_WAIT_V(6); PG8_BAR; PG8_MMA(1, 1, At, B1); PG8_BAR;
            PG8_LDB(B0, 1, 0); PG8_SCHED; PG8_LDA(At, 1, 0); PG8_STAGE(PG8_SA(0, 1), a2 + hstep, voffA);
            PG8_WAIT_L(8); PG8_BAR; PG8_WAIT_L(0); PG8_MMA(0, 0, At, B0); PG8_BAR; PG8_SCHED;
            PG8_LDB(B1, 1, 1); PG8_STAGE(PG8_SB(1, 0), b3, voffB);
            PG8_BAR; PG8_WAIT_L(0); PG8_MMA(0, 1, At, B1); PG8_BAR;
            PG8_LDA(At, 1, 1); PG8_STAGE(PG8_SA(1, 0), a3, voffA);
            PG8_BAR; PG8_WAIT_L(0); PG8_MMA(1, 0, At, B0); PG8_BAR; PG8_SCHED;
            PG8_STAGE(PG8_SB(1, 1), b3 + hstep, voffB);
            PG8_WAIT_V(6); PG8_BAR; PG8_MMA(1, 1, At, B1); PG8_BAR;
            }
        }
        if constexpr (ALIGN_EPI) { if (wr == 0) PG8_BAR; }
        if constexpr (!Epi::AFTER_DRAIN) { E(acc, cur, wr, wc, fr, fq); S.done(cur); }
        if (!has_next) break;
#pragma unroll
        for (int a = 0; a < 2; ++a)
#pragma unroll
            for (int b = 0; b < 2; ++b)
#pragma unroll
                for (int m = 0; m < 4; ++m)
#pragma unroll
                    for (int n = 0; n < 2; ++n) acc[a][b][m][n] = (f32x4){0.f, 0.f, 0.f, 0.f};
        cur = nxt; cA = nA; cB = nB; ++ui;
        if constexpr (ALIGN_EPI) { if (wr == 1) PG8_BAR; }
    }
    PG8_WAIT_V(0);
    if constexpr (!ALIGN_EPI) { if (wr == 0) PG8_BAR; }
    PG8_BAR;
    if constexpr (Epi::AFTER_DRAIN) { E.fused(acc, cur, wr, wc, fr, fq, lds, wid, lane); S.done(cur); }
#undef PG8_SA
#undef PG8_SB
#undef PG8_STAGE
#undef PG8_LDA
#undef PG8_LDB
#undef PG8_MMA
#undef PG8_WAIT_V
#undef PG8_WAIT_L
#undef PG8_BAR
#undef PG8_SCHED
}
}
#include <hip/hip_bf16.h>
#include <cmath>
namespace attn_body {
using bf16=__hip_bfloat16;
using bf16x8=__attribute__((ext_vector_type(8)))short;
using s16x4=__attribute__((ext_vector_type(4)))short;
using f32x16=__attribute__((ext_vector_type(16)))float;
using u32x4=__attribute__((ext_vector_type(4)))unsigned;
constexpr int SEQ=16384,D=64,DM=1024,OP=2048;
constexpr int NW=8,QBLK=32,QB=QBLK*NW,KVBLK=64,NQB=SEQ/QB;
constexpr int ATTN_PITCH=DM, ATTN_UNIT_ROWS=QB;
__device__ __forceinline__ int crow(int r,int hi){return (r&3)+8*(r>>2)+4*hi;}
__device__ __forceinline__ f32x16 zero16(){ float z; asm volatile("v_mov_b32 %0, 0":"=v"(z)); f32x16 r; _Pragma("unroll") for(int i=0;i<16;++i)r[i]=z; return r; }
#define SBAR() __builtin_amdgcn_sched_barrier(0)
__device__ __forceinline__ void cmask(f32x16&p0,f32x16&p1,int jb,int qrel,int hi){
  const float NEG=-INFINITY; (void)hi;
  if(jb>(qrel>>6)){
  #pragma unroll
  for(int r=0;r<16;++r){p0[r]=NEG;p1[r]=NEG;} }
}

constexpr int NSLOT=3, SLOTB=8192;
constexpr int LDS_K=0, LDS_V=NSLOT*SLOTB, LDS_WS=3*NSLOT*SLOTB, LDS_OST=LDS_WS+NW*64*4, LDS_BYTES=LDS_OST+NW*4096;
constexpr float C2=0.125f*1.4426950408889634f;
__device__ __forceinline__ void glds16(const void*gsrc,unsigned lds_dst){unsigned keep;
  asm volatile("s_mov_b32 %0, m0\n\ts_mov_b32 m0, %2\n\ts_nop 0\n\tglobal_load_lds_dwordx4 %1, off\n\ts_mov_b32 m0, %0":"=&s"(keep):"v"(gsrc),"s"(lds_dst):"memory");}
__device__ __forceinline__ float max3f(float a,float b,float c){float r;asm("v_max3_f32 %0, %1, %2, %3":"=v"(r):"v"(a),"v"(b),"v"(c));return r;}
__device__ __forceinline__ float max2f(float a,float b){float r;asm("v_max_f32_e32 %0, %1, %2":"=v"(r):"v"(a),"v"(b));return r;}
__device__ __forceinline__ float fadd_s(float a,float b){float r;asm("v_add_f32_e32 %0, %1, %2":"=v"(r):"v"(a),"v"(b));return r;}
__device__ __forceinline__ float fsub_s(float a,float b){float r;asm("v_sub_f32_e32 %0, %1, %2":"=v"(r):"v"(a),"v"(b));return r;}
typedef float f32x2_t __attribute__((ext_vector_type(2))); typedef __bf16 bf16x2_t __attribute__((ext_vector_type(2)));
__device__ __forceinline__ unsigned cvtpk_s(float lo,float hi){f32x2_t v={lo,hi};bf16x2_t b=__builtin_convertvector(v,bf16x2_t);return __builtin_bit_cast(unsigned,b);}
#define WAIT_BAR(N) asm volatile("s_waitcnt vmcnt(" #N ") lgkmcnt(0)\n\ts_barrier":::"memory")

__device__ __forceinline__ void qkt(f32x16&p0,f32x16&p1,const char*Kslot,const bf16x8*qr,const f32x16&negm,int r32,int hi){
  const char*kb=Kslot+hi*1024+r32*16;
  #pragma unroll
  for(int d0=0;d0<4;++d0){
    const bf16x8 b0=*reinterpret_cast<const bf16x8*>(kb+d0*2048);
    const bf16x8 b1=*reinterpret_cast<const bf16x8*>(kb+d0*2048+512);
    if(d0==0){p0=__builtin_amdgcn_mfma_f32_32x32x16_bf16(b0,qr[0],negm,0,0,0);p1=__builtin_amdgcn_mfma_f32_32x32x16_bf16(b1,qr[0],negm,0,0,0);}
    else{p0=__builtin_amdgcn_mfma_f32_32x32x16_bf16(b0,qr[d0],p0,0,0,0);p1=__builtin_amdgcn_mfma_f32_32x32x16_bf16(b1,qr[d0],p1,0,0,0);}}
}
typedef __attribute__((address_space(3))) const char* lds_cptr;
typedef short v4i16_t __attribute__((ext_vector_type(4)));
__device__ __forceinline__ void kload8(bf16x8*kf,lds_cptr kp){
  kf[0]=*(const __attribute__((address_space(3))) bf16x8*)(kp);      kf[1]=*(const __attribute__((address_space(3))) bf16x8*)(kp+512);
  kf[2]=*(const __attribute__((address_space(3))) bf16x8*)(kp+2048); kf[3]=*(const __attribute__((address_space(3))) bf16x8*)(kp+2560);
  kf[4]=*(const __attribute__((address_space(3))) bf16x8*)(kp+4096); kf[5]=*(const __attribute__((address_space(3))) bf16x8*)(kp+4608);
  kf[6]=*(const __attribute__((address_space(3))) bf16x8*)(kp+6144); kf[7]=*(const __attribute__((address_space(3))) bf16x8*)(kp+6656);
}
__device__ __forceinline__ void kload2(bf16x8*kf,lds_cptr kp,int j){ kf[2*j]=*(const __attribute__((address_space(3))) bf16x8*)(kp+j*2048); kf[2*j+1]=*(const __attribute__((address_space(3))) bf16x8*)(kp+j*2048+512); }
__device__ __forceinline__ s16x4 vtr(lds_cptr p){ return __builtin_bit_cast(s16x4,__builtin_amdgcn_ds_read_tr16_b64_v4i16((__attribute__((address_space(3))) v4i16_t*)p)); }
__device__ __forceinline__ float rowmax(const f32x16&p0,const f32x16&p1){
  float a=max3f(p0[0],p0[1],p1[0]),b=max3f(p0[2],p0[3],p1[1]);a=max3f(a,p1[2],p1[3]);
  #pragma unroll
  for(int r=4;r<16;r+=4){a=max3f(a,p0[r],p0[r+1]);b=max3f(b,p0[r+2],p0[r+3]);a=max3f(a,p1[r],p1[r+1]);b=max3f(b,p1[r+2],p1[r+3]);}
  const float m=max2f(a,b);
  auto rr=__builtin_amdgcn_permlane32_swap(__float_as_uint(m),__float_as_uint(m),false,false);
  return max2f(__uint_as_float(rr[0]),__uint_as_float(rr[1]));
}
__device__ __forceinline__ void pv(f32x16*o,int vb,bf16x8 pa0,bf16x8 pa1,bf16x8 pa2,bf16x8 pa3){
  #pragma unroll
  for(int d0=0;d0<4;++d0){s16x4 lo[4],hi[4];
    #pragma unroll
    for(int ks=0;ks<4;++ks){
      asm volatile("ds_read_b64_tr_b16 %0,%1 offset:%c2":"=&v"(lo[ks]):"v"(vb),"i"(d0*4096+ks*1024):"memory");
      asm volatile("ds_read_b64_tr_b16 %0,%1 offset:%c2":"=&v"(hi[ks]):"v"(vb),"i"(d0*4096+ks*1024+512):"memory");}
    asm volatile("s_waitcnt lgkmcnt(0)":::"memory");SBAR();
    #define PK(k) (bf16x8){lo[k][0],lo[k][1],lo[k][2],lo[k][3],hi[k][0],hi[k][1],hi[k][2],hi[k][3]}
    o[d0]=__builtin_amdgcn_mfma_f32_32x32x16_bf16(pa0,PK(0),o[d0],0,0,0);
    o[d0]=__builtin_amdgcn_mfma_f32_32x32x16_bf16(pa1,PK(1),o[d0],0,0,0);
    o[d0]=__builtin_amdgcn_mfma_f32_32x32x16_bf16(pa2,PK(2),o[d0],0,0,0);
    o[d0]=__builtin_amdgcn_mfma_f32_32x32x16_bf16(pa3,PK(3),o[d0],0,0,0);
    #undef PK
  }
}

#ifndef ATTN_STORE16
#define ATTN_STORE16(p,v) (*(u32x4*)(p)=(v))
#endif
template<int THRL> __device__ __forceinline__ void attn_unit(int b,int map,int qb,const bf16*Q,const bf16*__restrict__ K,const bf16*__restrict__ V,bf16*O,char*shm,const int wave){
  int lane_; asm volatile("v_mbcnt_lo_u32_b32 %0, -1, 0\n\tv_mbcnt_hi_u32_b32 %0, -1, %0":"=v"(lane_)); const int lane=lane_,r32=lane&31,hi=lane>>5; const int wid=wave;
  const long rowbase=(long)b*SEQ; const int q0=qb*QB;
  const bf16*Qw=Q+(rowbase+q0+wid*QBLK)*DM+map*D;
  const bf16*Kh=K+rowbase*DM+map*D,*Vh=V+rowbase*DM+(map>>1)*128;
  const unsigned lds0=(unsigned)(uintptr_t)shm;
  float*wsf=(float*)(shm+LDS_WS)+wid*64;
  const bf16*ksrc=Kh+(long)lane*DM+wid*8;
  const bf16*vsrc=Vh+(long)(16*(wid&3)+(lane>>2))*DM+(wid>>2)*32+(lane&3)*8;
  const unsigned kdst=lds0+LDS_K+wid*1024, vdst=lds0+LDS_V+wid*1024;
  #define DMA_K(t,slot) glds16(ksrc+(long)(t)*KVBLK*DM,(unsigned)__builtin_amdgcn_readfirstlane(kdst+(slot)))
  #define DMA_V(t,slot) do{ glds16(vsrc+(long)(t)*KVBLK*DM,(unsigned)__builtin_amdgcn_readfirstlane(vdst+2*(slot))); glds16(vsrc+(long)(t)*KVBLK*DM+64,(unsigned)__builtin_amdgcn_readfirstlane(vdst+2*(slot)+8192)); }while(0)
  const int vb0=(int)(lds0+LDS_V)+((lane>>4)&1)*32+(lane&3)*8+(4*hi+((lane&15)>>2))*64;
  const char*Kbase=shm+LDS_K; bf16x8 kf[8];
  const lds_cptr shm3=(lds_cptr)shm; const lds_cptr kp0=shm3+LDS_K+hi*1024+r32*16; const lds_cptr vp0=shm3+LDS_V+((lane>>4)&1)*32+(lane&3)*8+(4*hi+((lane&15)>>2))*64;
  const int NT=(q0+QB)/KVBLK;
  DMA_K(0,0);DMA_V(0,0);DMA_K(1,SLOTB);
  bf16x8 qr[4];
  #pragma unroll
  for(int d0=0;d0<4;++d0)qr[d0]=*reinterpret_cast<const bf16x8*>(&Qw[(long)r32*DM+d0*16+hi*8]);
  float mhat=0.f,l_reg=0.f;f32x16 o[4];o[0]=zero16();o[1]=zero16();o[2]=zero16();o[3]=zero16();f32x16 negm=zero16();asm volatile("":"+v"(negm));
  const int qrel=wid*QBLK+r32;
  #define CMASK(P0,P1,t) do{int jb_=(t)-(NT-4); if(jb_>=0)cmask(P0,P1,jb_,qrel,hi);}while(0)
  bool resc=false;
  #define START(P0,P1) do{ const float rm=rowmax(P0,P1); resc=false; \
    { const float dl=rm; mhat=fadd_s(mhat,dl); \
      _Pragma("unroll") for(int r=0;r<16;++r){P0[r]=fsub_s(P0[r],dl);P1[r]=fsub_s(P1[r],dl);} \
      _Pragma("unroll") for(int r=0;r<16;++r)negm[r]=-mhat; asm volatile("":"+v"(negm)); } \
    _Pragma("unroll") for(int r=0;r<16;++r)P0[r]=__builtin_amdgcn_exp2f(P0[r]); }while(0)
  #define RESC() do{ if(resc){ asm volatile("s_waitcnt lgkmcnt(0)":::"memory"); \
      _Pragma("unroll") for(int d_=0;d_<4;++d_) _Pragma("unroll") for(int r=0;r<16;++r)o[d_][r]*=wsf[crow(r,hi)]; } }while(0)
  f32x16 pA0,pA1,pB0,pB1;
  int sl_prev=0,sl_cur=0,sl_next=SLOTB;
  #define ROT() do{sl_prev=sl_cur;sl_cur=sl_next;sl_next=(sl_next==(NSLOT-1)*SLOTB)?0:sl_next+SLOTB;}while(0)
  DMA_K(2,2*SLOTB);
  WAIT_BAR(3);
  qkt(pA0,pA1,Kbase,qr,negm,r32,hi);asm volatile("s_nop 15\n\ts_nop 7":"+v"(pA0),"+v"(pA1));CMASK(pA0,pA1,0);
  START(pA0,pA1);
  _Pragma("unroll") for(int r=0;r<16;++r)pA1[r]=__builtin_amdgcn_exp2f(pA1[r]);
  WAIT_BAR(0);
  DMA_K(3,0);DMA_V(1,SLOTB);
  ROT();
  kload8(kf,kp0+sl_cur);
  WAIT_BAR(3);
  s16x4 vlo[16],vhi[16]; u32x4 pw0,pw1,pw2,pw3;
  #define PKW(P,B) cvtpk_s(P[B],P[B+1])
  #define PAF(k) __builtin_bit_cast(bf16x8,pw##k)
  #define VFR(i) (bf16x8){vlo[i][0],vlo[i][1],vlo[i][2],vlo[i][3],vhi[i][0],vhi[i][1],vhi[i][2],vhi[i][3]}
  #define PIN(x) asm volatile("":"+v"(x))
  #define MX3(a,b,c) __builtin_fmaxf(__builtin_fmaxf((a),(b)),(c))
  #define GAPA(MF,A0,A1,A2,A3,W0,W1,PW) do{ MF; sacc+=A0; sacc+=A1; sacc+=A2; sacc+=A3; PIN(sacc); W0; W1; PIN(PW); SBAR(); }while(0)
  #define EX(v) __builtin_amdgcn_exp2f(v)
  #define GAPB2(MF,X,B) do{ MF; X[B]=EX(X[B]); X[B+1]=EX(X[B+1]); PIN(X); SBAR(); }while(0)
  #define GAPB(MF,X,B) do{ MF; X[B]=EX(X[B]); X[B+1]=EX(X[B+1]); X[B+2]=EX(X[B+2]); X[B+3]=EX(X[B+3]); PIN(X); SBAR(); }while(0)
  #define VRD(i) do{ vlo[i]=vtr(vp_+(((i)>>2)*4096+((i)&3)*1024)); vhi[i]=vtr(vp_+(((i)>>2)*4096+((i)&3)*1024+512)); }while(0)
  #define KRD(G,j) do{ if(G){ kload2(kf,kp0+sl_next,j); SBAR(); } }while(0)
  #define STEP(C0,C1,P0,P1,t,GK,GV,GL) do{ SBAR(); \
    const lds_cptr vp_=vp0+2*sl_prev; \
    VRD(0); SBAR(); float sacc=(P0[0]+P0[1]); \
    GAPA(C0=__builtin_amdgcn_mfma_f32_32x32x16_bf16(kf[0],qr[0],negm,0,0,0), P0[2],P0[3],P0[4],P0[5],     pw0[0]=PKW(P0,0), pw0[1]=PKW(P0,2), pw0); \
    VRD(4); SBAR(); GAPA(C1=__builtin_amdgcn_mfma_f32_32x32x16_bf16(kf[1],qr[0],negm,0,0,0), P0[6],P0[7],P0[8],P0[9],     pw0[2]=PKW(P0,4), pw0[3]=PKW(P0,6), pw0); \
    VRD(1); SBAR(); GAPA(C0=__builtin_amdgcn_mfma_f32_32x32x16_bf16(kf[2],qr[1],C0,0,0,0),   P0[10],P0[11],P0[12],P0[13], pw1[0]=PKW(P0,8), pw1[1]=PKW(P0,10), pw1); \
    VRD(5); SBAR(); GAPA(C1=__builtin_amdgcn_mfma_f32_32x32x16_bf16(kf[3],qr[1],C1,0,0,0),   P0[14],P0[15],P1[0],P1[1],   pw1[2]=PKW(P0,12),pw1[3]=PKW(P0,14), pw1); \
    VRD(2); SBAR(); GAPA(C0=__builtin_amdgcn_mfma_f32_32x32x16_bf16(kf[4],qr[2],C0,0,0,0),   P1[2],P1[3],P1[4],P1[5],     pw2[0]=PKW(P1,0), pw2[1]=PKW(P1,2), pw2); \
    VRD(6); SBAR(); GAPA(C1=__builtin_amdgcn_mfma_f32_32x32x16_bf16(kf[5],qr[2],C1,0,0,0),   P1[6],P1[7],P1[8],P1[9],     pw2[2]=PKW(P1,4), pw2[3]=PKW(P1,6), pw2); \
    VRD(3); SBAR(); GAPA(C0=__builtin_amdgcn_mfma_f32_32x32x16_bf16(kf[6],qr[3],C0,0,0,0),   P1[10],P1[11],P1[12],P1[13], pw3[0]=PKW(P1,8), pw3[1]=PKW(P1,10), pw3); \
    VRD(7); SBAR(); GAPA(C1=__builtin_amdgcn_mfma_f32_32x32x16_bf16(kf[7],qr[3],C1,0,0,0),   P1[14],P1[15],0.f,0.f,       pw3[2]=PKW(P1,12),pw3[3]=PKW(P1,14), pw3); \
    l_reg+=sacc; \
    if(GK){DMA_K((t)+3,sl_cur);} if(GV){DMA_V((t)+1,sl_next);} \
    CMASK(C0,C1,t); \
    { float a=MX3(C0[0],C0[1],C1[0]),b=MX3(C0[2],C0[3],C1[1]); a=MX3(a,C1[2],C1[3]); \
      _Pragma("unroll") for(int r=4;r<16;r+=4){a=MX3(a,C0[r],C0[r+1]);b=MX3(b,C0[r+2],C0[r+3]);a=MX3(a,C1[r],C1[r+1]);b=MX3(b,C1[r+2],C1[r+3]);} \
      float rm=__builtin_fmaxf(a,b); { auto rr=__builtin_amdgcn_permlane32_swap(__float_as_uint(rm),__float_as_uint(rm),false,false); rm=__builtin_fmaxf(__uint_as_float(rr[0]),__uint_as_float(rr[1])); } \
      resc=false; \
      if(__builtin_expect(__any(rm>(float)THRL),0)){ const float dl=__builtin_fmaxf(rm,0.f); mhat+=dl; \
        _Pragma("unroll") for(int r=0;r<16;++r){C0[r]-=dl;C1[r]-=dl;} \
        _Pragma("unroll") for(int r=0;r<16;++r)negm[r]=-mhat; asm volatile("":"+v"(negm)); \
        const float f=__builtin_amdgcn_exp2f(-dl); l_reg*=f; if(hi==0)wsf[r32]=f; resc=true; } } \
    SBAR(); \
    VRD(8); SBAR();  GAPB2(o[0]=__builtin_amdgcn_mfma_f32_32x32x16_bf16(PAF(0),VFR(0),o[0],0,0,0), C0,0); \
    VRD(12); SBAR(); GAPB2(o[1]=__builtin_amdgcn_mfma_f32_32x32x16_bf16(PAF(0),VFR(4),o[1],0,0,0), C0,2); \
    KRD(GL,0); GAPB2(o[0]=__builtin_amdgcn_mfma_f32_32x32x16_bf16(PAF(1),VFR(1),o[0],0,0,0), C0,4); \
    KRD(GL,1); GAPB2(o[1]=__builtin_amdgcn_mfma_f32_32x32x16_bf16(PAF(1),VFR(5),o[1],0,0,0), C0,6); \
    KRD(GL,2); GAPB2(o[0]=__builtin_amdgcn_mfma_f32_32x32x16_bf16(PAF(2),VFR(2),o[0],0,0,0), C0,8); \
    KRD(GL,3); GAPB2(o[1]=__builtin_amdgcn_mfma_f32_32x32x16_bf16(PAF(2),VFR(6),o[1],0,0,0), C0,10); \
    VRD(9); SBAR();  GAPB2(o[0]=__builtin_amdgcn_mfma_f32_32x32x16_bf16(PAF(3),VFR(3),o[0],0,0,0), C0,12); \
    VRD(13); SBAR(); GAPB2(o[1]=__builtin_amdgcn_mfma_f32_32x32x16_bf16(PAF(3),VFR(7),o[1],0,0,0), C0,14); \
    VRD(10); SBAR(); GAPB2(o[2]=__builtin_amdgcn_mfma_f32_32x32x16_bf16(PAF(0),VFR(8),o[2],0,0,0), C1,0); \
    VRD(14); SBAR(); GAPB2(o[3]=__builtin_amdgcn_mfma_f32_32x32x16_bf16(PAF(0),VFR(12),o[3],0,0,0), C1,2); \
    VRD(11); SBAR(); GAPB2(o[2]=__builtin_amdgcn_mfma_f32_32x32x16_bf16(PAF(1),VFR(9),o[2],0,0,0), C1,4); \
    VRD(15); SBAR(); GAPB2(o[3]=__builtin_amdgcn_mfma_f32_32x32x16_bf16(PAF(1),VFR(13),o[3],0,0,0), C1,6); \
    GAPB2(o[2]=__builtin_amdgcn_mfma_f32_32x32x16_bf16(PAF(2),VFR(10),o[2],0,0,0), C1,8); \
    GAPB2(o[3]=__builtin_amdgcn_mfma_f32_32x32x16_bf16(PAF(2),VFR(14),o[3],0,0,0), C1,10); \
    GAPB2(o[2]=__builtin_amdgcn_mfma_f32_32x32x16_bf16(PAF(3),VFR(11),o[2],0,0,0), C1,12); \
    GAPB2(o[3]=__builtin_amdgcn_mfma_f32_32x32x16_bf16(PAF(3),VFR(15),o[3],0,0,0), C1,14); \
    }while(0)
  int t=1;
  #undef CMASK
  #define CMASK(P0,P1,t) do{}while(0)
  for(;t+5<NT;t+=2){
    STEP(pB0,pB1,pA0,pA1,t,true,true,true);     WAIT_BAR(3); RESC(); ROT();
    STEP(pA0,pA1,pB0,pB1,t+1,true,true,true);   WAIT_BAR(3); RESC(); ROT();
  }
  #undef CMASK
  #define CMASK(P0,P1,t) do{int jb_=(t)-(NT-4); if(jb_>=0)cmask(P0,P1,jb_,qrel,hi);}while(0)
  #define ENDW(tt) do{ if((tt)+3<NT){WAIT_BAR(3);} else if((tt)+2<NT){WAIT_BAR(2);} else {WAIT_BAR(0);} }while(0)
  for(;t+1<NT;t+=2){
    STEP(pB0,pB1,pA0,pA1,t,(t+3<NT),(t+1<NT),(t+1<NT));       ENDW(t);   RESC(); ROT();
    STEP(pA0,pA1,pB0,pB1,t+1,(t+4<NT),(t+2<NT),(t+2<NT));     ENDW(t+1); RESC(); ROT();
  }
  STEP(pB0,pB1,pA0,pA1,NT-1,false,false,false); RESC();
  { float sacc=pB0[0]+pB0[1]; _Pragma("unroll") for(int r=2;r<16;++r)sacc+=pB0[r]; _Pragma("unroll") for(int r=0;r<16;++r)sacc+=pB1[r]; l_reg+=sacc;
    pw0=(u32x4){PKW(pB0,0),PKW(pB0,2),PKW(pB0,4),PKW(pB0,6)};pw1=(u32x4){PKW(pB0,8),PKW(pB0,10),PKW(pB0,12),PKW(pB0,14)};pw2=(u32x4){PKW(pB1,0),PKW(pB1,2),PKW(pB1,4),PKW(pB1,6)};pw3=(u32x4){PKW(pB1,8),PKW(pB1,10),PKW(pB1,12),PKW(pB1,14)};
    SBAR(); pv(o,vb0+2*sl_cur,PAF(0),PAF(1),PAF(2),PAF(3)); }
  #undef PKW
  #undef PAF
  #undef VFR
  #undef PIN
  #undef MX3
  #undef GAPA
  #undef GAPB
  #undef GAPB2
  #undef EX
  #undef VRD
  #undef KRD
  #undef STEP
  #undef ENDW
  {auto rr=__builtin_amdgcn_permlane32_swap(__float_as_uint(l_reg),__float_as_uint(l_reg),false,false);l_reg=__uint_as_float(rr[0])+__uint_as_float(rr[1]);}
  if(hi==0)wsf[32+r32]=l_reg;asm volatile("s_waitcnt lgkmcnt(0)":::"memory");
  float rli[16];
  #pragma unroll
  for(int r=0;r<16;++r)rli[r]=__builtin_amdgcn_rcpf(wsf[32+crow(r,hi)]);
  bf16*Ow=O+(rowbase+q0+wid*QBLK)*OP+map*128;
  { bf16*stg=(bf16*)(shm+LDS_OST)+wid*2048;
    #pragma unroll
    for(int hp=0;hp<2;++hp){
    #pragma unroll
    for(int r=0;r<16;++r){const int orow=crow(r,hi);
      #pragma unroll
      for(int d0=0;d0<2;++d0)stg[orow*64+d0*32+r32]=__float2bfloat16(o[2*hp+d0][r]*rli[r]);}
    asm volatile("s_waitcnt lgkmcnt(0)":::"memory");
    #pragma unroll
    for(int i=0;i<4;++i){const int row=i*8+(lane>>3),ch=lane&7; const u32x4 v=*(const u32x4*)(stg+row*64+ch*8); ATTN_STORE16(Ow+(long)row*OP+hp*64+ch*8,v);}
    asm volatile("s_waitcnt lgkmcnt(0)":::"memory"); } }
  asm volatile("s_waitcnt lgkmcnt(0)\n\ts_barrier":::"memory");
  #undef DMA_K
  #undef DMA_V
  #undef CMASK
  #undef START
  #undef RESC
  #undef ROT
}
constexpr int ATTN_LDS_BYTES=LDS_BYTES;
struct AttnTensors { const bf16* Q; const bf16* K; const bf16* V; bf16* O; };
template<int THRL=8> __device__ __forceinline__ void attn_phase(char*lds,const AttnTensors&T,int vcu,const int wave){
  const int xcd=vcu>>5, s=vcu&31, b=xcd>>2;
  for(int c=0;c<4;++c){ const int map=4*(xcd&3)+c;
    attn_unit<THRL>(b,map,s,T.Q,T.K,T.V,T.O,lds,wave); attn_unit<THRL>(b,map,63-s,T.Q,T.K,T.V,T.O,lds,wave); }
}
#undef SBAR
#undef WAIT_BAR
}
constexpr int NWAVES = 8;
constexpr int D = 1024, MP = 32768, MS = 512, M = MP + MS, SEQ = 16384, DEPTH = 4, DFF = 2816, NUP = 2 * DFF, NIN = 8192, KBR = 2048, PLE = 256;
constexpr int DSEQ = 32, PAST = 1024, DB = 16;
constexpr float RMS_EPS = 1e-6f;
constexpr int PH_PER_LAYER = 14, NPH = 1 + DEPTH * PH_PER_LAYER;
#ifndef REP_ATT
#define REP_ATT 1
#endif
#ifndef REP_PRO
#define REP_PRO 1
#endif
#ifndef REP_ROW
#define REP_ROW 1
#endif
#ifndef REP_E2
#define REP_E2 1
#endif
#ifndef REP_LB
#define REP_LB 1
#endif
#ifndef REP_BAR
#define REP_BAR 1
#endif
#ifndef REP_SG
#define REP_SG 1
#endif
#ifndef REP_SA
#define REP_SA 1
#endif
#ifndef REP_SE2
#define REP_SE2 1
#endif
#ifndef REP_GEMM_BAR
#define REP_GEMM_BAR 0
#endif
#ifndef REP_GEMM
#define REP_GEMM 1
#endif
#ifndef MK_PER_PHASE
#define MK_PER_PHASE 0
#endif

constexpr size_t MiB = 1u << 20;
constexpr size_t WS_CTL = 0, CTL_ZERO_BYTES = 1 * MiB;
constexpr size_t WS_ROPEC = 2 * MiB, WS_ROPES = 4 * MiB;
constexpr size_t WS_W = 8 * MiB, W_LAYER = 64 * MiB;
constexpr size_t W_UP1 = 0, W_UP2 = 11 * MiB, W_DN1 = 22 * MiB, W_DN2 = 22 * MiB + 5632 * 1024, W_IN = 33 * MiB, W_BR = 49 * MiB, W_OUT = 53 * MiB, W_PG = 55 * MiB, W_PU = 57 * MiB;
constexpr size_t WS_PB = 272 * MiB, PB_LAYER = 17 * MiB;
constexpr size_t WS_XN = 344 * MiB, WS_HFF = 416 * MiB, WS_Q = 600 * MiB, WS_K = 672 * MiB, WS_V = 744 * MiB, WS_BG = 816 * MiB, WS_C = 852 * MiB, WS_ZP = 888 * MiB;
constexpr size_t WS_GS = 924 * MiB, WS_O = 1120 * MiB, WS_A2 = 1256 * MiB, WS_MG = 1392 * MiB, WS_Y = 1464 * MiB, WS_PU = 1600 * MiB, WS_YS = 1672 * MiB  , WS_END = 1680 * MiB, WS_YB = 1688 * MiB  , WS_HB = 1760 * MiB  , WS_TOP = 1828 * MiB, WS_DUMMY = 1832 * MiB  ;
static_assert(WS_XN + (size_t)M * D * 2 <= WS_HFF && WS_HFF + (size_t)M * DFF * 2 <= WS_Q && WS_GS + (size_t)M * 3072 * 2 <= WS_O && WS_O + (size_t)M * 2048 * 2 <= WS_A2 && WS_Y + (size_t)M * D * 4 <= WS_PU && WS_PU + (size_t)M * D * 2 <= WS_END, "d_ws map");
static_assert(W_PU + (size_t)D * PLE * 2 <= W_LAYER && (size_t)M * PLE * 2 <= PB_LAYER && WS_W + DEPTH * W_LAYER <= WS_PB && WS_PB + DEPTH * PB_LAYER <= WS_XN, "d_ws map 2");
constexpr int CW_TMO = 0, CW_CODE = 1, CW_BAR = 4096;
constexpr size_t O_Y = 0, O_KP = (size_t)M * D, O_VP = O_KP + (size_t)DEPTH * MP * D, O_CP = O_VP + (size_t)DEPTH * MP * D, O_PP = O_CP + (size_t)DEPTH * 2 * 2 * 512, O_KS = O_PP + (size_t)DEPTH * 2 * 15 * 512,
                 O_VS = O_KS + (size_t)DEPTH * MS * D, O_CS = O_VS + (size_t)DEPTH * MS * D, O_PS = O_CS + (size_t)DEPTH * DB * 2 * 512, O_END = O_PS + (size_t)DEPTH * DB * 15 * 512;

constexpr int RING_OFF = 0, RING_BYTES = 131072;
constexpr int LDSCTL_OFF = RING_BYTES, MISC_OFF = LDSCTL_OFF + 320;
constexpr int LDS_BYTES = 147456;
static_assert(MISC_OFF + 128 <= LDS_BYTES, "LDS map");
#define GAS __attribute__((address_space(1)))
#define LAS __attribute__((address_space(3)))
typedef unsigned short bf16;
typedef unsigned v4u __attribute__((ext_vector_type(4)));
typedef float f32x4 __attribute__((ext_vector_type(4)));
typedef short bf16x8 __attribute__((ext_vector_type(8)));
typedef GAS unsigned gu32;
typedef GAS unsigned long long gu64;
#define RLX_AGENT __ATOMIC_RELAXED, __HIP_MEMORY_SCOPE_AGENT
#define LDS_WAIT() asm volatile("s_waitcnt lgkmcnt(0)" ::: "memory")
#define VM_WAIT() asm volatile("s_waitcnt vmcnt(0)" ::: "memory")
__device__ __forceinline__ unsigned long long rt() { return __builtin_amdgcn_s_memrealtime(); }
__device__ __forceinline__ unsigned f2bf(float f) { unsigned u = __builtin_bit_cast(unsigned, f); return (u + 0x7fffu + ((u >> 16) & 1u)) >> 16; }
__device__ __forceinline__ unsigned pk2(float lo, float hi) { return f2bf(lo) | (f2bf(hi) << 16); }

#define XB_TMO      128
#define XB_XCNT(j)  (256  + 64 * (j))
#define XB_XSUB(j)  (1280 + 64 * (j))
#define XB_XGEN(j)  (2304 + 64 * (j))
#define XB_TOP      3328
#define XB_TOPGEN   3392
#define XCD_BAR_WORDS 3456
#define XB_SPIN_CAP (1u << 18)

__device__ __forceinline__ unsigned xb_ld(unsigned* p)              { return __hip_atomic_load(p, __ATOMIC_RELAXED, __HIP_MEMORY_SCOPE_AGENT); }
__device__ __forceinline__ unsigned xb_add(unsigned* p, unsigned v) { return __hip_atomic_fetch_add(p, v, __ATOMIC_RELAXED, __HIP_MEMORY_SCOPE_AGENT); }
__device__ __forceinline__ unsigned xb_xcc_id() { return (unsigned)__builtin_amdgcn_s_getreg((3 << 11) | 20) & 0xFu; }
#define XB_SPIN(cond, bar) do { unsigned _sp = 0; while (cond) { __builtin_amdgcn_s_sleep(1); \
    if ((++_sp & 255u) == 0u) { if (xb_ld(&(bar)[XB_TMO])) break; if (_sp > XB_SPIN_CAP) { atomicAdd(&(bar)[XB_TMO], 1u); break; } } } } while (0)

__device__ __forceinline__ int lane_now() { int l; asm volatile("v_mbcnt_lo_u32_b32 %0, -1, 0\n\tv_mbcnt_hi_u32_b32 %0, -1, %0" : "=v"(l)); return l; }
struct XcdBarrier {
    int wave;
    unsigned* bar; unsigned x;
    volatile LAS unsigned* st;
};

__device__ __forceinline__ XcdBarrier xcd_barrier_post(unsigned* bar, volatile LAS unsigned* st) {
    XcdBarrier b; b.wave = (int)__builtin_amdgcn_readfirstlane(threadIdx.x >> 6); b.bar = bar; b.x = xb_xcc_id(); b.st = st;
    if (threadIdx.x == 0) (void)xb_add(&bar[XB_XCNT(b.x)], 1u);
    return b;
}
__device__ __forceinline__ void xcd_barrier_complete(unsigned* bar, unsigned x, unsigned& nloc, unsigned& nx) {
    const unsigned G = gridDim.x * gridDim.y * gridDim.z;
    unsigned sum, cnt, mine, sp = 0u;
    for (;;) {
        sum = 0u; cnt = 0u; mine = 0u;
#pragma unroll
        for (unsigned j = 0; j < 16; ++j) { const unsigned c = xb_ld(&bar[XB_XCNT(j)]); sum += c; cnt += (c > 0u) ? 1u : 0u; mine = (j == x) ? c : mine; }
        if (sum == G) break;
        __builtin_amdgcn_s_sleep(1);
        if ((++sp & 255u) == 0u) { if (xb_ld(&bar[XB_TMO])) break; if (sp > XB_SPIN_CAP) { atomicAdd(&bar[XB_TMO], 1u); break; } }
    }
    nloc = mine > 0u ? mine : 1u; nx = cnt > 0u ? cnt : 1u;
}

__device__ __forceinline__ void xcd_barrier(const XcdBarrier& b) {
    asm volatile("s_waitcnt vmcnt(0)" ::: "memory");
    __syncthreads();
    if (b.wave == 0 && lane_now() == 0) {
        unsigned* bar = b.bar;
        __builtin_amdgcn_s_waitcnt(0);
        unsigned nloc = b.st[0], nx = b.st[1];
        if (nloc == 0u) { xcd_barrier_complete(bar, b.x, nloc, nx); b.st[0] = nloc; b.st[1] = nx; }
        const unsigned old = xb_add(&bar[XB_XSUB(b.x)], 1u);
        const unsigned gen = old / nloc;
        if (old + 1u == (gen + 1u) * nloc) {
            __builtin_amdgcn_fence(__ATOMIC_RELEASE, "agent");
            asm volatile("s_waitcnt vmcnt(0)" ::: "memory");
            const unsigned og = xb_add(&bar[XB_TOP], 1u);
            const unsigned tg = og / nx;
            if (og + 1u == (tg + 1u) * nx) xb_add(&bar[XB_TOPGEN], 1u);
            else XB_SPIN(xb_ld(&bar[XB_TOPGEN]) == tg, bar);
            __builtin_amdgcn_fence(__ATOMIC_ACQUIRE, "agent");
            xb_add(&bar[XB_XGEN(b.x)], 1u);
            asm volatile("s_waitcnt vmcnt(0)" ::: "memory");
        } else {
            XB_SPIN(xb_ld(&bar[XB_XGEN(b.x)]) == gen, bar);
            __builtin_amdgcn_fence(__ATOMIC_ACQUIRE, "agent");
            asm volatile("s_waitcnt vmcnt(0)" ::: "memory");
        }
    }
    __syncthreads();
}
constexpr int NSG_C = 64;
struct Frame {
    LAS unsigned char* lds;
    volatile LAS unsigned* MISC;
    gu32* ctl;
    int wave;
    int vcu, G;
    unsigned lbn;
    int sidx, pidx;
    const float* in[21]; float* out; unsigned char* ws;
};
__device__ __forceinline__ float wave_sum(float v) {
#pragma unroll
    for (int o = 1; o < 64; o <<= 1) v += __shfl_xor(v, o);
    return v;
}
__device__ __forceinline__ bf16* wsb(Frame& F, size_t off) { return (bf16*)(F.ws + off); }
__device__ __forceinline__ bf16* wlayer(Frame& F, int li, size_t off) { return (bf16*)(F.ws + WS_W + (size_t)li * W_LAYER + off); }

__device__ __forceinline__ int map_row(int kind, int n0) {
    if (kind == 1) { const int bj = n0 / DFF, rem = n0 - bj * DFF; return (rem >> 7) * 256 + bj * 128 + (rem & 127); }
    if (kind == 2) {
        if (n0 < 2048) return (n0 & ~255) + ((n0 >> 5) & 1) * 128 + ((n0 >> 6) & 3) * 32;
        if (n0 >= 3584 && n0 < 4608) { const int x = n0 >= 4096, j = n0 - (x ? 4096 : 3584); return 3584 + (j >> 7) * 256 + x * 128 + (j & 127); }
        return n0; }
    return n0;
}
__device__ __forceinline__ void p0_transpose_item(const float* W, int N, bf16* WT, int ldk, int kind, LAS float* scr, int item, int lane) {
    const int nblk = N / 32, kb = item / nblk, nb = item % nblk, k0 = 64 * kb, n0 = 32 * nb;
#pragma unroll 8
    for (int i = 0; i < 32; ++i) { const int kk = 2 * i + (lane >> 5); scr[kk * 33 + (lane & 31)] = W[(size_t)(k0 + kk) * N + n0 + (lane & 31)]; }
    LDS_WAIT(); asm volatile("" ::: "memory");
    const int c = lane & 7; const int r0 = map_row(kind, n0);
#pragma unroll
    for (int j = 0; j < 4; ++j) { const int n = (lane >> 3) + 8 * j; const LAS float* s = scr + (8 * c) * 33 + n;
        v4u o; o.x = pk2(s[0 * 33], s[1 * 33]); o.y = pk2(s[2 * 33], s[3 * 33]); o.z = pk2(s[4 * 33], s[5 * 33]); o.w = pk2(s[6 * 33], s[7 * 33]);
        *(GAS v4u*)(WT + (size_t)(r0 + n) * ldk + k0 + 8 * c) = o; }
    LDS_WAIT(); asm volatile("" ::: "memory");
}
__device__ __forceinline__ void p0_weff_item(const float* pool_w, const float* pool_scale, const float* wbr, bf16* WT, int item, int lane) {
    const int kb = item >> 4, nb = item & 15, k0 = kb * 8, g = k0 >> 7, c0 = k0 & 127, n = nb * 64 + lane;
    float acc[8];
#pragma unroll
    for (int i = 0; i < 8; ++i) acc[i] = 0.f;
    const float* pw = pool_w + ((size_t)g * 128 + c0) * 128; const float* ps = pool_scale + g * 128; const float* wb = wbr + (size_t)(1536 + g * 128) * D + n;
    for (int dd = 0; dd < 128; ++dd) { const float w = wb[(size_t)dd * D] * ps[dd];
#pragma unroll
        for (int i = 0; i < 8; ++i) acc[i] += pw[i * 128 + dd] * w; }
    v4u o; o.x = pk2(acc[0], acc[1]); o.y = pk2(acc[2], acc[3]); o.z = pk2(acc[4], acc[5]); o.w = pk2(acc[6], acc[7]);
    *(GAS v4u*)(WT + (size_t)n * KBR + 1536 + k0) = o;
}
__device__ __forceinline__ void norm_row(int lane, const float* yrow, const float* hin, float coef, const float* ga, float* hout, const float* gb, bf16* xnrow) {
    const GAS f32x4* hr = (const GAS f32x4*)hin + lane;
    f32x4 h[4];
#pragma unroll
    for (int j = 0; j < 4; ++j) h[j] = hr[64 * j];
    if (yrow) {
        const GAS f32x4* yr = (const GAS f32x4*)yrow + lane; f32x4 y[4]; float s = 0.f;
#pragma unroll
        for (int j = 0; j < 4; ++j) { y[j] = yr[64 * j]; s += (y[j].x * y[j].x + y[j].y * y[j].y) + (y[j].z * y[j].z + y[j].w * y[j].w); }
        const float r = coef * __builtin_amdgcn_rsqf(wave_sum(s) * (1.f / D) + RMS_EPS);
#pragma unroll
        for (int j = 0; j < 4; ++j) { const f32x4 g = ((const GAS f32x4*)ga + lane)[64 * j]; h[j] = h[j] + y[j] * r * g; }
    }
    GAS f32x4* ho = (GAS f32x4*)hout + lane;
#pragma unroll
    for (int j = 0; j < 4; ++j) ho[64 * j] = h[j];
    if (xnrow) {
        float s2 = 0.f;
#pragma unroll
        for (int j = 0; j < 4; ++j) s2 += (h[j].x * h[j].x + h[j].y * h[j].y) + (h[j].z * h[j].z + h[j].w * h[j].w);
        const float r2 = __builtin_amdgcn_rsqf(wave_sum(s2) * (1.f / D) + RMS_EPS);
        GAS unsigned long long* o8 = (GAS unsigned long long*)xnrow + lane;
#pragma unroll
        for (int j = 0; j < 4; ++j) { const f32x4 g = ((const GAS f32x4*)gb + lane)[64 * j]; const f32x4 v = h[j] * r2 * g;
            o8[64 * j] = (unsigned long long)pk2(v.x, v.y) | ((unsigned long long)pk2(v.z, v.w) << 32); }
    }
}
__device__ __forceinline__ void rope_entry(int pos, int d, float& c, float& s) {
    double inv = 1.0; for (int i = 0; i < d; ++i) inv *= 0.7498942093324559;
    const float ang = (float)pos * (float)inv; const double a = (double)ang;
    const double q = __builtin_rint(a * 0.6366197723675814);
    double y = __builtin_fma(-q, 1.5707963267948966, a); y = __builtin_fma(-q, 6.123233995736766e-17, y);
    const double y2 = y * y;
    const double sp = y * (1.0 + y2 * (-1.0 / 6.0 + y2 * (1.0 / 120.0 + y2 * (-1.0 / 5040.0 + y2 * (1.0 / 362880.0 + y2 * (-1.0 / 39916800.0 + y2 * (1.0 / 6227020800.0)))))));
    const double cp = 1.0 + y2 * (-0.5 + y2 * (1.0 / 24.0 + y2 * (-1.0 / 720.0 + y2 * (1.0 / 40320.0 + y2 * (-1.0 / 3628800.0 + y2 * (1.0 / 479001600.0 + y2 * (-1.0 / 87178291200.0)))))));
    const int qi = ((int)q) & 3;
    const double sv = (qi == 0) ? sp : (qi == 1) ? cp : (qi == 2) ? -sp : -cp;
    const double cv = (qi == 0) ? cp : (qi == 1) ? -sp : (qi == 2) ? -cp : sp;
    c = (float)cv; s = (float)sv;
}
struct RowRegs { f32x4 y[4], h[4]; };
typedef unsigned u32x2r __attribute__((ext_vector_type(2)));
__device__ __forceinline__ f32x4 bf4_to_f32(const u32x2r w) { return (f32x4){__uint_as_float(w.x << 16), __uint_as_float(w.x & 0xffff0000u), __uint_as_float(w.y << 16), __uint_as_float(w.y & 0xffff0000u)}; }
__device__ __forceinline__ void row_load(int lane, const bf16* Y, const bf16* H, int m, RowRegs& R) {
    const GAS u32x2r* yr = (const GAS u32x2r*)(Y + (size_t)m * D) + lane; const GAS u32x2r* hr = (const GAS u32x2r*)(H + (size_t)m * D) + lane;
    u32x2r yw[4], hw[4];
#pragma unroll
    for (int j = 0; j < 4; ++j) { yw[j] = yr[64 * j]; hw[j] = hr[64 * j]; }
#pragma unroll
    for (int j = 0; j < 4; ++j) { R.y[j] = bf4_to_f32(yw[j]); R.h[j] = bf4_to_f32(hw[j]); }
}
__device__ __forceinline__ void row_finish(int lane, RowRegs& R, float coef, const f32x4 (&ga)[4], const f32x4 (&gb)[4], bf16* H, bf16* XN, int m, bool write_xn, float* fin) {
    float s = 0.f;
#pragma unroll
    for (int j = 0; j < 4; ++j) s += (R.y[j].x * R.y[j].x + R.y[j].y * R.y[j].y) + (R.y[j].z * R.y[j].z + R.y[j].w * R.y[j].w);
    const float r = coef * __builtin_amdgcn_rsqf(wave_sum(s) * (1.f / D) + RMS_EPS);
    GAS unsigned long long* hb = (GAS unsigned long long*)(H + (size_t)m * D) + lane; GAS f32x4* ho = (GAS f32x4*)(fin + (size_t)m * D) + lane; float s2 = 0.f;
#pragma unroll
    for (int j = 0; j < 4; ++j) { R.h[j] = R.h[j] + R.y[j] * r * ga[j]; if (fin) ho[64 * j] = R.h[j]; else hb[64 * j] = (unsigned long long)pk2(R.h[j].x, R.h[j].y) | ((unsigned long long)pk2(R.h[j].z, R.h[j].w) << 32); s2 += (R.h[j].x * R.h[j].x + R.h[j].y * R.h[j].y) + (R.h[j].z * R.h[j].z + R.h[j].w * R.h[j].w); }
    if (write_xn) {
        const float r2 = __builtin_amdgcn_rsqf(wave_sum(s2) * (1.f / D) + RMS_EPS);
        GAS unsigned long long* o8 = (GAS unsigned long long*)(XN + (size_t)m * D) + lane;
#pragma unroll
        for (int j = 0; j < 4; ++j) { const f32x4 v = R.h[j] * r2 * gb[j]; o8[64 * j] = (unsigned long long)pk2(v.x, v.y) | ((unsigned long long)pk2(v.z, v.w) << 32); }
    }
}
__device__ __forceinline__ void norm_phase(Frame& F, float coef, const float* ga_, const float* gb_, bool write_xn, int m0, int m1, int gw, int NGW, bool dry = false, bool final_ = false) {
    const bf16* Y = (const bf16*)(F.ws + WS_YB); bf16* XN = dry ? (bf16*)(F.ws + WS_DUMMY + 160 * MiB) : wsb(F, WS_XN); const bf16* H = wsb(F, WS_HB); bf16* HO = dry ? (bf16*)(F.ws + WS_DUMMY) : wsb(F, WS_HB);
    float* fin = (final_ && !dry) ? F.out : nullptr;
    const int lane = lane_now();
    f32x4 ga[4], gb[4];
#pragma unroll
    for (int j = 0; j < 4; ++j) { ga[j] = ((const GAS f32x4*)ga_ + lane)[64 * j]; gb[j] = write_xn ? ((const GAS f32x4*)gb_ + lane)[64 * j] : (f32x4){0.f, 0.f, 0.f, 0.f}; }
    for (int m = m0 + gw; m < m1; m += 4 * NGW) {
        const int mb = m + NGW, mc = m + 2 * NGW, md = m + 3 * NGW; const bool hasb = mb < m1, hasc = mc < m1, hasd = md < m1;
        RowRegs A, B, C, E; row_load(lane, Y, H, m, A); if (hasb) row_load(lane, Y, H, mb, B); if (hasc) row_load(lane, Y, H, mc, C); if (hasd) row_load(lane, Y, H, md, E);
        row_finish(lane, A, coef, ga, gb, HO, XN, m, write_xn, fin);
        if (hasb) row_finish(lane, B, coef, ga, gb, HO, XN, mb, write_xn, fin);
        if (hasc) row_finish(lane, C, coef, ga, gb, HO, XN, mc, write_xn, fin);
        if (hasd) row_finish(lane, E, coef, ga, gb, HO, XN, md, write_xn, fin);
    }
}
__device__ __forceinline__ void norm_phase_sample(Frame& F, float coef, const float* ga_, const float* gb_, bool write_xn, const float* ysrc, int nslab, bool final_ = false) {
    const int lane = lane_now(); bf16* XN = wsb(F, WS_XN); bf16* H = wsb(F, WS_HB); float* fin = final_ ? F.out : nullptr;
    f32x4 ga[4], gb[4];
#pragma unroll
    for (int j = 0; j < 4; ++j) { ga[j] = ((const GAS f32x4*)ga_ + lane)[64 * j]; gb[j] = write_xn ? ((const GAS f32x4*)gb_ + lane)[64 * j] : (f32x4){0.f, 0.f, 0.f, 0.f}; }
    for (int r = F.sidx * NWAVES + F.wave; r < MS; r += NSG_C * NWAVES) {
        RowRegs A; const int m = MP + r;
        const GAS u32x2r* hr = (const GAS u32x2r*)(H + (size_t)m * D) + lane;
#pragma unroll
        for (int j = 0; j < 4; ++j) { A.h[j] = bf4_to_f32(hr[64 * j]); A.y[j] = (f32x4){0.f, 0.f, 0.f, 0.f}; }
        for (int sl = 0; sl < nslab; ++sl) { const GAS f32x4* yr = (const GAS f32x4*)(ysrc + (size_t)sl * MS * D + (size_t)r * D) + lane;
#pragma unroll
            for (int j = 0; j < 4; ++j) A.y[j] = A.y[j] + yr[64 * j]; }
        if (nslab == 0) { const GAS u32x2r* yr = (const GAS u32x2r*)((const bf16*)(F.ws + WS_YB) + (size_t)m * D) + lane;
#pragma unroll
            for (int j = 0; j < 4; ++j) A.y[j] = bf4_to_f32(yr[64 * j]); }
        row_finish(lane, A, coef, ga, gb, H, XN, m, write_xn, fin);
    }
}
__device__ __forceinline__ void p0_layer(Frame& F, const int li, const int gw, const int NGW, const int parts = 31) {
    LAS float* scr = (LAS float*)(F.lds + RING_OFF + F.wave * 16384);
    const int lane = lane_now();
    for (int f = 0; f < 2; ++f) {
        if (parts & 1) { const float* wu = F.in[9] + (size_t)(li * 2 + f) * D * NUP; bf16* du = wlayer(F, li, f ? W_UP2 : W_UP1);
            for (int it = gw; it < (D / 64) * (NUP / 32); it += NGW) p0_transpose_item(wu, NUP, du, D, 1, scr, it, lane); }
        if (parts & 2) { const float* wd = F.in[10] + (size_t)(li * 2 + f) * DFF * D; bf16* dd = wlayer(F, li, f ? W_DN2 : W_DN1);
            for (int it = gw; it < (DFF / 64) * (D / 32); it += NGW) p0_transpose_item(wd, D, dd, DFF, 0, scr, it, lane); }
    }
    if (parts & 4) for (int it = gw; it < (D / 64) * (NIN / 32); it += NGW) p0_transpose_item(F.in[11] + (size_t)li * D * NIN, NIN, wlayer(F, li, W_IN), D, 2, scr, it, lane);
    if (parts & 8) {
        for (int it = gw; it < (1536 / 64) * (D / 32); it += NGW) p0_transpose_item(F.in[17] + (size_t)li * KBR * D, D, wlayer(F, li, W_BR), KBR, 0, scr, it, lane);
        for (int it = gw; it < (D / 64) * (D / 32); it += NGW) p0_transpose_item(F.in[18] + (size_t)li * D * D, D, wlayer(F, li, W_OUT), D, 0, scr, it, lane);
        for (int it = gw; it < (D / 64) * (D / 32); it += NGW) p0_transpose_item(F.in[20] + (size_t)li * D * D, D, wlayer(F, li, W_PG), D, 0, scr, it, lane);
        for (int it = gw; it < (PLE / 64) * (D / 32); it += NGW) p0_transpose_item(F.in[19] + (size_t)li * PLE * D, D, wlayer(F, li, W_PU), PLE, 0, scr, it, lane);
        for (int it = gw; it < 64 * 16; it += NGW) p0_weff_item(F.in[15] + (size_t)li * 4 * 128 * 128, F.in[16] + (size_t)li * 512, F.in[17] + (size_t)li * KBR * D, wlayer(F, li, W_BR), it, lane);
    }
    if (parts & 16) { bf16* pb = (bf16*)(F.ws + WS_PB + (size_t)li * PB_LAYER);
        for (int m = gw; m < M; m += NGW) { const float* src = m < MP ? F.in[6] + ((size_t)li * MP + m) * PLE : F.in[7] + ((size_t)li * MS + (m - MP)) * PLE;
            const f32x4 v = ((const GAS f32x4*)src)[lane]; ((GAS unsigned long long*)(pb + (size_t)m * PLE))[lane] = (unsigned long long)pk2(v.x, v.y) | ((unsigned long long)pk2(v.z, v.w) << 32); } }
}
__device__ __forceinline__ void p0_prologue(Frame& F) {
    const int gw = F.vcu * NWAVES + F.wave, NGW = F.G * NWAVES; const int lane = lane_now();
    p0_layer(F, 0, gw, NGW);
    { float* rc = (float*)(F.ws + WS_ROPEC); float* rs = (float*)(F.ws + WS_ROPES);
      for (int i = gw * 64 + lane; i < SEQ * 32; i += NGW * 64) { float c, s; rope_entry(i >> 5, i & 31, c, s); rc[i] = c; rs[i] = s; } }
    bf16* XN = wsb(F, WS_XN); bf16* HB = wsb(F, WS_HB);
    for (int m = gw; m < M; m += NGW) { const float* xr = m < MP ? F.in[0] + (size_t)m * D : F.in[1] + (size_t)(m - MP) * D;
        const GAS f32x4* xp = (const GAS f32x4*)xr + lane; f32x4 h[4]; float s2 = 0.f;
#pragma unroll
        for (int j = 0; j < 4; ++j) { h[j] = xp[64 * j]; s2 += (h[j].x * h[j].x + h[j].y * h[j].y) + (h[j].z * h[j].z + h[j].w * h[j].w); }
        const float r2 = __builtin_amdgcn_rsqf(wave_sum(s2) * (1.f / D) + RMS_EPS);
        GAS unsigned long long* hb = (GAS unsigned long long*)(HB + (size_t)m * D) + lane; GAS unsigned long long* o8 = (GAS unsigned long long*)(XN + (size_t)m * D) + lane;
#pragma unroll
        for (int j = 0; j < 4; ++j) { hb[64 * j] = (unsigned long long)pk2(h[j].x, h[j].y) | ((unsigned long long)pk2(h[j].z, h[j].w) << 32);
            const f32x4 g = ((const GAS f32x4*)F.in[8] + lane)[64 * j]; const f32x4 v = h[j] * r2 * g; o8[64 * j] = (unsigned long long)pk2(v.x, v.y) | ((unsigned long long)pk2(v.z, v.w) << 32); } }
}
__device__ __forceinline__ void unpack8f(const v4u w, float (&f)[8]) {
    f[0] = __uint_as_float(w.x << 16); f[1] = __uint_as_float(w.x & 0xffff0000u); f[2] = __uint_as_float(w.y << 16); f[3] = __uint_as_float(w.y & 0xffff0000u);
    f[4] = __uint_as_float(w.z << 16); f[5] = __uint_as_float(w.z & 0xffff0000u); f[6] = __uint_as_float(w.w << 16); f[7] = __uint_as_float(w.w & 0xffff0000u); }
__device__ __forceinline__ v4u pack8f(const float (&f)[8]) { v4u o; o.x = pk2(f[0], f[1]); o.y = pk2(f[2], f[3]); o.z = pk2(f[4], f[5]); o.w = pk2(f[6], f[7]); return o; }
__device__ __forceinline__ void e2_phase(Frame& F, int li, int m0, int m1, int gw, int NGW) {
    const int lane = lane_now();
    const float* lam = F.in[12] + li * 256;
    const float s1 = wave_sum(lam[lane] * lam[64 + lane]), s2 = wave_sum(lam[128 + lane] * lam[192 + lane]);
    const float lam_init = 0.8f - 0.6f * __expf(-0.3f * (float)li);
    const float lam_full = __expf(s1) - __expf(s2) + lam_init, osc = 1.0f - lam_init;
    const bf16* O = wsb(F, WS_O); const bf16* BG = wsb(F, WS_BG); const bf16* C = wsb(F, WS_C); const bf16* ZP = wsb(F, WS_ZP); bf16* A2 = wsb(F, WS_A2);
    const int hh = lane >> 3, e0 = (lane & 7) * 16, c0 = lane * 8, grp = lane >> 4, win = 2 << grp;
    float sg[16];
#pragma unroll
    for (int i = 0; i < 16; ++i) sg[i] = F.in[13][li * 1024 + hh * 128 + e0 + i];
    float cw[3][8];
#pragma unroll
    for (int j = 0; j < 3; ++j)
#pragma unroll
        for (int i = 0; i < 8; ++i) cw[j][i] = F.in[14][(li * 3 + j) * 512 + c0 + i];
    for (int m = m0 + gw; m < m1; m += NGW) {
        const bool samp = m >= MP; const int t = samp ? ((m - MP) & 31) : (m & (SEQ - 1)); const int b = samp ? ((m - MP) >> 5) : (m >> 14); const int T = samp ? DSEQ : SEQ;
        { const bf16* orow = O + (size_t)m * 2048 + hh * 256 + e0;
          float o1[16], o2[16]; { float t8[8]; unpack8f(*(const GAS v4u*)orow, t8); for (int i = 0; i < 8; ++i) o1[i] = t8[i]; unpack8f(*(const GAS v4u*)(orow + 8), t8); for (int i = 0; i < 8; ++i) o1[8 + i] = t8[i];
              unpack8f(*(const GAS v4u*)(orow + 128), t8); for (int i = 0; i < 8; ++i) o2[i] = t8[i]; unpack8f(*(const GAS v4u*)(orow + 136), t8); for (int i = 0; i < 8; ++i) o2[8 + i] = t8[i]; }
          float ss = 0.f;
#pragma unroll
          for (int i = 0; i < 16; ++i) { o1[i] = o1[i] - lam_full * o2[i]; ss += o1[i] * o1[i]; }
          ss += __shfl_xor(ss, 1); ss += __shfl_xor(ss, 2); ss += __shfl_xor(ss, 4);
          const float r = __builtin_amdgcn_rsqf(ss * (1.f / 128.f) + RMS_EPS) * osc;
          float a0[8], a1[8];
#pragma unroll
          for (int i = 0; i < 8; ++i) { a0[i] = o1[i] * r * sg[i]; a1[i] = o1[8 + i] * r * sg[8 + i]; }
          bf16* arow = A2 + (size_t)m * KBR + hh * 128 + e0; *(GAS v4u*)arow = pack8f(a0); *(GAS v4u*)(arow + 8) = pack8f(a1); }
        { float z0[8], z1[8], z2[8], bgv[8];
          unpack8f(*(const GAS v4u*)(C + (size_t)m * 512 + c0), z0); unpack8f(*(const GAS v4u*)(BG + (size_t)m * 512 + c0), bgv);
          const float* hist = F.in[4] + ((size_t)(li * DB + b) * 2) * 512 + c0;
          if (t >= 1) unpack8f(*(const GAS v4u*)(C + (size_t)(m - 1) * 512 + c0), z1);
          else { for (int i = 0; i < 8; ++i) z1[i] = samp ? hist[512 + i] : 0.f; }
          if (t >= 2) unpack8f(*(const GAS v4u*)(C + (size_t)(m - 2) * 512 + c0), z2);
          else { for (int i = 0; i < 8; ++i) z2[i] = samp ? hist[t * 512 + i] : 0.f; }
          float y[8];
#pragma unroll
          for (int i = 0; i < 8; ++i) y[i] = bgv[i] * (cw[0][i] * z2[i] + cw[1][i] * z1[i] + cw[2][i] * z0[i]);
          *(GAS v4u*)(A2 + (size_t)m * KBR + 1024 + c0) = pack8f(y);
          if (t >= T - 2) { float* dst = samp ? F.out + O_CS + ((size_t)(li * DB + b) * 2 + (t - (T - 2))) * 512 + c0 : F.out + O_CP + ((size_t)(li * 2 + b) * 2 + (t - (T - 2))) * 512 + c0;
              *(GAS f32x4*)dst = (f32x4){z0[0], z0[1], z0[2], z0[3]}; *(GAS f32x4*)(dst + 4) = (f32x4){z0[4], z0[5], z0[6], z0[7]}; } }
        { float zc[8], ws8[8]; unpack8f(*(const GAS v4u*)(ZP + (size_t)m * 512 + c0), zc);
#pragma unroll
          for (int i = 0; i < 8; ++i) ws8[i] = zc[i];
          if (t >= 15) {
              v4u zr[15];
#pragma unroll
              for (int j = 1; j < 16; ++j) { const int jj = j < win ? j : win - 1; zr[j - 1] = *(const GAS v4u*)(ZP + (size_t)(m - jj) * 512 + c0); }
#pragma unroll
              for (int j = 1; j < 16; ++j) { float zz[8]; unpack8f(zr[j - 1], zz); const float wj = j < win ? 1.f : 0.f;
#pragma unroll
                  for (int q = 0; q < 8; ++q) ws8[q] += wj * zz[q]; }
          } else {
          const float* phist = F.in[5] + ((size_t)(li * DB + b) * 15) * 512 + c0;
          for (int j = 1; j < 16; ++j) { if (j < win) { const int i = t - j;
                  if (i >= 0) { float zz[8]; unpack8f(*(const GAS v4u*)(ZP + (size_t)(m - j) * 512 + c0), zz);
#pragma unroll
                      for (int q = 0; q < 8; ++q) ws8[q] += zz[q]; }
                  else if (samp) { const float* hp = phist + (size_t)(15 + i) * 512;
#pragma unroll
                      for (int q = 0; q < 8; ++q) ws8[q] += hp[q]; } } }
          }
          const int cnt = min(t + 1 + (samp ? 15 : 0), win); const float rc = 1.0f / (float)cnt;
          float dv[8];
#pragma unroll
          for (int i = 0; i < 8; ++i) dv[i] = ws8[i] * rc - zc[i];
          *(GAS v4u*)(A2 + (size_t)m * KBR + 1536 + c0) = pack8f(dv);
          if (t >= T - 15) { float* dst = samp ? F.out + O_PS + ((size_t)(li * DB + b) * 15 + (t - (T - 15))) * 512 + c0 : F.out + O_PP + ((size_t)(li * 2 + b) * 15 + (t - (T - 15))) * 512 + c0;
              *(GAS f32x4*)dst = (f32x4){zc[0], zc[1], zc[2], zc[3]}; *(GAS f32x4*)(dst + 4) = (f32x4){zc[4], zc[5], zc[6], zc[7]}; } }
    }
}
typedef float f32x16 __attribute__((ext_vector_type(16)));
__device__ __forceinline__ bf16x8 cvt8(const f32x4 a, const f32x4 b) { v4u w; w.x = pk2(a.x, a.y); w.y = pk2(a.z, a.w); w.z = pk2(b.x, b.y); w.w = pk2(b.z, b.w); return __builtin_bit_cast(bf16x8, w); }
__device__ __forceinline__ int crow16(int r, int hi) { return (r & 3) + 8 * (r >> 2) + 4 * hi; }
__device__ __forceinline__ void sattn_unit(Frame& F, int li, int b, int head) {
    const int lane = lane_now(), wid = F.wave, r32 = lane & 31, hi = lane >> 5;
    LAS float* Lmx = (LAS float*)(F.lds + LDSCTL_OFF + 1024);
    LAS float* Lsum = (LAS float*)(F.lds + LDSCTL_OFF + 3072);
    const bf16* Qs = wsb(F, WS_Q) + (size_t)(MP + b * DSEQ) * D;
    const float* kc = F.in[2] + ((size_t)(li * DB + b) * PAST) * D; const float* vc = F.in[3] + ((size_t)(li * DB + b) * PAST) * D;
    const float* kn = F.out + O_KS + ((size_t)li * MS + b * DSEQ) * D; const float* vn = F.out + O_VS + ((size_t)li * MS + b * DSEQ) * D;
    bf16x8 qr[2][4];
#pragma unroll
    for (int mm = 0; mm < 2; ++mm)
#pragma unroll
        for (int d0 = 0; d0 < 4; ++d0) qr[mm][d0] = *(const GAS bf16x8*)(Qs + (size_t)r32 * D + (2 * head + mm) * 64 + d0 * 16 + hi * 8);
    const int nblk = (wid == 0) ? 5 : 4;
    f32x16 o[2][4];
#pragma unroll
    for (int mm = 0; mm < 2; ++mm)
#pragma unroll
        for (int eb = 0; eb < 4; ++eb) o[mm][eb] = (f32x16){};
    float lsum[2] = {0.f, 0.f}, mrun[2] = {-1e30f, -1e30f};
    for (int i = 0; i < nblk; ++i) { const int blk = (i < 4) ? wid + 8 * i : 32; const float* kb = (blk < 32) ? kc + (size_t)(blk * 32) * D : kn; const float* vb = (blk < 32) ? vc + (size_t)(blk * 32) * D : vn;
        f32x16 s[2];
#pragma unroll
        for (int mm = 0; mm < 2; ++mm) { s[mm] = (f32x16){};
#pragma unroll
            for (int d0 = 0; d0 < 4; ++d0) { const float* kp = kb + (size_t)r32 * D + (2 * head + mm) * 64 + d0 * 16 + hi * 8; const bf16x8 kf = cvt8(*(const GAS f32x4*)kp, *(const GAS f32x4*)(kp + 4));
                s[mm] = __builtin_amdgcn_mfma_f32_32x32x16_bf16(kf, qr[mm][d0], s[mm], 0, 0, 0); } }
        bf16x8 pf[2][2];
#pragma unroll
        for (int mm = 0; mm < 2; ++mm) {
            float mloc = s[mm][0];
#pragma unroll
            for (int r = 1; r < 16; ++r) mloc = fmaxf(mloc, s[mm][r]);
            mloc = fmaxf(mloc, __shfl_xor(mloc, 32));
            const float mnew = fmaxf(mrun[mm], mloc), sc = __builtin_amdgcn_exp2f(mrun[mm] - mnew); mrun[mm] = mnew;
            lsum[mm] *= sc;
#pragma unroll
            for (int eb = 0; eb < 4; ++eb)
#pragma unroll
                for (int r = 0; r < 16; ++r) o[mm][eb][r] *= sc;
            float acc = 0.f;
#pragma unroll
            for (int r = 0; r < 16; ++r) { s[mm][r] = __builtin_amdgcn_exp2f(s[mm][r] - mnew); acc += s[mm][r]; }
            lsum[mm] += acc;
#pragma unroll
            for (int k2 = 0; k2 < 2; ++k2) pf[mm][k2] = cvt8((f32x4){s[mm][8 * k2], s[mm][8 * k2 + 1], s[mm][8 * k2 + 2], s[mm][8 * k2 + 3]}, (f32x4){s[mm][8 * k2 + 4], s[mm][8 * k2 + 5], s[mm][8 * k2 + 6], s[mm][8 * k2 + 7]}); }
#pragma unroll
        for (int eb = 0; eb < 4; ++eb)
#pragma unroll
            for (int k2 = 0; k2 < 2; ++k2) { const float* vp = vb + (size_t)(16 * k2 + 4 * hi) * D + head * 128 + eb * 32 + r32;
                const f32x4 va = {vp[0], vp[D], vp[2 * D], vp[3 * D]}, vb4 = {vp[8 * D], vp[9 * D], vp[10 * D], vp[11 * D]}; const bf16x8 vf = cvt8(va, vb4);
                o[0][eb] = __builtin_amdgcn_mfma_f32_32x32x16_bf16(vf, pf[0][k2], o[0][eb], 0, 0, 0); o[1][eb] = __builtin_amdgcn_mfma_f32_32x32x16_bf16(vf, pf[1][k2], o[1][eb], 0, 0, 0); } }
#pragma unroll
    for (int mm = 0; mm < 2; ++mm) { lsum[mm] += __shfl_xor(lsum[mm], 32); if (hi == 0) { Lmx[(mm * 8 + wid) * 32 + r32] = mrun[mm]; Lsum[(mm * 8 + wid) * 32 + r32] = lsum[mm]; } }
    __syncthreads();
#pragma unroll
    for (int mm = 0; mm < 2; ++mm) { float M = Lmx[(mm * 8) * 32 + r32];
#pragma unroll
        for (int w = 1; w < 8; ++w) M = fmaxf(M, Lmx[(mm * 8 + w) * 32 + r32]);
        const float f = __builtin_amdgcn_exp2f(mrun[mm] - M);
#pragma unroll
        for (int eb = 0; eb < 4; ++eb)
#pragma unroll
            for (int r = 0; r < 16; ++r) o[mm][eb][r] *= f; }
    LAS float* Lw = (LAS float*)(F.lds + RING_OFF) + wid * 4096;
#pragma unroll
    for (int mm = 0; mm < 2; ++mm) {
        __syncthreads();
#pragma unroll
        for (int eb = 0; eb < 4; ++eb)
#pragma unroll
            for (int r = 0; r < 16; ++r) Lw[(eb * 32 + crow16(r, hi)) * 32 + r32] = o[mm][eb][r];
        __syncthreads();
        { const int q = lane & 31, e0 = (wid * 2 + (lane >> 5)) * 8; float L = 0.f;
          float Mq = Lmx[(mm * 8) * 32 + q];
#pragma unroll
          for (int w = 1; w < 8; ++w) Mq = fmaxf(Mq, Lmx[(mm * 8 + w) * 32 + q]);
#pragma unroll
          for (int w = 0; w < 8; ++w) L += Lsum[(mm * 8 + w) * 32 + q] * __builtin_amdgcn_exp2f(Lmx[(mm * 8 + w) * 32 + q] - Mq);
          const float inv = 1.0f / L; float v[8];
#pragma unroll
          for (int i = 0; i < 8; ++i) { float a = 0.f;
#pragma unroll
              for (int w = 0; w < 8; ++w) a += ((LAS float*)(F.lds + RING_OFF))[w * 4096 + (e0 + i) * 32 + q];
              v[i] = a * inv; }
          bf16* orow = wsb(F, WS_O) + (size_t)(MP + b * DSEQ + q) * 2048 + (2 * head + mm) * 128 + e0; *(GAS v4u*)orow = pack8f(v); }
    }
    __syncthreads();
}
#ifndef KEEP_UP
#define KEEP_UP 1
#endif
#ifndef KEEP_DOWN
#define KEEP_DOWN 1
#endif
#ifndef KEEP_N1
#define KEEP_N1 1
#endif
#ifndef KEEP_WIN
#define KEEP_WIN 1
#endif
#ifndef KEEP_ATT
#define KEEP_ATT 1
#endif
#ifndef KEEP_E2
#define KEEP_E2 1
#endif
#ifndef KEEP_BR
#define KEEP_BR 1
#endif
#ifndef KEEP_WOUT
#define KEEP_WOUT 1
#endif
#ifndef KEEP_N3
#define KEEP_N3 1
#endif
#ifndef KEEP_PG
#define KEEP_PG 1
#endif
#ifndef KEEP_N5
#define KEEP_N5 1
#endif
#ifndef KEEP_PRO
#define KEEP_PRO 1
#endif
struct Args { const float* in[21]; float* out; unsigned char* ws; int ph_lo, ph_hi; };
#if !MK_PER_PHASE
#define GRID_BAR() do { for (int rb_ = 0; rb_ < REP_BAR; ++rb_) xcd_barrier(bar); } while (0)
#else
#define GRID_BAR() do { if (F.wave == 0 && lane_now() == 0) __hip_atomic_store(F.ctl + CW_TMO, 0xBADBA0u, RLX_AGENT); } while (0)
#endif
#define IN(k) (lo <= (k) && (k) < hi)
#define SEAM(k) do { if (IN(k) && IN((k) + 1)) GRID_BAR(); } while (0)
__device__ __forceinline__ unsigned long long uni64_opaque(unsigned long long v) { unsigned lo = __builtin_amdgcn_readfirstlane((unsigned)v), hi = __builtin_amdgcn_readfirstlane((unsigned)(v >> 32)); asm volatile("" : "+s"(lo), "+s"(hi)); return ((unsigned long long)hi << 32) | lo; }
#define FRESH() do { F.ws = (unsigned char*)(GAS unsigned char*)uni64_opaque((unsigned long long)F.ws); F.out = (float*)(GAS float*)uni64_opaque((unsigned long long)F.out); } while (0)
#define RING (F.lds + RING_OFF)
constexpr int NSG = 64, NPG = 192;
constexpr int CW_GRP = 8192, CW_GRP_TMO = 8256;
constexpr int LB_PER_LAYER = 9;
__device__ __forceinline__ void group_barrier1(Frame& F, const unsigned n) {
    asm volatile("s_waitcnt vmcnt(0)" ::: "memory");
    __syncthreads();
    if (F.wave == 0 && lane_now() == 0) {
        __builtin_amdgcn_s_waitcnt(0);
        __builtin_amdgcn_fence(__ATOMIC_RELEASE, "agent");
        asm volatile("s_waitcnt vmcnt(0)" ::: "memory");
        gu32* c = F.ctl + CW_GRP; const unsigned target = (unsigned)NSG * (n + 1u);
        (void)__hip_atomic_fetch_add(c, 1u, RLX_AGENT);
        unsigned sp = 0u;
        while (__hip_atomic_load(c, RLX_AGENT) < target) { __builtin_amdgcn_s_sleep(1);
            if ((++sp & 255u) == 0u) { if (__hip_atomic_load(F.ctl + CW_GRP_TMO, RLX_AGENT)) break; if (sp > (1u << 20)) { __hip_atomic_store(F.ctl + CW_GRP_TMO, 1u, RLX_AGENT); break; } } }
        __builtin_amdgcn_fence(__ATOMIC_ACQUIRE, "agent");
        asm volatile("s_waitcnt vmcnt(0)" ::: "memory");
    }
    __syncthreads();
}
__device__ __forceinline__ void group_barrier(Frame& F) { for (unsigned r = 0; r < REP_LB; ++r) group_barrier1(F, F.lbn++); }
#define OPAQUE_K(name, val) int name = (val); asm volatile("" : "+s"(name))
#define SAMPLE (F.sidx >= 0)
template <int LI, int HALF> __device__ __forceinline__ void ffn_part(Frame& F, const XcdBarrier& bar, const int lo, const int hi) {
    constexpr int pb = 1 + LI * PH_PER_LAYER, p0 = pb + HALF * 9;
    if (KEEP_UP && IN(p0)) { FRESH(); pg8::Gemm g{wsb(F, WS_XN), wlayer(F, LI, HALF ? W_UP2 : W_UP1), MP, NUP, D}; pg8::StaticOrder S; S.init(MP, NUP, F.G, (int)blockIdx.x);
        pg8::EpiSwiGLU E{wsb(F, WS_HFF), DFF};
        for (int rep = 0; rep < REP_GEMM; ++rep) { if (rep && REP_GEMM_BAR) GRID_BAR(); pg8::gemm_phase<pg8::EpiSwiGLU, pg8::StaticOrder, true, true>(RING, g, S, E, F.wave); } SEAM(p0); }
    if (KEEP_DOWN && IN(p0 + 1)) { FRESH(); { pg8::Gemm g{wsb(F, WS_HFF), wlayer(F, LI, HALF ? W_DN2 : W_DN1), MP, D, DFF}; pg8::StaticOrder S; S.init(MP, D, F.G, (int)blockIdx.x);
        pg8::EpiBf E{wsb(F, WS_YB), D};
        for (int rep = 0; rep < REP_GEMM; ++rep) { if (rep && REP_GEMM_BAR) GRID_BAR(); pg8::gemm_phase<pg8::EpiBf, pg8::StaticOrder, true, true>(RING, g, S, E, F.wave); } } }
    if (KEEP_DOWN && IN(p0 + 1)) {
        if (HALF == 1) { FRESH(); OPAQUE_K(kple, PLE);
            pg8::Gemm g2{(const bf16*)(F.ws + WS_PB + (size_t)LI * PB_LAYER), wlayer(F, LI, W_PU), MP, D, kple}; pg8::StaticOrder S2; S2.init(MP, D, F.G, (int)blockIdx.x);
            pg8::EpiBf E2{wsb(F, WS_PU), D};
            for (int rep = 0; rep < REP_GEMM; ++rep) { if (rep && REP_GEMM_BAR) GRID_BAR(); pg8::gemm_phase<pg8::EpiBf, pg8::StaticOrder, true, true>(RING, g2, S2, E2, F.wave); } }
        SEAM(p0 + 1); }
    if (KEEP_N1 && IN(p0 + 2) && !SAMPLE) { FRESH(); const float* ng = F.in[8] + (size_t)LI * 8 * D; for (int rep = 0; rep < REP_ROW; ++rep) norm_phase(F, 0.5f, ng + (HALF ? 5 : 1) * D, ng + (HALF ? 6 : 2) * D, true, 0, MP, F.pidx * NWAVES + F.wave, NPG * NWAVES, rep + 1 < REP_ROW);
        if (HALF == 0 && LI + 1 < DEPTH) p0_layer(F, LI + 1 < DEPTH ? LI + 1 : LI, F.pidx * NWAVES + F.wave, NPG * NWAVES, 16); }
    if (KEEP_N1 && IN(p0 + 2) && SAMPLE && (HALF == 1 || LI == 0)) { FRESH(); OPAQUE_K(kd, D); pg8::Gemm g{wsb(F, WS_XN), wlayer(F, LI, HALF ? W_UP2 : W_UP1), M, NUP, kd}; pg8::SampleOrder S; S.init(NUP, NSG, F.sidx);
        pg8::EpiSwiGLU E{wsb(F, WS_HFF), DFF};
        for (int rs_ = 0; rs_ < REP_SG; ++rs_) pg8::gemm_phase<pg8::EpiSwiGLU, pg8::SampleOrder, true, true>(RING, g, S, E, F.wave); group_barrier(F); }
    if (KEEP_N1 && IN(p0 + 2) && SAMPLE) { FRESH(); OPAQUE_K(kf, DFF); pg8::Gemm g{wsb(F, WS_HFF), wlayer(F, LI, HALF ? W_DN2 : W_DN1), M, D, kf}; pg8::SampleSplitOrder S; S.init(D, NSG, F.sidx);
        pg8::EpiF32Slab E{(float*)(F.ws + WS_YS)};
        for (int rs_ = 0; rs_ < REP_SG; ++rs_) pg8::gemm_phase<pg8::EpiF32Slab, pg8::SampleSplitOrder, true, true>(RING, g, S, E, F.wave); }
    if (KEEP_N1 && IN(p0 + 2) && SAMPLE && HALF == 1) { FRESH(); OPAQUE_K(kple, PLE);
        pg8::Gemm g2{(const bf16*)(F.ws + WS_PB + (size_t)LI * PB_LAYER), wlayer(F, LI, W_PU), M, D, kple}; pg8::SampleOrder S2; S2.init(D, NSG, (F.sidx + NSG - 32) % NSG);
        pg8::EpiBf E2{wsb(F, WS_PU), D};
        for (int rs_ = 0; rs_ < REP_SG; ++rs_) pg8::gemm_phase<pg8::EpiBf, pg8::SampleOrder, true, true>(RING, g2, S2, E2, F.wave); }
    if (KEEP_N1 && IN(p0 + 2) && SAMPLE) { FRESH(); group_barrier(F); const float* ng = F.in[8] + (size_t)LI * 8 * D;
        norm_phase_sample(F, 0.5f, ng + (HALF ? 5 : 1) * D, ng + (HALF ? 6 : 2) * D, true, (const float*)(F.ws + WS_YS), 4); }
    if (KEEP_N1 && IN(p0 + 2) && SAMPLE && HALF == 0) { FRESH(); group_barrier(F); OPAQUE_K(kd, D); pg8::Gemm g{wsb(F, WS_XN), wlayer(F, LI, W_IN), M, NIN, kd}; pg8::SampleOrder S; S.init(NIN, NSG, F.sidx);
        pg8::EpiWin E{wsb(F, WS_Q), wsb(F, WS_K), wsb(F, WS_V), wsb(F, WS_BG), wsb(F, WS_C), wsb(F, WS_ZP), wsb(F, WS_GS), (const float*)(F.ws + WS_ROPEC), (const float*)(F.ws + WS_ROPES),
                      F.out + O_KP + (size_t)LI * MP * D, F.out + O_VP + (size_t)LI * MP * D, F.out + O_KS + (size_t)LI * MS * D, F.out + O_VS + (size_t)LI * MS * D};
        for (int rs_ = 0; rs_ < REP_SG; ++rs_) pg8::gemm_phase<pg8::EpiWin, pg8::SampleOrder, true, true>(RING, g, S, E, F.wave); }
    if (IN(p0 + 2)) SEAM(p0 + 2);
}
template <int LI> __device__ __forceinline__ void mixer_part(Frame& F, const XcdBarrier& bar, const int lo, const int hi) {
    constexpr int pb = 1 + LI * PH_PER_LAYER;
    if (KEEP_WIN && IN(pb + 3)) { FRESH(); pg8::Gemm g{wsb(F, WS_XN), wlayer(F, LI, W_IN), MP, NIN, D}; pg8::StaticOrder S; S.init(MP, NIN, F.G, (int)blockIdx.x);
        pg8::EpiWin E{wsb(F, WS_Q), wsb(F, WS_K), wsb(F, WS_V), wsb(F, WS_BG), wsb(F, WS_C), wsb(F, WS_ZP), wsb(F, WS_GS), (const float*)(F.ws + WS_ROPEC), (const float*)(F.ws + WS_ROPES),
                      F.out + O_KP + (size_t)LI * MP * D, F.out + O_VP + (size_t)LI * MP * D, F.out + O_KS + (size_t)LI * MS * D, F.out + O_VS + (size_t)LI * MS * D};
        for (int rep = 0; rep < REP_GEMM; ++rep) { if (rep && REP_GEMM_BAR) GRID_BAR(); pg8::gemm_phase<pg8::EpiWin, pg8::StaticOrder, true, true>(RING, g, S, E, F.wave); } SEAM(pb + 3); }
    if (KEEP_ATT && IN(pb + 4)) { FRESH();
        const attn_body::AttnTensors AT{(const attn_body::bf16*)wsb(F, WS_Q), (const attn_body::bf16*)wsb(F, WS_K), (const attn_body::bf16*)wsb(F, WS_V), (attn_body::bf16*)wsb(F, WS_O)};
        for (int rep = 0; rep < REP_ATT; ++rep)
        for (int v = F.vcu; v < 256; v += F.G) attn_body::attn_phase<8>((char*)RING, AT, v, F.wave);
        SEAM(pb + 4); }
    if (KEEP_E2 && IN(pb + 5) && !SAMPLE) { FRESH(); for (int rep = 0; rep < REP_E2; ++rep) e2_phase(F, LI, 0, MP, F.pidx * NWAVES + F.wave, NPG * NWAVES);
        if (LI + 1 < DEPTH) p0_layer(F, LI + 1 < DEPTH ? LI + 1 : LI, F.pidx * NWAVES + F.wave, NPG * NWAVES, 1); }
    if (KEEP_E2 && IN(pb + 5) && SAMPLE) { FRESH(); for (int rs_ = 0; rs_ < REP_SA; ++rs_) for (int su = F.sidx; su < DB * 8; su += NSG) sattn_unit(F, LI, su >> 3, su & 7); group_barrier(F); }
    if (KEEP_E2 && IN(pb + 5) && SAMPLE) { FRESH(); for (int rs_ = 0; rs_ < REP_SE2; ++rs_) e2_phase(F, LI, MP, M, F.sidx * NWAVES + F.wave, NSG * NWAVES); }
    if (IN(pb + 5)) SEAM(pb + 5);
    if (KEEP_BR && IN(pb + 6)) { FRESH(); pg8::Gemm g{wsb(F, WS_A2), wlayer(F, LI, W_BR), MP, D, KBR}; pg8::SegOrder S; S.init(MP, D, F.G, (int)blockIdx.x);
        pg8::EpiSeg E{wsb(F, WS_GS), (float*)(F.ws + WS_Y), wsb(F, WS_MG)};
        for (int rep = 0; rep < REP_GEMM; ++rep) { if (rep && REP_GEMM_BAR) GRID_BAR(); pg8::gemm_phase<pg8::EpiSeg, pg8::SegOrder, true, true>(RING, g, S, E, F.wave); } SEAM(pb + 6); }
    if (KEEP_WOUT && IN(pb + 7)) { FRESH(); pg8::Gemm g{wsb(F, WS_MG), wlayer(F, LI, W_OUT), MP, D, D}; pg8::StaticOrder S; S.init(MP, D, F.G, (int)blockIdx.x);
        pg8::EpiBf E{wsb(F, WS_YB), D};
        for (int rep = 0; rep < REP_GEMM; ++rep) { if (rep && REP_GEMM_BAR) GRID_BAR(); pg8::gemm_phase<pg8::EpiBf, pg8::StaticOrder, true, true>(RING, g, S, E, F.wave); } SEAM(pb + 7); }
    if (KEEP_N3 && IN(pb + 8) && !SAMPLE) { FRESH(); const float* ng = F.in[8] + (size_t)LI * 8 * D; for (int rep = 0; rep < REP_ROW; ++rep) norm_phase(F, 1.0f, ng + 3 * D, ng + 4 * D, true, 0, MP, F.pidx * NWAVES + F.wave, NPG * NWAVES, rep + 1 < REP_ROW);
        if (LI + 1 < DEPTH) p0_layer(F, LI + 1 < DEPTH ? LI + 1 : LI, F.pidx * NWAVES + F.wave, NPG * NWAVES, 4 | 8); }
    if (KEEP_N3 && IN(pb + 8) && SAMPLE) { FRESH(); pg8::Gemm g{wsb(F, WS_A2), wlayer(F, LI, W_BR), M, D, KBR}; pg8::SampleSegOrder S; S.init(D, NSG, F.sidx);
        pg8::EpiSeg E{wsb(F, WS_GS), (float*)(F.ws + WS_Y), wsb(F, WS_MG)};
        for (int rs_ = 0; rs_ < REP_SG; ++rs_) pg8::gemm_phase<pg8::EpiSeg, pg8::SampleSegOrder, true, true>(RING, g, S, E, F.wave); group_barrier(F); }
    if (KEEP_N3 && IN(pb + 8) && SAMPLE) { FRESH(); OPAQUE_K(kd, D); pg8::Gemm g{wsb(F, WS_MG), wlayer(F, LI, W_OUT), M, D, kd}; pg8::SampleOrder S; S.init(D, NSG, F.sidx);
        pg8::EpiBf E{wsb(F, WS_YB), D};
        for (int rs_ = 0; rs_ < REP_SG; ++rs_) pg8::gemm_phase<pg8::EpiBf, pg8::SampleOrder, true, true>(RING, g, S, E, F.wave); group_barrier(F); }
    if (KEEP_N3 && IN(pb + 8) && SAMPLE) { FRESH(); const float* ng = F.in[8] + (size_t)LI * 8 * D; norm_phase_sample(F, 1.0f, ng + 3 * D, ng + 4 * D, true, nullptr, 0); }
    if (IN(pb + 8)) SEAM(pb + 8);
}
template <int LI> __device__ __forceinline__ void ple_part(Frame& F, const XcdBarrier& bar, const int lo, const int hi) {
    constexpr int pb = 1 + LI * PH_PER_LAYER;
    if (KEEP_PG && IN(pb + 12)) { FRESH(); pg8::Gemm g{wsb(F, WS_XN), wlayer(F, LI, W_PG), MP, D, D}; pg8::StaticOrder S; S.init(MP, D, F.G, (int)blockIdx.x);
        pg8::EpiPle E{wsb(F, WS_YB), wsb(F, WS_PU), D};
        for (int rep = 0; rep < REP_GEMM; ++rep) { if (rep && REP_GEMM_BAR) GRID_BAR(); pg8::gemm_phase<pg8::EpiPle, pg8::StaticOrder, true, true>(RING, g, S, E, F.wave); } SEAM(pb + 12); }
    if (KEEP_N5 && IN(pb + 13) && !SAMPLE) { FRESH(); const float* ng = F.in[8] + (size_t)LI * 8 * D; for (int rep = 0; rep < REP_ROW; ++rep) norm_phase(F, 1.0f, ng + 7 * D, ng + 8 * D, LI + 1 < DEPTH, 0, MP, F.pidx * NWAVES + F.wave, NPG * NWAVES, rep + 1 < REP_ROW, LI + 1 == DEPTH);
        if (LI + 1 < DEPTH) p0_layer(F, LI + 1 < DEPTH ? LI + 1 : LI, F.pidx * NWAVES + F.wave, NPG * NWAVES, 2); }
    if (KEEP_N5 && IN(pb + 13) && SAMPLE) { FRESH(); OPAQUE_K(kd, D); pg8::Gemm g{wsb(F, WS_XN), wlayer(F, LI, W_PG), M, D, kd}; pg8::SampleOrder S; S.init(D, NSG, F.sidx);
        pg8::EpiPle E{wsb(F, WS_YB), wsb(F, WS_PU), D};
        for (int rs_ = 0; rs_ < REP_SG; ++rs_) pg8::gemm_phase<pg8::EpiPle, pg8::SampleOrder, true, true>(RING, g, S, E, F.wave); group_barrier(F); }
    if (KEEP_N5 && IN(pb + 13) && SAMPLE) { FRESH(); const float* ng = F.in[8] + (size_t)LI * 8 * D; norm_phase_sample(F, 1.0f, ng + 7 * D, ng + 8 * D, LI + 1 < DEPTH, nullptr, 0, LI + 1 == DEPTH); }
    if (KEEP_N5 && IN(pb + 13) && SAMPLE && LI + 1 < DEPTH) { FRESH(); group_barrier(F); OPAQUE_K(kd, D); pg8::Gemm g{wsb(F, WS_XN), wlayer(F, LI + 1 < DEPTH ? LI + 1 : LI, W_UP1), M, NUP, kd}; pg8::SampleOrder S; S.init(NUP, NSG, F.sidx);
        pg8::EpiSwiGLU E{wsb(F, WS_HFF), DFF};
        for (int rs_ = 0; rs_ < REP_SG; ++rs_) pg8::gemm_phase<pg8::EpiSwiGLU, pg8::SampleOrder, true, true>(RING, g, S, E, F.wave); }
    if (IN(pb + 13)) SEAM(pb + 13);
}
template <int LI> __device__ __forceinline__ void layer_part(Frame& F, const XcdBarrier& bar, const int lo, const int hi) {
    ffn_part<LI, 0>(F, bar, lo, hi); mixer_part<LI>(F, bar, lo, hi); ffn_part<LI, 1>(F, bar, lo, hi); ple_part<LI>(F, bar, lo, hi);
}
__global__ void __launch_bounds__(NWAVES * 64, 2) enc_fwd(Args args) {
    extern __shared__ __attribute__((aligned(16))) unsigned char lds[];
    Frame F;
    F.lds = (LAS unsigned char*)lds;
    F.MISC = (volatile LAS unsigned*)(F.lds + MISC_OFF);
    F.wave = __builtin_amdgcn_readfirstlane(threadIdx.x >> 6);
    F.G = gridDim.x; { const int bx = blockIdx.x; F.vcu = (F.G % 8 == 0) ? (bx % 8) * (F.G / 8) + bx / 8 : bx; }
    { const int w = F.vcu & 31, x = F.vcu >> 5; F.sidx = (w < 8) ? x * 8 + w : -1; F.pidx = (w >= 8) ? x * 24 + (w - 8) : -1; } F.lbn = 0u;
#pragma unroll
    for (int i = 0; i < 21; ++i) F.in[i] = args.in[i];
    F.out = args.out; F.ws = args.ws;
    F.ctl = (gu32*)(F.ws + WS_CTL);
    for (int u = threadIdx.x; u < (LDS_BYTES - LDSCTL_OFF) / 4; u += NWAVES * 64) ((LAS unsigned*)(F.lds + LDSCTL_OFF))[u] = 0u;
    __syncthreads();
    XcdBarrier bar; bar.wave = F.wave; bar.bar = (unsigned*)(F.ctl + CW_BAR); bar.x = 0; bar.st = nullptr;
#if !MK_PER_PHASE
    bar = xcd_barrier_post((unsigned*)(F.ctl + CW_BAR), F.MISC + 8);
#endif
    const int lo = args.ph_lo, hi = args.ph_hi;
    if (KEEP_PRO && IN(0)) { FRESH(); for (int rep = 0; rep < REP_PRO; ++rep) p0_prologue(F); SEAM(0); }
    layer_part<0>(F, bar, lo, hi); layer_part<1>(F, bar, lo, hi); layer_part<2>(F, bar, lo, hi); layer_part<3>(F, bar, lo, hi);
}
#undef IN
#undef SEAM
#undef FRESH
#undef RING
#undef SAMPLE

#ifndef DBG_DUMP
#define DBG_DUMP 0
#endif
#if DBG_DUMP
__global__ void dbg_dump_bf16(const unsigned short* src, float* dst, size_t n) { size_t i = (size_t)blockIdx.x * blockDim.x + threadIdx.x; const size_t st = (size_t)gridDim.x * blockDim.x; for (; i < n; i += st) dst[i] = __uint_as_float((unsigned)src[i] << 16); }
#endif
#ifndef PH_STOP
#define PH_STOP 1000
#endif
extern "C" void kernel_launch(void* const* d_in, const int* in_sizes, int n_in, void* d_out, int out_size, void* d_ws, size_t ws_size, hipStream_t stream) {
    static int grid = 0;
    if (grid == 0) {
        if (n_in != 21 || (size_t)(unsigned)out_size != O_END || ws_size < WS_TOP) { fprintf(stderr, "kernel_launch: unexpected shapes (n_in %d, out %d, ws %zu); nothing launched\n", n_in, out_size, ws_size); grid = -1; return; }
        int dev = 0, cus = 0, per_cu = 0;
        if (hipGetDevice(&dev) != hipSuccess || hipDeviceGetAttribute(&cus, hipDeviceAttributeMultiprocessorCount, dev) != hipSuccess) { grid = -1; return; }
        if (hipFuncSetAttribute((const void*)enc_fwd, hipFuncAttributeMaxDynamicSharedMemorySize, LDS_BYTES) != hipSuccess) { fprintf(stderr, "kernel_launch: hipFuncSetAttribute failed\n"); grid = -1; return; }
        if (hipOccupancyMaxActiveBlocksPerMultiprocessor(&per_cu, (const void*)enc_fwd, NWAVES * 64, LDS_BYTES) != hipSuccess || per_cu < 1)
            fprintf(stderr, "kernel_launch: note: occupancy query reports %d workgroups per CU\n", per_cu);
        (void)hipGetLastError();
        grid = cus;
    }
    if (grid < 0) return;
    if (hipMemsetAsync((char*)d_ws + WS_CTL, 0, CTL_ZERO_BYTES, stream) != hipSuccess) return;
    Args a{};
    for (int i = 0; i < 21; ++i) a.in[i] = (const float*)d_in[i];
    a.out = (float*)d_out; a.ws = (unsigned char*)d_ws;
#if MK_PER_PHASE
    for (int ph = 0; ph < (NPH < PH_STOP ? NPH : PH_STOP); ++ph) { a.ph_lo = ph; a.ph_hi = ph + 1; hipLaunchKernelGGL(enc_fwd, dim3(grid), dim3(NWAVES * 64), LDS_BYTES, stream, a); }
#if DBG_DUMP
    { const unsigned char* ws = (const unsigned char*)d_ws; float* out = (float*)d_out;
      if (DBG_DUMP & 1) { hipLaunchKernelGGL(dbg_dump_bf16, dim3(2048), dim3(256), 0, stream, (const unsigned short*)(ws + WS_O), out + O_KP + (size_t)1 * MP * D, (size_t)MP * 2048);
                          hipLaunchKernelGGL(dbg_dump_bf16, dim3(256), dim3(256), 0, stream, (const unsigned short*)(ws + WS_O) + (size_t)MP * 2048, out + O_KS + (size_t)1 * MS * D, (size_t)MS * 2048); }
      if (DBG_DUMP & 2) { hipLaunchKernelGGL(dbg_dump_bf16, dim3(2048), dim3(256), 0, stream, (const unsigned short*)(ws + WS_A2), out + O_VP + (size_t)1 * MP * D, (size_t)MP * 2048);
                          hipLaunchKernelGGL(dbg_dump_bf16, dim3(256), dim3(256), 0, stream, (const unsigned short*)(ws + WS_A2) + (size_t)MP * 2048, out + O_VS + (size_t)1 * MS * D, (size_t)MS * 2048); }
      if (DBG_DUMP & 8) { hipLaunchKernelGGL(dbg_dump_bf16, dim3(2048), dim3(256), 0, stream, (const unsigned short*)(ws + WS_GS), out + O_KP + (size_t)1 * MP * D, (size_t)MP * 3072); }
      if (DBG_DUMP & 16) { hipLaunchKernelGGL(dbg_dump_bf16, dim3(2048), dim3(256), 0, stream, (const unsigned short*)(ws + WS_W + W_BR), out + O_VP + (size_t)1 * MP * D, (size_t)1024 * 2048); }
      if (DBG_DUMP & 4) { hipLaunchKernelGGL(dbg_dump_bf16, dim3(2048), dim3(256), 0, stream, (const unsigned short*)(ws + WS_MG), out + O_KP + (size_t)3 * MP * D, (size_t)MP * 1024);
                          hipLaunchKernelGGL(dbg_dump_bf16, dim3(256), dim3(256), 0, stream, (const unsigned short*)(ws + WS_MG) + (size_t)MP * 1024, out + O_KS + (size_t)3 * MS * D, (size_t)MS * 1024); } }
#endif
#else
    a.ph_lo = 0; a.ph_hi = (NPH < PH_STOP ? NPH : PH_STOP);
    hipLaunchKernelGGL(enc_fwd, dim3(grid), dim3(NWAVES * 64), LDS_BYTES, stream, a);
#endif
}
```

```cpp
#include <hip/hip_runtime.h>
#include <cstdio>
#include <cstdint>

namespace pg8 {
#define PG8_LAS __attribute__((address_space(3)))
typedef unsigned short bf16_t;
typedef short bf16x8 __attribute__((ext_vector_type(8)));
typedef float f32x4 __attribute__((ext_vector_type(4)));
typedef unsigned u32x4 __attribute__((ext_vector_type(4)));
constexpr int BM = 256, BK = 64, HALF = 128, HTB = HALF * BK * 2  , STAGE_BYTES = 8 * HTB, NXCD = 8, WGM = 8;

__host__ __device__ __forceinline__ int lds_byte(int r, int c) { const int st = (r >> 4) * 2 + (c >> 5), rr = r & 15, cc = c & 31, ob = rr * 64 + cc * 2; return st * 1024 + (ob ^ (((ob >> 9) & 1) << 5)); }
__host__ __device__ __forceinline__ void stage_rc(int b, int& R, int& C) { const int st = b / 1024, sb = b % 1024, swz = sb ^ (((sb >> 9) & 1) << 5); R = (st >> 1) * 16 + swz / 64; C = (st & 1) * 32 + (swz % 64) / 2; }
__host__ __device__ __forceinline__ int perm32(int rho) { const int n = rho >> 4, i = rho & 15; return 8 * (i >> 2) + 4 * n + (i & 3); }

struct Unit { int pm, pn, seg; };
constexpr int MPROMPT_TILES = 128;
struct Gemm { const bf16_t* A; const bf16_t* Bt; int M, N, K; };

struct StaticOrder {
    int nM, nN, nwg, G, c;
    __host__ __device__ void init(int M, int N, int G_, int c_) { nM = M / BM; nN = N / BM; nwg = nM * nN; G = G_; c = c_; }
    __host__ __device__ bool next(int i, Unit& u) const {
        const long L = (long)i * G + c; if (L >= nwg) return false;
        int wgid = (int)L; { const int q = nwg / NXCD, r = nwg % NXCD, xcd = wgid % NXCD, off = wgid / NXCD; wgid = (xcd < r ? xcd * (q + 1) : r * (q + 1) + (xcd - r) * q) + off; }
        const int nig = WGM * nN, gid = wgid / nig, fm = gid * WGM, gsz = (nM - fm) < WGM ? (nM - fm) : WGM;
        u.pm = fm + ((wgid % nig) % gsz); u.pn = (wgid % nig) / gsz; u.seg = 0; return true;
    }
    __device__ __forceinline__ size_t koff_bytes(const Unit&) const { return 0; }
    __device__ __forceinline__ int ntiles(const Unit&, int K) const { return K / BK; }
    __device__ __forceinline__ void a_ready(const Unit&) const {}
    __device__ __forceinline__ void done(const Unit&) const {}
};
struct SampleOrder {
    int nN, G, c;
    __host__ __device__ void init(int N, int G_, int c_) { nN = N / BM; G = G_; c = c_; }
    __host__ __device__ bool next(int i, Unit& u) const { const int L = i * G + c; if (L >= 2 * nN) return false; u.pm = MPROMPT_TILES + L / nN; u.pn = L % nN; u.seg = 0; return true; }
    __device__ __forceinline__ size_t koff_bytes(const Unit&) const { return 0; }
    __device__ __forceinline__ int ntiles(const Unit&, int K) const { return K / BK; }
    __device__ __forceinline__ void a_ready(const Unit&) const {}
    __device__ __forceinline__ void done(const Unit&) const {}
};
struct SampleSplitOrder : SampleOrder {
    __host__ __device__ bool next(int i, Unit& u) const { const int L = i * G + c; if (L >= 32) return false; const int tile = L >> 2; u.pm = MPROMPT_TILES + (tile >> 2); u.pn = tile & 3; u.seg = L & 3; return true; }
    __device__ __forceinline__ size_t koff_bytes(const Unit& u) const { return (size_t)(u.seg == 0 ? 0 : (u.seg == 1 ? 12 : (u.seg == 2 ? 24 : 34))) * BK * 2; }
    __device__ __forceinline__ int ntiles(const Unit& u, int) const { return u.seg < 2 ? 12 : 10; }
};
struct SampleSegOrder : SampleOrder {
    __host__ __device__ bool next(int i, Unit& u) const { const int r = i / 3; if (!SampleOrder::next(r, u)) return false; u.seg = i - 3 * r; return true; }
    __device__ __forceinline__ size_t koff_bytes(const Unit& u) const { return u.seg == 0 ? 0 : (u.seg == 1 ? 2048 : 3072); }
    __device__ __forceinline__ int ntiles(const Unit& u, int) const { return u.seg == 0 ? 16 : 8; }
};
struct SegOrder : StaticOrder {
    __host__ __device__ bool next(int i, Unit& u) const { const int r = i / 3; if (!StaticOrder::next(r, u)) return false; u.seg = i - 3 * r; return true; }
    __device__ __forceinline__ size_t koff_bytes(const Unit& u) const { return u.seg == 0 ? 0 : (u.seg == 1 ? 2048 : 3072); }
    __device__ __forceinline__ int ntiles(const Unit& u, int) const { return u.seg == 0 ? 16 : 8; }
};

typedef float cvt_f32x2_t __attribute__((ext_vector_type(2))); typedef __bf16 cvt_bf16x2_t __attribute__((ext_vector_type(2)));
__device__ __forceinline__ unsigned cvt_pk_bf16(float lo, float hi) { const cvt_f32x2_t v = {lo, hi}; const cvt_bf16x2_t b = __builtin_convertvector(v, cvt_bf16x2_t); return __builtin_bit_cast(unsigned, b); }
typedef float f32x2 __attribute__((ext_vector_type(2)));
constexpr int MPROMPT = 32768;
constexpr float QSCALE = 0.125f * 1.4426950408889634f;
__device__ __forceinline__ float sigm(float x) { return __builtin_amdgcn_rcpf(1.0f + __builtin_amdgcn_exp2f(-1.4426950408889634f * x)); }
__device__ __forceinline__ u32x4 pack8(const f32x4 a, const f32x4 b) { u32x4 w; w.x = cvt_pk_bf16(a[0], a[1]); w.y = cvt_pk_bf16(a[2], a[3]); w.z = cvt_pk_bf16(b[0], b[1]); w.w = cvt_pk_bf16(b[2], b[3]); return w; }
__device__ __forceinline__ void unpack8(const u32x4 w, f32x4& a, f32x4& b) {
    a[0] = __uint_as_float(w.x << 16); a[1] = __uint_as_float(w.x & 0xffff0000u); a[2] = __uint_as_float(w.y << 16); a[3] = __uint_as_float(w.y & 0xffff0000u);
    b[0] = __uint_as_float(w.z << 16); b[1] = __uint_as_float(w.z & 0xffff0000u); b[2] = __uint_as_float(w.w << 16); b[3] = __uint_as_float(w.w & 0xffff0000u); }

struct EpiSwiGLU {
    static constexpr bool PERM = true, AFTER_DRAIN = false;
    bf16_t* O; int ldc;
    __device__ __forceinline__ void operator()(const f32x4 (&acc)[2][2][4][2], const Unit& u, int wr, int wc, int fr, int fq) const {
        const int row0 = u.pm * BM + wr * 64 + fr, col0 = u.pn * HALF + wc * 32 + 8 * fq;
#pragma unroll
        for (int ai = 0; ai < 2; ++ai)
#pragma unroll
            for (int m = 0; m < 4; ++m) { bf16_t* p = O + (size_t)(row0 + ai * HALF + m * 16) * ldc + col0; f32x4 h[2];
#pragma unroll
                for (int n = 0; n < 2; ++n)
#pragma unroll
                    for (int j = 0; j < 4; ++j) { const float g = acc[ai][0][m][n][j]; h[n][j] = g * sigm(g) * acc[ai][1][m][n][j]; }
                *(u32x4*)p = pack8(h[0], h[1]); }
    }
};
struct EpiF32 {
    static constexpr bool PERM = false, AFTER_DRAIN = false;
    float* Y; int ldc;
    __device__ __forceinline__ void operator()(const f32x4 (&acc)[2][2][4][2], const Unit& u, int wr, int wc, int fr, int fq) const {
        float* yb = Y + (size_t)(u.pm * BM) * ldc + u.pn * BM;
        int lrow = wr * 64 + fr, lcol = wc * 32 + 4 * fq; asm volatile("" : "+v"(lrow), "+v"(lcol));
#pragma unroll
        for (int ai = 0; ai < 2; ++ai)
#pragma unroll
            for (int m = 0; m < 4; ++m) { const int o = (lrow + ai * HALF + m * 16) * ldc + lcol;
#pragma unroll
                for (int bj = 0; bj < 2; ++bj)
#pragma unroll
                    for (int n = 0; n < 2; ++n) *(f32x4*)(yb + o + bj * HALF + n * 16) = acc[ai][bj][m][n]; }
    }
};
struct EpiF32Slab {
    static constexpr bool PERM = false, AFTER_DRAIN = false;
    float* YS;
    __device__ __forceinline__ void operator()(const f32x4 (&acc)[2][2][4][2], const Unit& u, int wr, int wc, int fr, int fq) const {
        float* yb = YS + (size_t)u.seg * 512 * 1024 + (size_t)((u.pm - MPROMPT_TILES) * BM) * 1024 + u.pn * BM;
        int lrow = wr * 64 + fr, lcol = wc * 32 + 4 * fq; asm volatile("" : "+v"(lrow), "+v"(lcol));
#pragma unroll
        for (int ai = 0; ai < 2; ++ai)
#pragma unroll
            for (int m = 0; m < 4; ++m) { const int o = (lrow + ai * HALF + m * 16) * 1024 + lcol;
#pragma unroll
                for (int bj = 0; bj < 2; ++bj)
#pragma unroll
                    for (int n = 0; n < 2; ++n) *(f32x4*)(yb + o + bj * HALF + n * 16) = acc[ai][bj][m][n]; }
    }
};
struct EpiPle {
    static constexpr bool PERM = true, AFTER_DRAIN = false;
    bf16_t* Y; const bf16_t* PU; int ldc;
    __device__ __forceinline__ void operator()(const f32x4 (&acc)[2][2][4][2], const Unit& u, int wr, int wc, int fr, int fq) const {
        const size_t tb = (size_t)(u.pm * BM) * ldc + u.pn * BM;
        int lrow = wr * 64 + fr, lcol = wc * 32 + 8 * fq; asm volatile("" : "+v"(lrow), "+v"(lcol));
#pragma unroll
        for (int ai = 0; ai < 2; ++ai)
#pragma unroll
            for (int m = 0; m < 4; ++m) { const int o = (lrow + ai * HALF + m * 16) * ldc + lcol;
#pragma unroll
                for (int bj = 0; bj < 2; ++bj) { const u32x4 w = *(const u32x4*)(PU + tb + o + bj * HALF); f32x4 p0, p1; unpack8(w, p0, p1); f32x4 o0, o1;
#pragma unroll
                    for (int j = 0; j < 4; ++j) { o0[j] = p0[j] * sigm(acc[ai][bj][m][0][j]); o1[j] = p1[j] * sigm(acc[ai][bj][m][1][j]); }
                    *(u32x4*)(Y + tb + o + bj * HALF) = pack8(o0, o1); } }
    }
};
struct EpiBf {
    static constexpr bool PERM = true, AFTER_DRAIN = false;
    bf16_t* O; int ldc;
    __device__ __forceinline__ void operator()(const f32x4 (&acc)[2][2][4][2], const Unit& u, int wr, int wc, int fr, int fq) const {
        bf16_t* ob = O + (size_t)(u.pm * BM) * ldc + u.pn * BM;
        int lrow = wr * 64 + fr, lcol = wc * 32 + 8 * fq; asm volatile("" : "+v"(lrow), "+v"(lcol));
#pragma unroll
        for (int ai = 0; ai < 2; ++ai)
#pragma unroll
            for (int m = 0; m < 4; ++m) { const int o = (lrow + ai * HALF + m * 16) * ldc + lcol;
#pragma unroll
                for (int bj = 0; bj < 2; ++bj) *(u32x4*)(ob + o + bj * HALF) = pack8(acc[ai][bj][m][0], acc[ai][bj][m][1]); }
    }
};
struct EpiSeg {
    static constexpr bool PERM = true, AFTER_DRAIN = false;
    const bf16_t* S; float* T; bf16_t* O;
    __device__ __forceinline__ void operator()(const f32x4 (&acc)[2][2][4][2], const Unit& u, int wr, int wc, int fr, int fq) const {
        const int seg = u.seg;
        const bf16_t* sb = S + (size_t)(u.pm * BM) * 3072 + u.pn * BM + seg * 1024; float* tb = T + (size_t)(u.pm * BM) * 1024 + u.pn * BM; bf16_t* ob = O + (size_t)(u.pm * BM) * 1024 + u.pn * BM;
        int lrow = wr * 64 + fr, lcol = wc * 32 + 8 * fq; asm volatile("" : "+v"(lrow), "+v"(lcol));
#pragma unroll
        for (int ai = 0; ai < 2; ++ai)
#pragma unroll
            for (int m = 0; m < 4; ++m) { const int r = lrow + ai * HALF + m * 16;
#pragma unroll
                for (int bj = 0; bj < 2; ++bj) { const u32x4 ws = *(const u32x4*)(sb + r * 3072 + lcol + bj * HALF); f32x4 s0, s1; unpack8(ws, s0, s1);
                    f32x4 o0 = acc[ai][bj][m][0] * s0, o1 = acc[ai][bj][m][1] * s1; float* tp = tb + r * 1024 + lcol + bj * HALF;
                    if (seg != 0) { o0 = o0 + *(const f32x4*)tp; o1 = o1 + *(const f32x4*)(tp + 4); }
                    if (seg != 2) { *(f32x4*)tp = o0; *(f32x4*)(tp + 4) = o1; }
                    else *(u32x4*)(ob + r * 1024 + lcol + bj * HALF) = pack8(o0, o1); } }
    }
};
struct EpiWin {
    static constexpr bool PERM = true, AFTER_DRAIN = false;
    bf16_t *Q, *K, *V, *BG, *C, *ZP, *GS; const float *ropec, *ropes; float *kp, *vp, *ks, *vs;
    __device__ __forceinline__ void operator()(const f32x4 (&acc)[2][2][4][2], const Unit& u, int wr, int wc, int fr, int fq) const {
        const int pn = u.pn; const bool samp = u.pm >= MPROMPT / BM; const int row0 = u.pm * BM + wr * 64 + fr;
        if (pn < 8) {
            const bool isq = pn < 4; const int map = (pn & 3) * 4 + wc; bf16_t* dst = isq ? Q : K; const float sc = isq ? QSCALE : 1.0f;
            float* ko = samp ? ks - (size_t)MPROMPT * 1024 : kp;
#pragma unroll
            for (int ai = 0; ai < 2; ++ai)
#pragma unroll
                for (int m = 0; m < 4; ++m) { const int row = row0 + ai * HALF + m * 16; const int pos = samp ? 1024 + ((row - MPROMPT) & 31) : (row & 16383);
                    const float* cp = ropec + (size_t)pos * 32 + 8 * fq; const float* sp = ropes + (size_t)pos * 32 + 8 * fq;
                    f32x4 o1[2], o2[2];
#pragma unroll
                    for (int n = 0; n < 2; ++n) { const f32x4 c = *(const f32x4*)(cp + 4 * n), s = *(const f32x4*)(sp + 4 * n), x1 = acc[ai][0][m][n], x2 = acc[ai][1][m][n]; o1[n] = x1 * c - x2 * s; o2[n] = x2 * c + x1 * s; }
                    const size_t off = (size_t)row * 1024 + map * 64 + 8 * fq;
                    if (!isq) { float* kf = ko + off; __builtin_nontemporal_store(o1[0], (f32x4*)kf); __builtin_nontemporal_store(o1[1], (f32x4*)(kf + 4)); __builtin_nontemporal_store(o2[0], (f32x4*)(kf + 32)); __builtin_nontemporal_store(o2[1], (f32x4*)(kf + 36)); }
                    *(u32x4*)(dst + off) = pack8(o1[0] * sc, o1[1] * sc); *(u32x4*)(dst + off + 32) = pack8(o2[0] * sc, o2[1] * sc); }
        } else if (pn < 12) {
            float* vo = samp ? vs - (size_t)MPROMPT * 1024 : vp; const int col0 = (pn - 8) * BM + wc * 32 + 8 * fq;
#pragma unroll
            for (int ai = 0; ai < 2; ++ai)
#pragma unroll
                for (int m = 0; m < 4; ++m) { const size_t off = (size_t)(row0 + ai * HALF + m * 16) * 1024 + col0;
#pragma unroll
                    for (int bj = 0; bj < 2; ++bj) { float* vf = vo + off + bj * HALF; __builtin_nontemporal_store(acc[ai][bj][m][0], (f32x4*)vf); __builtin_nontemporal_store(acc[ai][bj][m][1], (f32x4*)(vf + 4)); *(u32x4*)(V + off + bj * HALF) = pack8(acc[ai][bj][m][0], acc[ai][bj][m][1]); } }
        } else if (pn < 14 || (pn >= 18 && pn < 20)) {
            bf16_t* dst = pn < 14 ? BG : ZP; const int col0 = (pn < 14 ? pn - 12 : pn - 18) * BM + wc * 32 + 8 * fq;
#pragma unroll
            for (int ai = 0; ai < 2; ++ai)
#pragma unroll
                for (int m = 0; m < 4; ++m) { bf16_t* p = dst + (size_t)(row0 + ai * HALF + m * 16) * 512 + col0;
#pragma unroll
                    for (int bj = 0; bj < 2; ++bj) *(u32x4*)(p + bj * HALF) = pack8(acc[ai][bj][m][0], acc[ai][bj][m][1]); }
        } else if (pn < 18) {
            const int col0 = (pn - 14) * HALF + wc * 32 + 8 * fq;
#pragma unroll
            for (int ai = 0; ai < 2; ++ai)
#pragma unroll
                for (int m = 0; m < 4; ++m) *(u32x4*)(C + (size_t)(row0 + ai * HALF + m * 16) * 512 + col0) = pack8(acc[ai][0][m][0] * acc[ai][1][m][0], acc[ai][0][m][1] * acc[ai][1][m][1]);
        } else {
            const int col0 = (pn - 20) * BM + wc * 32 + 8 * fq;
#pragma unroll
            for (int ai = 0; ai < 2; ++ai)
#pragma unroll
                for (int m = 0; m < 4; ++m) { bf16_t* p = GS + (size_t)(row0 + ai * HALF + m * 16) * 3072 + col0;
#pragma unroll
                    for (int bj = 0; bj < 2; ++bj) { f32x4 g0, g1;
#pragma unroll
                        for (int j = 0; j < 4; ++j) { g0[j] = sigm(acc[ai][bj][m][0][j]); g1[j] = sigm(acc[ai][bj][m][1][j]); }
                        *(u32x4*)(p + bj * HALF) = pack8(g0, g1); } }
        }
    }
};
template <class Epi, class Sched, bool ALIGN_EPI = false, bool SP2 = false>
__device__ __forceinline__ void gemm_phase(PG8_LAS unsigned char* lds, const Gemm g, const Sched& S, const Epi& E, const int wave) {
    int lane_; asm volatile("v_mbcnt_lo_u32_b32 %0, -1, 0\n\tv_mbcnt_hi_u32_b32 %0, -1, %0" : "=v"(lane_));
    const int wid = wave, lane = lane_, tid = wid * 64 + lane, wr = wid >> 2, wc = wid & 3, fr = lane & 15, fq = lane >> 4;
    const int K = g.K;
    unsigned voffA[2], voffB[2];
#pragma unroll
    for (int i = 0; i < 2; ++i) { int R, C; stage_rc(tid * 16 + i * 8192, R, C); const int Rb = Epi::PERM ? ((R & ~31) + perm32(R & 31)) : R;
        voffA[i] = (unsigned)(R * K + C) * 2u; voffB[i] = (unsigned)(Rb * K + C) * 2u; }
    const size_t kstep = (size_t)(BK * 2);
    const size_t hstep = (size_t)HALF * K * 2;
    const size_t tstep = 2 * hstep;
    const unsigned ldsw = (unsigned)wid * 1024u;
    const int aoff = lds_byte(wr * 64 + fr, fq * 8), boff = lds_byte(wc * 32 + fr, fq * 8);
#define PG8_SA(b, h) (((b) * 2 + (h)) * HTB)
#define PG8_SB(b, h) ((4 + (b) * 2 + (h)) * HTB)
#define PG8_STAGE(bufoff, gbase, voff) do { _Pragma("unroll") for (int _i = 0; _i < 2; ++_i) \
        __builtin_amdgcn_global_load_lds((const unsigned*)((const char*)(gbase) + (voff)[_i]), (PG8_LAS unsigned*)(lds + (bufoff) + ldsw + _i * 8192), 16, 0, 0); } while (0)
#define PG8_LDA(dst, b, h) do { _Pragma("unroll") for (int m = 0; m < 4; ++m) _Pragma("unroll") for (int k = 0; k < 2; ++k) dst[m][k] = *(const PG8_LAS bf16x8*)(lds + PG8_SA(b, h) + aoff + m * 2048 + k * 1024); } while (0)
#define PG8_LDB(dst, b, h) do { _Pragma("unroll") for (int n = 0; n < 2; ++n) _Pragma("unroll") for (int k = 0; k < 2; ++k) dst[n][k] = *(const PG8_LAS bf16x8*)(lds + PG8_SB(b, h) + boff + n * 2048 + k * 1024); } while (0)
#define PG8_MMA(ai, bj, At, Bt) do { __builtin_amdgcn_s_setprio(1); _Pragma("unroll") for (int m = 0; m < 4; ++m) _Pragma("unroll") for (int n = 0; n < 2; ++n) _Pragma("unroll") for (int k = 0; k < 2; ++k) \
        acc[ai][bj][m][n] = __builtin_amdgcn_mfma_f32_16x16x32_bf16(Bt[n][k], At[m][k], acc[ai][bj][m][n], 0, 0, 0); __builtin_amdgcn_s_setprio(0); } while (0)
#define PG8_WAIT_V(n) asm volatile("s_waitcnt vmcnt(" #n ")" ::: "memory")
#define PG8_WAIT_L(n) asm volatile("s_waitcnt lgkmcnt(" #n ")" ::: "memory")
#define PG8_BAR __builtin_amdgcn_s_barrier()
#define PG8_SCHED __builtin_amdgcn_sched_barrier(0)
    Unit cur, nxt; int ui = 0;
    if (!S.next(0, cur)) return;
    f32x4 acc[2][2][4][2];
#pragma unroll
    for (int a = 0; a < 2; ++a)
#pragma unroll
        for (int b = 0; b < 2; ++b)
#pragma unroll
            for (int m = 0; m < 4; ++m)
#pragma unroll
                for (int n = 0; n < 2; ++n) acc[a][b][m][n] = (f32x4){0.f, 0.f, 0.f, 0.f};
    bf16x8 At[4][2], B0[2][2], B1[2][2];
    const char* cA = (const char*)g.A + (size_t)cur.pm * tstep + S.koff_bytes(cur); const char* cB = (const char*)g.Bt + (size_t)cur.pn * tstep + S.koff_bytes(cur);
    S.a_ready(cur);
    if constexpr (SP2) {
        PG8_STAGE(PG8_SB(0, 0), cB, voffB); PG8_STAGE(PG8_SB(0, 1), cB + hstep, voffB); PG8_STAGE(PG8_SA(0, 0), cA, voffA); PG8_STAGE(PG8_SA(0, 1), cA + hstep, voffA);
        if (wr == 1) PG8_BAR;
        PG8_WAIT_V(2); PG8_BAR;
        PG8_STAGE(PG8_SB(1, 0), cB + kstep, voffB); PG8_STAGE(PG8_SA(1, 0), cA + kstep, voffA); PG8_STAGE(PG8_SB(1, 1), cB + hstep + kstep, voffB);
        PG8_WAIT_V(6); PG8_BAR;
    } else {
        PG8_STAGE(PG8_SB(0, 0), cB, voffB); PG8_STAGE(PG8_SA(0, 0), cA, voffA); PG8_STAGE(PG8_SB(0, 1), cB + hstep, voffB); PG8_STAGE(PG8_SA(0, 1), cA + hstep, voffA);
        if (wr == 1) PG8_BAR;
        PG8_WAIT_V(4); PG8_BAR;
        PG8_STAGE(PG8_SB(1, 0), cB + kstep, voffB); PG8_STAGE(PG8_SA(1, 0), cA + kstep, voffA); PG8_STAGE(PG8_SB(1, 1), cB + hstep + kstep, voffB);
        PG8_WAIT_V(6); PG8_BAR;
    }
    for (;;) {
        const bool has_next = S.next(ui + 1, nxt);
        const char* nA = has_next ? (const char*)g.A + (size_t)nxt.pm * tstep + S.koff_bytes(nxt) : cA; const char* nB = has_next ? (const char*)g.Bt + (size_t)nxt.pn * tstep + S.koff_bytes(nxt) : cB;
        const int nt = S.ntiles(cur, K);
        for (int t = 0; t < nt; t += 2) {
            const bool last = (t == nt - 2);
            const char* a1 = cA + (size_t)(t + 1) * kstep;
            const char* a2 = last ? nA : cA + (size_t)(t + 2) * kstep; const char* b2 = last ? nB : cB + (size_t)(t + 2) * kstep;
            const char* a3 = a2 + kstep; const char* b3 = b2 + kstep;
            if (last && has_next) S.a_ready(nxt);
            if constexpr (SP2) {
            PG8_LDB(B0, 0, 0); PG8_LDB(B1, 0, 1); PG8_SCHED; PG8_LDA(At, 0, 0); PG8_STAGE(PG8_SA(1, 1), a1 + hstep, voffA);
            PG8_WAIT_V(8); PG8_WAIT_L(0); PG8_BAR; PG8_MMA(0, 0, At, B0); PG8_MMA(0, 1, At, B1); PG8_BAR; PG8_SCHED;
            PG8_LDA(At, 0, 1); PG8_STAGE(PG8_SB(0, 0), b2, voffB); PG8_STAGE(PG8_SB(0, 1), b2 + hstep, voffB); PG8_STAGE(PG8_SA(0, 0), a2, voffA);
            PG8_WAIT_V(8); PG8_WAIT_L(0); PG8_BAR; PG8_MMA(1, 0, At, B0); PG8_MMA(1, 1, At, B1); PG8_BAR; PG8_SCHED;
            PG8_LDB(B0, 1, 0); PG8_LDB(B1, 1, 1); PG8_SCHED; PG8_LDA(At, 1, 0); PG8_STAGE(PG8_SA(0, 1), a2 + hstep, voffA);
            PG8_WAIT_V(8); PG8_WAIT_L(0); PG8_BAR; PG8_MMA(0, 0, At, B0); PG8_MMA(0, 1, At, B1); PG8_BAR; PG8_SCHED;
            PG8_LDA(At, 1, 1); PG8_STAGE(PG8_SB(1, 0), b3, voffB); PG8_STAGE(PG8_SB(1, 1), b3 + hstep, voffB); PG8_STAGE(PG8_SA(1, 0), a3, voffA);
            PG8_WAIT_V(8); PG8_WAIT_L(0); PG8_BAR; PG8_MMA(1, 0, At, B0); PG8_MMA(1, 1, At, B1); PG8_BAR; PG8_SCHED;
            } else {
            PG8_LDB(B0, 0, 0); PG8_SCHED; PG8_LDA(At, 0, 0); PG8_STAGE(PG8_SA(1, 1), a1 + hstep, voffA);
            PG8_WAIT_L(8); PG8_BAR; PG8_WAIT_L(0); PG8_MMA(0, 0, At, B0); PG8_BAR; PG8_SCHED;
            PG8_LDB(B1, 0, 1); PG8_STAGE(PG8_SB(0, 0), b2, voffB);
            PG8_BAR; PG8_WAIT_L(0); PG8_MMA(0, 1, At, B1); PG8_BAR;
            PG8_LDA(At, 0, 1); PG8_STAGE(PG8_SA(0, 0), a2, voffA);
            PG8_BAR; PG8_WAIT_L(0); PG8_MMA(1, 0, At, B0); PG8_BAR; PG8_SCHED;
            PG8_STAGE(PG8_SB(0, 1), b2 + hstep, voffB);
            PG8_WAIT_V(6); PG8_BAR; PG8_MMA(1, 1, At, B1); PG8_BAR;
            PG8_LDB(B0, 1, 0); PG8_SCHED; PG8_LDA(At, 1, 0); PG8_STAGE(PG8_SA(0, 1), a2 + hstep, voffA);
            PG8_WAIT_L(8); PG8_BAR; PG8_WAIT_L(0); PG8_MMA(0, 0, At, B0); PG8_BAR; PG8_SCHED;
            PG8_LDB(B1, 1, 1); PG8_STAGE(PG8_SB(1, 0), b3, voffB);
            PG8_BAR; PG8_WAIT_L(0); PG8_MMA(0, 1, At, B1); PG8_BAR;
            PG8_LDA(At, 1, 1); PG8_STAGE(PG8_SA(1, 0), a3, voffA);
            PG8_BAR; PG8_WAIT_L(0); PG8_MMA(1, 0, At, B0); PG8_BAR; PG8_SCHED;
            PG8_STAGE(PG8_SB(1, 1), b3 + hstep, voffB);
            PG8_WAIT_V(6); PG8_BAR; PG8_MMA(1, 1, At, B1); PG8_BAR;
            }
        }
        if constexpr (ALIGN_EPI) { if (wr == 0) PG8_BAR; }
        if constexpr (!Epi::AFTER_DRAIN) { E(acc, cur, wr, wc, fr, fq); S.done(cur); }
        if (!has_next) break;
#pragma unroll
        for (int a = 0; a < 2; ++a)
#pragma unroll
            for (int b = 0; b < 2; ++b)
#pragma unroll
                for (int m = 0; m < 4; ++m)
#pragma unroll
                    for (int n = 0; n < 2; ++n) acc[a][b][m][n] = (f32x4){0.f, 0.f, 0.f, 0.f};
        cur = nxt; cA = nA; cB = nB; ++ui;
        if constexpr (ALIGN_EPI) { if (wr == 1) PG8_BAR; }
    }
    PG8_WAIT_V(0);
    if constexpr (!ALIGN_EPI) { if (wr == 0) PG8_BAR; }
    PG8_BAR;
    if constexpr (Epi::AFTER_DRAIN) { E.fused(acc, cur, wr, wc, fr, fq, lds, wid, lane); S.done(cur); }
#undef PG8_SA
#undef PG8_SB
#undef PG8_STAGE
#undef PG8_LDA
#undef PG8_LDB
#undef PG8_MMA
#undef PG8_WAIT_V
#undef PG8_WAIT_L
#undef PG8_BAR
#undef PG8_SCHED
}
}
#include <hip/hip_bf16.h>
#include <cmath>
namespace attn_body {
using bf16=__hip_bfloat16;
using bf16x8=__attribute__((ext_vector_type(8)))short;
using s16x4=__attribute__((ext_vector_type(4)))short;
using f32x16=__attribute__((ext_vector_type(16)))float;
using u32x4=__attribute__((ext_vector_type(4)))unsigned;
constexpr int SEQ=16384,D=64,DM=1024,OP=2048;
constexpr int NW=8,QBLK=32,QB=QBLK*NW,KVBLK=64,NQB=SEQ/QB;
constexpr int ATTN_PITCH=DM, ATTN_UNIT_ROWS=QB;
__device__ __forceinline__ int crow(int r,int hi){return (r&3)+8*(r>>2)+4*hi;}
__device__ __forceinline__ f32x16 zero16(){ float z; asm volatile("v_mov_b32 %0, 0":"=v"(z)); f32x16 r; _Pragma("unroll") for(int i=0;i<16;++i)r[i]=z; return r; }
#define SBAR() __builtin_amdgcn_sched_barrier(0)
__device__ __forceinline__ void cmask(f32x16&p0,f32x16&p1,int jb,int qrel,int hi){
  const float NEG=-INFINITY; (void)hi;
  if(jb>(qrel>>6)){
  #pragma unroll
  for(int r=0;r<16;++r){p0[r]=NEG;p1[r]=NEG;} }
}

constexpr int NSLOT=3, SLOTB=8192;
constexpr int LDS_K=0, LDS_V=NSLOT*SLOTB, LDS_WS=3*NSLOT*SLOTB, LDS_OST=LDS_WS+NW*64*4, LDS_BYTES=LDS_OST+NW*4096;
constexpr float C2=0.125f*1.4426950408889634f;
__device__ __forceinline__ void glds16(const void*gsrc,unsigned lds_dst){unsigned keep;
  asm volatile("s_mov_b32 %0, m0\n\ts_mov_b32 m0, %2\n\ts_nop 0\n\tglobal_load_lds_dwordx4 %1, off\n\ts_mov_b32 m0, %0":"=&s"(keep):"v"(gsrc),"s"(lds_dst):"memory");}
__device__ __forceinline__ float max3f(float a,float b,float c){float r;asm("v_max3_f32 %0, %1, %2, %3":"=v"(r):"v"(a),"v"(b),"v"(c));return r;}
__device__ __forceinline__ float max2f(float a,float b){float r;asm("v_max_f32_e32 %0, %1, %2":"=v"(r):"v"(a),"v"(b));return r;}
__device__ __forceinline__ float fadd_s(float a,float b){float r;asm("v_add_f32_e32 %0, %1, %2":"=v"(r):"v"(a),"v"(b));return r;}
__device__ __forceinline__ float fsub_s(float a,float b){float r;asm("v_sub_f32_e32 %0, %1, %2":"=v"(r):"v"(a),"v"(b));return r;}
typedef float f32x2_t __attribute__((ext_vector_type(2))); typedef __bf16 bf16x2_t __attribute__((ext_vector_type(2)));
__device__ __forceinline__ unsigned cvtpk_s(float lo,float hi){f32x2_t v={lo,hi};bf16x2_t b=__builtin_convertvector(v,bf16x2_t);return __builtin_bit_cast(unsigned,b);}
#define WAIT_BAR(N) asm volatile("s_waitcnt vmcnt(" #N ") lgkmcnt(0)\n\ts_barrier":::"memory")

__device__ __forceinline__ void qkt(f32x16&p0,f32x16&p1,const char*Kslot,const bf16x8*qr,const f32x16&negm,int r32,int hi){
  const char*kb=Kslot+hi*1024+r32*16;
  #pragma unroll
  for(int d0=0;d0<4;++d0){
    const bf16x8 b0=*reinterpret_cast<const bf16x8*>(kb+d0*2048);
    const bf16x8 b1=*reinterpret_cast<const bf16x8*>(kb+d0*2048+512);
    if(d0==0){p0=__builtin_amdgcn_mfma_f32_32x32x16_bf16(b0,qr[0],negm,0,0,0);p1=__builtin_amdgcn_mfma_f32_32x32x16_bf16(b1,qr[0],negm,0,0,0);}
    else{p0=__builtin_amdgcn_mfma_f32_32x32x16_bf16(b0,qr[d0],p0,0,0,0);p1=__builtin_amdgcn_mfma_f32_32x32x16_bf16(b1,qr[d0],p1,0,0,0);}}
}
typedef __attribute__((address_space(3))) const char* lds_cptr;
typedef short v4i16_t __attribute__((ext_vector_type(4)));
__device__ __forceinline__ void kload8(bf16x8*kf,lds_cptr kp){
  kf[0]=*(const __attribute__((address_space(3))) bf16x8*)(kp);      kf[1]=*(const __attribute__((address_space(3))) bf16x8*)(kp+512);
  kf[2]=*(const __attribute__((address_space(3))) bf16x8*)(kp+2048); kf[3]=*(const __attribute__((address_space(3))) bf16x8*)(kp+2560);
  kf[4]=*(const __attribute__((address_space(3))) bf16x8*)(kp+4096); kf[5]=*(const __attribute__((address_space(3))) bf16x8*)(kp+4608);
  kf[6]=*(const __attribute__((address_space(3))) bf16x8*)(kp+6144); kf[7]=*(const __attribute__((address_space(3))) bf16x8*)(kp+6656);
}
__device__ __forceinline__ void kload2(bf16x8*kf,lds_cptr kp,int j){ kf[2*j]=*(const __attribute__((address_space(3))) bf16x8*)(kp+j*2048); kf[2*j+1]=*(const __attribute__((address_space(3))) bf16x8*)(kp+j*2048+512); }
__device__ __forceinline__ s16x4 vtr(lds_cptr p){ return __builtin_bit_cast(s16x4,__builtin_amdgcn_ds_read_tr16_b64_v4i16((__attribute__((address_space(3))) v4i16_t*)p)); }
__device__ __forceinline__ float rowmax(const f32x16&p0,const f32x16&p1){
  float a=max3f(p0[0],p0[1],p1[0]),b=max3f(p0[2],p0[3],p1[1]);a=max3f(a,p1[2],p1[3]);
  #pragma unroll
  for(int r=4;r<16;r+=4){a=max3f(a,p0[r],p0[r+1]);b=max3f(b,p0[r+2],p0[r+3]);a=max3f(a,p1[r],p1[r+1]);b=max3f(b,p1[r+2],p1[r+3]);}
  const float m=max2f(a,b);
  auto rr=__builtin_amdgcn_permlane32_swap(__float_as_uint(m),__float_as_uint(m),false,false);
  return max2f(__uint_as_float(rr[0]),__uint_as_float(rr[1]));
}
__device__ __forceinline__ void pv(f32x16*o,int vb,bf16x8 pa0,bf16x8 pa1,bf16x8 pa2,bf16x8 pa3){
  #pragma unroll
  for(int d0=0;d0<4;++d0){s16x4 lo[4],hi[4];
    #pragma unroll
    for(int ks=0;ks<4;++ks){
      asm volatile("ds_read_b64_tr_b16 %0,%1 offset:%c2":"=&v"(lo[ks]):"v"(vb),"i"(d0*4096+ks*1024):"memory");
      asm volatile("ds_read_b64_tr_b16 %0,%1 offset:%c2":"=&v"(hi[ks]):"v"(vb),"i"(d0*4096+ks*1024+512):"memory");}
    asm volatile("s_waitcnt lgkmcnt(0)":::"memory");SBAR();
    #define PK(k) (bf16x8){lo[k][0],lo[k][1],lo[k][2],lo[k][3],hi[k][0],hi[k][1],hi[k][2],hi[k][3]}
    o[d0]=__builtin_amdgcn_mfma_f32_32x32x16_bf16(pa0,PK(0),o[d0],0,0,0);
    o[d0]=__builtin_amdgcn_mfma_f32_32x32x16_bf16(pa1,PK(1),o[d0],0,0,0);
    o[d0]=__builtin_amdgcn_mfma_f32_32x32x16_bf16(pa2,PK(2),o[d0],0,0,0);
    o[d0]=__builtin_amdgcn_mfma_f32_32x32x16_bf16(pa3,PK(3),o[d0],0,0,0);
    #undef PK
  }
}

#ifndef ATTN_STORE16
#define ATTN_STORE16(p,v) (*(u32x4*)(p)=(v))
#endif
template<int THRL> __device__ __forceinline__ void attn_unit(int b,int map,int qb,const bf16*Q,const bf16*__restrict__ K,const bf16*__restrict__ V,bf16*O,char*shm,const int wave){
  int lane_; asm volatile("v_mbcnt_lo_u32_b32 %0, -1, 0\n\tv_mbcnt_hi_u32_b32 %0, -1, %0":"=v"(lane_)); const int lane=lane_,r32=lane&31,hi=lane>>5; const int wid=wave;
  const long rowbase=(long)b*SEQ; const int q0=qb*QB;
  const bf16*Qw=Q+(rowbase+q0+wid*QBLK)*DM+map*D;
  const bf16*Kh=K+rowbase*DM+map*D,*Vh=V+rowbase*DM+(map>>1)*128;
  const unsigned lds0=(unsigned)(uintptr_t)shm;
  float*wsf=(float*)(shm+LDS_WS)+wid*64;
  const bf16*ksrc=Kh+(long)lane*DM+wid*8;
  const bf16*vsrc=Vh+(long)(16*(wid&3)+(lane>>2))*DM+(wid>>2)*32+(lane&3)*8;
  const unsigned kdst=lds0+LDS_K+wid*1024, vdst=lds0+LDS_V+wid*1024;
  #define DMA_K(t,slot) glds16(ksrc+(long)(t)*KVBLK*DM,(unsigned)__builtin_amdgcn_readfirstlane(kdst+(slot)))
  #define DMA_V(t,slot) do{ glds16(vsrc+(long)(t)*KVBLK*DM,(unsigned)__builtin_amdgcn_readfirstlane(vdst+2*(slot))); glds16(vsrc+(long)(t)*KVBLK*DM+64,(unsigned)__builtin_amdgcn_readfirstlane(vdst+2*(slot)+8192)); }while(0)
  const int vb0=(int)(lds0+LDS_V)+((lane>>4)&1)*32+(lane&3)*8+(4*hi+((lane&15)>>2))*64;
  const char*Kbase=shm+LDS_K; bf16x8 kf[8];
  const lds_cptr shm3=(lds_cptr)shm; const lds_cptr kp0=shm3+LDS_K+hi*1024+r32*16; const lds_cptr vp0=shm3+LDS_V+((lane>>4)&1)*32+(lane&3)*8+(4*hi+((lane&15)>>2))*64;
  const int NT=(q0+QB)/KVBLK;
  DMA_K(0,0);DMA_V(0,0);DMA_K(1,SLOTB);
  bf16x8 qr[4];
  #pragma unroll
  for(int d0=0;d0<4;++d0)qr[d0]=*reinterpret_cast<const bf16x8*>(&Qw[(long)r32*DM+d0*16+hi*8]);
  float mhat=0.f,l_reg=0.f;f32x16 o[4];o[0]=zero16();o[1]=zero16();o[2]=zero16();o[3]=zero16();f32x16 negm=zero16();asm volatile("":"+v"(negm));
  const int qrel=wid*QBLK+r32;
  #define CMASK(P0,P1,t) do{int jb_=(t)-(NT-4); if(jb_>=0)cmask(P0,P1,jb_,qrel,hi);}while(0)
  bool resc=false;
  #define START(P0,P1) do{ const float rm=rowmax(P0,P1); resc=false; \
    { const float dl=rm; mhat=fadd_s(mhat,dl); \
      _Pragma("unroll") for(int r=0;r<16;++r){P0[r]=fsub_s(P0[r],dl);P1[r]=fsub_s(P1[r],dl);} \
      _Pragma("unroll") for(int r=0;r<16;++r)negm[r]=-mhat; asm volatile("":"+v"(negm)); } \
    _Pragma("unroll") for(int r=0;r<16;++r)P0[r]=__builtin_amdgcn_exp2f(P0[r]); }while(0)
  #define RESC() do{ if(resc){ asm volatile("s_waitcnt lgkmcnt(0)":::"memory"); \
      _Pragma("unroll") for(int d_=0;d_<4;++d_) _Pragma("unroll") for(int r=0;r<16;++r)o[d_][r]*=wsf[crow(r,hi)]; } }while(0)
  f32x16 pA0,pA1,pB0,pB1;
  int sl_prev=0,sl_cur=0,sl_next=SLOTB;
  #define ROT() do{sl_prev=sl_cur;sl_cur=sl_next;sl_next=(sl_next==(NSLOT-1)*SLOTB)?0:sl_next+SLOTB;}while(0)
  DMA_K(2,2*SLOTB);
  WAIT_BAR(3);
  qkt(pA0,pA1,Kbase,qr,negm,r32,hi);asm volatile("s_nop 15\n\ts_nop 7":"+v"(pA0),"+v"(pA1));CMASK(pA0,pA1,0);
  START(pA0,pA1);
  _Pragma("unroll") for(int r=0;r<16;++r)pA1[r]=__builtin_amdgcn_exp2f(pA1[r]);
  WAIT_BAR(0);
  DMA_K(3,0);DMA_V(1,SLOTB);
  ROT();
  kload8(kf,kp0+sl_cur);
  WAIT_BAR(3);
  s16x4 vlo[16],vhi[16]; u32x4 pw0,pw1,pw2,pw3;
  #define PKW(P,B) cvtpk_s(P[B],P[B+1])
  #define PAF(k) __builtin_bit_cast(bf16x8,pw##k)
  #define VFR(i) (bf16x8){vlo[i][0],vlo[i][1],vlo[i][2],vlo[i][3],vhi[i][0],vhi[i][1],vhi[i][2],vhi[i][3]}
  #define PIN(x) asm volatile("":"+v"(x))
  #define MX3(a,b,c) __builtin_fmaxf(__builtin_fmaxf((a),(b)),(c))
  #define GAPA(MF,A0,A1,A2,A3,W0,W1,PW) do{ MF; sacc+=A0; sacc+=A1; sacc+=A2; sacc+=A3; PIN(sacc); W0; W1; PIN(PW); SBAR(); }while(0)
  #define EX(v) __builtin_amdgcn_exp2f(v)
  #define GAPB2(MF,X,B) do{ MF; X[B]=EX(X[B]); X[B+1]=EX(X[B+1]); PIN(X); SBAR(); }while(0)
  #define GAPB(MF,X,B) do{ MF; X[B]=EX(X[B]); X[B+1]=EX(X[B+1]); X[B+2]=EX(X[B+2]); X[B+3]=EX(X[B+3]); PIN(X); SBAR(); }while(0)
  #define VRD(i) do{ vlo[i]=vtr(vp_+(((i)>>2)*4096+((i)&3)*1024)); vhi[i]=vtr(vp_+(((i)>>2)*4096+((i)&3)*1024+512)); }while(0)
  #define KRD(G,j) do{ if(G){ kload2(kf,kp0+sl_next,j); SBAR(); } }while(0)
  #define STEP(C0,C1,P0,P1,t,GK,GV,GL) do{ SBAR(); \
    const lds_cptr vp_=vp0+2*sl_prev; \
    VRD(0); SBAR(); float sacc=(P0[0]+P0[1]); \
    GAPA(C0=__builtin_amdgcn_mfma_f32_32x32x16_bf16(kf[0],qr[0],negm,0,0,0), P0[2],P0[3],P0[4],P0[5],     pw0[0]=PKW(P0,0), pw0[1]=PKW(P0,2), pw0); \
    VRD(4); SBAR(); GAPA(C1=__builtin_amdgcn_mfma_f32_32x32x16_bf16(kf[1],qr[0],negm,0,0,0), P0[6],P0[7],P0[8],P0[9],     pw0[2]=PKW(P0,4), pw0[3]=PKW(P0,6), pw0); \
    VRD(1); SBAR(); GAPA(C0=__builtin_amdgcn_mfma_f32_32x32x16_bf16(kf[2],qr[1],C0,0,0,0),   P0[10],P0[11],P0[12],P0[13], pw1[0]=PKW(P0,8), pw1[1]=PKW(P0,10), pw1); \
    VRD(5); SBAR(); GAPA(C1=__builtin_amdgcn_mfma_f32_32x32x16_bf16(kf[3],qr[1],C1,0,0,0),   P0[14],P0[15],P1[0],P1[1],   pw1[2]=PKW(P0,12),pw1[3]=PKW(P0,14), pw1); \
    VRD(2); SBAR(); GAPA(C0=__builtin_amdgcn_mfma_f32_32x32x16_bf16(kf[4],qr[2],C0,0,0,0),   P1[2],P1[3],P1[4],P1[5],     pw2[0]=PKW(P1,0), pw2[1]=PKW(P1,2), pw2); \
    VRD(6); SBAR(); GAPA(C1=__builtin_amdgcn_mfma_f32_32x32x16_bf16(kf[5],qr[2],C1,0,0,0),   P1[6],P1[7],P1[8],P1[9],     pw2[2]=PKW(P1,4), pw2[3]=PKW(P1,6), pw2); \
    VRD(3); SBAR(); GAPA(C0=__builtin_amdgcn_mfma_f32_32x32x16_bf16(kf[6],qr[3],C0,0,0,0),   P1[10],P1[11],P1[12],P1[13], pw3[0]=PKW(P1,8), pw3[1]=PKW(P1,10), pw3); \
    VRD(7); SBAR(); GAPA(C1=__builtin_amdgcn_mfma_f32_32x32x16_bf16(kf[7],qr[3],C1,0,0,0),   P1[14],P1[15],0.f,0.f,       pw3[2]=PKW(P1,12),pw3[3]=PKW(P1,14), pw3); \
    l_reg+=sacc; \
    if(GK){DMA_K((t)+3,sl_cur);} if(GV){DMA_V((t)+1,sl_next);} \
    CMASK(C0,C1,t); \
    { float a=MX3(C0[0],C0[1],C1[0]),b=MX3(C0[2],C0[3],C1[1]); a=MX3(a,C1[2],C1[3]); \
      _Pragma("unroll") for(int r=4;r<16;r+=4){a=MX3(a,C0[r],C0[r+1]);b=MX3(b,C0[r+2],C0[r+3]);a=MX3(a,C1[r],C1[r+1]);b=MX3(b,C1[r+2],C1[r+3]);} \
      float rm=__builtin_fmaxf(a,b); { auto rr=__builtin_amdgcn_permlane32_swap(__float_as_uint(rm),__float_as_uint(rm),false,false); rm=__builtin_fmaxf(__uint_as_float(rr[0]),__uint_as_float(rr[1])); } \
      resc=false; \
      if(__builtin_expect(__any(rm>(float)THRL),0)){ const float dl=__builtin_fmaxf(rm,0.f); mhat+=dl; \
        _Pragma("unroll") for(int r=0;r<16;++r){C0[r]-=dl;C1[r]-=dl;} \
        _Pragma("unroll") for(int r=0;r<16;++r)negm[r]=-mhat; asm volatile("":"+v"(negm)); \
        const float f=__builtin_amdgcn_exp2f(-dl); l_reg*=f; if(hi==0)wsf[r32]=f; resc=true; } } \
    SBAR(); \
    VRD(8); SBAR();  GAPB2(o[0]=__builtin_amdgcn_mfma_f32_32x32x16_bf16(PAF(0),VFR(0),o[0],0,0,0), C0,0); \
    VRD(12); SBAR(); GAPB2(o[1]=__builtin_amdgcn_mfma_f32_32x32x16_bf16(PAF(0),VFR(4),o[1],0,0,0), C0,2); \
    KRD(GL,0); GAPB2(o[0]=__builtin_amdgcn_mfma_f32_32x32x16_bf16(PAF(1),VFR(1),o[0],0,0,0), C0,4); \
    KRD(GL,1); GAPB2(o[1]=__builtin_amdgcn_mfma_f32_32x32x16_bf16(PAF(1),VFR(5),o[1],0,0,0), C0,6); \
    KRD(GL,2); GAPB2(o[0]=__builtin_amdgcn_mfma_f32_32x32x16_bf16(PAF(2),VFR(2),o[0],0,0,0), C0,8); \
    KRD(GL,3); GAPB2(o[1]=__builtin_amdgcn_mfma_f32_32x32x16_bf16(PAF(2),VFR(6),o[1],0,0,0), C0,10); \
    VRD(9); SBAR();  GAPB2(o[0]=__builtin_amdgcn_mfma_f32_32x32x16_bf16(PAF(3),VFR(3),o[0],0,0,0), C0,12); \
    VRD(13); SBAR(); GAPB2(o[1]=__builtin_amdgcn_mfma_f32_32x32x16_bf16(PAF(3),VFR(7),o[1],0,0,0), C0,14); \
    VRD(10); SBAR(); GAPB2(o[2]=__builtin_amdgcn_mfma_f32_32x32x16_bf16(PAF(0),VFR(8),o[2],0,0,0), C1,0); \
    VRD(14); SBAR(); GAPB2(o[3]=__builtin_amdgcn_mfma_f32_32x32x16_bf16(PAF(0),VFR(12),o[3],0,0,0), C1,2); \
    VRD(11); SBAR(); GAPB2(o[2]=__builtin_amdgcn_mfma_f32_32x32x16_bf16(PAF(1),VFR(9),o[2],0,0,0), C1,4); \
    VRD(15); SBAR(); GAPB2(o[3]=__builtin_amdgcn_mfma_f32_32x32x16_bf16(PAF(1),VFR(13),o[3],0,0,0), C1,6); \
    GAPB2(o[2]=__builtin_amdgcn_mfma_f32_32x32x16_bf16(PAF(2),VFR(10),o[2],0,0,0), C1,8); \
    GAPB2(o[3]=__builtin_amdgcn_mfma_f32_32x32x16_bf16(PAF(2),VFR(14),o[3],0,0,0), C1,10); \
    GAPB2(o[2]=__builtin_amdgcn_mfma_f32_32x32x16_bf16(PAF(3),VFR(11),o[2],0,0,0), C1,12); \
    GAPB2(o[3]=__builtin_amdgcn_mfma_f32_32x32x16_bf16(PAF(3),VFR(15),o[3],0,0,0), C1,14); \
    }while(0)
  int t=1;
  #undef CMASK
  #define CMASK(P0,P1,t) do{}while(0)
  for(;t+5<NT;t+=2){
    STEP(pB0,pB1,pA0,pA1,t,true,true,true);     WAIT_BAR(3); RESC(); ROT();
    STEP(pA0,pA1,pB0,pB1,t+1,true,true,true);   WAIT_BAR(3); RESC(); ROT();
  }
  #undef CMASK
  #define CMASK(P0,P1,t) do{int jb_=(t)-(NT-4); if(jb_>=0)cmask(P0,P1,jb_,qrel,hi);}while(0)
  #define ENDW(tt) do{ if((tt)+3<NT){WAIT_BAR(3);} else if((tt)+2<NT){WAIT_BAR(2);} else {WAIT_BAR(0);} }while(0)
  for(;t+1<NT;t+=2){
    STEP(pB0,pB1,pA0,pA1,t,(t+3<NT),(t+1<NT),(t+1<NT));       ENDW(t);   RESC(); ROT();
    STEP(pA0,pA1,pB0,pB1,t+1,(t+4<NT),(t+2<NT),(t+2<NT));     ENDW(t+1); RESC(); ROT();
  }
  STEP(pB0,pB1,pA0,pA1,NT-1,false,false,false); RESC();
  { float sacc=pB0[0]+pB0[1]; _Pragma("unroll") for(int r=2;r<16;++r)sacc+=pB0[r]; _Pragma("unroll") for(int r=0;r<16;++r)sacc+=pB1[r]; l_reg+=sacc;
    pw0=(u32x4){PKW(pB0,0),PKW(pB0,2),PKW(pB0,4),PKW(pB0,6)};pw1=(u32x4){PKW(pB0,8),PKW(pB0,10),PKW(pB0,12),PKW(pB0,14)};pw2=(u32x4){PKW(pB1,0),PKW(pB1,2),PKW(pB1,4),PKW(pB1,6)};pw3=(u32x4){PKW(pB1,8),PKW(pB1,10),PKW(pB1,12),PKW(pB1,14)};
    SBAR(); pv(o,vb0+2*sl_cur,PAF(0),PAF(1),PAF(2),PAF(3)); }
  #undef PKW
  #undef PAF
  #undef VFR
  #undef PIN
  #undef MX3
  #undef GAPA
  #undef GAPB
  #undef GAPB2
  #undef EX
  #undef VRD
  #undef KRD
  #undef STEP
  #undef ENDW
  {auto rr=__builtin_amdgcn_permlane32_swap(__float_as_uint(l_reg),__float_as_uint(l_reg),false,false);l_reg=__uint_as_float(rr[0])+__uint_as_float(rr[1]);}
  if(hi==0)wsf[32+r32]=l_reg;asm volatile("s_waitcnt lgkmcnt(0)":::"memory");
  float rli[16];
  #pragma unroll
  for(int r=0;r<16;++r)rli[r]=__builtin_amdgcn_rcpf(wsf[32+crow(r,hi)]);
  bf16*Ow=O+(rowbase+q0+wid*QBLK)*OP+map*128;
  { bf16*stg=(bf16*)(shm+LDS_OST)+wid*2048;
    #pragma unroll
    for(int hp=0;hp<2;++hp){
    #pragma unroll
    for(int r=0;r<16;++r){const int orow=crow(r,hi);
      #pragma unroll
      for(int d0=0;d0<2;++d0)stg[orow*64+d0*32+r32]=__float2bfloat16(o[2*hp+d0][r]*rli[r]);}
    asm volatile("s_waitcnt lgkmcnt(0)":::"memory");
    #pragma unroll
    for(int i=0;i<4;++i){const int row=i*8+(lane>>3),ch=lane&7; const u32x4 v=*(const u32x4*)(stg+row*64+ch*8); ATTN_STORE16(Ow+(long)row*OP+hp*64+ch*8,v);}
    asm volatile("s_waitcnt lgkmcnt(0)":::"memory"); } }
  asm volatile("s_waitcnt lgkmcnt(0)\n\ts_barrier":::"memory");
  #undef DMA_K
  #undef DMA_V
  #undef CMASK
  #undef START
  #undef RESC
  #undef ROT
}
constexpr int ATTN_LDS_BYTES=LDS_BYTES;
struct AttnTensors { const bf16* Q; const bf16* K; const bf16* V; bf16* O; };
template<int THRL=8> __device__ __forceinline__ void attn_phase(char*lds,const AttnTensors&T,int vcu,const int wave){
  const int xcd=vcu>>5, s=vcu&31, b=xcd>>2;
  for(int c=0;c<4;++c){ const int map=4*(xcd&3)+c;
    attn_unit<THRL>(b,map,s,T.Q,T.K,T.V,T.O,lds,wave); attn_unit<THRL>(b,map,63-s,T.Q,T.K,T.V,T.O,lds,wave); }
}
#undef SBAR
#undef WAIT_BAR
}
constexpr int NWAVES = 8;
constexpr int D = 1024, MP = 32768, MS = 512, M = MP + MS, SEQ = 16384, DEPTH = 4, DFF = 2816, NUP = 2 * DFF, NIN = 8192, KBR = 2048, PLE = 256;
constexpr int DSEQ = 32, PAST = 1024, DB = 16;
constexpr float RMS_EPS = 1e-6f;
constexpr int PH_PER_LAYER = 14, NPH = 1 + DEPTH * PH_PER_LAYER;
#ifndef REP_ATT
#define REP_ATT 1
#endif
#ifndef REP_PRO
#define REP_PRO 1
#endif
#ifndef REP_ROW
#define REP_ROW 1
#endif
#ifndef REP_E2
#define REP_E2 1
#endif
#ifndef REP_LB
#define REP_LB 1
#endif
#ifndef REP_BAR
#define REP_BAR 1
#endif
#ifndef REP_SG
#define REP_SG 1
#endif
#ifndef REP_SA
#define REP_SA 1
#endif
#ifndef REP_SE2
#define REP_SE2 1
#endif
#ifndef REP_GEMM_BAR
#define REP_GEMM_BAR 0
#endif
#ifndef REP_GEMM
#define REP_GEMM 1
#endif
#ifndef MK_PER_PHASE
#define MK_PER_PHASE 0
#endif

constexpr size_t MiB = 1u << 20;
constexpr size_t WS_CTL = 0, CTL_ZERO_BYTES = 1 * MiB;
constexpr size_t WS_ROPEC = 2 * MiB, WS_ROPES = 4 * MiB;
constexpr size_t WS_W = 8 * MiB, W_LAYER = 64 * MiB;
constexpr size_t W_UP1 = 0, W_UP2 = 11 * MiB, W_DN1 = 22 * MiB, W_DN2 = 22 * MiB + 5632 * 1024, W_IN = 33 * MiB, W_BR = 49 * MiB, W_OUT = 53 * MiB, W_PG = 55 * MiB, W_PU = 57 * MiB;
constexpr size_t WS_PB = 272 * MiB, PB_LAYER = 17 * MiB;
constexpr size_t WS_XN = 344 * MiB, WS_HFF = 416 * MiB, WS_Q = 600 * MiB, WS_K = 672 * MiB, WS_V = 744 * MiB, WS_BG = 816 * MiB, WS_C = 852 * MiB, WS_ZP = 888 * MiB;
constexpr size_t WS_GS = 924 * MiB, WS_O = 1120 * MiB, WS_A2 = 1256 * MiB, WS_MG = 1392 * MiB, WS_Y = 1464 * MiB, WS_PU = 1600 * MiB, WS_YS = 1672 * MiB  , WS_END = 1680 * MiB, WS_YB = 1688 * MiB  , WS_HB = 1760 * MiB  , WS_TOP = 1828 * MiB, WS_DUMMY = 1832 * MiB  ;
static_assert(WS_XN + (size_t)M * D * 2 <= WS_HFF && WS_HFF + (size_t)M * DFF * 2 <= WS_Q && WS_GS + (size_t)M * 3072 * 2 <= WS_O && WS_O + (size_t)M * 2048 * 2 <= WS_A2 && WS_Y + (size_t)M * D * 4 <= WS_PU && WS_PU + (size_t)M * D * 2 <= WS_END, "d_ws map");
static_assert(W_PU + (size_t)D * PLE * 2 <= W_LAYER && (size_t)M * PLE * 2 <= PB_LAYER && WS_W + DEPTH * W_LAYER <= WS_PB && WS_PB + DEPTH * PB_LAYER <= WS_XN, "d_ws map 2");
constexpr int CW_TMO = 0, CW_CODE = 1, CW_BAR = 4096;
constexpr size_t O_Y = 0, O_KP = (size_t)M * D, O_VP = O_KP + (size_t)DEPTH * MP * D, O_CP = O_VP + (size_t)DEPTH * MP * D, O_PP = O_CP + (size_t)DEPTH * 2 * 2 * 512, O_KS = O_PP + (size_t)DEPTH * 2 * 15 * 512,
                 O_VS = O_KS + (size_t)DEPTH * MS * D, O_CS = O_VS + (size_t)DEPTH * MS * D, O_PS = O_CS + (size_t)DEPTH * DB * 2 * 512, O_END = O_PS + (size_t)DEPTH * DB * 15 * 512;

constexpr int RING_OFF = 0, RING_BYTES = 131072;
constexpr int LDSCTL_OFF = RING_BYTES, MISC_OFF = LDSCTL_OFF + 320;
constexpr int LDS_BYTES = 147456;
static_assert(MISC_OFF + 128 <= LDS_BYTES, "LDS map");
#define GAS __attribute__((address_space(1)))
#define LAS __attribute__((address_space(3)))
typedef unsigned short bf16;
typedef unsigned v4u __attribute__((ext_vector_type(4)));
typedef float f32x4 __attribute__((ext_vector_type(4)));
typedef short bf16x8 __attribute__((ext_vector_type(8)));
typedef GAS unsigned gu32;
typedef GAS unsigned long long gu64;
#define RLX_AGENT __ATOMIC_RELAXED, __HIP_MEMORY_SCOPE_AGENT
#define LDS_WAIT() asm volatile("s_waitcnt lgkmcnt(0)" ::: "memory")
#define VM_WAIT() asm volatile("s_waitcnt vmcnt(0)" ::: "memory")
__device__ __forceinline__ unsigned long long rt() { return __builtin_amdgcn_s_memrealtime(); }
__device__ __forceinline__ unsigned f2bf(float f) { unsigned u = __builtin_bit_cast(unsigned, f); return (u + 0x7fffu + ((u >> 16) & 1u)) >> 16; }
__device__ __forceinline__ unsigned pk2(float lo, float hi) { return f2bf(lo) | (f2bf(hi) << 16); }

#define XB_TMO      128
#define XB_XCNT(j)  (256  + 64 * (j))
#define XB_XSUB(j)  (1280 + 64 * (j))
#define XB_XGEN(j)  (2304 + 64 * (j))
#define XB_TOP      3328
#define XB_TOPGEN   3392
#define XCD_BAR_WORDS 3456
#define XB_SPIN_CAP (1u << 18)

__device__ __forceinline__ unsigned xb_ld(unsigned* p)              { return __hip_atomic_load(p, __ATOMIC_RELAXED, __HIP_MEMORY_SCOPE_AGENT); }
__device__ __forceinline__ unsigned xb_add(unsigned* p, unsigned v) { return __hip_atomic_fetch_add(p, v, __ATOMIC_RELAXED, __HIP_MEMORY_SCOPE_AGENT); }
__device__ __forceinline__ unsigned xb_xcc_id() { return (unsigned)__builtin_amdgcn_s_getreg((3 << 11) | 20) & 0xFu; }
#define XB_SPIN(cond, bar) do { unsigned _sp = 0; while (cond) { __builtin_amdgcn_s_sleep(1); \
    if ((++_sp & 255u) == 0u) { if (xb_ld(&(bar)[XB_TMO])) break; if (_sp > XB_SPIN_CAP) { atomicAdd(&(bar)[XB_TMO], 1u); break; } } } } while (0)

__device__ __forceinline__ int lane_now() { int l; asm volatile("v_mbcnt_lo_u32_b32 %0, -1, 0\n\tv_mbcnt_hi_u32_b32 %0, -1, %0" : "=v"(l)); return l; }
struct XcdBarrier {
    int wave;
    unsigned* bar; unsigned x;
    volatile LAS unsigned* st;
};

__device__ __forceinline__ XcdBarrier xcd_barrier_post(unsigned* bar, volatile LAS unsigned* st) {
    XcdBarrier b; b.wave = (int)__builtin_amdgcn_readfirstlane(threadIdx.x >> 6); b.bar = bar; b.x = xb_xcc_id(); b.st = st;
    if (threadIdx.x == 0) (void)xb_add(&bar[XB_XCNT(b.x)], 1u);
    return b;
}
__device__ __forceinline__ void xcd_barrier_complete(unsigned* bar, unsigned x, unsigned& nloc, unsigned& nx) {
    const unsigned G = gridDim.x * gridDim.y * gridDim.z;
    unsigned sum, cnt, mine, sp = 0u;
    for (;;) {
        sum = 0u; cnt = 0u; mine = 0u;
#pragma unroll
        for (unsigned j = 0; j < 16; ++j) { const unsigned c = xb_ld(&bar[XB_XCNT(j)]); sum += c; cnt += (c > 0u) ? 1u : 0u; mine = (j == x) ? c : mine; }
        if (sum == G) break;
        __builtin_amdgcn_s_sleep(1);
        if ((++sp & 255u) == 0u) { if (xb_ld(&bar[XB_TMO])) break; if (sp > XB_SPIN_CAP) { atomicAdd(&bar[XB_TMO], 1u); break; } }
    }
    nloc = mine > 0u ? mine : 1u; nx = cnt > 0u ? cnt : 1u;
}

__device__ __forceinline__ void xcd_barrier(const XcdBarrier& b) {
    asm volatile("s_waitcnt vmcnt(0)" ::: "memory");
    __syncthreads();
    if (b.wave == 0 && lane_now() == 0) {
        unsigned* bar = b.bar;
        __builtin_amdgcn_s_waitcnt(0);
        unsigned nloc = b.st[0], nx = b.st[1];
        if (nloc == 0u) { xcd_barrier_complete(bar, b.x, nloc, nx); b.st[0] = nloc; b.st[1] = nx; }
        const unsigned old = xb_add(&bar[XB_XSUB(b.x)], 1u);
        const unsigned gen = old / nloc;
        if (old + 1u == (gen + 1u) * nloc) {
            __builtin_amdgcn_fence(__ATOMIC_RELEASE, "agent");
            asm volatile("s_waitcnt vmcnt(0)" ::: "memory");
            const unsigned og = xb_add(&bar[XB_TOP], 1u);
            const unsigned tg = og / nx;
            if (og + 1u == (tg + 1u) * nx) xb_add(&bar[XB_TOPGEN], 1u);
            else XB_SPIN(xb_ld(&bar[XB_TOPGEN]) == tg, bar);
            __builtin_amdgcn_fence(__ATOMIC_ACQUIRE, "agent");
            xb_add(&bar[XB_XGEN(b.x)], 1u);
            asm volatile("s_waitcnt vmcnt(0)" ::: "memory");
        } else {
            XB_SPIN(xb_ld(&bar[XB_XGEN(b.x)]) == gen, bar);
            __builtin_amdgcn_fence(__ATOMIC_ACQUIRE, "agent");
            asm volatile("s_waitcnt vmcnt(0)" ::: "memory");
        }
    }
    __syncthreads();
}
constexpr int NSG_C = 64;
struct Frame {
    LAS unsigned char* lds;
    volatile LAS unsigned* MISC;
    gu32* ctl;
    int wave;
    int vcu, G;
    unsigned lbn;
    int sidx, pidx;
    const float* in[21]; float* out; unsigned char* ws;
};
__device__ __forceinline__ float wave_sum(float v) {
#pragma unroll
    for (int o = 1; o < 64; o <<= 1) v += __shfl_xor(v, o);
    return v;
}
__device__ __forceinline__ bf16* wsb(Frame& F, size_t off) { return (bf16*)(F.ws + off); }
__device__ __forceinline__ bf16* wlayer(Frame& F, int li, size_t off) { return (bf16*)(F.ws + WS_W + (size_t)li * W_LAYER + off); }

__device__ __forceinline__ int map_row(int kind, int n0) {
    if (kind == 1) { const int bj = n0 / DFF, rem = n0 - bj * DFF; return (rem >> 7) * 256 + bj * 128 + (rem & 127); }
    if (kind == 2) {
        if (n0 < 2048) return (n0 & ~255) + ((n0 >> 5) & 1) * 128 + ((n0 >> 6) & 3) * 32;
        if (n0 >= 3584 && n0 < 4608) { const int x = n0 >= 4096, j = n0 - (x ? 4096 : 3584); return 3584 + (j >> 7) * 256 + x * 128 + (j & 127); }
        return n0; }
    return n0;
}
__device__ __forceinline__ void p0_transpose_item(const float* W, int N, bf16* WT, int ldk, int kind, LAS float* scr, int item, int lane) {
    const int nblk = N / 32, kb = item / nblk, nb = item % nblk, k0 = 64 * kb, n0 = 32 * nb;
#pragma unroll 8
    for (int i = 0; i < 32; ++i) { const int kk = 2 * i + (lane >> 5); scr[kk * 33 + (lane & 31)] = W[(size_t)(k0 + kk) * N + n0 + (lane & 31)]; }
    LDS_WAIT(); asm volatile("" ::: "memory");
    const int c = lane & 7; const int r0 = map_row(kind, n0);
#pragma unroll
    for (int j = 0; j < 4; ++j) { const int n = (lane >> 3) + 8 * j; const LAS float* s = scr + (8 * c) * 33 + n;
        v4u o; o.x = pk2(s[0 * 33], s[1 * 33]); o.y = pk2(s[2 * 33], s[3 * 33]); o.z = pk2(s[4 * 33], s[5 * 33]); o.w = pk2(s[6 * 33], s[7 * 33]);
        *(GAS v4u*)(WT + (size_t)(r0 + n) * ldk + k0 + 8 * c) = o; }
    LDS_WAIT(); asm volatile("" ::: "memory");
}
__device__ __forceinline__ void p0_weff_item(const float* pool_w, const float* pool_scale, const float* wbr, bf16* WT, int item, int lane) {
    const int kb = item >> 4, nb = item & 15, k0 = kb * 8, g = k0 >> 7, c0 = k0 & 127, n = nb * 64 + lane;
    float acc[8];
#pragma unroll
    for (int i = 0; i < 8; ++i) acc[i] = 0.f;
    const float* pw = pool_w + ((size_t)g * 128 + c0) * 128; const float* ps = pool_scale + g * 128; const float* wb = wbr + (size_t)(1536 + g * 128) * D + n;
    for (int dd = 0; dd < 128; ++dd) { const float w = wb[(size_t)dd * D] * ps[dd];
#pragma unroll
        for (int i = 0; i < 8; ++i) acc[i] += pw[i * 128 + dd] * w; }
    v4u o; o.x = pk2(acc[0], acc[1]); o.y = pk2(acc[2], acc[3]); o.z = pk2(acc[4], acc[5]); o.w = pk2(acc[6], acc[7]);
    *(GAS v4u*)(WT + (size_t)n * KBR + 1536 + k0) = o;
}
__device__ __forceinline__ void norm_row(int lane, const float* yrow, const float* hin, float coef, const float* ga, float* hout, const float* gb, bf16* xnrow) {
    const GAS f32x4* hr = (const GAS f32x4*)hin + lane;
    f32x4 h[4];
#pragma unroll
    for (int j = 0; j < 4; ++j) h[j] = hr[64 * j];
    if (yrow) {
        const GAS f32x4* yr = (const GAS f32x4*)yrow + lane; f32x4 y[4]; float s = 0.f;
#pragma unroll
        for (int j = 0; j < 4; ++j) { y[j] = yr[64 * j]; s += (y[j].x * y[j].x + y[j].y * y[j].y) + (y[j].z * y[j].z + y[j].w * y[j].w); }
        const float r = coef * __builtin_amdgcn_rsqf(wave_sum(s) * (1.f / D) + RMS_EPS);
#pragma unroll
        for (int j = 0; j < 4; ++j) { const f32x4 g = ((const GAS f32x4*)ga + lane)[64 * j]; h[j] = h[j] + y[j] * r * g; }
    }
    GAS f32x4* ho = (GAS f32x4*)hout + lane;
#pragma unroll
    for (int j = 0; j < 4; ++j) ho[64 * j] = h[j];
    if (xnrow) {
        float s2 = 0.f;
#pragma unroll
        for (int j = 0; j < 4; ++j) s2 += (h[j].x * h[j].x + h[j].y * h[j].y) + (h[j].z * h[j].z + h[j].w * h[j].w);
        const float r2 = __builtin_amdgcn_rsqf(wave_sum(s2) * (1.f / D) + RMS_EPS);
        GAS unsigned long long* o8 = (GAS unsigned long long*)xnrow + lane;
#pragma unroll
        for (int j = 0; j < 4; ++j) { const f32x4 g = ((const GAS f32x4*)gb + lane)[64 * j]; const f32x4 v = h[j] * r2 * g;
            o8[64 * j] = (unsigned long long)pk2(v.x, v.y) | ((unsigned long long)pk2(v.z, v.w) << 32); }
    }
}
__device__ __forceinline__ void rope_entry(int pos, int d, float& c, float& s) {
    double inv = 1.0; for (int i = 0; i < d; ++i) inv *= 0.7498942093324559;
    const float ang = (float)pos * (float)inv; const double a = (double)ang;
    const double q = __builtin_rint(a * 0.6366197723675814);
    double y = __builtin_fma(-q, 1.5707963267948966, a); y = __builtin_fma(-q, 6.123233995736766e-17, y);
    const double y2 = y * y;
    const double sp = y * (1.0 + y2 * (-1.0 / 6.0 + y2 * (1.0 / 120.0 + y2 * (-1.0 / 5040.0 + y2 * (1.0 / 362880.0 + y2 * (-1.0 / 39916800.0 + y2 * (1.0 / 6227020800.0)))))));
    const double cp = 1.0 + y2 * (-0.5 + y2 * (1.0 / 24.0 + y2 * (-1.0 / 720.0 + y2 * (1.0 / 40320.0 + y2 * (-1.0 / 3628800.0 + y2 * (1.0 / 479001600.0 + y2 * (-1.0 / 87178291200.0)))))));
    const int qi = ((int)q) & 3;
    const double sv = (qi == 0) ? sp : (qi == 1) ? cp : (qi == 2) ? -sp : -cp;
    const double cv = (qi == 0) ? cp : (qi == 1) ? -sp : (qi == 2) ? -cp : sp;
    c = (float)cv; s = (float)sv;
}
struct RowRegs { f32x4 y[4], h[4]; };
typedef unsigned u32x2r __attribute__((ext_vector_type(2)));
__device__ __forceinline__ f32x4 bf4_to_f32(const u32x2r w) { return (f32x4){__uint_as_float(w.x << 16), __uint_as_float(w.x & 0xffff0000u), __uint_as_float(w.y << 16), __uint_as_float(w.y & 0xffff0000u)}; }
__device__ __forceinline__ void row_load(int lane, const bf16* Y, const bf16* H, int m, RowRegs& R) {
    const GAS u32x2r* yr = (const GAS u32x2r*)(Y + (size_t)m * D) + lane; const GAS u32x2r* hr = (const GAS u32x2r*)(H + (size_t)m * D) + lane;
    u32x2r yw[4], hw[4];
#pragma unroll
    for (int j = 0; j < 4; ++j) { yw[j] = yr[64 * j]; hw[j] = hr[64 * j]; }
#pragma unroll
    for (int j = 0; j < 4; ++j) { R.y[j] = bf4_to_f32(yw[j]); R.h[j] = bf4_to_f32(hw[j]); }
}
__device__ __forceinline__ void row_finish(int lane, RowRegs& R, float coef, const f32x4 (&ga)[4], const f32x4 (&gb)[4], bf16* H, bf16* XN, int m, bool write_xn, float* fin) {
    float s = 0.f;
#pragma unroll
    for (int j = 0; j < 4; ++j) s += (R.y[j].x * R.y[j].x + R.y[j].y * R.y[j].y) + (R.y[j].z * R.y[j].z + R.y[j].w * R.y[j].w);
    const float r = coef * __builtin_amdgcn_rsqf(wave_sum(s) * (1.f / D) + RMS_EPS);
    GAS unsigned long long* hb = (GAS unsigned long long*)(H + (size_t)m * D) + lane; GAS f32x4* ho = (GAS f32x4*)(fin + (size_t)m * D) + lane; float s2 = 0.f;
#pragma unroll
    for (int j = 0; j < 4; ++j) { R.h[j] = R.h[j] + R.y[j] * r * ga[j]; if (fin) ho[64 * j] = R.h[j]; else hb[64 * j] = (unsigned long long)pk2(R.h[j].x, R.h[j].y) | ((unsigned long long)pk2(R.h[j].z, R.h[j].w) << 32); s2 += (R.h[j].x * R.h[j].x + R.h[j].y * R.h[j].y) + (R.h[j].z * R.h[j].z + R.h[j].w * R.h[j].w); }
    if (write_xn) {
        const float r2 = __builtin_amdgcn_rsqf(wave_sum(s2) * (1.f / D) + RMS_EPS);
        GAS unsigned long long* o8 = (GAS unsigned long long*)(XN + (size_t)m * D) + lane;
#pragma unroll
        for (int j = 0; j < 4; ++j) { const f32x4 v = R.h[j] * r2 * gb[j]; o8[64 * j] = (unsigned long long)pk2(v.x, v.y) | ((unsigned long long)pk2(v.z, v.w) << 32); }
    }
}
__device__ __forceinline__ void norm_phase(Frame& F, float coef, const float* ga_, const float* gb_, bool write_xn, int m0, int m1, int gw, int NGW, bool dry = false, bool final_ = false) {
    const bf16* Y = (const bf16*)(F.ws + WS_YB); bf16* XN = dry ? (bf16*)(F.ws + WS_DUMMY + 160 * MiB) : wsb(F, WS_XN); const bf16* H = wsb(F, WS_HB); bf16* HO = dry ? (bf16*)(F.ws + WS_DUMMY) : wsb(F, WS_HB);
    float* fin = (final_ && !dry) ? F.out : nullptr;
    const int lane = lane_now();
    f32x4 ga[4], gb[4];
#pragma unroll
    for (int j = 0; j < 4; ++j) { ga[j] = ((const GAS f32x4*)ga_ + lane)[64 * j]; gb[j] = write_xn ? ((const GAS f32x4*)gb_ + lane)[64 * j] : (f32x4){0.f, 0.f, 0.f, 0.f}; }
    for (int m = m0 + gw; m < m1; m += 4 * NGW) {
        const int mb = m + NGW, mc = m + 2 * NGW, md = m + 3 * NGW; const bool hasb = mb < m1, hasc = mc < m1, hasd = md < m1;
        RowRegs A, B, C, E; row_load(lane, Y, H, m, A); if (hasb) row_load(lane, Y, H, mb, B); if (hasc) row_load(lane, Y, H, mc, C); if (hasd) row_load(lane, Y, H, md, E);
        row_finish(lane, A, coef, ga, gb, HO, XN, m, write_xn, fin);
        if (hasb) row_finish(lane, B, coef, ga, gb, HO, XN, mb, write_xn, fin);
        if (hasc) row_finish(lane, C, coef, ga, gb, HO, XN, mc, write_xn, fin);
        if (hasd) row_finish(lane, E, coef, ga, gb, HO, XN, md, write_xn, fin);
    }
}
__device__ __forceinline__ void norm_phase_sample(Frame& F, float coef, const float* ga_, const float* gb_, bool write_xn, const float* ysrc, int nslab, bool final_ = false) {
    const int lane = lane_now(); bf16* XN = wsb(F, WS_XN); bf16* H = wsb(F, WS_HB); float* fin = final_ ? F.out : nullptr;
    f32x4 ga[4], gb[4];
#pragma unroll
    for (int j = 0; j < 4; ++j) { ga[j] = ((const GAS f32x4*)ga_ + lane)[64 * j]; gb[j] = write_xn ? ((const GAS f32x4*)gb_ + lane)[64 * j] : (f32x4){0.f, 0.f, 0.f, 0.f}; }
    for (int r = F.sidx * NWAVES + F.wave; r < MS; r += NSG_C * NWAVES) {
        RowRegs A; const int m = MP + r;
        const GAS u32x2r* hr = (const GAS u32x2r*)(H + (size_t)m * D) + lane;
#pragma unroll
        for (int j = 0; j < 4; ++j) { A.h[j] = bf4_to_f32(hr[64 * j]); A.y[j] = (f32x4){0.f, 0.f, 0.f, 0.f}; }
        for (int sl = 0; sl < nslab; ++sl) { const GAS f32x4* yr = (const GAS f32x4*)(ysrc + (size_t)sl * MS * D + (size_t)r * D) + lane;
#pragma unroll
            for (int j = 0; j < 4; ++j) A.y[j] = A.y[j] + yr[64 * j]; }
        if (nslab == 0) { const GAS u32x2r* yr = (const GAS u32x2r*)((const bf16*)(F.ws + WS_YB) + (size_t)m * D) + lane;
#pragma unroll
            for (int j = 0; j < 4; ++j) A.y[j] = bf4_to_f32(yr[64 * j]); }
        row_finish(lane, A, coef, ga, gb, H, XN, m, write_xn, fin);
    }
}
__device__ __forceinline__ void p0_layer(Frame& F, const int li, const int gw, const int NGW, const int parts = 31) {
    LAS float* scr = (LAS float*)(F.lds + RING_OFF + F.wave * 16384);
    const int lane = lane_now();
    for (int f = 0; f < 2; ++f) {
        if (parts & 1) { const float* wu = F.in[9] + (size_t)(li * 2 + f) * D * NUP; bf16* du = wlayer(F, li, f ? W_UP2 : W_UP1);
            for (int it = gw; it < (D / 64) * (NUP / 32); it += NGW) p0_transpose_item(wu, NUP, du, D, 1, scr, it, lane); }
        if (parts & 2) { const float* wd = F.in[10] + (size_t)(li * 2 + f) * DFF * D; bf16* dd = wlayer(F, li, f ? W_DN2 : W_DN1);
            for (int it = gw; it < (DFF / 64) * (D / 32); it += NGW) p0_transpose_item(wd, D, dd, DFF, 0, scr, it, lane); }
    }
    if (parts & 4) for (int it = gw; it < (D / 64) * (NIN / 32); it += NGW) p0_transpose_item(F.in[11] + (size_t)li * D * NIN, NIN, wlayer(F, li, W_IN), D, 2, scr, it, lane);
    if (parts & 8) {
        for (int it = gw; it < (1536 / 64) * (D / 32); it += NGW) p0_transpose_item(F.in[17] + (size_t)li * KBR * D, D, wlayer(F, li, W_BR), KBR, 0, scr, it, lane);
        for (int it = gw; it < (D / 64) * (D / 32); it += NGW) p0_transpose_item(F.in[18] + (size_t)li * D * D, D, wlayer(F, li, W_OUT), D, 0, scr, it, lane);
        for (int it = gw; it < (D / 64) * (D / 32); it += NGW) p0_transpose_item(F.in[20] + (size_t)li * D * D, D, wlayer(F, li, W_PG), D, 0, scr, it, lane);
        for (int it = gw; it < (PLE / 64) * (D / 32); it += NGW) p0_transpose_item(F.in[19] + (size_t)li * PLE * D, D, wlayer(F, li, W_PU), PLE, 0, scr, it, lane);
        for (int it = gw; it < 64 * 16; it += NGW) p0_weff_item(F.in[15] + (size_t)li * 4 * 128 * 128, F.in[16] + (size_t)li * 512, F.in[17] + (size_t)li * KBR * D, wlayer(F, li, W_BR), it, lane);
    }
    if (parts & 16) { bf16* pb = (bf16*)(F.ws + WS_PB + (size_t)li * PB_LAYER);
        for (int m = gw; m < M; m += NGW) { const float* src = m < MP ? F.in[6] + ((size_t)li * MP + m) * PLE : F.in[7] + ((size_t)li * MS + (m - MP)) * PLE;
            const f32x4 v = ((const GAS f32x4*)src)[lane]; ((GAS unsigned long long*)(pb + (size_t)m * PLE))[lane] = (unsigned long long)pk2(v.x, v.y) | ((unsigned long long)pk2(v.z, v.w) << 32); } }
}
__device__ __forceinline__ void p0_prologue(Frame& F) {
    const int gw = F.vcu * NWAVES + F.wave, NGW = F.G * NWAVES; const int lane = lane_now();
    p0_layer(F, 0, gw, NGW);
    { float* rc = (float*)(F.ws + WS_ROPEC); float* rs = (float*)(F.ws + WS_ROPES);
      for (int i = gw * 64 + lane; i < SEQ * 32; i += NGW * 64) { float c, s; rope_entry(i >> 5, i & 31, c, s); rc[i] = c; rs[i] = s; } }
    bf16* XN = wsb(F, WS_XN); bf16* HB = wsb(F, WS_HB);
    for (int m = gw; m < M; m += NGW) { const float* xr = m < MP ? F.in[0] + (size_t)m * D : F.in[1] + (size_t)(m - MP) * D;
        const GAS f32x4* xp = (const GAS f32x4*)xr + lane; f32x4 h[4]; float s2 = 0.f;
#pragma unroll
        for (int j = 0; j < 4; ++j) { h[j] = xp[64 * j]; s2 += (h[j].x * h[j].x + h[j].y * h[j].y) + (h[j].z * h[j].z + h[j].w * h[j].w); }
        const float r2 = __builtin_amdgcn_rsqf(wave_sum(s2) * (1.f / D) + RMS_EPS);
        GAS unsigned long long* hb = (GAS unsigned long long*)(HB + (size_t)m * D) + lane; GAS unsigned long long* o8 = (GAS unsigned long long*)(XN + (size_t)m * D) + lane;
#pragma unroll
        for (int j = 0; j < 4; ++j) { hb[64 * j] = (unsigned long long)pk2(h[j].x, h[j].y) | ((unsigned long long)pk2(h[j].z, h[j].w) << 32);
            const f32x4 g = ((const GAS f32x4*)F.in[8] + lane)[64 * j]; const f32x4 v = h[j] * r2 * g; o8[64 * j] = (unsigned long long)pk2(v.x, v.y) | ((unsigned long long)pk2(v.z, v.w) << 32); } }
}
__device__ __forceinline__ void unpack8f(const v4u w, float (&f)[8]) {
    f[0] = __uint_as_float(w.x << 16); f[1] = __uint_as_float(w.x & 0xffff0000u); f[2] = __uint_as_float(w.y << 16); f[3] = __uint_as_float(w.y & 0xffff0000u);
    f[4] = __uint_as_float(w.z << 16); f[5] = __uint_as_float(w.z & 0xffff0000u); f[6] = __uint_as_float(w.w << 16); f[7] = __uint_as_float(w.w & 0xffff0000u); }
__device__ __forceinline__ v4u pack8f(const float (&f)[8]) { v4u o; o.x = pk2(f[0], f[1]); o.y = pk2(f[2], f[3]); o.z = pk2(f[4], f[5]); o.w = pk2(f[6], f[7]); return o; }
__device__ __forceinline__ void e2_phase(Frame& F, int li, int m0, int m1, int gw, int NGW) {
    const int lane = lane_now();
    const float* lam = F.in[12] + li * 256;
    const float s1 = wave_sum(lam[lane] * lam[64 + lane]), s2 = wave_sum(lam[128 + lane] * lam[192 + lane]);
    const float lam_init = 0.8f - 0.6f * __expf(-0.3f * (float)li);
    const float lam_full = __expf(s1) - __expf(s2) + lam_init, osc = 1.0f - lam_init;
    const bf16* O = wsb(F, WS_O); const bf16* BG = wsb(F, WS_BG); const bf16* C = wsb(F, WS_C); const bf16* ZP = wsb(F, WS_ZP); bf16* A2 = wsb(F, WS_A2);
    const int hh = lane >> 3, e0 = (lane & 7) * 16, c0 = lane * 8, grp = lane >> 4, win = 2 << grp;
    float sg[16];
#pragma unroll
    for (int i = 0; i < 16; ++i) sg[i] = F.in[13][li * 1024 + hh * 128 + e0 + i];
    float cw[3][8];
#pragma unroll
    for (int j = 0; j < 3; ++j)
#pragma unroll
        for (int i = 0; i < 8; ++i) cw[j][i] = F.in[14][(li * 3 + j) * 512 + c0 + i];
    for (int m = m0 + gw; m < m1; m += NGW) {
        const bool samp = m >= MP; const int t = samp ? ((m - MP) & 31) : (m & (SEQ - 1)); const int b = samp ? ((m - MP) >> 5) : (m >> 14); const int T = samp ? DSEQ : SEQ;
        { const bf16* orow = O + (size_t)m * 2048 + hh * 256 + e0;
          float o1[16], o2[16]; { float t8[8]; unpack8f(*(const GAS v4u*)orow, t8); for (int i = 0; i < 8; ++i) o1[i] = t8[i]; unpack8f(*(const GAS v4u*)(orow + 8), t8); for (int i = 0; i < 8; ++i) o1[8 + i] = t8[i];
              unpack8f(*(const GAS v4u*)(orow + 128), t8); for (int i = 0; i < 8; ++i) o2[i] = t8[i]; unpack8f(*(const GAS v4u*)(orow + 136), t8); for (int i = 0; i < 8; ++i) o2[8 + i] = t8[i]; }
          float ss = 0.f;
#pragma unroll
          for (int i = 0; i < 16; ++i) { o1[i] = o1[i] - lam_full * o2[i]; ss += o1[i] * o1[i]; }
          ss += __shfl_xor(ss, 1); ss += __shfl_xor(ss, 2); ss += __shfl_xor(ss, 4);
          const float r = __builtin_amdgcn_rsqf(ss * (1.f / 128.f) + RMS_EPS) * osc;
          float a0[8], a1[8];
#pragma unroll
          for (int i = 0; i < 8; ++i) { a0[i] = o1[i] * r * sg[i]; a1[i] = o1[8 + i] * r * sg[8 + i]; }
          bf16* arow = A2 + (size_t)m * KBR + hh * 128 + e0; *(GAS v4u*)arow = pack8f(a0); *(GAS v4u*)(arow + 8) = pack8f(a1); }
        { float z0[8], z1[8], z2[8], bgv[8];
          unpack8f(*(const GAS v4u*)(C + (size_t)m * 512 + c0), z0); unpack8f(*(const GAS v4u*)(BG + (size_t)m * 512 + c0), bgv);
          const float* hist = F.in[4] + ((size_t)(li * DB + b) * 2) * 512 + c0;
          if (t >= 1) unpack8f(*(const GAS v4u*)(C + (size_t)(m - 1) * 512 + c0), z1);
          else { for (int i = 0; i < 8; ++i) z1[i] = samp ? hist[512 + i] : 0.f; }
          if (t >= 2) unpack8f(*(const GAS v4u*)(C + (size_t)(m - 2) * 512 + c0), z2);
          else { for (int i = 0; i < 8; ++i) z2[i] = samp ? hist[t * 512 + i] : 0.f; }
          float y[8];
#pragma unroll
          for (int i = 0; i < 8; ++i) y[i] = bgv[i] * (cw[0][i] * z2[i] + cw[1][i] * z1[i] + cw[2][i] * z0[i]);
          *(GAS v4u*)(A2 + (size_t)m * KBR + 1024 + c0) = pack8f(y);
          if (t >= T - 2) { float* dst = samp ? F.out + O_CS + ((size_t)(li * DB + b) * 2 + (t - (T - 2))) * 512 + c0 : F.out + O_CP + ((size_t)(li * 2 + b) * 2 + (t - (T - 2))) * 512 + c0;
              *(GAS f32x4*)dst = (f32x4){z0[0], z0[1], z0[2], z0[3]}; *(GAS f32x4*)(dst + 4) = (f32x4){z0[4], z0[5], z0[6], z0[7]}; } }
        { float zc[8], ws8[8]; unpack8f(*(const GAS v4u*)(ZP + (size_t)m * 512 + c0), zc);
#pragma unroll
          for (int i = 0; i < 8; ++i) ws8[i] = zc[i];
          if (t >= 15) {
              v4u zr[15];
#pragma unroll
              for (int j = 1; j < 16; ++j) { const int jj = j < win ? j : win - 1; zr[j - 1] = *(const GAS v4u*)(ZP + (size_t)(m - jj) * 512 + c0); }
#pragma unroll
              for (int j = 1; j < 16; ++j) { float zz[8]; unpack8f(zr[j - 1], zz); const float wj = j < win ? 1.f : 0.f;
#pragma unroll
                  for (int q = 0; q < 8; ++q) ws8[q] += wj * zz[q]; }
          } else {
          const float* phist = F.in[5] + ((size_t)(li * DB + b) * 15) * 512 + c0;
          for (int j = 1; j < 16; ++j) { if (j < win) { const int i = t - j;
                  if (i >= 0) { float zz[8]; unpack8f(*(const GAS v4u*)(ZP + (size_t)(m - j) * 512 + c0), zz);
#pragma unroll
                      for (int q = 0; q < 8; ++q) ws8[q] += zz[q]; }
                  else if (samp) { const float* hp = phist + (size_t)(15 + i) * 512;
#pragma unroll
                      for (int q = 0; q < 8; ++q) ws8[q] += hp[q]; } } }
          }
          const int cnt = min(t + 1 + (samp ? 15 : 0), win); const float rc = 1.0f / (float)cnt;
          float dv[8];
#pragma unroll
          for (int i = 0; i < 8; ++i) dv[i] = ws8[i] * rc - zc[i];
          *(GAS v4u*)(A2 + (size_t)m * KBR + 1536 + c0) = pack8f(dv);
          if (t >= T - 15) { float* dst = samp ? F.out + O_PS + ((size_t)(li * DB + b) * 15 + (t - (T - 15))) * 512 + c0 : F.out + O_PP + ((size_t)(li * 2 + b) * 15 + (t - (T - 15))) * 512 + c0;
              *(GAS f32x4*)dst = (f32x4){zc[0], zc[1], zc[2], zc[3]}; *(GAS f32x4*)(dst + 4) = (f32x4){zc[4], zc[5], zc[6], zc[7]}; } }
    }
}
typedef float f32x16 __attribute__((ext_vector_type(16)));
__device__ __forceinline__ bf16x8 cvt8(const f32x4 a, const f32x4 b) { v4u w; w.x = pk2(a.x, a.y); w.y = pk2(a.z, a.w); w.z = pk2(b.x, b.y); w.w = pk2(b.z, b.w); return __builtin_bit_cast(bf16x8, w); }
__device__ __forceinline__ int crow16(int r, int hi) { return (r & 3) + 8 * (r >> 2) + 4 * hi; }
__device__ __forceinline__ void sattn_unit(Frame& F, int li, int b, int head) {
    const int lane = lane_now(), wid = F.wave, r32 = lane & 31, hi = lane >> 5;
    LAS float* Lmx = (LAS float*)(F.lds + LDSCTL_OFF + 1024);
    LAS float* Lsum = (LAS float*)(F.lds + LDSCTL_OFF + 3072);
    const bf16* Qs = wsb(F, WS_Q) + (size_t)(MP + b * DSEQ) * D;
    const float* kc = F.in[2] + ((size_t)(li * DB + b) * PAST) * D; const float* vc = F.in[3] + ((size_t)(li * DB + b) * PAST) * D;
    const float* kn = F.out + O_KS + ((size_t)li * MS + b * DSEQ) * D; const float* vn = F.out + O_VS + ((size_t)li * MS + b * DSEQ) * D;
    bf16x8 qr[2][4];
#pragma unroll
    for (int mm = 0; mm < 2; ++mm)
#pragma unroll
        for (int d0 = 0; d0 < 4; ++d0) qr[mm][d0] = *(const GAS bf16x8*)(Qs + (size_t)r32 * D + (2 * head + mm) * 64 + d0 * 16 + hi * 8);
    const int nblk = (wid == 0) ? 5 : 4;
    f32x16 o[2][4];
#pragma unroll
    for (int mm = 0; mm < 2; ++mm)
#pragma unroll
        for (int eb = 0; eb < 4; ++eb) o[mm][eb] = (f32x16){};
    float lsum[2] = {0.f, 0.f}, mrun[2] = {-1e30f, -1e30f};
    for (int i = 0; i < nblk; ++i) { const int blk = (i < 4) ? wid + 8 * i : 32; const float* kb = (blk < 32) ? kc + (size_t)(blk * 32) * D : kn; const float* vb = (blk < 32) ? vc + (size_t)(blk * 32) * D : vn;
        f32x16 s[2];
#pragma unroll
        for (int mm = 0; mm < 2; ++mm) { s[mm] = (f32x16){};
#pragma unroll
            for (int d0 = 0; d0 < 4; ++d0) { const float* kp = kb + (size_t)r32 * D + (2 * head + mm) * 64 + d0 * 16 + hi * 8; const bf16x8 kf = cvt8(*(const GAS f32x4*)kp, *(const GAS f32x4*)(kp + 4));
                s[mm] = __builtin_amdgcn_mfma_f32_32x32x16_bf16(kf, qr[mm][d0], s[mm], 0, 0, 0); } }
        bf16x8 pf[2][2];
#pragma unroll
        for (int mm = 0; mm < 2; ++mm) {
            float mloc = s[mm][0];
#pragma unroll
            for (int r = 1; r < 16; ++r) mloc = fmaxf(mloc, s[mm][r]);
            mloc = fmaxf(mloc, __shfl_xor(mloc, 32));
            const float mnew = fmaxf(mrun[mm], mloc), sc = __builtin_amdgcn_exp2f(mrun[mm] - mnew); mrun[mm] = mnew;
            lsum[mm] *= sc;
#pragma unroll
            for (int eb = 0; eb < 4; ++eb)
#pragma unroll
                for (int r = 0; r < 16; ++r) o[mm][eb][r] *= sc;
            float acc = 0.f;
#pragma unroll
            for (int r = 0; r < 16; ++r) { s[mm][r] = __builtin_amdgcn_exp2f(s[mm][r] - mnew); acc += s[mm][r]; }
            lsum[mm] += acc;
#pragma unroll
            for (int k2 = 0; k2 < 2; ++k2) pf[mm][k2] = cvt8((f32x4){s[mm][8 * k2], s[mm][8 * k2 + 1], s[mm][8 * k2 + 2], s[mm][8 * k2 + 3]}, (f32x4){s[mm][8 * k2 + 4], s[mm][8 * k2 + 5], s[mm][8 * k2 + 6], s[mm][8 * k2 + 7]}); }
#pragma unroll
        for (int eb = 0; eb < 4; ++eb)
#pragma unroll
            for (int k2 = 0; k2 < 2; ++k2) { const float* vp = vb + (size_t)(16 * k2 + 4 * hi) * D + head * 128 + eb * 32 + r32;
                const f32x4 va = {vp[0], vp[D], vp[2 * D], vp[3 * D]}, vb4 = {vp[8 * D], vp[9 * D], vp[10 * D], vp[11 * D]}; const bf16x8 vf = cvt8(va, vb4);
                o[0][eb] = __builtin_amdgcn_mfma_f32_32x32x16_bf16(vf, pf[0][k2], o[0][eb], 0, 0, 0); o[1][eb] = __builtin_amdgcn_mfma_f32_32x32x16_bf16(vf, pf[1][k2], o[1][eb], 0, 0, 0); } }
#pragma unroll
    for (int mm = 0; mm < 2; ++mm) { lsum[mm] += __shfl_xor(lsum[mm], 32); if (hi == 0) { Lmx[(mm * 8 + wid) * 32 + r32] = mrun[mm]; Lsum[(mm * 8 + wid) * 32 + r32] = lsum[mm]; } }
    __syncthreads();
#pragma unroll
    for (int mm = 0; mm < 2; ++mm) { float M = Lmx[(mm * 8) * 32 + r32];
#pragma unroll
        for (int w = 1; w < 8; ++w) M = fmaxf(M, Lmx[(mm * 8 + w) * 32 + r32]);
        const float f = __builtin_amdgcn_exp2f(mrun[mm] - M);
#pragma unroll
        for (int eb = 0; eb < 4; ++eb)
#pragma unroll
            for (int r = 0; r < 16; ++r) o[mm][eb][r] *= f; }
    LAS float* Lw = (LAS float*)(F.lds + RING_OFF) + wid * 4096;
#pragma unroll
    for (int mm = 0; mm < 2; ++mm) {
        __syncthreads();
#pragma unroll
        for (int eb = 0; eb < 4; ++eb)
#pragma unroll
            for (int r = 0; r < 16; ++r) Lw[(eb * 32 + crow16(r, hi)) * 32 + r32] = o[mm][eb][r];
        __syncthreads();
        { const int q = lane & 31, e0 = (wid * 2 + (lane >> 5)) * 8; float L = 0.f;
          float Mq = Lmx[(mm * 8) * 32 + q];
#pragma unroll
          for (int w = 1; w < 8; ++w) Mq = fmaxf(Mq, Lmx[(mm * 8 + w) * 32 + q]);
#pragma unroll
          for (int w = 0; w < 8; ++w) L += Lsum[(mm * 8 + w) * 32 + q] * __builtin_amdgcn_exp2f(Lmx[(mm * 8 + w) * 32 + q] - Mq);
          const float inv = 1.0f / L; float v[8];
#pragma unroll
          for (int i = 0; i < 8; ++i) { float a = 0.f;
#pragma unroll
              for (int w = 0; w < 8; ++w) a += ((LAS float*)(F.lds + RING_OFF))[w * 4096 + (e0 + i) * 32 + q];
              v[i] = a * inv; }
          bf16* orow = wsb(F, WS_O) + (size_t)(MP + b * DSEQ + q) * 2048 + (2 * head + mm) * 128 + e0; *(GAS v4u*)orow = pack8f(v); }
    }
    __syncthreads();
}
#ifndef KEEP_UP
#define KEEP_UP 1
#endif
#ifndef KEEP_DOWN
#define KEEP_DOWN 1
#endif
#ifndef KEEP_N1
#define KEEP_N1 1
#endif
#ifndef KEEP_WIN
#define KEEP_WIN 1
#endif
#ifndef KEEP_ATT
#define KEEP_ATT 1
#endif
#ifndef KEEP_E2
#define KEEP_E2 1
#endif
#ifndef KEEP_BR
#define KEEP_BR 1
#endif
#ifndef KEEP_WOUT
#define KEEP_WOUT 1
#endif
#ifndef KEEP_N3
#define KEEP_N3 1
#endif
#ifndef KEEP_PG
#define KEEP_PG 1
#endif
#ifndef KEEP_N5
#define KEEP_N5 1
#endif
#ifndef KEEP_PRO
#define KEEP_PRO 1
#endif
struct Args { const float* in[21]; float* out; unsigned char* ws; int ph_lo, ph_hi; };
#if !MK_PER_PHASE
#define GRID_BAR() do { for (int rb_ = 0; rb_ < REP_BAR; ++rb_) xcd_barrier(bar); } while (0)
#else
#define GRID_BAR() do { if (F.wave == 0 && lane_now() == 0) __hip_atomic_store(F.ctl + CW_TMO, 0xBADBA0u, RLX_AGENT); } while (0)
#endif
#define IN(k) (lo <= (k) && (k) < hi)
#define SEAM(k) do { if (IN(k) && IN((k) + 1)) GRID_BAR(); } while (0)
__device__ __forceinline__ unsigned long long uni64_opaque(unsigned long long v) { unsigned lo = __builtin_amdgcn_readfirstlane((unsigned)v), hi = __builtin_amdgcn_readfirstlane((unsigned)(v >> 32)); asm volatile("" : "+s"(lo), "+s"(hi)); return ((unsigned long long)hi << 32) | lo; }
#define FRESH() do { F.ws = (unsigned char*)(GAS unsigned char*)uni64_opaque((unsigned long long)F.ws); F.out = (float*)(GAS float*)uni64_opaque((unsigned long long)F.out); } while (0)
#define RING (F.lds + RING_OFF)
constexpr int NSG = 64, NPG = 192;
constexpr int CW_GRP = 8192, CW_GRP_TMO = 8256;
constexpr int LB_PER_LAYER = 9;
__device__ __forceinline__ void group_barrier1(Frame& F, const unsigned n) {
    asm volatile("s_waitcnt vmcnt(0)" ::: "memory");
    __syncthreads();
    if (F.wave == 0 && lane_now() == 0) {
        __builtin_amdgcn_s_waitcnt(0);
        __builtin_amdgcn_fence(__ATOMIC_RELEASE, "agent");
        asm volatile("s_waitcnt vmcnt(0)" ::: "memory");
        gu32* c = F.ctl + CW_GRP; const unsigned target = (unsigned)NSG * (n + 1u);
        (void)__hip_atomic_fetch_add(c, 1u, RLX_AGENT);
        unsigned sp = 0u;
        while (__hip_atomic_load(c, RLX_AGENT) < target) { __builtin_amdgcn_s_sleep(1);
            if ((++sp & 255u) == 0u) { if (__hip_atomic_load(F.ctl + CW_GRP_TMO, RLX_AGENT)) break; if (sp > (1u << 20)) { __hip_atomic_store(F.ctl + CW_GRP_TMO, 1u, RLX_AGENT); break; } } }
        __builtin_amdgcn_fence(__ATOMIC_ACQUIRE, "agent");
        asm volatile("s_waitcnt vmcnt(0)" ::: "memory");
    }
    __syncthreads();
}
__device__ __forceinline__ void group_barrier(Frame& F) { for (unsigned r = 0; r < REP_LB; ++r) group_barrier1(F, F.lbn++); }
#define OPAQUE_K(name, val) int name = (val); asm volatile("" : "+s"(name))
#define SAMPLE (F.sidx >= 0)
template <int LI, int HALF> __device__ __forceinline__ void ffn_part(Frame& F, const XcdBarrier& bar, const int lo, const int hi) {
    constexpr int pb = 1 + LI * PH_PER_LAYER, p0 = pb + HALF * 9;
    if (KEEP_UP && IN(p0)) { FRESH(); pg8::Gemm g{wsb(F, WS_XN), wlayer(F, LI, HALF ? W_UP2 : W_UP1), MP, NUP, D}; pg8::StaticOrder S; S.init(MP, NUP, F.G, (int)blockIdx.x);
        pg8::EpiSwiGLU E{wsb(F, WS_HFF), DFF};
        for (int rep = 0; rep < REP_GEMM; ++rep) { if (rep && REP_GEMM_BAR) GRID_BAR(); pg8::gemm_phase<pg8::EpiSwiGLU, pg8::StaticOrder, true, true>(RING, g, S, E, F.wave); } SEAM(p0); }
    if (KEEP_DOWN && IN(p0 + 1)) { FRESH(); { pg8::Gemm g{wsb(F, WS_HFF), wlayer(F, LI, HALF ? W_DN2 : W_DN1), MP, D, DFF}; pg8::StaticOrder S; S.init(MP, D, F.G, (int)blockIdx.x);
        pg8::EpiBf E{wsb(F, WS_YB), D};
        for (int rep = 0; rep < REP_GEMM; ++rep) { if (rep && REP_GEMM_BAR) GRID_BAR(); pg8::gemm_phase<pg8::EpiBf, pg8::StaticOrder, true, true>(RING, g, S, E, F.wave); } } }
    if (KEEP_DOWN && IN(p0 + 1)) {
        if (HALF == 1) { FRESH(); OPAQUE_K(kple, PLE);
            pg8::Gemm g2{(const bf16*)(F.ws + WS_PB + (size_t)LI * PB_LAYER), wlayer(F, LI, W_PU), MP, D, kple}; pg8::StaticOrder S2; S2.init(MP, D, F.G, (int)blockIdx.x);
            pg8::EpiBf E2{wsb(F, WS_PU), D};
            for (int rep = 0; rep < REP_GEMM; ++rep) { if (rep && REP_GEMM_BAR) GRID_BAR(); pg8::gemm_phase<pg8::EpiBf, pg8::StaticOrder, true, true>(RING, g2, S2, E2, F.wave); } }
        SEAM(p0 + 1); }
    if (KEEP_N1 && IN(p0 + 2) && !SAMPLE) { FRESH(); const float* ng = F.in[8] + (size_t)LI * 8 * D; for (int rep = 0; rep < REP_ROW; ++rep) norm_phase(F, 0.5f, ng + (HALF ? 5 : 1) * D, ng + (HALF ? 6 : 2) * D, true, 0, MP, F.pidx * NWAVES + F.wave, NPG * NWAVES, rep + 1 < REP_ROW);
        if (HALF == 0 && LI + 1 < DEPTH) p0_layer(F, LI + 1 < DEPTH ? LI + 1 : LI, F.pidx * NWAVES + F.wave, NPG * NWAVES, 16); }
    if (KEEP_N1 && IN(p0 + 2) && SAMPLE && (HALF == 1 || LI == 0)) { FRESH(); OPAQUE_K(kd, D); pg8::Gemm g{wsb(F, WS_XN), wlayer(F, LI, HALF ? W_UP2 : W_UP1), M, NUP, kd}; pg8::SampleOrder S; S.init(NUP, NSG, F.sidx);
        pg8::EpiSwiGLU E{wsb(F, WS_HFF), DFF};
        for (int rs_ = 0; rs_ < REP_SG; ++rs_) pg8::gemm_phase<pg8::EpiSwiGLU, pg8::SampleOrder, true, true>(RING, g, S, E, F.wave); group_barrier(F); }
    if (KEEP_N1 && IN(p0 + 2) && SAMPLE) { FRESH(); OPAQUE_K(kf, DFF); pg8::Gemm g{wsb(F, WS_HFF), wlayer(F, LI, HALF ? W_DN2 : W_DN1), M, D, kf}; pg8::SampleSplitOrder S; S.init(D, NSG, F.sidx);
        pg8::EpiF32Slab E{(float*)(F.ws + WS_YS)};
        for (int rs_ = 0; rs_ < REP_SG; ++rs_) pg8::gemm_phase<pg8::EpiF32Slab, pg8::SampleSplitOrder, true, true>(RING, g, S, E, F.wave); }
    if (KEEP_N1 && IN(p0 + 2) && SAMPLE && HALF == 1) { FRESH(); OPAQUE_K(kple, PLE);
        pg8::Gemm g2{(const bf16*)(F.ws + WS_PB + (size_t)LI * PB_LAYER), wlayer(F, LI, W_PU), M, D, kple}; pg8::SampleOrder S2; S2.init(D, NSG, (F.sidx + NSG - 32) % NSG);
        pg8::EpiBf E2{wsb(F, WS_PU), D};
        for (int rs_ = 0; rs_ < REP_SG; ++rs_) pg8::gemm_phase<pg8::EpiBf, pg8::SampleOrder, true, true>(RING, g2, S2, E2, F.wave); }
    if (KEEP_N1 && IN(p0 + 2) && SAMPLE) { FRESH(); group_barrier(F); const float* ng = F.in[8] + (size_t)LI * 8 * D;
        norm_phase_sample(F, 0.5f, ng + (HALF ? 5 : 1) * D, ng + (HALF ? 6 : 2) * D, true, (const float*)(F.ws + WS_YS), 4); }
    if (KEEP_N1 && IN(p0 + 2) && SAMPLE && HALF == 0) { FRESH(); group_barrier(F); OPAQUE_K(kd, D); pg8::Gemm g{wsb(F, WS_XN), wlayer(F, LI, W_IN), M, NIN, kd}; pg8::SampleOrder S; S.init(NIN, NSG, F.sidx);
        pg8::EpiWin E{wsb(F, WS_Q), wsb(F, WS_K), wsb(F, WS_V), wsb(F, WS_BG), wsb(F, WS_C), wsb(F, WS_ZP), wsb(F, WS_GS), (const float*)(F.ws + WS_ROPEC), (const float*)(F.ws + WS_ROPES),
                      F.out + O_KP + (size_t)LI * MP * D, F.out + O_VP + (size_t)LI * MP * D, F.out + O_KS + (size_t)LI * MS * D, F.out + O_VS + (size_t)LI * MS * D};
        for (int rs_ = 0; rs_ < REP_SG; ++rs_) pg8::gemm_phase<pg8::EpiWin, pg8::SampleOrder, true, true>(RING, g, S, E, F.wave); }
    if (IN(p0 + 2)) SEAM(p0 + 2);
}
template <int LI> __device__ __forceinline__ void mixer_part(Frame& F, const XcdBarrier& bar, const int lo, const int hi) {
    constexpr int pb = 1 + LI * PH_PER_LAYER;
    if (KEEP_WIN && IN(pb + 3)) { FRESH(); pg8::Gemm g{wsb(F, WS_XN), wlayer(F, LI, W_IN), MP, NIN, D}; pg8::StaticOrder S; S.init(MP, NIN, F.G, (int)blockIdx.x);
        pg8::EpiWin E{wsb(F, WS_Q), wsb(F, WS_K), wsb(F, WS_V), wsb(F, WS_BG), wsb(F, WS_C), wsb(F, WS_ZP), wsb(F, WS_GS), (const float*)(F.ws + WS_ROPEC), (const float*)(F.ws + WS_ROPES),
                      F.out + O_KP + (size_t)LI * MP * D, F.out + O_VP + (size_t)LI * MP * D, F.out + O_KS + (size_t)LI * MS * D, F.out + O_VS + (size_t)LI * MS * D};
        for (int rep = 0; rep < REP_GEMM; ++rep) { if (rep && REP_GEMM_BAR) GRID_BAR(); pg8::gemm_phase<pg8::EpiWin, pg8::StaticOrder, true, true>(RING, g, S, E, F.wave); } SEAM(pb + 3); }
    if (KEEP_ATT && IN(pb + 4)) { FRESH();
        const attn_body::AttnTensors AT{(const attn_body::bf16*)wsb(F, WS_Q), (const attn_body::bf16*)wsb(F, WS_K), (const attn_body::bf16*)wsb(F, WS_V), (attn_body::bf16*)wsb(F, WS_O)};
        for (int rep = 0; rep < REP_ATT; ++rep)
        for (int v = F.vcu; v < 256; v += F.G) attn_body::attn_phase<8>((char*)RING, AT, v, F.wave);
        SEAM(pb + 4); }
    if (KEEP_E2 && IN(pb + 5) && !SAMPLE) { FRESH(); for (int rep = 0; rep < REP_E2; ++rep) e2_phase(F, LI, 0, MP, F.pidx * NWAVES + F.wave, NPG * NWAVES);
        if (LI + 1 < DEPTH) p0_layer(F, LI + 1 < DEPTH ? LI + 1 : LI, F.pidx * NWAVES + F.wave, NPG * NWAVES, 1); }
    if (KEEP_E2 && IN(pb + 5) && SAMPLE) { FRESH(); for (int rs_ = 0; rs_ < REP_SA; ++rs_) for (int su = F.sidx; su < DB * 8; su += NSG) sattn_unit(F, LI, su >> 3, su & 7); group_barrier(F); }
    if (KEEP_E2 && IN(pb + 5) && SAMPLE) { FRESH(); for (int rs_ = 0; rs_ < REP_SE2; ++rs_) e2_phase(F, LI, MP, M, F.sidx * NWAVES + F.wave, NSG * NWAVES); }
    if (IN(pb + 5)) SEAM(pb + 5);
    if (KEEP_BR && IN(pb + 6)) { FRESH(); pg8::Gemm g{wsb(F, WS_A2), wlayer(F, LI, W_BR), MP, D, KBR}; pg8::SegOrder S; S.init(MP, D, F.G, (int)blockIdx.x);
        pg8::EpiSeg E{wsb(F, WS_GS), (float*)(F.ws + WS_Y), wsb(F, WS_MG)};
        for (int rep = 0; rep < REP_GEMM; ++rep) { if (rep && REP_GEMM_BAR) GRID_BAR(); pg8::gemm_phase<pg8::EpiSeg, pg8::SegOrder, true, true>(RING, g, S, E, F.wave); } SEAM(pb + 6); }
    if (KEEP_WOUT && IN(pb + 7)) { FRESH(); pg8::Gemm g{wsb(F, WS_MG), wlayer(F, LI, W_OUT), MP, D, D}; pg8::StaticOrder S; S.init(MP, D, F.G, (int)blockIdx.x);
        pg8::EpiBf E{wsb(F, WS_YB), D};
        for (int rep = 0; rep < REP_GEMM; ++rep) { if (rep && REP_GEMM_BAR) GRID_BAR(); pg8::gemm_phase<pg8::EpiBf, pg8::StaticOrder, true, true>(RING, g, S, E, F.wave); } SEAM(pb + 7); }
    if (KEEP_N3 && IN(pb + 8) && !SAMPLE) { FRESH(); const float* ng = F.in[8] + (size_t)LI * 8 * D; for (int rep = 0; rep < REP_ROW; ++rep) norm_phase(F, 1.0f, ng + 3 * D, ng + 4 * D, true, 0, MP, F.pidx * NWAVES + F.wave, NPG * NWAVES, rep + 1 < REP_ROW);
        if (LI + 1 < DEPTH) p0_layer(F, LI + 1 < DEPTH ? LI + 1 : LI, F.pidx * NWAVES + F.wave, NPG * NWAVES, 4 | 8); }
    if (KEEP_N3 && IN(pb + 8) && SAMPLE) { FRESH(); pg8::Gemm g{wsb(F, WS_A2), wlayer(F, LI, W_BR), M, D, KBR}; pg8::SampleSegOrder S; S.init(D, NSG, F.sidx);
        pg8::EpiSeg E{wsb(F, WS_GS), (float*)(F.ws + WS_Y), wsb(F, WS_MG)};
        for (int rs_ = 0; rs_ < REP_SG; ++rs_) pg8::gemm_phase<pg8::EpiSeg, pg8::SampleSegOrder, true, true>(RING, g, S, E, F.wave); group_barrier(F); }
    if (KEEP_N3 && IN(pb + 8) && SAMPLE) { FRESH(); OPAQUE_K(kd, D); pg8::Gemm g{wsb(F, WS_MG), wlayer(F, LI, W_OUT), M, D, kd}; pg8::SampleOrder S; S.init(D, NSG, F.sidx);
        pg8::EpiBf E{wsb(F, WS_YB), D};
        for (int rs_ = 0; rs_ < REP_SG; ++rs_) pg8::gemm_phase<pg8::EpiBf, pg8::SampleOrder, true, true>(RING, g, S, E, F.wave); group_barrier(F); }
    if (KEEP_N3 && IN(pb + 8) && SAMPLE) { FRESH(); const float* ng = F.in[8] + (size_t)LI * 8 * D; norm_phase_sample(F, 1.0f, ng + 3 * D, ng + 4 * D, true, nullptr, 0); }
    if (IN(pb + 8)) SEAM(pb + 8);
}
template <int LI> __device__ __forceinline__ void ple_part(Frame& F, const XcdBarrier& bar, const int lo, const int hi) {
    constexpr int pb = 1 + LI * PH_PER_LAYER;
    if (KEEP_PG && IN(pb + 12)) { FRESH(); pg8::Gemm g{wsb(F, WS_XN), wlayer(F, LI, W_PG), MP, D, D}; pg8::StaticOrder S; S.init(MP, D, F.G, (int)blockIdx.x);
        pg8::EpiPle E{wsb(F, WS_YB), wsb(F, WS_PU), D};
        for (int rep = 0; rep < REP_GEMM; ++rep) { if (rep && REP_GEMM_BAR) GRID_BAR(); pg8::gemm_phase<pg8::EpiPle, pg8::StaticOrder, true, true>(RING, g, S, E, F.wave); } SEAM(pb + 12); }
    if (KEEP_N5 && IN(pb + 13) && !SAMPLE) { FRESH(); const float* ng = F.in[8] + (size_t)LI * 8 * D; for (int rep = 0; rep < REP_ROW; ++rep) norm_phase(F, 1.0f, ng + 7 * D, ng + 8 * D, LI + 1 < DEPTH, 0, MP, F.pidx * NWAVES + F.wave, NPG * NWAVES, rep + 1 < REP_ROW, LI + 1 == DEPTH);
        if (LI + 1 < DEPTH) p0_layer(F, LI + 1 < DEPTH ? LI + 1 : LI, F.pidx * NWAVES + F.wave, NPG * NWAVES, 2); }
    if (KEEP_N5 && IN(pb + 13) && SAMPLE) { FRESH(); OPAQUE_K(kd, D); pg8::Gemm g{wsb(F, WS_XN), wlayer(F, LI, W_PG), M, D, kd}; pg8::SampleOrder S; S.init(D, NSG, F.sidx);
        pg8::EpiPle E{wsb(F, WS_YB), wsb(F, WS_PU), D};
        for (int rs_ = 0; rs_ < REP_SG; ++rs_) pg8::gemm_phase<pg8::EpiPle, pg8::SampleOrder, true, true>(RING, g, S, E, F.wave); group_barrier(F); }
    if (KEEP_N5 && IN(pb + 13) && SAMPLE) { FRESH(); const float* ng = F.in[8] + (size_t)LI * 8 * D; norm_phase_sample(F, 1.0f, ng + 7 * D, ng + 8 * D, LI + 1 < DEPTH, nullptr, 0, LI + 1 == DEPTH); }
    if (KEEP_N5 && IN(pb + 13) && SAMPLE && LI + 1 < DEPTH) { FRESH(); group_barrier(F); OPAQUE_K(kd, D); pg8::Gemm g{wsb(F, WS_XN), wlayer(F, LI + 1 < DEPTH ? LI + 1 : LI, W_UP1), M, NUP, kd}; pg8::SampleOrder S; S.init(NUP, NSG, F.sidx);
        pg8::EpiSwiGLU E{wsb(F, WS_HFF), DFF};
        for (int rs_ = 0; rs_ < REP_SG; ++rs_) pg8::gemm_phase<pg8::EpiSwiGLU, pg8::SampleOrder, true, true>(RING, g, S, E, F.wave); }
    if (IN(pb + 13)) SEAM(pb + 13);
}
template <int LI> __device__ __forceinline__ void layer_part(Frame& F, const XcdBarrier& bar, const int lo, const int hi) {
    ffn_part<LI, 0>(F, bar, lo, hi); mixer_part<LI>(F, bar, lo, hi); ffn_part<LI, 1>(F, bar, lo, hi); ple_part<LI>(F, bar, lo, hi);
}
__global__ void __launch_bounds__(NWAVES * 64, 2) enc_fwd(Args args) {
    extern __shared__ __attribute__((aligned(16))) unsigned char lds[];
    Frame F;
    F.lds = (LAS unsigned char*)lds;
    F.MISC = (volatile LAS unsigned*)(F.lds + MISC_OFF);
    F.wave = __builtin_amdgcn_readfirstlane(threadIdx.x >> 6);
    F.G = gridDim.x; { const int bx = blockIdx.x; F.vcu = (F.G % 8 == 0) ? (bx % 8) * (F.G / 8) + bx / 8 : bx; }
    { const int w = F.vcu & 31, x = F.vcu >> 5; F.sidx = (w < 8) ? x * 8 + w : -1; F.pidx = (w >= 8) ? x * 24 + (w - 8) : -1; } F.lbn = 0u;
#pragma unroll
    for (int i = 0; i < 21; ++i) F.in[i] = args.in[i];
    F.out = args.out; F.ws = args.ws;
    F.ctl = (gu32*)(F.ws + WS_CTL);
    for (int u = threadIdx.x; u < (LDS_BYTES - LDSCTL_OFF) / 4; u += NWAVES * 64) ((LAS unsigned*)(F.lds + LDSCTL_OFF))[u] = 0u;
    __syncthreads();
    XcdBarrier bar; bar.wave = F.wave; bar.bar = (unsigned*)(F.ctl + CW_BAR); bar.x = 0; bar.st = nullptr;
#if !MK_PER_PHASE
    bar = xcd_barrier_post((unsigned*)(F.ctl + CW_BAR), F.MISC + 8);
#endif
    const int lo = args.ph_lo, hi = args.ph_hi;
    if (KEEP_PRO && IN(0)) { FRESH(); for (int rep = 0; rep < REP_PRO; ++rep) p0_prologue(F); SEAM(0); }
    layer_part<0>(F, bar, lo, hi); layer_part<1>(F, bar, lo, hi); layer_part<2>(F, bar, lo, hi); layer_part<3>(F, bar, lo, hi);
}
#undef IN
#undef SEAM
#undef FRESH
#undef RING
#undef SAMPLE

#ifndef DBG_DUMP
#define DBG_DUMP 0
#endif
#if DBG_DUMP
__global__ void dbg_dump_bf16(const unsigned short* src, float* dst, size_t n) { size_t i = (size_t)blockIdx.x * blockDim.x + threadIdx.x; const size_t st = (size_t)gridDim.x * blockDim.x; for (; i < n; i += st) dst[i] = __uint_as_float((unsigned)src[i] << 16); }
#endif
#ifndef PH_STOP
#define PH_STOP 1000
#endif
extern "C" void kernel_launch(void* const* d_in, const int* in_sizes, int n_in, void* d_out, int out_size, void* d_ws, size_t ws_size, hipStream_t stream) {
    static int grid = 0;
    if (grid == 0) {
        if (n_in != 21 || (size_t)(unsigned)out_size != O_END || ws_size < WS_TOP) { fprintf(stderr, "kernel_launch: unexpected shapes (n_in %d, out %d, ws %zu); nothing launched\n", n_in, out_size, ws_size); grid = -1; return; }
        int dev = 0, cus = 0, per_cu = 0;
        if (hipGetDevice(&dev) != hipSuccess || hipDeviceGetAttribute(&cus, hipDeviceAttributeMultiprocessorCount, dev) != hipSuccess) { grid = -1; return; }
        if (hipFuncSetAttribute((const void*)enc_fwd, hipFuncAttributeMaxDynamicSharedMemorySize, LDS_BYTES) != hipSuccess) { fprintf(stderr, "kernel_launch: hipFuncSetAttribute failed\n"); grid = -1; return; }
        if (hipOccupancyMaxActiveBlocksPerMultiprocessor(&per_cu, (const void*)enc_fwd, NWAVES * 64, LDS_BYTES) != hipSuccess || per_cu < 1)
            fprintf(stderr, "kernel_launch: note: occupancy query reports %d workgroups per CU\n", per_cu);
        (void)hipGetLastError();
        grid = cus;
    }
    if (grid < 0) return;
    if (hipMemsetAsync((char*)d_ws + WS_CTL, 0, CTL_ZERO_BYTES, stream) != hipSuccess) return;
    Args a{};
    for (int i = 0; i < 21; ++i) a.in[i] = (const float*)d_in[i];
    a.out = (float*)d_out; a.ws = (unsigned char*)d_ws;
#if MK_PER_PHASE
    for (int ph = 0; ph < (NPH < PH_STOP ? NPH : PH_STOP); ++ph) { a.ph_lo = ph; a.ph_hi = ph + 1; hipLaunchKernelGGL(enc_fwd, dim3(grid), dim3(NWAVES * 64), LDS_BYTES, stream, a); }
#if DBG_DUMP
    { const unsigned char* ws = (const unsigned char*)d_ws; float* out = (float*)d_out;
      if (DBG_DUMP & 1) { hipLaunchKernelGGL(dbg_dump_bf16, dim3(2048), dim3(256), 0, stream, (const unsigned short*)(ws + WS_O), out + O_KP + (size_t)1 * MP * D, (size_t)MP * 2048);
                          hipLaunchKernelGGL(dbg_dump_bf16, dim3(256), dim3(256), 0, stream, (const unsigned short*)(ws + WS_O) + (size_t)MP * 2048, out + O_KS + (size_t)1 * MS * D, (size_t)MS * 2048); }
      if (DBG_DUMP & 2) { hipLaunchKernelGGL(dbg_dump_bf16, dim3(2048), dim3(256), 0, stream, (const unsigned short*)(ws + WS_A2), out + O_VP + (size_t)1 * MP * D, (size_t)MP * 2048);
                          hipLaunchKernelGGL(dbg_dump_bf16, dim3(256), dim3(256), 0, stream, (const unsigned short*)(ws + WS_A2) + (size_t)MP * 2048, out + O_VS + (size_t)1 * MS * D, (size_t)MS * 2048); }
      if (DBG_DUMP & 8) { hipLaunchKernelGGL(dbg_dump_bf16, dim3(2048), dim3(256), 0, stream, (const unsigned short*)(ws + WS_GS), out + O_KP + (size_t)1 * MP * D, (size_t)MP * 3072); }
      if (DBG_DUMP & 16) { hipLaunchKernelGGL(dbg_dump_bf16, dim3(2048), dim3(256), 0, stream, (const unsigned short*)(ws + WS_W + W_BR), out + O_VP + (size_t)1 * MP * D, (size_t)1024 * 2048); }
      if (DBG_DUMP & 4) { hipLaunchKernelGGL(dbg_dump_bf16, dim3(2048), dim3(256), 0, stream, (const unsigned short*)(ws + WS_MG), out + O_KP + (size_t)3 * MP * D, (size_t)MP * 1024);
                          hipLaunchKernelGGL(dbg_dump_bf16, dim3(256), dim3(256), 0, stream, (const unsigned short*)(ws + WS_MG) + (size_t)MP * 1024, out + O_KS + (size_t)3 * MS * D, (size_t)MS * 1024); } }
#endif
#else
    a.ph_lo = 0; a.ph_hi = (NPH < PH_STOP ? NPH : PH_STOP);
    hipLaunchKernelGGL(enc_fwd, dim3(grid), dim3(NWAVES * 64), LDS_BYTES, stream, a);
#endif
}
```

```cpp
#include <hip/hip_runtime.h>
#include <cstdio>
#include <cstdint>

namespace pg8 {
#define PG8_LAS __attribute__((address_space(3)))
typedef unsigned short bf16_t;
typedef short bf16x8 __attribute__((ext_vector_type(8)));
typedef float f32x4 __attribute__((ext_vector_type(4)));
typedef unsigned u32x4 __attribute__((ext_vector_type(4)));
constexpr int BM = 256, BK = 64, HALF = 128, HTB = HALF * BK * 2  , STAGE_BYTES = 8 * HTB, NXCD = 8, WGM = 8;

__host__ __device__ __forceinline__ int lds_byte(int r, int c) { const int st = (r >> 4) * 2 + (c >> 5), rr = r & 15, cc = c & 31, ob = rr * 64 + cc * 2; return st * 1024 + (ob ^ (((ob >> 9) & 1) << 5)); }
__host__ __device__ __forceinline__ void stage_rc(int b, int& R, int& C) { const int st = b / 1024, sb = b % 1024, swz = sb ^ (((sb >> 9) & 1) << 5); R = (st >> 1) * 16 + swz / 64; C = (st & 1) * 32 + (swz % 64) / 2; }
__host__ __device__ __forceinline__ int perm32(int rho) { const int n = rho >> 4, i = rho & 15; return 8 * (i >> 2) + 4 * n + (i & 3); }

struct Unit { int pm, pn, seg; };
constexpr int MPROMPT_TILES = 128;
struct Gemm { const bf16_t* A; const bf16_t* Bt; int M, N, K; };

struct StaticOrder {
    int nM, nN, nwg, G, c;
    __host__ __device__ void init(int M, int N, int G_, int c_) { nM = M / BM; nN = N / BM; nwg = nM * nN; G = G_; c = c_; }
    __host__ __device__ bool next(int i, Unit& u) const {
        const long L = (long)i * G + c; if (L >= nwg) return false;
        int wgid = (int)L; { const int q = nwg / NXCD, r = nwg % NXCD, xcd = wgid % NXCD, off = wgid / NXCD; wgid = (xcd < r ? xcd * (q + 1) : r * (q + 1) + (xcd - r) * q) + off; }
        const int nig = WGM * nN, gid = wgid / nig, fm = gid * WGM, gsz = (nM - fm) < WGM ? (nM - fm) : WGM;
        u.pm = fm + ((wgid % nig) % gsz); u.pn = (wgid % nig) / gsz; u.seg = 0; return true;
    }
    __device__ __forceinline__ size_t koff_bytes(const Unit&) const { return 0; }
    __device__ __forceinline__ int ntiles(const Unit&, int K) const { return K / BK; }
    __device__ __forceinline__ void a_ready(const Unit&) const {}
    __device__ __forceinline__ void done(const Unit&) const {}
};
struct SampleOrder {
    int nN, G, c;
    __host__ __device__ void init(int N, int G_, int c_) { nN = N / BM; G = G_; c = c_; }
    __host__ __device__ bool next(int i, Unit& u) const { const int L = i * G + c; if (L >= 2 * nN) return false; u.pm = MPROMPT_TILES + L / nN; u.pn = L % nN; u.seg = 0; return true; }
    __device__ __forceinline__ size_t koff_bytes(const Unit&) const { return 0; }
    __device__ __forceinline__ int ntiles(const Unit&, int K) const { return K / BK; }
    __device__ __forceinline__ void a_ready(const Unit&) const {}
    __device__ __forceinline__ void done(const Unit&) const {}
};
struct SampleSplitOrder : SampleOrder {
    __host__ __device__ bool next(int i, Unit& u) const { const int L = i * G + c; if (L >= 32) return false; const int tile = L >> 2; u.pm = MPROMPT_TILES + (tile >> 2); u.pn = tile & 3; u.seg = L & 3; return true; }
    __device__ __forceinline__ size_t koff_bytes(const Unit& u) const { return (size_t)(u.seg == 0 ? 0 : (u.seg == 1 ? 12 : (u.seg == 2 ? 24 : 34))) * BK * 2; }
    __device__ __forceinline__ int ntiles(const Unit& u, int) const { return u.seg < 2 ? 12 : 10; }
};
struct SampleSegOrder : SampleOrder {
    __host__ __device__ bool next(int i, Unit& u) const { const int r = i / 3; if (!SampleOrder::next(r, u)) return false; u.seg = i - 3 * r; return true; }
    __device__ __forceinline__ size_t koff_bytes(const Unit& u) const { return u.seg == 0 ? 0 : (u.seg == 1 ? 2048 : 3072); }
    __device__ __forceinline__ int ntiles(const Unit& u, int) const { return u.seg == 0 ? 16 : 8; }
};
struct SegOrder : StaticOrder {
    __host__ __device__ bool next(int i, Unit& u) const { const int r = i / 3; if (!StaticOrder::next(r, u)) return false; u.seg = i - 3 * r; return true; }
    __device__ __forceinline__ size_t koff_bytes(const Unit& u) const { return u.seg == 0 ? 0 : (u.seg == 1 ? 2048 : 3072); }
    __device__ __forceinline__ int ntiles(const Unit& u, int) const { return u.seg == 0 ? 16 : 8; }
};

typedef float cvt_f32x2_t __attribute__((ext_vector_type(2))); typedef __bf16 cvt_bf16x2_t __attribute__((ext_vector_type(2)));
__device__ __forceinline__ unsigned cvt_pk_bf16(float lo, float hi) { const cvt_f32x2_t v = {lo, hi}; const cvt_bf16x2_t b = __builtin_convertvector(v, cvt_bf16x2_t); return __builtin_bit_cast(unsigned, b); }
typedef float f32x2 __attribute__((ext_vector_type(2)));
constexpr int MPROMPT = 32768;
constexpr float QSCALE = 0.125f * 1.4426950408889634f;
__device__ __forceinline__ float sigm(float x) { return __builtin_amdgcn_rcpf(1.0f + __builtin_amdgcn_exp2f(-1.4426950408889634f * x)); }
__device__ __forceinline__ u32x4 pack8(const f32x4 a, const f32x4 b) { u32x4 w; w.x = cvt_pk_bf16(a[0], a[1]); w.y = cvt_pk_bf16(a[2], a[3]); w.z = cvt_pk_bf16(b[0], b[1]); w.w = cvt_pk_bf16(b[2], b[3]); return w; }
__device__ __forceinline__ void unpack8(const u32x4 w, f32x4& a, f32x4& b) {
    a[0] = __uint_as_float(w.x << 16); a[1] = __uint_as_float(w.x & 0xffff0000u); a[2] = __uint_as_float(w.y << 16); a[3] = __uint_as_float(w.y & 0xffff0000u);
    b[0] = __uint_as_float(w.z << 16); b[1] = __uint_as_float(w.z & 0xffff0000u); b[2] = __uint_as_float(w.w << 16); b[3] = __uint_as_float(w.w & 0xffff0000u); }

struct EpiSwiGLU {
    static constexpr bool PERM = true, AFTER_DRAIN = false;
    bf16_t* O; int ldc;
    __device__ __forceinline__ void operator()(const f32x4 (&acc)[2][2][4][2], const Unit& u, int wr, int wc, int fr, int fq) const {
        const int row0 = u.pm * BM + wr * 64 + fr, col0 = u.pn * HALF + wc * 32 + 8 * fq;
#pragma unroll
        for (int ai = 0; ai < 2; ++ai)
#pragma unroll
            for (int m = 0; m < 4; ++m) { bf16_t* p = O + (size_t)(row0 + ai * HALF + m * 16) * ldc + col0; f32x4 h[2];
#pragma unroll
                for (int n = 0; n < 2; ++n)
#pragma unroll
                    for (int j = 0; j < 4; ++j) { const float g = acc[ai][0][m][n][j]; h[n][j] = g * sigm(g) * acc[ai][1][m][n][j]; }
                *(u32x4*)p = pack8(h[0], h[1]); }
    }
};
struct EpiF32 {
    static constexpr bool PERM = false, AFTER_DRAIN = false;
    float* Y; int ldc;
    __device__ __forceinline__ void operator()(const f32x4 (&acc)[2][2][4][2], const Unit& u, int wr, int wc, int fr, int fq) const {
        float* yb = Y + (size_t)(u.pm * BM) * ldc + u.pn * BM;
        int lrow = wr * 64 + fr, lcol = wc * 32 + 4 * fq; asm volatile("" : "+v"(lrow), "+v"(lcol));
#pragma unroll
        for (int ai = 0; ai < 2; ++ai)
#pragma unroll
            for (int m = 0; m < 4; ++m) { const int o = (lrow + ai * HALF + m * 16) * ldc + lcol;
#pragma unroll
                for (int bj = 0; bj < 2; ++bj)
#pragma unroll
                    for (int n = 0; n < 2; ++n) *(f32x4*)(yb + o + bj * HALF + n * 16) = acc[ai][bj][m][n]; }
    }
};
struct EpiF32Slab {
    static constexpr bool PERM = false, AFTER_DRAIN = false;
    float* YS;
    __device__ __forceinline__ void operator()(const f32x4 (&acc)[2][2][4][2], const Unit& u, int wr, int wc, int fr, int fq) const {
        float* yb = YS + (size_t)u.seg * 512 * 1024 + (size_t)((u.pm - MPROMPT_TILES) * BM) * 1024 + u.pn * BM;
        int lrow = wr * 64 + fr, lcol = wc * 32 + 4 * fq; asm volatile("" : "+v"(lrow), "+v"(lcol));
#pragma unroll
        for (int ai = 0; ai < 2; ++ai)
#pragma unroll
            for (int m = 0; m < 4; ++m) { const int o = (lrow + ai * HALF + m * 16) * 1024 + lcol;
#pragma unroll
                for (int bj = 0; bj < 2; ++bj)
#pragma unroll
                    for (int n = 0; n < 2; ++n) *(f32x4*)(yb + o + bj * HALF + n * 16) = acc[ai][bj][m][n]; }
    }
};
struct EpiPle {
    static constexpr bool PERM = true, AFTER_DRAIN = false;
    bf16_t* Y; const bf16_t* PU; int ldc;
    __device__ __forceinline__ void operator()(const f32x4 (&acc)[2][2][4][2], const Unit& u, int wr, int wc, int fr, int fq) const {
        const size_t tb = (size_t)(u.pm * BM) * ldc + u.pn * BM;
        int lrow = wr * 64 + fr, lcol = wc * 32 + 8 * fq; asm volatile("" : "+v"(lrow), "+v"(lcol));
#pragma unroll
        for (int ai = 0; ai < 2; ++ai)
#pragma unroll
            for (int m = 0; m < 4; ++m) { const int o = (lrow + ai * HALF + m * 16) * ldc + lcol;
#pragma unroll
                for (int bj = 0; bj < 2; ++bj) { const u32x4 w = *(const u32x4*)(PU + tb + o + bj * HALF); f32x4 p0, p1; unpack8(w, p0, p1); f32x4 o0, o1;
#pragma unroll
                    for (int j = 0; j < 4; ++j) { o0[j] = p0[j] * sigm(acc[ai][bj][m][0][j]); o1[j] = p1[j] * sigm(acc[ai][bj][m][1][j]); }
                    *(u32x4*)(Y + tb + o + bj * HALF) = pack8(o0, o1); } }
    }
};
struct EpiBf {
    static constexpr bool PERM = true, AFTER_DRAIN = false;
    bf16_t* O; int ldc;
    __device__ __forceinline__ void operator()(const f32x4 (&acc)[2][2][4][2], const Unit& u, int wr, int wc, int fr, int fq) const {
        bf16_t* ob = O + (size_t)(u.pm * BM) * ldc + u.pn * BM;
        int lrow = wr * 64 + fr, lcol = wc * 32 + 8 * fq; asm volatile("" : "+v"(lrow), "+v"(lcol));
#pragma unroll
        for (int ai = 0; ai < 2; ++ai)
#pragma unroll
            for (int m = 0; m < 4; ++m) { const int o = (lrow + ai * HALF + m * 16) * ldc + lcol;
#pragma unroll
                for (int bj = 0; bj < 2; ++bj) *(u32x4*)(ob + o + bj * HALF) = pack8(acc[ai][bj][m][0], acc[ai][bj][m][1]); }
    }
};
struct EpiSeg {
    static constexpr bool PERM = true, AFTER_DRAIN = false;
    const bf16_t* S; float* T; bf16_t* O;
    __device__ __forceinline__ void operator()(const f32x4 (&acc)[2][2][4][2], const Unit& u, int wr, int wc, int fr, int fq) const {
        const int seg = u.seg;
        const bf16_t* sb = S + (size_t)(u.pm * BM) * 3072 + u.pn * BM + seg * 1024; float* tb = T + (size_t)(u.pm * BM) * 1024 + u.pn * BM; bf16_t* ob = O + (size_t)(u.pm * BM) * 1024 + u.pn * BM;
        int lrow = wr * 64 + fr, lcol = wc * 32 + 8 * fq; asm volatile("" : "+v"(lrow), "+v"(lcol));
#pragma unroll
        for (int ai = 0; ai < 2; ++ai)
#pragma unroll
            for (int m = 0; m < 4; ++m) { const int r = lrow + ai * HALF + m * 16;
#pragma unroll
                for (int bj = 0; bj < 2; ++bj) { const u32x4 ws = *(const u32x4*)(sb + r * 3072 + lcol + bj * HALF); f32x4 s0, s1; unpack8(ws, s0, s1);
                    f32x4 o0 = acc[ai][bj][m][0] * s0, o1 = acc[ai][bj][m][1] * s1; float* tp = tb + r * 1024 + lcol + bj * HALF;
                    if (seg != 0) { o0 = o0 + *(const f32x4*)tp; o1 = o1 + *(const f32x4*)(tp + 4); }
                    if (seg != 2) { *(f32x4*)tp = o0; *(f32x4*)(tp + 4) = o1; }
                    else *(u32x4*)(ob + r * 1024 + lcol + bj * HALF) = pack8(o0, o1); } }
    }
};
struct EpiWin {
    static constexpr bool PERM = true, AFTER_DRAIN = false;
    bf16_t *Q, *K, *V, *BG, *C, *ZP, *GS; const float *ropec, *ropes; float *kp, *vp, *ks, *vs;
    __device__ __forceinline__ void operator()(const f32x4 (&acc)[2][2][4][2], const Unit& u, int wr, int wc, int fr, int fq) const {
        const int pn = u.pn; const bool samp = u.pm >= MPROMPT / BM; const int row0 = u.pm * BM + wr * 64 + fr;
        if (pn < 8) {
            const bool isq = pn < 4; const int map = (pn & 3) * 4 + wc; bf16_t* dst = isq ? Q : K; const float sc = isq ? QSCALE : 1.0f;
            float* ko = samp ? ks - (size_t)MPROMPT * 1024 : kp;
#pragma unroll
            for (int ai = 0; ai < 2; ++ai)
#pragma unroll
                for (int m = 0; m < 4; ++m) { const int row = row0 + ai * HALF + m * 16; const int pos = samp ? 1024 + ((row - MPROMPT) & 31) : (row & 16383);
                    const float* cp = ropec + (size_t)pos * 32 + 8 * fq; const float* sp = ropes + (size_t)pos * 32 + 8 * fq;
                    f32x4 o1[2], o2[2];
#pragma unroll
                    for (int n = 0; n < 2; ++n) { const f32x4 c = *(const f32x4*)(cp + 4 * n), s = *(const f32x4*)(sp + 4 * n), x1 = acc[ai][0][m][n], x2 = acc[ai][1][m][n]; o1[n] = x1 * c - x2 * s; o2[n] = x2 * c + x1 * s; }
                    const size_t off = (size_t)row * 1024 + map * 64 + 8 * fq;
                    if (!isq) { float* kf = ko + off; __builtin_nontemporal_store(o1[0], (f32x4*)kf); __builtin_nontemporal_store(o1[1], (f32x4*)(kf + 4)); __builtin_nontemporal_store(o2[0], (f32x4*)(kf + 32)); __builtin_nontemporal_store(o2[1], (f32x4*)(kf + 36)); }
                    *(u32x4*)(dst + off) = pack8(o1[0] * sc, o1[1] * sc); *(u32x4*)(dst + off + 32) = pack8(o2[0] * sc, o2[1] * sc); }
        } else if (pn < 12) {
            float* vo = samp ? vs - (size_t)MPROMPT * 1024 : vp; const int col0 = (pn - 8) * BM + wc * 32 + 8 * fq;
#pragma unroll
            for (int ai = 0; ai < 2; ++ai)
#pragma unroll
                for (int m = 0; m < 4; ++m) { const size_t off = (size_t)(row0 + ai * HALF + m * 16) * 1024 + col0;
#pragma unroll
                    for (int bj = 0; bj < 2; ++bj) { float* vf = vo + off + bj * HALF; __builtin_nontemporal_store(acc[ai][bj][m][0], (f32x4*)vf); __builtin_nontemporal_store(acc[ai][bj][m][1], (f32x4*)(vf + 4)); *(u32x4*)(V + off + bj * HALF) = pack8(acc[ai][bj][m][0], acc[ai][bj][m][1]); } }
        } else if (pn < 14 || (pn >= 18 && pn < 20)) {
            bf16_t* dst = pn < 14 ? BG : ZP; const int col0 = (pn < 14 ? pn - 12 : pn - 18) * BM + wc * 32 + 8 * fq;
#pragma unroll
            for (int ai = 0; ai < 2; ++ai)
#pragma unroll
                for (int m = 0; m < 4; ++m) { bf16_t* p = dst + (size_t)(row0 + ai * HALF + m * 16) * 512 + col0;
#pragma unroll
                    for (int bj = 0; bj < 2; ++bj) *(u32x4*)(p + bj * HALF) = pack8(acc[ai][bj][m][0], acc[ai][bj][m][1]); }
        } else if (pn < 18) {
            const int col0 = (pn - 14) * HALF + wc * 32 + 8 * fq;
#pragma unroll
            for (int ai = 0; ai < 2; ++ai)
#pragma unroll
                for (int m = 0; m < 4; ++m) *(u32x4*)(C + (size_t)(row0 + ai * HALF + m * 16) * 512 + col0) = pack8(acc[ai][0][m][0] * acc[ai][1][m][0], acc[ai][0][m][1] * acc[ai][1][m][1]);
        } else {
            const int col0 = (pn - 20) * BM + wc * 32 + 8 * fq;
#pragma unroll
            for (int ai = 0; ai < 2; ++ai)
#pragma unroll
                for (int m = 0; m < 4; ++m) { bf16_t* p = GS + (size_t)(row0 + ai * HALF + m * 16) * 3072 + col0;
#pragma unroll
                    for (int bj = 0; bj < 2; ++bj) { f32x4 g0, g1;
#pragma unroll
                        for (int j = 0; j < 4; ++j) { g0[j] = sigm(acc[ai][bj][m][0][j]); g1[j] = sigm(acc[ai][bj][m][1][j]); }
                        *(u32x4*)(p + bj * HALF) = pack8(g0, g1); } }
        }
    }
};
template <class Epi, class Sched, bool ALIGN_EPI = false, bool SP2 = false>
__device__ __forceinline__ void gemm_phase(PG8_LAS unsigned char* lds, const Gemm g, const Sched& S, const Epi& E, const int wave) {
    int lane_; asm volatile("v_mbcnt_lo_u32_b32 %0, -1, 0\n\tv_mbcnt_hi_u32_b32 %0, -1, %0" : "=v"(lane_));
    const int wid = wave, lane = lane_, tid = wid * 64 + lane, wr = wid >> 2, wc = wid & 3, fr = lane & 15, fq = lane >> 4;
    const int K = g.K;
    unsigned voffA[2], voffB[2];
#pragma unroll
    for (int i = 0; i < 2; ++i) { int R, C; stage_rc(tid * 16 + i * 8192, R, C); const int Rb = Epi::PERM ? ((R & ~31) + perm32(R & 31)) : R;
        voffA[i] = (unsigned)(R * K + C) * 2u; voffB[i] = (unsigned)(Rb * K + C) * 2u; }
    const size_t kstep = (size_t)(BK * 2);
    const size_t hstep = (size_t)HALF * K * 2;
    const size_t tstep = 2 * hstep;
    const unsigned ldsw = (unsigned)wid * 1024u;
    const int aoff = lds_byte(wr * 64 + fr, fq * 8), boff = lds_byte(wc * 32 + fr, fq * 8);
#define PG8_SA(b, h) (((b) * 2 + (h)) * HTB)
#define PG8_SB(b, h) ((4 + (b) * 2 + (h)) * HTB)
#define PG8_STAGE(bufoff, gbase, voff) do { _Pragma("unroll") for (int _i = 0; _i < 2; ++_i) \
        __builtin_amdgcn_global_load_lds((const unsigned*)((const char*)(gbase) + (voff)[_i]), (PG8_LAS unsigned*)(lds + (bufoff) + ldsw + _i * 8192), 16, 0, 0); } while (0)
#define PG8_LDA(dst, b, h) do { _Pragma("unroll") for (int m = 0; m < 4; ++m) _Pragma("unroll") for (int k = 0; k < 2; ++k) dst[m][k] = *(const PG8_LAS bf16x8*)(lds + PG8_SA(b, h) + aoff + m * 2048 + k * 1024); } while (0)
#define PG8_LDB(dst, b, h) do { _Pragma("unroll") for (int n = 0; n < 2; ++n) _Pragma("unroll") for (int k = 0; k < 2; ++k) dst[n][k] = *(const PG8_LAS bf16x8*)(lds + PG8_SB(b, h) + boff + n * 2048 + k * 1024); } while (0)
#define PG8_MMA(ai, bj, At, Bt) do { __builtin_amdgcn_s_setprio(1); _Pragma("unroll") for (int m = 0; m < 4; ++m) _Pragma("unroll") for (int n = 0; n < 2; ++n) _Pragma("unroll") for (int k = 0; k < 2; ++k) \
        acc[ai][bj][m][n] = __builtin_amdgcn_mfma_f32_16x16x32_bf16(Bt[n][k], At[m][k], acc[ai][bj][m][n], 0, 0, 0); __builtin_amdgcn_s_setprio(0); } while (0)
#define PG8_WAIT_V(n) asm volatile("s_waitcnt vmcnt(" #n ")" ::: "memory")
#define PG8_WAIT_L(n) asm volatile("s_waitcnt lgkmcnt(" #n ")" ::: "memory")
#define PG8_BAR __builtin_amdgcn_s_barrier()
#define PG8_SCHED __builtin_amdgcn_sched_barrier(0)
    Unit cur, nxt; int ui = 0;
    if (!S.next(0, cur)) return;
    f32x4 acc[2][2][4][2];
#pragma unroll
    for (int a = 0; a < 2; ++a)
#pragma unroll
        for (int b = 0; b < 2; ++b)
#pragma unroll
            for (int m = 0; m < 4; ++m)
#pragma unroll
                for (int n = 0; n < 2; ++n) acc[a][b][m][n] = (f32x4){0.f, 0.f, 0.f, 0.f};
    bf16x8 At[4][2], B0[2][2], B1[2][2];
    const char* cA = (const char*)g.A + (size_t)cur.pm * tstep + S.koff_bytes(cur); const char* cB = (const char*)g.Bt + (size_t)cur.pn * tstep + S.koff_bytes(cur);
    S.a_ready(cur);
    if constexpr (SP2) {
        PG8_STAGE(PG8_SB(0, 0), cB, voffB); PG8_STAGE(PG8_SB(0, 1), cB + hstep, voffB); PG8_STAGE(PG8_SA(0, 0), cA, voffA); PG8_STAGE(PG8_SA(0, 1), cA + hstep, voffA);
        if (wr == 1) PG8_BAR;
        PG8_WAIT_V(2); PG8_BAR;
        PG8_STAGE(PG8_SB(1, 0), cB + kstep, voffB); PG8_STAGE(PG8_SA(1, 0), cA + kstep, voffA); PG8_STAGE(PG8_SB(1, 1), cB + hstep + kstep, voffB);
        PG8_WAIT_V(6); PG8_BAR;
    } else {
        PG8_STAGE(PG8_SB(0, 0), cB, voffB); PG8_STAGE(PG8_SA(0, 0), cA, voffA); PG8_STAGE(PG8_SB(0, 1), cB + hstep, voffB); PG8_STAGE(PG8_SA(0, 1), cA + hstep, voffA);
        if (wr == 1) PG8_BAR;
        PG8_WAIT_V(4); PG8_BAR;
        PG8_STAGE(PG8_SB(1, 0), cB + kstep, voffB); PG8_STAGE(PG8_SA(1, 0), cA + kstep, voffA); PG8_STAGE(PG8_SB(1, 1), cB + hstep + kstep, voffB);
        PG8_WAIT_V(6); PG8_BAR;
    }
    for (;;) {
        const bool has_next = S.next(ui + 1, nxt);
        const char* nA = has_next ? (const char*)g.A + (size_t)nxt.pm * tstep + S.koff_bytes(nxt) : cA; const char* nB = has_next ? (const char*)g.Bt + (size_t)nxt.pn * tstep + S.koff_bytes(nxt) : cB;
        const int nt = S.ntiles(cur, K);
        for (int t = 0; t < nt; t += 2) {
            const bool last = (t == nt - 2);
            const char* a1 = cA + (size_t)(t + 1) * kstep;
            const char* a2 = last ? nA : cA + (size_t)(t + 2) * kstep; const char* b2 = last ? nB : cB + (size_t)(t + 2) * kstep;
            const char* a3 = a2 + kstep; const char* b3 = b2 + kstep;
            if (last && has_next) S.a_ready(nxt);
            if constexpr (SP2) {
            PG8_LDB(B0, 0, 0); PG8_LDB(B1, 0, 1); PG8_SCHED; PG8_LDA(At, 0, 0); PG8_STAGE(PG8_SA(1, 1), a1 + hstep, voffA);
            PG8_WAIT_V(8); PG8_WAIT_L(0); PG8_BAR; PG8_MMA(0, 0, At, B0); PG8_MMA(0, 1, At, B1); PG8_BAR; PG8_SCHED;
            PG8_LDA(At, 0, 1); PG8_STAGE(PG8_SB(0, 0), b2, voffB); PG8_STAGE(PG8_SB(0, 1), b2 + hstep, voffB); PG8_STAGE(PG8_SA(0, 0), a2, voffA);
            PG8_WAIT_V(8); PG8_WAIT_L(0); PG8_BAR; PG8_MMA(1, 0, At, B0); PG8_MMA(1, 1, At, B1); PG8_BAR; PG8_SCHED;
            PG8_LDB(B0, 1, 0); PG8_LDB(B1, 1, 1); PG8_SCHED; PG8_LDA(At, 1, 0); PG8_STAGE(PG8_SA(0, 1), a2 + hstep, voffA);
            PG8_WAIT_V(8); PG8_WAIT_L(0); PG8_BAR; PG8_MMA(0, 0, At, B0); PG8_MMA(0, 1, At, B1); PG8_BAR; PG8_SCHED;
            PG8_LDA(At, 1, 1); PG8_STAGE(PG8_SB(1, 0), b3, voffB); PG8_STAGE(PG8_SB(1, 1), b3 + hstep, voffB); PG8_STAGE(PG8_SA(1, 0), a3, voffA);
            PG8_WAIT_V(8); PG8_WAIT_L(0); PG8_BAR; PG8_MMA(1, 0, At, B0); PG8_MMA(1, 1, At, B1); PG8_BAR; PG8_SCHED;
            } else {
            PG8_LDB(B0, 0, 0); PG8_SCHED; PG8_LDA(At, 0, 0); PG8_STAGE(PG8_SA(1, 1), a1 + hstep, voffA);
            PG8_WAIT_L(8); PG8_BAR; PG8_WAIT_L(0); PG8_MMA(0, 0, At, B0); PG8_BAR; PG8_SCHED;
            PG8_LDB(B1, 0, 1); PG8_STAGE(PG8_SB(0, 0), b2, voffB);
            PG8_BAR; PG8_WAIT_L(0); PG8_MMA(0, 1, At, B1); PG8_BAR;
            PG8_LDA(At, 0, 1); PG8_STAGE(PG8_SA(0, 0), a2, voffA);
            PG8_BAR; PG8_WAIT_L(0); PG8_MMA(1, 0, At, B0); PG8_BAR; PG8_SCHED;
            PG8_STAGE(PG8_SB(0, 1), b2 + hstep, voffB);
            PG8_WAIT_V(6); PG8_BAR; PG8_MMA(1, 1, At, B1); PG8_BAR;
            PG8_LDB(B0, 1, 0); PG8_SCHED; PG8_LDA(At, 1, 0); PG8_STAGE(PG8_SA(0, 1), a2 + hstep, voffA);
            PG8_WAIT_L(8); PG8_BAR; PG8_WAIT_L(0); PG8_MMA(0, 0, At, B0); PG8_BAR; PG8_SCHED;
            PG8_LDB(B1, 1, 1); PG8_STAGE(PG8_SB(1, 0), b3, voffB);
            PG8_BAR; PG8_WAIT_L(0); PG8_MMA(0, 1, At, B1); PG8_BAR;
            PG8_LDA(At, 1, 1); PG8_STAGE(PG8_SA(1, 0), a3, voffA);
            PG8_BAR; PG8_WAIT_L(0); PG8_MMA(1, 0, At, B0); PG8_BAR; PG8_SCHED;
            PG8_STAGE(PG8_SB(1, 1), b3 + hstep, voffB);
            PG8_WAIT_V(6); PG8_BAR; PG8_MMA(1, 1, At, B1); PG8_BAR;
            }
        }
        if constexpr (ALIGN_EPI) { if (wr == 0) PG8_BAR; }
        if constexpr (!Epi::AFTER_DRAIN) { E(acc, cur, wr, wc, fr, fq); S.done(cur); }
        if (!has_next) break;
#pragma unroll
        for (int a = 0; a < 2; ++a)
#pragma unroll
            for (int b = 0; b < 2; ++b)
#pragma unroll
                for (int m = 0; m < 4; ++m)
#pragma unroll
                    for (int n = 0; n < 2; ++n) acc[a][b][m][n] = (f32x4){0.f, 0.f, 0.f, 0.f};
        cur = nxt; cA = nA; cB = nB; ++ui;
        if constexpr (ALIGN_EPI) { if (wr == 1) PG8_BAR; }
    }
    PG8_WAIT_V(0);
    if constexpr (!ALIGN_EPI) { if (wr == 0) PG8_BAR; }
    PG8_BAR;
    if constexpr (Epi::AFTER_DRAIN) { E.fused(acc, cur, wr, wc, fr, fq, lds, wid, lane); S.done(cur); }
#undef PG8_SA
#undef PG8_SB
#undef PG8_STAGE
#undef PG8_LDA
#undef PG8_LDB
#undef PG8_MMA
#undef PG8_WAIT_V
#undef PG8_WAIT_L
#undef PG8_BAR
#undef PG8_SCHED
}
}
#include <hip/hip_bf16.h>
#include <cmath>
namespace attn_body {
using bf16=__hip_bfloat16;
using bf16x8=__attribute__((ext_vector_type(8)))short;
using s16x4=__attribute__((ext_vector_type(4)))short;
using f32x16=__attribute__((ext_vector_type(16)))float;
using u32x4=__attribute__((ext_vector_type(4)))unsigned;
constexpr int SEQ=16384,D=64,DM=1024,OP=2048;
constexpr int NW=8,QBLK=32,QB=QBLK*NW,KVBLK=64,NQB=SEQ/QB;
constexpr int ATTN_PITCH=DM, ATTN_UNIT_ROWS=QB;
__device__ __forceinline__ int crow(int r,int hi){return (r&3)+8*(r>>2)+4*hi;}
__device__ __forceinline__ f32x16 zero16(){ float z; asm volatile("v_mov_b32 %0, 0":"=v"(z)); f32x16 r; _Pragma("unroll") for(int i=0;i<16;++i)r[i]=z; return r; }
#define SBAR() __builtin_amdgcn_sched_barrier(0)
__device__ __forceinline__ void cmask(f32x16&p0,f32x16&p1,int jb,int qrel,int hi){
  const float NEG=-INFINITY; (void)hi;
  if(jb>(qrel>>6)){
  #pragma unroll
  for(int r=0;r<16;++r){p0[r]=NEG;p1[r]=NEG;} }
}

constexpr int NSLOT=3, SLOTB=8192;
constexpr int LDS_K=0, LDS_V=NSLOT*SLOTB, LDS_WS=3*NSLOT*SLOTB, LDS_OST=LDS_WS+NW*64*4, LDS_BYTES=LDS_OST+NW*4096;
constexpr float C2=0.125f*1.4426950408889634f;
__device__ __forceinline__ void glds16(const void*gsrc,unsigned lds_dst){unsigned keep;
  asm volatile("s_mov_b32 %0, m0\n\ts_mov_b32 m0, %2\n\ts_nop 0\n\tglobal_load_lds_dwordx4 %1, off\n\ts_mov_b32 m0, %0":"=&s"(keep):"v"(gsrc),"s"(lds_dst):"memory");}
__device__ __forceinline__ float max3f(float a,float b,float c){float r;asm("v_max3_f32 %0, %1, %2, %3":"=v"(r):"v"(a),"v"(b),"v"(c));return r;}
__device__ __forceinline__ float max2f(float a,float b){float r;asm("v_max_f32_e32 %0, %1, %2":"=v"(r):"v"(a),"v"(b));return r;}
__device__ __forceinline__ float fadd_s(float a,float b){float r;asm("v_add_f32_e32 %0, %1, %2":"=v"(r):"v"(a),"v"(b));return r;}
__device__ __forceinline__ float fsub_s(float a,float b){float r;asm("v_sub_f32_e32 %0, %1, %2":"=v"(r):"v"(a),"v"(b));return r;}
typedef float f32x2_t __attribute__((ext_vector_type(2))); typedef __bf16 bf16x2_t __attribute__((ext_vector_type(2)));
__device__ __forceinline__ unsigned cvtpk_s(float lo,float hi){f32x2_t v={lo,hi};bf16x2_t b=__builtin_convertvector(v,bf16x2_t);return __builtin_bit_cast(unsigned,b);}
#define WAIT_BAR(N) asm volatile("s_waitcnt vmcnt(" #N ") lgkmcnt(0)\n\ts_barrier":::"memory")

__device__ __forceinline__ void qkt(f32x16&p0,f32x16&p1,const char*Kslot,const bf16x8*qr,const f32x16&negm,int r32,int hi){
  const char*kb=Kslot+hi*1024+r32*16;
  #pragma unroll
  for(int d0=0;d0<4;++d0){
    const bf16x8 b0=*reinterpret_cast<const bf16x8*>(kb+d0*2048);
    const bf16x8 b1=*reinterpret_cast<const bf16x8*>(kb+d0*2048+512);
    if(d0==0){p0=__builtin_amdgcn_mfma_f32_32x32x16_bf16(b0,qr[0],negm,0,0,0);p1=__builtin_amdgcn_mfma_f32_32x32x16_bf16(b1,qr[0],negm,0,0,0);}
    else{p0=__builtin_amdgcn_mfma_f32_32x32x16_bf16(b0,qr[d0],p0,0,0,0);p1=__builtin_amdgcn_mfma_f32_32x32x16_bf16(b1,qr[d0],p1,0,0,0);}}
}
typedef __attribute__((address_space(3))) const char* lds_cptr;
typedef short v4i16_t __attribute__((ext_vector_type(4)));
__device__ __forceinline__ void kload8(bf16x8*kf,lds_cptr kp){
  kf[0]=*(const __attribute__((address_space(3))) bf16x8*)(kp);      kf[1]=*(const __attribute__((address_space(3))) bf16x8*)(kp+512);
  kf[2]=*(const __attribute__((address_space(3))) bf16x8*)(kp+2048); kf[3]=*(const __attribute__((address_space(3))) bf16x8*)(kp+2560);
  kf[4]=*(const __attribute__((address_space(3))) bf16x8*)(kp+4096); kf[5]=*(const __attribute__((address_space(3))) bf16x8*)(kp+4608);
  kf[6]=*(const __attribute__((address_space(3))) bf16x8*)(kp+6144); kf[7]=*(const __attribute__((address_space(3))) bf16x8*)(kp+6656);
}
__device__ __forceinline__ void kload2(bf16x8*kf,lds_cptr kp,int j){ kf[2*j]=*(const __attribute__((address_space(3))) bf16x8*)(kp+j*2048); kf[2*j+1]=*(const __attribute__((address_space(3))) bf16x8*)(kp+j*2048+512); }
__device__ __forceinline__ s16x4 vtr(lds_cptr p){ return __builtin_bit_cast(s16x4,__builtin_amdgcn_ds_read_tr16_b64_v4i16((__attribute__((address_space(3))) v4i16_t*)p)); }
__device__ __forceinline__ float rowmax(const f32x16&p0,const f32x16&p1){
  float a=max3f(p0[0],p0[1],p1[0]),b=max3f(p0[2],p0[3],p1[1]);a=max3f(a,p1[2],p1[3]);
  #pragma unroll
  for(int r=4;r<16;r+=4){a=max3f(a,p0[r],p0[r+1]);b=max3f(b,p0[r+2],p0[r+3]);a=max3f(a,p1[r],p1[r+1]);b=max3f(b,p1[r+2],p1[r+3]);}
  const float m=max2f(a,b);
  auto rr=__builtin_amdgcn_permlane32_swap(__float_as_uint(m),__float_as_uint(m),false,false);
  return max2f(__uint_as_float(rr[0]),__uint_as_float(rr[1]));
}
__device__ __forceinline__ void pv(f32x16*o,int vb,bf16x8 pa0,bf16x8 pa1,bf16x8 pa2,bf16x8 pa3){
  #pragma unroll
  for(int d0=0;d0<4;++d0){s16x4 lo[4],hi[4];
    #pragma unroll
    for(int ks=0;ks<4;++ks){
      asm volatile("ds_read_b64_tr_b16 %0,%1 offset:%c2":"=&v"(lo[ks]):"v"(vb),"i"(d0*4096+ks*1024):"memory");
      asm volatile("ds_read_b64_tr_b16 %0,%1 offset:%c2":"=&v"(hi[ks]):"v"(vb),"i"(d0*4096+ks*1024+512):"memory");}
    asm volatile("s_waitcnt lgkmcnt(0)":::"memory");SBAR();
    #define PK(k) (bf16x8){lo[k][0],lo[k][1],lo[k][2],lo[k][3],hi[k][0],hi[k][1],hi[k][2],hi[k][3]}
    o[d0]=__builtin_amdgcn_mfma_f32_32x32x16_bf16(pa0,PK(0),o[d0],0,0,0);
    o[d0]=__builtin_amdgcn_mfma_f32_32x32x16_bf16(pa1,PK(1),o[d0],0,0,0);
    o[d0]=__builtin_amdgcn_mfma_f32_32x32x16_bf16(pa2,PK(2),o[d0],0,0,0);
    o[d0]=__builtin_amdgcn_mfma_f32_32x32x16_bf16(pa3,PK(3),o[d0],0,0,0);
    #undef PK
  }
}

#ifndef ATTN_STORE16
#define ATTN_STORE16(p,v) (*(u32x4*)(p)=(v))
#endif
template<int THRL> __device__ __forceinline__ void attn_unit(int b,int map,int qb,const bf16*Q,const bf16*__restrict__ K,const bf16*__restrict__ V,bf16*O,char*shm,const int wave,const bool primed,const int nb,const int nmap){
  int lane_; asm volatile("v_mbcnt_lo_u32_b32 %0, -1, 0\n\tv_mbcnt_hi_u32_b32 %0, -1, %0":"=v"(lane_)); const int lane=lane_,r32=lane&31,hi=lane>>5; const int wid=wave;
  const long rowbase=(long)b*SEQ; const int q0=qb*QB;
  const bf16*Qw=Q+(rowbase+q0+wid*QBLK)*DM+map*D;
  const bf16*Kh=K+rowbase*DM+map*D,*Vh=V+rowbase*DM+(map>>1)*128;
  const unsigned lds0=(unsigned)(uintptr_t)shm;
  float*wsf=(float*)(shm+LDS_WS)+wid*64;
  const bf16*ksrc=Kh+(long)lane*DM+wid*8;
  const bf16*vsrc=Vh+(long)(16*(wid&3)+(lane>>2))*DM+(wid>>2)*32+(lane&3)*8;
  const unsigned kdst=lds0+LDS_K+wid*1024, vdst=lds0+LDS_V+wid*1024;
  #define DMA_K(t,slot) glds16(ksrc+(long)(t)*KVBLK*DM,(unsigned)__builtin_amdgcn_readfirstlane(kdst+(slot)))
  #define DMA_V(t,slot) do{ glds16(vsrc+(long)(t)*KVBLK*DM,(unsigned)__builtin_amdgcn_readfirstlane(vdst+2*(slot))); glds16(vsrc+(long)(t)*KVBLK*DM+64,(unsigned)__builtin_amdgcn_readfirstlane(vdst+2*(slot)+8192)); }while(0)
  const int vb0=(int)(lds0+LDS_V)+((lane>>4)&1)*32+(lane&3)*8+(4*hi+((lane&15)>>2))*64;
  const char*Kbase=shm+LDS_K; bf16x8 kf[8];
  const lds_cptr shm3=(lds_cptr)shm; const lds_cptr kp0=shm3+LDS_K+hi*1024+r32*16; const lds_cptr vp0=shm3+LDS_V+((lane>>4)&1)*32+(lane&3)*8+(4*hi+((lane&15)>>2))*64;
  const int NT=(q0+QB)/KVBLK;
  if(!primed){DMA_K(0,0);DMA_V(0,0);DMA_K(1,SLOTB);}
  bf16x8 qr[4];
  #pragma unroll
  for(int d0=0;d0<4;++d0)qr[d0]=*reinterpret_cast<const bf16x8*>(&Qw[(long)r32*DM+d0*16+hi*8]);
  float mhat=0.f,l_reg=0.f;f32x16 o[4];o[0]=zero16();o[1]=zero16();o[2]=zero16();o[3]=zero16();f32x16 negm=zero16();asm volatile("":"+v"(negm));
  const int qrel=wid*QBLK+r32;
  #define CMASK(P0,P1,t) do{int jb_=(t)-(NT-4); if(jb_>=0)cmask(P0,P1,jb_,qrel,hi);}while(0)
  bool resc=false;
  #define START(P0,P1) do{ const float rm=rowmax(P0,P1); resc=false; \
    { const float dl=rm; mhat=fadd_s(mhat,dl); \
      _Pragma("unroll") for(int r=0;r<16;++r){P0[r]=fsub_s(P0[r],dl);P1[r]=fsub_s(P1[r],dl);} \
      _Pragma("unroll") for(int r=0;r<16;++r)negm[r]=-mhat; asm volatile("":"+v"(negm)); } \
    _Pragma("unroll") for(int r=0;r<16;++r)P0[r]=__builtin_amdgcn_exp2f(P0[r]); }while(0)
  #define RESC() do{ if(resc){ asm volatile("s_waitcnt lgkmcnt(0)":::"memory"); \
      _Pragma("unroll") for(int d_=0;d_<4;++d_) _Pragma("unroll") for(int r=0;r<16;++r)o[d_][r]*=wsf[crow(r,hi)]; } }while(0)
  f32x16 pA0,pA1,pB0,pB1;
  int sl_prev=0,sl_cur=0,sl_next=SLOTB;
  #define ROT() do{sl_prev=sl_cur;sl_cur=sl_next;sl_next=(sl_next==(NSLOT-1)*SLOTB)?0:sl_next+SLOTB;}while(0)
  if(!primed){DMA_K(2,2*SLOTB);}
  WAIT_BAR(3);
  qkt(pA0,pA1,Kbase,qr,negm,r32,hi);asm volatile("s_nop 15\n\ts_nop 7":"+v"(pA0),"+v"(pA1));CMASK(pA0,pA1,0);
  START(pA0,pA1);
  _Pragma("unroll") for(int r=0;r<16;++r)pA1[r]=__builtin_amdgcn_exp2f(pA1[r]);
  WAIT_BAR(0);
  DMA_K(3,0);DMA_V(1,SLOTB);
  ROT();
  kload8(kf,kp0+sl_cur);
  WAIT_BAR(3);
  s16x4 vlo[16],vhi[16]; u32x4 pw0,pw1,pw2,pw3;
  #define PKW(P,B) cvtpk_s(P[B],P[B+1])
  #define PAF(k) __builtin_bit_cast(bf16x8,pw##k)
  #define VFR(i) (bf16x8){vlo[i][0],vlo[i][1],vlo[i][2],vlo[i][3],vhi[i][0],vhi[i][1],vhi[i][2],vhi[i][3]}
  #define PIN(x) asm volatile("":"+v"(x))
  #define MX3(a,b,c) __builtin_fmaxf(__builtin_fmaxf((a),(b)),(c))
  #define GAPA(MF,A0,A1,A2,A3,W0,W1,PW) do{ MF; sacc+=A0; sacc+=A1; sacc+=A2; sacc+=A3; PIN(sacc); W0; W1; PIN(PW); SBAR(); }while(0)
  #define EX(v) __builtin_amdgcn_exp2f(v)
  #define GAPB2(MF,X,B) do{ MF; X[B]=EX(X[B]); X[B+1]=EX(X[B+1]); PIN(X); SBAR(); }while(0)
  #define GAPB(MF,X,B) do{ MF; X[B]=EX(X[B]); X[B+1]=EX(X[B+1]); X[B+2]=EX(X[B+2]); X[B+3]=EX(X[B+3]); PIN(X); SBAR(); }while(0)
  #define VRD(i) do{ vlo[i]=vtr(vp_+(((i)>>2)*4096+((i)&3)*1024)); vhi[i]=vtr(vp_+(((i)>>2)*4096+((i)&3)*1024+512)); }while(0)
  #define KRD(G,j) do{ if(G){ kload2(kf,kp0+sl_next,j); SBAR(); } }while(0)
  #define STEP(C0,C1,P0,P1,t,GK,GV,GL) do{ SBAR(); \
    const lds_cptr vp_=vp0+2*sl_prev; \
    VRD(0); SBAR(); float sacc=(P0[0]+P0[1]); \
    GAPA(C0=__builtin_amdgcn_mfma_f32_32x32x16_bf16(kf[0],qr[0],negm,0,0,0), P0[2],P0[3],P0[4],P0[5],     pw0[0]=PKW(P0,0), pw0[1]=PKW(P0,2), pw0); \
    VRD(4); SBAR(); GAPA(C1=__builtin_amdgcn_mfma_f32_32x32x16_bf16(kf[1],qr[0],negm,0,0,0), P0[6],P0[7],P0[8],P0[9],     pw0[2]=PKW(P0,4), pw0[3]=PKW(P0,6), pw0); \
    VRD(1); SBAR(); GAPA(C0=__builtin_amdgcn_mfma_f32_32x32x16_bf16(kf[2],qr[1],C0,0,0,0),   P0[10],P0[11],P0[12],P0[13], pw1[0]=PKW(P0,8), pw1[1]=PKW(P0,10), pw1); \
    VRD(5); SBAR(); GAPA(C1=__builtin_amdgcn_mfma_f32_32x32x16_bf16(kf[3],qr[1],C1,0,0,0),   P0[14],P0[15],P1[0],P1[1],   pw1[2]=PKW(P0,12),pw1[3]=PKW(P0,14), pw1); \
    VRD(2); SBAR(); GAPA(C0=__builtin_amdgcn_mfma_f32_32x32x16_bf16(kf[4],qr[2],C0,0,0,0),   P1[2],P1[3],P1[4],P1[5],     pw2[0]=PKW(P1,0), pw2[1]=PKW(P1,2), pw2); \
    VRD(6); SBAR(); GAPA(C1=__builtin_amdgcn_mfma_f32_32x32x16_bf16(kf[5],qr[2],C1,0,0,0),   P1[6],P1[7],P1[8],P1[9],     pw2[2]=PKW(P1,4), pw2[3]=PKW(P1,6), pw2); \
    VRD(3); SBAR(); GAPA(C0=__builtin_amdgcn_mfma_f32_32x32x16_bf16(kf[6],qr[3],C0,0,0,0),   P1[10],P1[11],P1[12],P1[13], pw3[0]=PKW(P1,8), pw3[1]=PKW(P1,10), pw3); \
    VRD(7); SBAR(); GAPA(C1=__builtin_amdgcn_mfma_f32_32x32x16_bf16(kf[7],qr[3],C1,0,0,0),   P1[14],P1[15],0.f,0.f,       pw3[2]=PKW(P1,12),pw3[3]=PKW(P1,14), pw3); \
    l_reg+=sacc; \
    if(GK){DMA_K((t)+3,sl_cur);} if(GV){DMA_V((t)+1,sl_next);} \
    CMASK(C0,C1,t); \
    { float a=MX3(C0[0],C0[1],C1[0]),b=MX3(C0[2],C0[3],C1[1]); a=MX3(a,C1[2],C1[3]); \
      _Pragma("unroll") for(int r=4;r<16;r+=4){a=MX3(a,C0[r],C0[r+1]);b=MX3(b,C0[r+2],C0[r+3]);a=MX3(a,C1[r],C1[r+1]);b=MX3(b,C1[r+2],C1[r+3]);} \
      float rm=__builtin_fmaxf(a,b); { auto rr=__builtin_amdgcn_permlane32_swap(__float_as_uint(rm),__float_as_uint(rm),false,false); rm=__builtin_fmaxf(__uint_as_float(rr[0]),__uint_as_float(rr[1])); } \
      resc=false; \
      if(__builtin_expect(__any(rm>(float)THRL),0)){ const float dl=__builtin_fmaxf(rm,0.f); mhat+=dl; \
        _Pragma("unroll") for(int r=0;r<16;++r){C0[r]-=dl;C1[r]-=dl;} \
        _Pragma("unroll") for(int r=0;r<16;++r)negm[r]=-mhat; asm volatile("":"+v"(negm)); \
        const float f=__builtin_amdgcn_exp2f(-dl); l_reg*=f; if(hi==0)wsf[r32]=f; resc=true; } } \
    SBAR(); \
    VRD(8); SBAR();  GAPB2(o[0]=__builtin_amdgcn_mfma_f32_32x32x16_bf16(PAF(0),VFR(0),o[0],0,0,0), C0,0); \
    VRD(12); SBAR(); GAPB2(o[1]=__builtin_amdgcn_mfma_f32_32x32x16_bf16(PAF(0),VFR(4),o[1],0,0,0), C0,2); \
    KRD(GL,0); GAPB2(o[0]=__builtin_amdgcn_mfma_f32_32x32x16_bf16(PAF(1),VFR(1),o[0],0,0,0), C0,4); \
    KRD(GL,1); GAPB2(o[1]=__builtin_amdgcn_mfma_f32_32x32x16_bf16(PAF(1),VFR(5),o[1],0,0,0), C0,6); \
    KRD(GL,2); GAPB2(o[0]=__builtin_amdgcn_mfma_f32_32x32x16_bf16(PAF(2),VFR(2),o[0],0,0,0), C0,8); \
    KRD(GL,3); GAPB2(o[1]=__builtin_amdgcn_mfma_f32_32x32x16_bf16(PAF(2),VFR(6),o[1],0,0,0), C0,10); \
    VRD(9); SBAR();  GAPB2(o[0]=__builtin_amdgcn_mfma_f32_32x32x16_bf16(PAF(3),VFR(3),o[0],0,0,0), C0,12); \
    VRD(13); SBAR(); GAPB2(o[1]=__builtin_amdgcn_mfma_f32_32x32x16_bf16(PAF(3),VFR(7),o[1],0,0,0), C0,14); \
    VRD(10); SBAR(); GAPB2(o[2]=__builtin_amdgcn_mfma_f32_32x32x16_bf16(PAF(0),VFR(8),o[2],0,0,0), C1,0); \
    VRD(14); SBAR(); GAPB2(o[3]=__builtin_amdgcn_mfma_f32_32x32x16_bf16(PAF(0),VFR(12),o[3],0,0,0), C1,2); \
    VRD(11); SBAR(); GAPB2(o[2]=__builtin_amdgcn_mfma_f32_32x32x16_bf16(PAF(1),VFR(9),o[2],0,0,0), C1,4); \
    VRD(15); SBAR(); GAPB2(o[3]=__builtin_amdgcn_mfma_f32_32x32x16_bf16(PAF(1),VFR(13),o[3],0,0,0), C1,6); \
    GAPB2(o[2]=__builtin_amdgcn_mfma_f32_32x32x16_bf16(PAF(2),VFR(10),o[2],0,0,0), C1,8); \
    GAPB2(o[3]=__builtin_amdgcn_mfma_f32_32x32x16_bf16(PAF(2),VFR(14),o[3],0,0,0), C1,10); \
    GAPB2(o[2]=__builtin_amdgcn_mfma_f32_32x32x16_bf16(PAF(3),VFR(11),o[2],0,0,0), C1,12); \
    GAPB2(o[3]=__builtin_amdgcn_mfma_f32_32x32x16_bf16(PAF(3),VFR(15),o[3],0,0,0), C1,14); \
    }while(0)
  int t=1;
  #undef CMASK
  #define CMASK(P0,P1,t) do{}while(0)
  for(;t+5<NT;t+=2){
    STEP(pB0,pB1,pA0,pA1,t,true,true,true);     WAIT_BAR(3); RESC(); ROT();
    STEP(pA0,pA1,pB0,pB1,t+1,true,true,true);   WAIT_BAR(3); RESC(); ROT();
  }
  #undef CMASK
  #define CMASK(P0,P1,t) do{int jb_=(t)-(NT-4); if(jb_>=0)cmask(P0,P1,jb_,qrel,hi);}while(0)
  #define ENDW(tt) do{ if((tt)+3<NT){WAIT_BAR(3);} else if((tt)+2<NT){WAIT_BAR(2);} else {WAIT_BAR(0);} }while(0)
  for(;t+1<NT;t+=2){
    STEP(pB0,pB1,pA0,pA1,t,(t+3<NT),(t+1<NT),(t+1<NT));       ENDW(t);   RESC(); ROT();
    STEP(pA0,pA1,pB0,pB1,t+1,(t+4<NT),(t+2<NT),(t+2<NT));     ENDW(t+1); RESC(); ROT();
  }
  STEP(pB0,pB1,pA0,pA1,NT-1,false,false,false); RESC();
  { float sacc=pB0[0]+pB0[1]; _Pragma("unroll") for(int r=2;r<16;++r)sacc+=pB0[r]; _Pragma("unroll") for(int r=0;r<16;++r)sacc+=pB1[r]; l_reg+=sacc;
    pw0=(u32x4){PKW(pB0,0),PKW(pB0,2),PKW(pB0,4),PKW(pB0,6)};pw1=(u32x4){PKW(pB0,8),PKW(pB0,10),PKW(pB0,12),PKW(pB0,14)};pw2=(u32x4){PKW(pB1,0),PKW(pB1,2),PKW(pB1,4),PKW(pB1,6)};pw3=(u32x4){PKW(pB1,8),PKW(pB1,10),PKW(pB1,12),PKW(pB1,14)};
    SBAR(); pv(o,vb0+2*sl_cur,PAF(0),PAF(1),PAF(2),PAF(3)); }
  asm volatile("s_waitcnt lgkmcnt(0)\n\ts_barrier":::"memory");
  if(nb>=0){ const long nrow=(long)nb*SEQ; const bf16*nks=K+nrow*DM+nmap*D+(long)lane*DM+wid*8; const bf16*nvs=V+nrow*DM+(nmap>>1)*128+(long)(16*(wid&3)+(lane>>2))*DM+(wid>>2)*32+(lane&3)*8;
    glds16(nks,(unsigned)__builtin_amdgcn_readfirstlane(kdst));
    glds16(nvs,(unsigned)__builtin_amdgcn_readfirstlane(vdst)); glds16(nvs+64,(unsigned)__builtin_amdgcn_readfirstlane(vdst+8192));
    glds16(nks+(long)KVBLK*DM,(unsigned)__builtin_amdgcn_readfirstlane(kdst+SLOTB));
    glds16(nks+(long)2*KVBLK*DM,(unsigned)__builtin_amdgcn_readfirstlane(kdst+2*SLOTB)); }
  #undef PKW
  #undef PAF
  #undef VFR
  #undef PIN
  #undef MX3
  #undef GAPA
  #undef GAPB
  #undef GAPB2
  #undef EX
  #undef VRD
  #undef KRD
  #undef STEP
  #undef ENDW
  {auto rr=__builtin_amdgcn_permlane32_swap(__float_as_uint(l_reg),__float_as_uint(l_reg),false,false);l_reg=__uint_as_float(rr[0])+__uint_as_float(rr[1]);}
  if(hi==0)wsf[32+r32]=l_reg;asm volatile("s_waitcnt lgkmcnt(0)":::"memory");
  float rli[16];
  #pragma unroll
  for(int r=0;r<16;++r)rli[r]=__builtin_amdgcn_rcpf(wsf[32+crow(r,hi)]);
  bf16*Ow=O+(rowbase+q0+wid*QBLK)*OP+map*128;
  { bf16*stg=(bf16*)(shm+LDS_OST)+wid*2048;
    #pragma unroll
    for(int hp=0;hp<2;++hp){
    #pragma unroll
    for(int r=0;r<16;++r){const int orow=crow(r,hi);
      #pragma unroll
      for(int d0=0;d0<2;++d0)stg[orow*64+d0*32+r32]=__float2bfloat16(o[2*hp+d0][r]*rli[r]);}
    asm volatile("s_waitcnt lgkmcnt(0)":::"memory");
    #pragma unroll
    for(int i=0;i<4;++i){const int row=i*8+(lane>>3),ch=lane&7; const u32x4 v=*(const u32x4*)(stg+row*64+ch*8); ATTN_STORE16(Ow+(long)row*OP+hp*64+ch*8,v);}
    asm volatile("s_waitcnt lgkmcnt(0)":::"memory"); } }
  asm volatile("s_waitcnt lgkmcnt(0)":::"memory");
  #undef DMA_K
  #undef DMA_V
  #undef CMASK
  #undef START
  #undef RESC
  #undef ROT
}
constexpr int ATTN_LDS_BYTES=LDS_BYTES;
struct AttnTensors { const bf16* Q; const bf16* K; const bf16* V; bf16* O; };
template<int THRL=8> __device__ __forceinline__ void attn_phase(char*lds,const AttnTensors&T,int vcu,const int wave){
  const int xcd=vcu>>5, s=vcu&31, b=xcd>>2;
  for(int c=0;c<4;++c){ const int map=4*(xcd&3)+c;
    attn_unit<THRL>(b,map,s,T.Q,T.K,T.V,T.O,lds,wave,c>0,b,map); attn_unit<THRL>(b,map,63-s,T.Q,T.K,T.V,T.O,lds,wave,true,(c<3)?b:-1,map+1); }
}
#undef SBAR
#undef WAIT_BAR
}
constexpr int NWAVES = 8;
constexpr int D = 1024, MP = 32768, MS = 512, M = MP + MS, SEQ = 16384, DEPTH = 4, DFF = 2816, NUP = 2 * DFF, NIN = 8192, KBR = 2048, PLE = 256;
constexpr int DSEQ = 32, PAST = 1024, DB = 16;
constexpr float RMS_EPS = 1e-6f;
constexpr int PH_PER_LAYER = 14, NPH = 1 + DEPTH * PH_PER_LAYER;
#ifndef REP_ATT
#define REP_ATT 1
#endif
#ifndef REP_PRO
#define REP_PRO 1
#endif
#ifndef REP_ROW
#define REP_ROW 1
#endif
#ifndef REP_E2
#define REP_E2 1
#endif
#ifndef REP_LB
#define REP_LB 1
#endif
#ifndef REP_BAR
#define REP_BAR 1
#endif
#ifndef REP_SG
#define REP_SG 1
#endif
#ifndef REP_SA
#define REP_SA 1
#endif
#ifndef REP_SE2
#define REP_SE2 1
#endif
#ifndef REP_GEMM_BAR
#define REP_GEMM_BAR 0
#endif
#ifndef REP_GEMM
#define REP_GEMM 1
#endif
#ifndef MK_PER_PHASE
#define MK_PER_PHASE 0
#endif

constexpr size_t MiB = 1u << 20;
constexpr size_t WS_CTL = 0, CTL_ZERO_BYTES = 1 * MiB;
constexpr size_t WS_ROPEC = 2 * MiB, WS_ROPES = 4 * MiB;
constexpr size_t WS_W = 8 * MiB, W_LAYER = 64 * MiB;
constexpr size_t W_UP1 = 0, W_UP2 = 11 * MiB, W_DN1 = 22 * MiB, W_DN2 = 22 * MiB + 5632 * 1024, W_IN = 33 * MiB, W_BR = 49 * MiB, W_OUT = 53 * MiB, W_PG = 55 * MiB, W_PU = 57 * MiB;
constexpr size_t WS_PB = 272 * MiB, PB_LAYER = 17 * MiB;
constexpr size_t WS_XN = 344 * MiB, WS_HFF = 416 * MiB, WS_Q = 600 * MiB, WS_K = 672 * MiB, WS_V = 744 * MiB, WS_BG = 816 * MiB, WS_C = 852 * MiB, WS_ZP = 888 * MiB;
constexpr size_t WS_GS = 924 * MiB, WS_O = 1120 * MiB, WS_A2 = 1256 * MiB, WS_MG = 1392 * MiB, WS_Y = 1464 * MiB, WS_PU = 1600 * MiB, WS_YS = 1672 * MiB  , WS_END = 1680 * MiB, WS_YB = 1688 * MiB  , WS_HB = 1760 * MiB  , WS_TOP = 1828 * MiB, WS_DUMMY = 1832 * MiB  ;
static_assert(WS_XN + (size_t)M * D * 2 <= WS_HFF && WS_HFF + (size_t)M * DFF * 2 <= WS_Q && WS_GS + (size_t)M * 3072 * 2 <= WS_O && WS_O + (size_t)M * 2048 * 2 <= WS_A2 && WS_Y + (size_t)M * D * 4 <= WS_PU && WS_PU + (size_t)M * D * 2 <= WS_END, "d_ws map");
static_assert(W_PU + (size_t)D * PLE * 2 <= W_LAYER && (size_t)M * PLE * 2 <= PB_LAYER && WS_W + DEPTH * W_LAYER <= WS_PB && WS_PB + DEPTH * PB_LAYER <= WS_XN, "d_ws map 2");
constexpr int CW_TMO = 0, CW_CODE = 1, CW_BAR = 4096;
constexpr size_t O_Y = 0, O_KP = (size_t)M * D, O_VP = O_KP + (size_t)DEPTH * MP * D, O_CP = O_VP + (size_t)DEPTH * MP * D, O_PP = O_CP + (size_t)DEPTH * 2 * 2 * 512, O_KS = O_PP + (size_t)DEPTH * 2 * 15 * 512,
                 O_VS = O_KS + (size_t)DEPTH * MS * D, O_CS = O_VS + (size_t)DEPTH * MS * D, O_PS = O_CS + (size_t)DEPTH * DB * 2 * 512, O_END = O_PS + (size_t)DEPTH * DB * 15 * 512;

constexpr int RING_OFF = 0, RING_BYTES = 131072;
constexpr int LDSCTL_OFF = RING_BYTES, MISC_OFF = LDSCTL_OFF + 320;
constexpr int LDS_BYTES = 147456;
static_assert(MISC_OFF + 128 <= LDS_BYTES, "LDS map");
#define GAS __attribute__((address_space(1)))
#define LAS __attribute__((address_space(3)))
typedef unsigned short bf16;
typedef unsigned v4u __attribute__((ext_vector_type(4)));
typedef float f32x4 __attribute__((ext_vector_type(4)));
typedef short bf16x8 __attribute__((ext_vector_type(8)));
typedef GAS unsigned gu32;
typedef GAS unsigned long long gu64;
#define RLX_AGENT __ATOMIC_RELAXED, __HIP_MEMORY_SCOPE_AGENT
#define LDS_WAIT() asm volatile("s_waitcnt lgkmcnt(0)" ::: "memory")
#define VM_WAIT() asm volatile("s_waitcnt vmcnt(0)" ::: "memory")
__device__ __forceinline__ unsigned long long rt() { return __builtin_amdgcn_s_memrealtime(); }
__device__ __forceinline__ unsigned f2bf(float f) { unsigned u = __builtin_bit_cast(unsigned, f); return (u + 0x7fffu + ((u >> 16) & 1u)) >> 16; }
__device__ __forceinline__ unsigned pk2(float lo, float hi) { return f2bf(lo) | (f2bf(hi) << 16); }

#define XB_TMO      128
#define XB_XCNT(j)  (256  + 64 * (j))
#define XB_XSUB(j)  (1280 + 64 * (j))
#define XB_XGEN(j)  (2304 + 64 * (j))
#define XB_TOP      3328
#define XB_TOPGEN   3392
#define XCD_BAR_WORDS 3456
#define XB_SPIN_CAP (1u << 18)

__device__ __forceinline__ unsigned xb_ld(unsigned* p)              { return __hip_atomic_load(p, __ATOMIC_RELAXED, __HIP_MEMORY_SCOPE_AGENT); }
__device__ __forceinline__ unsigned xb_add(unsigned* p, unsigned v) { return __hip_atomic_fetch_add(p, v, __ATOMIC_RELAXED, __HIP_MEMORY_SCOPE_AGENT); }
__device__ __forceinline__ unsigned xb_xcc_id() { return (unsigned)__builtin_amdgcn_s_getreg((3 << 11) | 20) & 0xFu; }
#define XB_SPIN(cond, bar) do { unsigned _sp = 0; while (cond) { __builtin_amdgcn_s_sleep(1); \
    if ((++_sp & 255u) == 0u) { if (xb_ld(&(bar)[XB_TMO])) break; if (_sp > XB_SPIN_CAP) { atomicAdd(&(bar)[XB_TMO], 1u); break; } } } } while (0)

__device__ __forceinline__ int lane_now() { int l; asm volatile("v_mbcnt_lo_u32_b32 %0, -1, 0\n\tv_mbcnt_hi_u32_b32 %0, -1, %0" : "=v"(l)); return l; }
struct XcdBarrier {
    int wave;
    unsigned* bar; unsigned x;
    volatile LAS unsigned* st;
};

__device__ __forceinline__ XcdBarrier xcd_barrier_post(unsigned* bar, volatile LAS unsigned* st) {
    XcdBarrier b; b.wave = (int)__builtin_amdgcn_readfirstlane(threadIdx.x >> 6); b.bar = bar; b.x = xb_xcc_id(); b.st = st;
    if (threadIdx.x == 0) (void)xb_add(&bar[XB_XCNT(b.x)], 1u);
    return b;
}
__device__ __forceinline__ void xcd_barrier_complete(unsigned* bar, unsigned x, unsigned& nloc, unsigned& nx) {
    const unsigned G = gridDim.x * gridDim.y * gridDim.z;
    unsigned sum, cnt, mine, sp = 0u;
    for (;;) {
        sum = 0u; cnt = 0u; mine = 0u;
#pragma unroll
        for (unsigned j = 0; j < 16; ++j) { const unsigned c = xb_ld(&bar[XB_XCNT(j)]); sum += c; cnt += (c > 0u) ? 1u : 0u; mine = (j == x) ? c : mine; }
        if (sum == G) break;
        __builtin_amdgcn_s_sleep(1);
        if ((++sp & 255u) == 0u) { if (xb_ld(&bar[XB_TMO])) break; if (sp > XB_SPIN_CAP) { atomicAdd(&bar[XB_TMO], 1u); break; } }
    }
    nloc = mine > 0u ? mine : 1u; nx = cnt > 0u ? cnt : 1u;
}

__device__ __forceinline__ void xcd_barrier(const XcdBarrier& b) {
    asm volatile("s_waitcnt vmcnt(0)" ::: "memory");
    __syncthreads();
    if (b.wave == 0 && lane_now() == 0) {
        unsigned* bar = b.bar;
        __builtin_amdgcn_s_waitcnt(0);
        unsigned nloc = b.st[0], nx = b.st[1];
        if (nloc == 0u) { xcd_barrier_complete(bar, b.x, nloc, nx); b.st[0] = nloc; b.st[1] = nx; }
        const unsigned old = xb_add(&bar[XB_XSUB(b.x)], 1u);
        const unsigned gen = old / nloc;
        if (old + 1u == (gen + 1u) * nloc) {
            __builtin_amdgcn_fence(__ATOMIC_RELEASE, "agent");
            asm volatile("s_waitcnt vmcnt(0)" ::: "memory");
            const unsigned og = xb_add(&bar[XB_TOP], 1u);
            const unsigned tg = og / nx;
            if (og + 1u == (tg + 1u) * nx) xb_add(&bar[XB_TOPGEN], 1u);
            else XB_SPIN(xb_ld(&bar[XB_TOPGEN]) == tg, bar);
            __builtin_amdgcn_fence(__ATOMIC_ACQUIRE, "agent");
            xb_add(&bar[XB_XGEN(b.x)], 1u);
            asm volatile("s_waitcnt vmcnt(0)" ::: "memory");
        } else {
            XB_SPIN(xb_ld(&bar[XB_XGEN(b.x)]) == gen, bar);
            __builtin_amdgcn_fence(__ATOMIC_ACQUIRE, "agent");
            asm volatile("s_waitcnt vmcnt(0)" ::: "memory");
        }
    }
    __syncthreads();
}
constexpr int NSG_C = 64;
struct Frame {
    LAS unsigned char* lds;
    volatile LAS unsigned* MISC;
    gu32* ctl;
    int wave;
    int vcu, G;
    unsigned lbn;
    int sidx, pidx;
    const float* in[21]; float* out; unsigned char* ws;
};
__device__ __forceinline__ float wave_sum(float v) {
#pragma unroll
    for (int o = 1; o < 64; o <<= 1) v += __shfl_xor(v, o);
    return v;
}
__device__ __forceinline__ bf16* wsb(Frame& F, size_t off) { return (bf16*)(F.ws + off); }
__device__ __forceinline__ bf16* wlayer(Frame& F, int li, size_t off) { return (bf16*)(F.ws + WS_W + (size_t)li * W_LAYER + off); }

__device__ __forceinline__ int map_row(int kind, int n0) {
    if (kind == 1) { const int bj = n0 / DFF, rem = n0 - bj * DFF; return (rem >> 7) * 256 + bj * 128 + (rem & 127); }
    if (kind == 2) {
        if (n0 < 2048) return (n0 & ~255) + ((n0 >> 5) & 1) * 128 + ((n0 >> 6) & 3) * 32;
        if (n0 >= 3584 && n0 < 4608) { const int x = n0 >= 4096, j = n0 - (x ? 4096 : 3584); return 3584 + (j >> 7) * 256 + x * 128 + (j & 127); }
        return n0; }
    return n0;
}
__device__ __forceinline__ void p0_transpose_item(const float* W, int N, bf16* WT, int ldk, int kind, LAS float* scr, int item, int lane) {
    const int nblk = N / 32, kb = item / nblk, nb = item % nblk, k0 = 64 * kb, n0 = 32 * nb;
#pragma unroll 8
    for (int i = 0; i < 32; ++i) { const int kk = 2 * i + (lane >> 5); scr[kk * 33 + (lane & 31)] = W[(size_t)(k0 + kk) * N + n0 + (lane & 31)]; }
    LDS_WAIT(); asm volatile("" ::: "memory");
    const int c = lane & 7; const int r0 = map_row(kind, n0);
#pragma unroll
    for (int j = 0; j < 4; ++j) { const int n = (lane >> 3) + 8 * j; const LAS float* s = scr + (8 * c) * 33 + n;
        v4u o; o.x = pk2(s[0 * 33], s[1 * 33]); o.y = pk2(s[2 * 33], s[3 * 33]); o.z = pk2(s[4 * 33], s[5 * 33]); o.w = pk2(s[6 * 33], s[7 * 33]);
        *(GAS v4u*)(WT + (size_t)(r0 + n) * ldk + k0 + 8 * c) = o; }
    LDS_WAIT(); asm volatile("" ::: "memory");
}
__device__ __forceinline__ void p0_weff_item(const float* pool_w, const float* pool_scale, const float* wbr, bf16* WT, int item, int lane) {
    const int kb = item >> 4, nb = item & 15, k0 = kb * 8, g = k0 >> 7, c0 = k0 & 127, n = nb * 64 + lane;
    float acc[8];
#pragma unroll
    for (int i = 0; i < 8; ++i) acc[i] = 0.f;
    const float* pw = pool_w + ((size_t)g * 128 + c0) * 128; const float* ps = pool_scale + g * 128; const float* wb = wbr + (size_t)(1536 + g * 128) * D + n;
    for (int dd = 0; dd < 128; ++dd) { const float w = wb[(size_t)dd * D] * ps[dd];
#pragma unroll
        for (int i = 0; i < 8; ++i) acc[i] += pw[i * 128 + dd] * w; }
    v4u o; o.x = pk2(acc[0], acc[1]); o.y = pk2(acc[2], acc[3]); o.z = pk2(acc[4], acc[5]); o.w = pk2(acc[6], acc[7]);
    *(GAS v4u*)(WT + (size_t)n * KBR + 1536 + k0) = o;
}
__device__ __forceinline__ void norm_row(int lane, const float* yrow, const float* hin, float coef, const float* ga, float* hout, const float* gb, bf16* xnrow) {
    const GAS f32x4* hr = (const GAS f32x4*)hin + lane;
    f32x4 h[4];
#pragma unroll
    for (int j = 0; j < 4; ++j) h[j] = hr[64 * j];
    if (yrow) {
        const GAS f32x4* yr = (const GAS f32x4*)yrow + lane; f32x4 y[4]; float s = 0.f;
#pragma unroll
        for (int j = 0; j < 4; ++j) { y[j] = yr[64 * j]; s += (y[j].x * y[j].x + y[j].y * y[j].y) + (y[j].z * y[j].z + y[j].w * y[j].w); }
        const float r = coef * __builtin_amdgcn_rsqf(wave_sum(s) * (1.f / D) + RMS_EPS);
#pragma unroll
        for (int j = 0; j < 4; ++j) { const f32x4 g = ((const GAS f32x4*)ga + lane)[64 * j]; h[j] = h[j] + y[j] * r * g; }
    }
    GAS f32x4* ho = (GAS f32x4*)hout + lane;
#pragma unroll
    for (int j = 0; j < 4; ++j) ho[64 * j] = h[j];
    if (xnrow) {
        float s2 = 0.f;
#pragma unroll
        for (int j = 0; j < 4; ++j) s2 += (h[j].x * h[j].x + h[j].y * h[j].y) + (h[j].z * h[j].z + h[j].w * h[j].w);
        const float r2 = __builtin_amdgcn_rsqf(wave_sum(s2) * (1.f / D) + RMS_EPS);
        GAS unsigned long long* o8 = (GAS unsigned long long*)xnrow + lane;
#pragma unroll
        for (int j = 0; j < 4; ++j) { const f32x4 g = ((const GAS f32x4*)gb + lane)[64 * j]; const f32x4 v = h[j] * r2 * g;
            o8[64 * j] = (unsigned long long)pk2(v.x, v.y) | ((unsigned long long)pk2(v.z, v.w) << 32); }
    }
}
__device__ __forceinline__ void rope_entry(int pos, int d, float& c, float& s) {
    double inv = 1.0; for (int i = 0; i < d; ++i) inv *= 0.7498942093324559;
    const float ang = (float)pos * (float)inv; const double a = (double)ang;
    const double q = __builtin_rint(a * 0.6366197723675814);
    double y = __builtin_fma(-q, 1.5707963267948966, a); y = __builtin_fma(-q, 6.123233995736766e-17, y);
    const double y2 = y * y;
    const double sp = y * (1.0 + y2 * (-1.0 / 6.0 + y2 * (1.0 / 120.0 + y2 * (-1.0 / 5040.0 + y2 * (1.0 / 362880.0 + y2 * (-1.0 / 39916800.0 + y2 * (1.0 / 6227020800.0)))))));
    const double cp = 1.0 + y2 * (-0.5 + y2 * (1.0 / 24.0 + y2 * (-1.0 / 720.0 + y2 * (1.0 / 40320.0 + y2 * (-1.0 / 3628800.0 + y2 * (1.0 / 479001600.0 + y2 * (-1.0 / 87178291200.0)))))));
    const int qi = ((int)q) & 3;
    const double sv = (qi == 0) ? sp : (qi == 1) ? cp : (qi == 2) ? -sp : -cp;
    const double cv = (qi == 0) ? cp : (qi == 1) ? -sp : (qi == 2) ? -cp : sp;
    c = (float)cv; s = (float)sv;
}
struct RowRegs { f32x4 y[4], h[4]; };
typedef unsigned u32x2r __attribute__((ext_vector_type(2)));
__device__ __forceinline__ f32x4 bf4_to_f32(const u32x2r w) { return (f32x4){__uint_as_float(w.x << 16), __uint_as_float(w.x & 0xffff0000u), __uint_as_float(w.y << 16), __uint_as_float(w.y & 0xffff0000u)}; }
__device__ __forceinline__ void row_load(int lane, const bf16* Y, const bf16* H, int m, RowRegs& R) {
    const GAS u32x2r* yr = (const GAS u32x2r*)(Y + (size_t)m * D) + lane; const GAS u32x2r* hr = (const GAS u32x2r*)(H + (size_t)m * D) + lane;
    u32x2r yw[4], hw[4];
#pragma unroll
    for (int j = 0; j < 4; ++j) { yw[j] = yr[64 * j]; hw[j] = hr[64 * j]; }
#pragma unroll
    for (int j = 0; j < 4; ++j) { R.y[j] = bf4_to_f32(yw[j]); R.h[j] = bf4_to_f32(hw[j]); }
}
__device__ __forceinline__ void row_finish(int lane, RowRegs& R, float coef, const f32x4 (&ga)[4], const f32x4 (&gb)[4], bf16* H, bf16* XN, int m, bool write_xn, float* fin) {
    float s = 0.f;
#pragma unroll
    for (int j = 0; j < 4; ++j) s += (R.y[j].x * R.y[j].x + R.y[j].y * R.y[j].y) + (R.y[j].z * R.y[j].z + R.y[j].w * R.y[j].w);
    const float r = coef * __builtin_amdgcn_rsqf(wave_sum(s) * (1.f / D) + RMS_EPS);
    GAS unsigned long long* hb = (GAS unsigned long long*)(H + (size_t)m * D) + lane; GAS f32x4* ho = (GAS f32x4*)(fin + (size_t)m * D) + lane; float s2 = 0.f;
#pragma unroll
    for (int j = 0; j < 4; ++j) { R.h[j] = R.h[j] + R.y[j] * r * ga[j]; if (fin) ho[64 * j] = R.h[j]; else hb[64 * j] = (unsigned long long)pk2(R.h[j].x, R.h[j].y) | ((unsigned long long)pk2(R.h[j].z, R.h[j].w) << 32); s2 += (R.h[j].x * R.h[j].x + R.h[j].y * R.h[j].y) + (R.h[j].z * R.h[j].z + R.h[j].w * R.h[j].w); }
    if (write_xn) {
        const float r2 = __builtin_amdgcn_rsqf(wave_sum(s2) * (1.f / D) + RMS_EPS);
        GAS unsigned long long* o8 = (GAS unsigned long long*)(XN + (size_t)m * D) + lane;
#pragma unroll
        for (int j = 0; j < 4; ++j) { const f32x4 v = R.h[j] * r2 * gb[j]; o8[64 * j] = (unsigned long long)pk2(v.x, v.y) | ((unsigned long long)pk2(v.z, v.w) << 32); }
    }
}
__device__ __forceinline__ void norm_phase(Frame& F, float coef, const float* ga_, const float* gb_, bool write_xn, int m0, int m1, int gw, int NGW, bool dry = false, bool final_ = false) {
    const bf16* Y = (const bf16*)(F.ws + WS_YB); bf16* XN = dry ? (bf16*)(F.ws + WS_DUMMY + 160 * MiB) : wsb(F, WS_XN); const bf16* H = wsb(F, WS_HB); bf16* HO = dry ? (bf16*)(F.ws + WS_DUMMY) : wsb(F, WS_HB);
    float* fin = (final_ && !dry) ? F.out : nullptr;
    const int lane = lane_now();
    f32x4 ga[4], gb[4];
#pragma unroll
    for (int j = 0; j < 4; ++j) { ga[j] = ((const GAS f32x4*)ga_ + lane)[64 * j]; gb[j] = write_xn ? ((const GAS f32x4*)gb_ + lane)[64 * j] : (f32x4){0.f, 0.f, 0.f, 0.f}; }
    for (int m = m0 + gw; m < m1; m += 4 * NGW) {
        const int mb = m + NGW, mc = m + 2 * NGW, md = m + 3 * NGW; const bool hasb = mb < m1, hasc = mc < m1, hasd = md < m1;
        RowRegs A, B, C, E; row_load(lane, Y, H, m, A); if (hasb) row_load(lane, Y, H, mb, B); if (hasc) row_load(lane, Y, H, mc, C); if (hasd) row_load(lane, Y, H, md, E);
        row_finish(lane, A, coef, ga, gb, HO, XN, m, write_xn, fin);
        if (hasb) row_finish(lane, B, coef, ga, gb, HO, XN, mb, write_xn, fin);
        if (hasc) row_finish(lane, C, coef, ga, gb, HO, XN, mc, write_xn, fin);
        if (hasd) row_finish(lane, E, coef, ga, gb, HO, XN, md, write_xn, fin);
    }
}
__device__ __forceinline__ void norm_phase_sample(Frame& F, float coef, const float* ga_, const float* gb_, bool write_xn, const float* ysrc, int nslab, bool final_ = false) {
    const int lane = lane_now(); bf16* XN = wsb(F, WS_XN); bf16* H = wsb(F, WS_HB); float* fin = final_ ? F.out : nullptr;
    f32x4 ga[4], gb[4];
#pragma unroll
    for (int j = 0; j < 4; ++j) { ga[j] = ((const GAS f32x4*)ga_ + lane)[64 * j]; gb[j] = write_xn ? ((const GAS f32x4*)gb_ + lane)[64 * j] : (f32x4){0.f, 0.f, 0.f, 0.f}; }
    for (int r = F.sidx * NWAVES + F.wave; r < MS; r += NSG_C * NWAVES) {
        RowRegs A; const int m = MP + r;
        const GAS u32x2r* hr = (const GAS u32x2r*)(H + (size_t)m * D) + lane;
#pragma unroll
        for (int j = 0; j < 4; ++j) { A.h[j] = bf4_to_f32(hr[64 * j]); A.y[j] = (f32x4){0.f, 0.f, 0.f, 0.f}; }
        for (int sl = 0; sl < nslab; ++sl) { const GAS f32x4* yr = (const GAS f32x4*)(ysrc + (size_t)sl * MS * D + (size_t)r * D) + lane;
#pragma unroll
            for (int j = 0; j < 4; ++j) A.y[j] = A.y[j] + yr[64 * j]; }
        if (nslab == 0) { const GAS u32x2r* yr = (const GAS u32x2r*)((const bf16*)(F.ws + WS_YB) + (size_t)m * D) + lane;
#pragma unroll
            for (int j = 0; j < 4; ++j) A.y[j] = bf4_to_f32(yr[64 * j]); }
        row_finish(lane, A, coef, ga, gb, H, XN, m, write_xn, fin);
    }
}
__device__ __forceinline__ void p0_layer(Frame& F, const int li, const int gw, const int NGW, const int parts = 31) {
    LAS float* scr = (LAS float*)(F.lds + RING_OFF + F.wave * 16384);
    const int lane = lane_now();
    for (int f = 0; f < 2; ++f) {
        if (parts & 1) { const float* wu = F.in[9] + (size_t)(li * 2 + f) * D * NUP; bf16* du = wlayer(F, li, f ? W_UP2 : W_UP1);
            for (int it = gw; it < (D / 64) * (NUP / 32); it += NGW) p0_transpose_item(wu, NUP, du, D, 1, scr, it, lane); }
        if (parts & 2) { const float* wd = F.in[10] + (size_t)(li * 2 + f) * DFF * D; bf16* dd = wlayer(F, li, f ? W_DN2 : W_DN1);
            for (int it = gw; it < (DFF / 64) * (D / 32); it += NGW) p0_transpose_item(wd, D, dd, DFF, 0, scr, it, lane); }
    }
    if (parts & 4) for (int it = gw; it < (D / 64) * (NIN / 32); it += NGW) p0_transpose_item(F.in[11] + (size_t)li * D * NIN, NIN, wlayer(F, li, W_IN), D, 2, scr, it, lane);
    if (parts & 8) {
        for (int it = gw; it < (1536 / 64) * (D / 32); it += NGW) p0_transpose_item(F.in[17] + (size_t)li * KBR * D, D, wlayer(F, li, W_BR), KBR, 0, scr, it, lane);
        for (int it = gw; it < (D / 64) * (D / 32); it += NGW) p0_transpose_item(F.in[18] + (size_t)li * D * D, D, wlayer(F, li, W_OUT), D, 0, scr, it, lane);
        for (int it = gw; it < (D / 64) * (D / 32); it += NGW) p0_transpose_item(F.in[20] + (size_t)li * D * D, D, wlayer(F, li, W_PG), D, 0, scr, it, lane);
        for (int it = gw; it < (PLE / 64) * (D / 32); it += NGW) p0_transpose_item(F.in[19] + (size_t)li * PLE * D, D, wlayer(F, li, W_PU), PLE, 0, scr, it, lane);
        for (int it = gw; it < 64 * 16; it += NGW) p0_weff_item(F.in[15] + (size_t)li * 4 * 128 * 128, F.in[16] + (size_t)li * 512, F.in[17] + (size_t)li * KBR * D, wlayer(F, li, W_BR), it, lane);
    }
    if (parts & 16) { bf16* pb = (bf16*)(F.ws + WS_PB + (size_t)li * PB_LAYER);
        for (int m = gw; m < M; m += NGW) { const float* src = m < MP ? F.in[6] + ((size_t)li * MP + m) * PLE : F.in[7] + ((size_t)li * MS + (m - MP)) * PLE;
            const f32x4 v = ((const GAS f32x4*)src)[lane]; ((GAS unsigned long long*)(pb + (size_t)m * PLE))[lane] = (unsigned long long)pk2(v.x, v.y) | ((unsigned long long)pk2(v.z, v.w) << 32); } }
}
__device__ __forceinline__ void p0_prologue(Frame& F) {
    const int gw = F.vcu * NWAVES + F.wave, NGW = F.G * NWAVES; const int lane = lane_now();
    p0_layer(F, 0, gw, NGW);
    { float* rc = (float*)(F.ws + WS_ROPEC); float* rs = (float*)(F.ws + WS_ROPES);
      for (int i = gw * 64 + lane; i < SEQ * 32; i += NGW * 64) { float c, s; rope_entry(i >> 5, i & 31, c, s); rc[i] = c; rs[i] = s; } }
    bf16* XN = wsb(F, WS_XN); bf16* HB = wsb(F, WS_HB);
    for (int m = gw; m < M; m += NGW) { const float* xr = m < MP ? F.in[0] + (size_t)m * D : F.in[1] + (size_t)(m - MP) * D;
        const GAS f32x4* xp = (const GAS f32x4*)xr + lane; f32x4 h[4]; float s2 = 0.f;
#pragma unroll
        for (int j = 0; j < 4; ++j) { h[j] = xp[64 * j]; s2 += (h[j].x * h[j].x + h[j].y * h[j].y) + (h[j].z * h[j].z + h[j].w * h[j].w); }
        const float r2 = __builtin_amdgcn_rsqf(wave_sum(s2) * (1.f / D) + RMS_EPS);
        GAS unsigned long long* hb = (GAS unsigned long long*)(HB + (size_t)m * D) + lane; GAS unsigned long long* o8 = (GAS unsigned long long*)(XN + (size_t)m * D) + lane;
#pragma unroll
        for (int j = 0; j < 4; ++j) { hb[64 * j] = (unsigned long long)pk2(h[j].x, h[j].y) | ((unsigned long long)pk2(h[j].z, h[j].w) << 32);
            const f32x4 g = ((const GAS f32x4*)F.in[8] + lane)[64 * j]; const f32x4 v = h[j] * r2 * g; o8[64 * j] = (unsigned long long)pk2(v.x, v.y) | ((unsigned long long)pk2(v.z, v.w) << 32); } }
}
__device__ __forceinline__ void unpack8f(const v4u w, float (&f)[8]) {
    f[0] = __uint_as_float(w.x << 16); f[1] = __uint_as_float(w.x & 0xffff0000u); f[2] = __uint_as_float(w.y << 16); f[3] = __uint_as_float(w.y & 0xffff0000u);
    f[4] = __uint_as_float(w.z << 16); f[5] = __uint_as_float(w.z & 0xffff0000u); f[6] = __uint_as_float(w.w << 16); f[7] = __uint_as_float(w.w & 0xffff0000u); }
__device__ __forceinline__ v4u pack8f(const float (&f)[8]) { v4u o; o.x = pk2(f[0], f[1]); o.y = pk2(f[2], f[3]); o.z = pk2(f[4], f[5]); o.w = pk2(f[6], f[7]); return o; }
__device__ __forceinline__ void e2_phase(Frame& F, int li, int m0, int m1, int gw, int NGW) {
    const int lane = lane_now();
    const float* lam = F.in[12] + li * 256;
    const float s1 = wave_sum(lam[lane] * lam[64 + lane]), s2 = wave_sum(lam[128 + lane] * lam[192 + lane]);
    const float lam_init = 0.8f - 0.6f * __expf(-0.3f * (float)li);
    const float lam_full = __expf(s1) - __expf(s2) + lam_init, osc = 1.0f - lam_init;
    const bf16* O = wsb(F, WS_O); const bf16* BG = wsb(F, WS_BG); const bf16* C = wsb(F, WS_C); const bf16* ZP = wsb(F, WS_ZP); bf16* A2 = wsb(F, WS_A2);
    const int hh = lane >> 3, e0 = (lane & 7) * 16, c0 = lane * 8, grp = lane >> 4, win = 2 << grp;
    float sg[16];
#pragma unroll
    for (int i = 0; i < 16; ++i) sg[i] = F.in[13][li * 1024 + hh * 128 + e0 + i];
    float cw[3][8];
#pragma unroll
    for (int j = 0; j < 3; ++j)
#pragma unroll
        for (int i = 0; i < 8; ++i) cw[j][i] = F.in[14][(li * 3 + j) * 512 + c0 + i];
    for (int m = m0 + gw; m < m1; m += NGW) {
        const bool samp = m >= MP; const int t = samp ? ((m - MP) & 31) : (m & (SEQ - 1)); const int b = samp ? ((m - MP) >> 5) : (m >> 14); const int T = samp ? DSEQ : SEQ;
        { const bf16* orow = O + (size_t)m * 2048 + hh * 256 + e0;
          float o1[16], o2[16]; { float t8[8]; unpack8f(*(const GAS v4u*)orow, t8); for (int i = 0; i < 8; ++i) o1[i] = t8[i]; unpack8f(*(const GAS v4u*)(orow + 8), t8); for (int i = 0; i < 8; ++i) o1[8 + i] = t8[i];
              unpack8f(*(const GAS v4u*)(orow + 128), t8); for (int i = 0; i < 8; ++i) o2[i] = t8[i]; unpack8f(*(const GAS v4u*)(orow + 136), t8); for (int i = 0; i < 8; ++i) o2[8 + i] = t8[i]; }
          float ss = 0.f;
#pragma unroll
          for (int i = 0; i < 16; ++i) { o1[i] = o1[i] - lam_full * o2[i]; ss += o1[i] * o1[i]; }
          ss += __shfl_xor(ss, 1); ss += __shfl_xor(ss, 2); ss += __shfl_xor(ss, 4);
          const float r = __builtin_amdgcn_rsqf(ss * (1.f / 128.f) + RMS_EPS) * osc;
          float a0[8], a1[8];
#pragma unroll
          for (int i = 0; i < 8; ++i) { a0[i] = o1[i] * r * sg[i]; a1[i] = o1[8 + i] * r * sg[8 + i]; }
          bf16* arow = A2 + (size_t)m * KBR + hh * 128 + e0; *(GAS v4u*)arow = pack8f(a0); *(GAS v4u*)(arow + 8) = pack8f(a1); }
        { float z0[8], z1[8], z2[8], bgv[8];
          unpack8f(*(const GAS v4u*)(C + (size_t)m * 512 + c0), z0); unpack8f(*(const GAS v4u*)(BG + (size_t)m * 512 + c0), bgv);
          const float* hist = F.in[4] + ((size_t)(li * DB + b) * 2) * 512 + c0;
          if (t >= 1) unpack8f(*(const GAS v4u*)(C + (size_t)(m - 1) * 512 + c0), z1);
          else { for (int i = 0; i < 8; ++i) z1[i] = samp ? hist[512 + i] : 0.f; }
          if (t >= 2) unpack8f(*(const GAS v4u*)(C + (size_t)(m - 2) * 512 + c0), z2);
          else { for (int i = 0; i < 8; ++i) z2[i] = samp ? hist[t * 512 + i] : 0.f; }
          float y[8];
#pragma unroll
          for (int i = 0; i < 8; ++i) y[i] = bgv[i] * (cw[0][i] * z2[i] + cw[1][i] * z1[i] + cw[2][i] * z0[i]);
          *(GAS v4u*)(A2 + (size_t)m * KBR + 1024 + c0) = pack8f(y);
          if (t >= T - 2) { float* dst = samp ? F.out + O_CS + ((size_t)(li * DB + b) * 2 + (t - (T - 2))) * 512 + c0 : F.out + O_CP + ((size_t)(li * 2 + b) * 2 + (t - (T - 2))) * 512 + c0;
              *(GAS f32x4*)dst = (f32x4){z0[0], z0[1], z0[2], z0[3]}; *(GAS f32x4*)(dst + 4) = (f32x4){z0[4], z0[5], z0[6], z0[7]}; } }
        { float zc[8], ws8[8]; unpack8f(*(const GAS v4u*)(ZP + (size_t)m * 512 + c0), zc);
#pragma unroll
          for (int i = 0; i < 8; ++i) ws8[i] = zc[i];
          if (t >= 15) {
              v4u zr[15];
#pragma unroll
              for (int j = 1; j < 16; ++j) { const int jj = j < win ? j : win - 1; zr[j - 1] = *(const GAS v4u*)(ZP + (size_t)(m - jj) * 512 + c0); }
#pragma unroll
              for (int j = 1; j < 16; ++j) { float zz[8]; unpack8f(zr[j - 1], zz); const float wj = j < win ? 1.f : 0.f;
#pragma unroll
                  for (int q = 0; q < 8; ++q) ws8[q] += wj * zz[q]; }
          } else {
          const float* phist = F.in[5] + ((size_t)(li * DB + b) * 15) * 512 + c0;
          for (int j = 1; j < 16; ++j) { if (j < win) { const int i = t - j;
                  if (i >= 0) { float zz[8]; unpack8f(*(const GAS v4u*)(ZP + (size_t)(m - j) * 512 + c0), zz);
#pragma unroll
                      for (int q = 0; q < 8; ++q) ws8[q] += zz[q]; }
                  else if (samp) { const float* hp = phist + (size_t)(15 + i) * 512;
#pragma unroll
                      for (int q = 0; q < 8; ++q) ws8[q] += hp[q]; } } }
          }
          const int cnt = min(t + 1 + (samp ? 15 : 0), win); const float rc = 1.0f / (float)cnt;
          float dv[8];
#pragma unroll
          for (int i = 0; i < 8; ++i) dv[i] = ws8[i] * rc - zc[i];
          *(GAS v4u*)(A2 + (size_t)m * KBR + 1536 + c0) = pack8f(dv);
          if (t >= T - 15) { float* dst = samp ? F.out + O_PS + ((size_t)(li * DB + b) * 15 + (t - (T - 15))) * 512 + c0 : F.out + O_PP + ((size_t)(li * 2 + b) * 15 + (t - (T - 15))) * 512 + c0;
              *(GAS f32x4*)dst = (f32x4){zc[0], zc[1], zc[2], zc[3]}; *(GAS f32x4*)(dst + 4) = (f32x4){zc[4], zc[5], zc[6], zc[7]}; } }
    }
}
typedef float f32x16 __attribute__((ext_vector_type(16)));
__device__ __forceinline__ bf16x8 cvt8(const f32x4 a, const f32x4 b) { v4u w; w.x = pk2(a.x, a.y); w.y = pk2(a.z, a.w); w.z = pk2(b.x, b.y); w.w = pk2(b.z, b.w); return __builtin_bit_cast(bf16x8, w); }
__device__ __forceinline__ int crow16(int r, int hi) { return (r & 3) + 8 * (r >> 2) + 4 * hi; }
__device__ __forceinline__ void sattn_unit(Frame& F, int li, int b, int head) {
    const int lane = lane_now(), wid = F.wave, r32 = lane & 31, hi = lane >> 5;
    LAS float* Lmx = (LAS float*)(F.lds + LDSCTL_OFF + 1024);
    LAS float* Lsum = (LAS float*)(F.lds + LDSCTL_OFF + 3072);
    const bf16* Qs = wsb(F, WS_Q) + (size_t)(MP + b * DSEQ) * D;
    const float* kc = F.in[2] + ((size_t)(li * DB + b) * PAST) * D; const float* vc = F.in[3] + ((size_t)(li * DB + b) * PAST) * D;
    const float* kn = F.out + O_KS + ((size_t)li * MS + b * DSEQ) * D; const float* vn = F.out + O_VS + ((size_t)li * MS + b * DSEQ) * D;
    bf16x8 qr[2][4];
#pragma unroll
    for (int mm = 0; mm < 2; ++mm)
#pragma unroll
        for (int d0 = 0; d0 < 4; ++d0) qr[mm][d0] = *(const GAS bf16x8*)(Qs + (size_t)r32 * D + (2 * head + mm) * 64 + d0 * 16 + hi * 8);
    const int nblk = (wid == 0) ? 5 : 4;
    f32x16 o[2][4];
#pragma unroll
    for (int mm = 0; mm < 2; ++mm)
#pragma unroll
        for (int eb = 0; eb < 4; ++eb) o[mm][eb] = (f32x16){};
    float lsum[2] = {0.f, 0.f}, mrun[2] = {-1e30f, -1e30f};
    for (int i = 0; i < nblk; ++i) { const int blk = (i < 4) ? wid + 8 * i : 32; const float* kb = (blk < 32) ? kc + (size_t)(blk * 32) * D : kn; const float* vb = (blk < 32) ? vc + (size_t)(blk * 32) * D : vn;
        f32x16 s[2];
#pragma unroll
        for (int mm = 0; mm < 2; ++mm) { s[mm] = (f32x16){};
#pragma unroll
            for (int d0 = 0; d0 < 4; ++d0) { const float* kp = kb + (size_t)r32 * D + (2 * head + mm) * 64 + d0 * 16 + hi * 8; const bf16x8 kf = cvt8(*(const GAS f32x4*)kp, *(const GAS f32x4*)(kp + 4));
                s[mm] = __builtin_amdgcn_mfma_f32_32x32x16_bf16(kf, qr[mm][d0], s[mm], 0, 0, 0); } }
        bf16x8 pf[2][2];
#pragma unroll
        for (int mm = 0; mm < 2; ++mm) {
            float mloc = s[mm][0];
#pragma unroll
            for (int r = 1; r < 16; ++r) mloc = fmaxf(mloc, s[mm][r]);
            mloc = fmaxf(mloc, __shfl_xor(mloc, 32));
            const float mnew = fmaxf(mrun[mm], mloc), sc = __builtin_amdgcn_exp2f(mrun[mm] - mnew); mrun[mm] = mnew;
            lsum[mm] *= sc;
#pragma unroll
            for (int eb = 0; eb < 4; ++eb)
#pragma unroll
                for (int r = 0; r < 16; ++r) o[mm][eb][r] *= sc;
            float acc = 0.f;
#pragma unroll
            for (int r = 0; r < 16; ++r) { s[mm][r] = __builtin_amdgcn_exp2f(s[mm][r] - mnew); acc += s[mm][r]; }
            lsum[mm] += acc;
#pragma unroll
            for (int k2 = 0; k2 < 2; ++k2) pf[mm][k2] = cvt8((f32x4){s[mm][8 * k2], s[mm][8 * k2 + 1], s[mm][8 * k2 + 2], s[mm][8 * k2 + 3]}, (f32x4){s[mm][8 * k2 + 4], s[mm][8 * k2 + 5], s[mm][8 * k2 + 6], s[mm][8 * k2 + 7]}); }
#pragma unroll
        for (int eb = 0; eb < 4; ++eb)
#pragma unroll
            for (int k2 = 0; k2 < 2; ++k2) { const float* vp = vb + (size_t)(16 * k2 + 4 * hi) * D + head * 128 + eb * 32 + r32;
                const f32x4 va = {vp[0], vp[D], vp[2 * D], vp[3 * D]}, vb4 = {vp[8 * D], vp[9 * D], vp[10 * D], vp[11 * D]}; const bf16x8 vf = cvt8(va, vb4);
                o[0][eb] = __builtin_amdgcn_mfma_f32_32x32x16_bf16(vf, pf[0][k2], o[0][eb], 0, 0, 0); o[1][eb] = __builtin_amdgcn_mfma_f32_32x32x16_bf16(vf, pf[1][k2], o[1][eb], 0, 0, 0); } }
#pragma unroll
    for (int mm = 0; mm < 2; ++mm) { lsum[mm] += __shfl_xor(lsum[mm], 32); if (hi == 0) { Lmx[(mm * 8 + wid) * 32 + r32] = mrun[mm]; Lsum[(mm * 8 + wid) * 32 + r32] = lsum[mm]; } }
    __syncthreads();
#pragma unroll
    for (int mm = 0; mm < 2; ++mm) { float M = Lmx[(mm * 8) * 32 + r32];
#pragma unroll
        for (int w = 1; w < 8; ++w) M = fmaxf(M, Lmx[(mm * 8 + w) * 32 + r32]);
        const float f = __builtin_amdgcn_exp2f(mrun[mm] - M);
#pragma unroll
        for (int eb = 0; eb < 4; ++eb)
#pragma unroll
            for (int r = 0; r < 16; ++r) o[mm][eb][r] *= f; }
    LAS float* Lw = (LAS float*)(F.lds + RING_OFF) + wid * 4096;
#pragma unroll
    for (int mm = 0; mm < 2; ++mm) {
        __syncthreads();
#pragma unroll
        for (int eb = 0; eb < 4; ++eb)
#pragma unroll
            for (int r = 0; r < 16; ++r) Lw[(eb * 32 + crow16(r, hi)) * 32 + r32] = o[mm][eb][r];
        __syncthreads();
        { const int q = lane & 31, e0 = (wid * 2 + (lane >> 5)) * 8; float L = 0.f;
          float Mq = Lmx[(mm * 8) * 32 + q];
#pragma unroll
          for (int w = 1; w < 8; ++w) Mq = fmaxf(Mq, Lmx[(mm * 8 + w) * 32 + q]);
#pragma unroll
          for (int w = 0; w < 8; ++w) L += Lsum[(mm * 8 + w) * 32 + q] * __builtin_amdgcn_exp2f(Lmx[(mm * 8 + w) * 32 + q] - Mq);
          const float inv = 1.0f / L; float v[8];
#pragma unroll
          for (int i = 0; i < 8; ++i) { float a = 0.f;
#pragma unroll
              for (int w = 0; w < 8; ++w) a += ((LAS float*)(F.lds + RING_OFF))[w * 4096 + (e0 + i) * 32 + q];
              v[i] = a * inv; }
          bf16* orow = wsb(F, WS_O) + (size_t)(MP + b * DSEQ + q) * 2048 + (2 * head + mm) * 128 + e0; *(GAS v4u*)orow = pack8f(v); }
    }
    __syncthreads();
}
#ifndef KEEP_UP
#define KEEP_UP 1
#endif
#ifndef KEEP_DOWN
#define KEEP_DOWN 1
#endif
#ifndef KEEP_N1
#define KEEP_N1 1
#endif
#ifndef KEEP_WIN
#define KEEP_WIN 1
#endif
#ifndef KEEP_ATT
#define KEEP_ATT 1
#endif
#ifndef KEEP_E2
#define KEEP_E2 1
#endif
#ifndef KEEP_BR
#define KEEP_BR 1
#endif
#ifndef KEEP_WOUT
#define KEEP_WOUT 1
#endif
#ifndef KEEP_N3
#define KEEP_N3 1
#endif
#ifndef KEEP_PG
#define KEEP_PG 1
#endif
#ifndef KEEP_N5
#define KEEP_N5 1
#endif
#ifndef KEEP_PRO
#define KEEP_PRO 1
#endif
struct Args { const float* in[21]; float* out; unsigned char* ws; int ph_lo, ph_hi; };
#if !MK_PER_PHASE
#define GRID_BAR() do { for (int rb_ = 0; rb_ < REP_BAR; ++rb_) xcd_barrier(bar); } while (0)
#else
#define GRID_BAR() do { if (F.wave == 0 && lane_now() == 0) __hip_atomic_store(F.ctl + CW_TMO, 0xBADBA0u, RLX_AGENT); } while (0)
#endif
#define IN(k) (lo <= (k) && (k) < hi)
#define SEAM(k) do { if (IN(k) && IN((k) + 1)) GRID_BAR(); } while (0)
__device__ __forceinline__ unsigned long long uni64_opaque(unsigned long long v) { unsigned lo = __builtin_amdgcn_readfirstlane((unsigned)v), hi = __builtin_amdgcn_readfirstlane((unsigned)(v >> 32)); asm volatile("" : "+s"(lo), "+s"(hi)); return ((unsigned long long)hi << 32) | lo; }
#define FRESH() do { F.ws = (unsigned char*)(GAS unsigned char*)uni64_opaque((unsigned long long)F.ws); F.out = (float*)(GAS float*)uni64_opaque((unsigned long long)F.out); } while (0)
#define RING (F.lds + RING_OFF)
constexpr int NSG = 64, NPG = 192;
constexpr int CW_GRP = 8192, CW_GRP_TMO = 8256;
constexpr int LB_PER_LAYER = 9;
__device__ __forceinline__ void group_barrier1(Frame& F, const unsigned n) {
    asm volatile("s_waitcnt vmcnt(0)" ::: "memory");
    __syncthreads();
    if (F.wave == 0 && lane_now() == 0) {
        __builtin_amdgcn_s_waitcnt(0);
        __builtin_amdgcn_fence(__ATOMIC_RELEASE, "agent");
        asm volatile("s_waitcnt vmcnt(0)" ::: "memory");
        gu32* c = F.ctl + CW_GRP; const unsigned target = (unsigned)NSG * (n + 1u);
        (void)__hip_atomic_fetch_add(c, 1u, RLX_AGENT);
        unsigned sp = 0u;
        while (__hip_atomic_load(c, RLX_AGENT) < target) { __builtin_amdgcn_s_sleep(1);
            if ((++sp & 255u) == 0u) { if (__hip_atomic_load(F.ctl + CW_GRP_TMO, RLX_AGENT)) break; if (sp > (1u << 20)) { __hip_atomic_store(F.ctl + CW_GRP_TMO, 1u, RLX_AGENT); break; } } }
        __builtin_amdgcn_fence(__ATOMIC_ACQUIRE, "agent");
        asm volatile("s_waitcnt vmcnt(0)" ::: "memory");
    }
    __syncthreads();
}
__device__ __forceinline__ void group_barrier(Frame& F) { for (unsigned r = 0; r < REP_LB; ++r) group_barrier1(F, F.lbn++); }
#define OPAQUE_K(name, val) int name = (val); asm volatile("" : "+s"(name))
#define SAMPLE (F.sidx >= 0)
template <int LI, int HALF> __device__ __forceinline__ void ffn_part(Frame& F, const XcdBarrier& bar, const int lo, const int hi) {
    constexpr int pb = 1 + LI * PH_PER_LAYER, p0 = pb + HALF * 9;
    if (KEEP_UP && IN(p0)) { FRESH(); pg8::Gemm g{wsb(F, WS_XN), wlayer(F, LI, HALF ? W_UP2 : W_UP1), MP, NUP, D}; pg8::StaticOrder S; S.init(MP, NUP, F.G, (int)blockIdx.x);
        pg8::EpiSwiGLU E{wsb(F, WS_HFF), DFF};
        for (int rep = 0; rep < REP_GEMM; ++rep) { if (rep && REP_GEMM_BAR) GRID_BAR(); pg8::gemm_phase<pg8::EpiSwiGLU, pg8::StaticOrder, true, true>(RING, g, S, E, F.wave); } SEAM(p0); }
    if (KEEP_DOWN && IN(p0 + 1)) { FRESH(); { pg8::Gemm g{wsb(F, WS_HFF), wlayer(F, LI, HALF ? W_DN2 : W_DN1), MP, D, DFF}; pg8::StaticOrder S; S.init(MP, D, F.G, (int)blockIdx.x);
        pg8::EpiBf E{wsb(F, WS_YB), D};
        for (int rep = 0; rep < REP_GEMM; ++rep) { if (rep && REP_GEMM_BAR) GRID_BAR(); pg8::gemm_phase<pg8::EpiBf, pg8::StaticOrder, true, true>(RING, g, S, E, F.wave); } } }
    if (KEEP_DOWN && IN(p0 + 1)) {
        if (HALF == 1) { FRESH(); OPAQUE_K(kple, PLE);
            pg8::Gemm g2{(const bf16*)(F.ws + WS_PB + (size_t)LI * PB_LAYER), wlayer(F, LI, W_PU), MP, D, kple}; pg8::StaticOrder S2; S2.init(MP, D, F.G, (int)blockIdx.x);
            pg8::EpiBf E2{wsb(F, WS_PU), D};
            for (int rep = 0; rep < REP_GEMM; ++rep) { if (rep && REP_GEMM_BAR) GRID_BAR(); pg8::gemm_phase<pg8::EpiBf, pg8::StaticOrder, true, true>(RING, g2, S2, E2, F.wave); } }
        SEAM(p0 + 1); }
    if (KEEP_N1 && IN(p0 + 2) && !SAMPLE) { FRESH(); const float* ng = F.in[8] + (size_t)LI * 8 * D; for (int rep = 0; rep < REP_ROW; ++rep) norm_phase(F, 0.5f, ng + (HALF ? 5 : 1) * D, ng + (HALF ? 6 : 2) * D, true, 0, MP, F.pidx * NWAVES + F.wave, NPG * NWAVES, rep + 1 < REP_ROW);
        if (HALF == 0 && LI + 1 < DEPTH) p0_layer(F, LI + 1 < DEPTH ? LI + 1 : LI, F.pidx * NWAVES + F.wave, NPG * NWAVES, 16); }
    if (KEEP_N1 && IN(p0 + 2) && SAMPLE && (HALF == 1 || LI == 0)) { FRESH(); OPAQUE_K(kd, D); pg8::Gemm g{wsb(F, WS_XN), wlayer(F, LI, HALF ? W_UP2 : W_UP1), M, NUP, kd}; pg8::SampleOrder S; S.init(NUP, NSG, F.sidx);
        pg8::EpiSwiGLU E{wsb(F, WS_HFF), DFF};
        for (int rs_ = 0; rs_ < REP_SG; ++rs_) pg8::gemm_phase<pg8::EpiSwiGLU, pg8::SampleOrder, true, true>(RING, g, S, E, F.wave); group_barrier(F); }
    if (KEEP_N1 && IN(p0 + 2) && SAMPLE) { FRESH(); OPAQUE_K(kf, DFF); pg8::Gemm g{wsb(F, WS_HFF), wlayer(F, LI, HALF ? W_DN2 : W_DN1), M, D, kf}; pg8::SampleSplitOrder S; S.init(D, NSG, F.sidx);
        pg8::EpiF32Slab E{(float*)(F.ws + WS_YS)};
        for (int rs_ = 0; rs_ < REP_SG; ++rs_) pg8::gemm_phase<pg8::EpiF32Slab, pg8::SampleSplitOrder, true, true>(RING, g, S, E, F.wave); }
    if (KEEP_N1 && IN(p0 + 2) && SAMPLE && HALF == 1) { FRESH(); OPAQUE_K(kple, PLE);
        pg8::Gemm g2{(const bf16*)(F.ws + WS_PB + (size_t)LI * PB_LAYER), wlayer(F, LI, W_PU), M, D, kple}; pg8::SampleOrder S2; S2.init(D, NSG, (F.sidx + NSG - 32) % NSG);
        pg8::EpiBf E2{wsb(F, WS_PU), D};
        for (int rs_ = 0; rs_ < REP_SG; ++rs_) pg8::gemm_phase<pg8::EpiBf, pg8::SampleOrder, true, true>(RING, g2, S2, E2, F.wave); }
    if (KEEP_N1 && IN(p0 + 2) && SAMPLE) { FRESH(); group_barrier(F); const float* ng = F.in[8] + (size_t)LI * 8 * D;
        norm_phase_sample(F, 0.5f, ng + (HALF ? 5 : 1) * D, ng + (HALF ? 6 : 2) * D, true, (const float*)(F.ws + WS_YS), 4); }
    if (KEEP_N1 && IN(p0 + 2) && SAMPLE && HALF == 0) { FRESH(); group_barrier(F); OPAQUE_K(kd, D); pg8::Gemm g{wsb(F, WS_XN), wlayer(F, LI, W_IN), M, NIN, kd}; pg8::SampleOrder S; S.init(NIN, NSG, F.sidx);
        pg8::EpiWin E{wsb(F, WS_Q), wsb(F, WS_K), wsb(F, WS_V), wsb(F, WS_BG), wsb(F, WS_C), wsb(F, WS_ZP), wsb(F, WS_GS), (const float*)(F.ws + WS_ROPEC), (const float*)(F.ws + WS_ROPES),
                      F.out + O_KP + (size_t)LI * MP * D, F.out + O_VP + (size_t)LI * MP * D, F.out + O_KS + (size_t)LI * MS * D, F.out + O_VS + (size_t)LI * MS * D};
        for (int rs_ = 0; rs_ < REP_SG; ++rs_) pg8::gemm_phase<pg8::EpiWin, pg8::SampleOrder, true, true>(RING, g, S, E, F.wave); }
    if (IN(p0 + 2)) SEAM(p0 + 2);
}
template <int LI> __device__ __forceinline__ void mixer_part(Frame& F, const XcdBarrier& bar, const int lo, const int hi) {
    constexpr int pb = 1 + LI * PH_PER_LAYER;
    if (KEEP_WIN && IN(pb + 3)) { FRESH(); pg8::Gemm g{wsb(F, WS_XN), wlayer(F, LI, W_IN), MP, NIN, D}; pg8::StaticOrder S; S.init(MP, NIN, F.G, (int)blockIdx.x);
        pg8::EpiWin E{wsb(F, WS_Q), wsb(F, WS_K), wsb(F, WS_V), wsb(F, WS_BG), wsb(F, WS_C), wsb(F, WS_ZP), wsb(F, WS_GS), (const float*)(F.ws + WS_ROPEC), (const float*)(F.ws + WS_ROPES),
                      F.out + O_KP + (size_t)LI * MP * D, F.out + O_VP + (size_t)LI * MP * D, F.out + O_KS + (size_t)LI * MS * D, F.out + O_VS + (size_t)LI * MS * D};
        for (int rep = 0; rep < REP_GEMM; ++rep) { if (rep && REP_GEMM_BAR) GRID_BAR(); pg8::gemm_phase<pg8::EpiWin, pg8::StaticOrder, true, true>(RING, g, S, E, F.wave); } SEAM(pb + 3); }
    if (KEEP_ATT && IN(pb + 4)) { FRESH();
        const attn_body::AttnTensors AT{(const attn_body::bf16*)wsb(F, WS_Q), (const attn_body::bf16*)wsb(F, WS_K), (const attn_body::bf16*)wsb(F, WS_V), (attn_body::bf16*)wsb(F, WS_O)};
        for (int rep = 0; rep < REP_ATT; ++rep)
        for (int v = F.vcu; v < 256; v += F.G) attn_body::attn_phase<8>((char*)RING, AT, v, F.wave);
        SEAM(pb + 4); }
    if (KEEP_E2 && IN(pb + 5) && !SAMPLE) { FRESH(); for (int rep = 0; rep < REP_E2; ++rep) e2_phase(F, LI, 0, MP, F.pidx * NWAVES + F.wave, NPG * NWAVES);
        if (LI + 1 < DEPTH) p0_layer(F, LI + 1 < DEPTH ? LI + 1 : LI, F.pidx * NWAVES + F.wave, NPG * NWAVES, 1); }
    if (KEEP_E2 && IN(pb + 5) && SAMPLE) { FRESH(); for (int rs_ = 0; rs_ < REP_SA; ++rs_) for (int su = F.sidx; su < DB * 8; su += NSG) sattn_unit(F, LI, su >> 3, su & 7); group_barrier(F); }
    if (KEEP_E2 && IN(pb + 5) && SAMPLE) { FRESH(); for (int rs_ = 0; rs_ < REP_SE2; ++rs_) e2_phase(F, LI, MP, M, F.sidx * NWAVES + F.wave, NSG * NWAVES); }
    if (IN(pb + 5)) SEAM(pb + 5);
    if (KEEP_BR && IN(pb + 6)) { FRESH(); pg8::Gemm g{wsb(F, WS_A2), wlayer(F, LI, W_BR), MP, D, KBR}; pg8::SegOrder S; S.init(MP, D, F.G, (int)blockIdx.x);
        pg8::EpiSeg E{wsb(F, WS_GS), (float*)(F.ws + WS_Y), wsb(F, WS_MG)};
        for (int rep = 0; rep < REP_GEMM; ++rep) { if (rep && REP_GEMM_BAR) GRID_BAR(); pg8::gemm_phase<pg8::EpiSeg, pg8::SegOrder, true, true>(RING, g, S, E, F.wave); } SEAM(pb + 6); }
    if (KEEP_WOUT && IN(pb + 7)) { FRESH(); pg8::Gemm g{wsb(F, WS_MG), wlayer(F, LI, W_OUT), MP, D, D}; pg8::StaticOrder S; S.init(MP, D, F.G, (int)blockIdx.x);
        pg8::EpiBf E{wsb(F, WS_YB), D};
        for (int rep = 0; rep < REP_GEMM; ++rep) { if (rep && REP_GEMM_BAR) GRID_BAR(); pg8::gemm_phase<pg8::EpiBf, pg8::StaticOrder, true, true>(RING, g, S, E, F.wave); } SEAM(pb + 7); }
    if (KEEP_N3 && IN(pb + 8) && !SAMPLE) { FRESH(); const float* ng = F.in[8] + (size_t)LI * 8 * D; for (int rep = 0; rep < REP_ROW; ++rep) norm_phase(F, 1.0f, ng + 3 * D, ng + 4 * D, true, 0, MP, F.pidx * NWAVES + F.wave, NPG * NWAVES, rep + 1 < REP_ROW);
        if (LI + 1 < DEPTH) p0_layer(F, LI + 1 < DEPTH ? LI + 1 : LI, F.pidx * NWAVES + F.wave, NPG * NWAVES, 4 | 8); }
    if (KEEP_N3 && IN(pb + 8) && SAMPLE) { FRESH(); pg8::Gemm g{wsb(F, WS_A2), wlayer(F, LI, W_BR), M, D, KBR}; pg8::SampleSegOrder S; S.init(D, NSG, F.sidx);
        pg8::EpiSeg E{wsb(F, WS_GS), (float*)(F.ws + WS_Y), wsb(F, WS_MG)};
        for (int rs_ = 0; rs_ < REP_SG; ++rs_) pg8::gemm_phase<pg8::EpiSeg, pg8::SampleSegOrder, true, true>(RING, g, S, E, F.wave); group_barrier(F); }
    if (KEEP_N3 && IN(pb + 8) && SAMPLE) { FRESH(); OPAQUE_K(kd, D); pg8::Gemm g{wsb(F, WS_MG), wlayer(F, LI, W_OUT), M, D, kd}; pg8::SampleOrder S; S.init(D, NSG, F.sidx);
        pg8::EpiBf E{wsb(F, WS_YB), D};
        for (int rs_ = 0; rs_ < REP_SG; ++rs_) pg8::gemm_phase<pg8::EpiBf, pg8::SampleOrder, true, true>(RING, g, S, E, F.wave); group_barrier(F); }
    if (KEEP_N3 && IN(pb + 8) && SAMPLE) { FRESH(); const float* ng = F.in[8] + (size_t)LI * 8 * D; norm_phase_sample(F, 1.0f, ng + 3 * D, ng + 4 * D, true, nullptr, 0); }
    if (IN(pb + 8)) SEAM(pb + 8);
}
template <int LI> __device__ __forceinline__ void ple_part(Frame& F, const XcdBarrier& bar, const int lo, const int hi) {
    constexpr int pb = 1 + LI * PH_PER_LAYER;
    if (KEEP_PG && IN(pb + 12)) { FRESH(); pg8::Gemm g{wsb(F, WS_XN), wlayer(F, LI, W_PG), MP, D, D}; pg8::StaticOrder S; S.init(MP, D, F.G, (int)blockIdx.x);
        pg8::EpiPle E{wsb(F, WS_YB), wsb(F, WS_PU), D};
        for (int rep = 0; rep < REP_GEMM; ++rep) { if (rep && REP_GEMM_BAR) GRID_BAR(); pg8::gemm_phase<pg8::EpiPle, pg8::StaticOrder, true, true>(RING, g, S, E, F.wave); } SEAM(pb + 12); }
    if (KEEP_N5 && IN(pb + 13) && !SAMPLE) { FRESH(); const float* ng = F.in[8] + (size_t)LI * 8 * D; for (int rep = 0; rep < REP_ROW; ++rep) norm_phase(F, 1.0f, ng + 7 * D, ng + 8 * D, LI + 1 < DEPTH, 0, MP, F.pidx * NWAVES + F.wave, NPG * NWAVES, rep + 1 < REP_ROW, LI + 1 == DEPTH);
        if (LI + 1 < DEPTH) p0_layer(F, LI + 1 < DEPTH ? LI + 1 : LI, F.pidx * NWAVES + F.wave, NPG * NWAVES, 2); }
    if (KEEP_N5 && IN(pb + 13) && SAMPLE) { FRESH(); OPAQUE_K(kd, D); pg8::Gemm g{wsb(F, WS_XN), wlayer(F, LI, W_PG), M, D, kd}; pg8::SampleOrder S; S.init(D, NSG, F.sidx);
        pg8::EpiPle E{wsb(F, WS_YB), wsb(F, WS_PU), D};
        for (int rs_ = 0; rs_ < REP_SG; ++rs_) pg8::gemm_phase<pg8::EpiPle, pg8::SampleOrder, true, true>(RING, g, S, E, F.wave); group_barrier(F); }
    if (KEEP_N5 && IN(pb + 13) && SAMPLE) { FRESH(); const float* ng = F.in[8] + (size_t)LI * 8 * D; norm_phase_sample(F, 1.0f, ng + 7 * D, ng + 8 * D, LI + 1 < DEPTH, nullptr, 0, LI + 1 == DEPTH); }
    if (KEEP_N5 && IN(pb + 13) && SAMPLE && LI + 1 < DEPTH) { FRESH(); group_barrier(F); OPAQUE_K(kd, D); pg8::Gemm g{wsb(F, WS_XN), wlayer(F, LI + 1 < DEPTH ? LI + 1 : LI, W_UP1), M, NUP, kd}; pg8::SampleOrder S; S.init(NUP, NSG, F.sidx);
        pg8::EpiSwiGLU E{wsb(F, WS_HFF), DFF};
        for (int rs_ = 0; rs_ < REP_SG; ++rs_) pg8::gemm_phase<pg8::EpiSwiGLU, pg8::SampleOrder, true, true>(RING, g, S, E, F.wave); }
    if (IN(pb + 13)) SEAM(pb + 13);
}
template <int LI> __device__ __forceinline__ void layer_part(Frame& F, const XcdBarrier& bar, const int lo, const int hi) {
    ffn_part<LI, 0>(F, bar, lo, hi); mixer_part<LI>(F, bar, lo, hi); ffn_part<LI, 1>(F, bar, lo, hi); ple_part<LI>(F, bar, lo, hi);
}
__global__ void __launch_bounds__(NWAVES * 64, 2) enc_fwd(Args args) {
    extern __shared__ __attribute__((aligned(16))) unsigned char lds[];
    Frame F;
    F.lds = (LAS unsigned char*)lds;
    F.MISC = (volatile LAS unsigned*)(F.lds + MISC_OFF);
    F.wave = __builtin_amdgcn_readfirstlane(threadIdx.x >> 6);
    F.G = gridDim.x; { const int bx = blockIdx.x; F.vcu = (F.G % 8 == 0) ? (bx % 8) * (F.G / 8) + bx / 8 : bx; }
    { const int w = F.vcu & 31, x = F.vcu >> 5; F.sidx = (w < 8) ? x * 8 + w : -1; F.pidx = (w >= 8) ? x * 24 + (w - 8) : -1; } F.lbn = 0u;
#pragma unroll
    for (int i = 0; i < 21; ++i) F.in[i] = args.in[i];
    F.out = args.out; F.ws = args.ws;
    F.ctl = (gu32*)(F.ws + WS_CTL);
    for (int u = threadIdx.x; u < (LDS_BYTES - LDSCTL_OFF) / 4; u += NWAVES * 64) ((LAS unsigned*)(F.lds + LDSCTL_OFF))[u] = 0u;
    __syncthreads();
    XcdBarrier bar; bar.wave = F.wave; bar.bar = (unsigned*)(F.ctl + CW_BAR); bar.x = 0; bar.st = nullptr;
#if !MK_PER_PHASE
    bar = xcd_barrier_post((unsigned*)(F.ctl + CW_BAR), F.MISC + 8);
#endif
    const int lo = args.ph_lo, hi = args.ph_hi;
    if (KEEP_PRO && IN(0)) { FRESH(); for (int rep = 0; rep < REP_PRO; ++rep) p0_prologue(F); SEAM(0); }
    layer_part<0>(F, bar, lo, hi); layer_part<1>(F, bar, lo, hi); layer_part<2>(F, bar, lo, hi); layer_part<3>(F, bar, lo, hi);
}
#undef IN
#undef SEAM
#undef FRESH
#undef RING
#undef SAMPLE

#ifndef DBG_DUMP
#define DBG_DUMP 0
#endif
#if DBG_DUMP
__global__ void dbg_dump_bf16(const unsigned short* src, float* dst, size_t n) { size_t i = (size_t)blockIdx.x * blockDim.x + threadIdx.x; const size_t st = (size_t)gridDim.x * blockDim.x; for (; i < n; i += st) dst[i] = __uint_as_float((unsigned)src[i] << 16); }
#endif
#ifndef PH_STOP
#define PH_STOP 1000
#endif
extern "C" void kernel_launch(void* const* d_in, const int* in_sizes, int n_in, void* d_out, int out_size, void* d_ws, size_t ws_size, hipStream_t stream) {
    static int grid = 0;
    if (grid == 0) {
        if (n_in != 21 || (size_t)(unsigned)out_size != O_END || ws_size < WS_TOP) { fprintf(stderr, "kernel_launch: unexpected shapes (n_in %d, out %d, ws %zu); nothing launched\n", n_in, out_size, ws_size); grid = -1; return; }
        int dev = 0, cus = 0, per_cu = 0;
        if (hipGetDevice(&dev) != hipSuccess || hipDeviceGetAttribute(&cus, hipDeviceAttributeMultiprocessorCount, dev) != hipSuccess) { grid = -1; return; }
        if (hipFuncSetAttribute((const void*)enc_fwd, hipFuncAttributeMaxDynamicSharedMemorySize, LDS_BYTES) != hipSuccess) { fprintf(stderr, "kernel_launch: hipFuncSetAttribute failed\n"); grid = -1; return; }
        if (hipOccupancyMaxActiveBlocksPerMultiprocessor(&per_cu, (const void*)enc_fwd, NWAVES * 64, LDS_BYTES) != hipSuccess || per_cu < 1)
            fprintf(stderr, "kernel_launch: note: occupancy query reports %d workgroups per CU\n", per_cu);
        (void)hipGetLastError();
        grid = cus;
    }
    if (grid < 0) return;
    if (hipMemsetAsync((char*)d_ws + WS_CTL, 0, CTL_ZERO_BYTES, stream) != hipSuccess) return;
    Args a{};
    for (int i = 0; i < 21; ++i) a.in[i] = (const float*)d_in[i];
    a.out = (float*)d_out; a.ws = (unsigned char*)d_ws;
#if MK_PER_PHASE
    for (int ph = 0; ph < (NPH < PH_STOP ? NPH : PH_STOP); ++ph) { a.ph_lo = ph; a.ph_hi = ph + 1; hipLaunchKernelGGL(enc_fwd, dim3(grid), dim3(NWAVES * 64), LDS_BYTES, stream, a); }
#if DBG_DUMP
    { const unsigned char* ws = (const unsigned char*)d_ws; float* out = (float*)d_out;
      if (DBG_DUMP & 1) { hipLaunchKernelGGL(dbg_dump_bf16, dim3(2048), dim3(256), 0, stream, (const unsigned short*)(ws + WS_O), out + O_KP + (size_t)1 * MP * D, (size_t)MP * 2048);
                          hipLaunchKernelGGL(dbg_dump_bf16, dim3(256), dim3(256), 0, stream, (const unsigned short*)(ws + WS_O) + (size_t)MP * 2048, out + O_KS + (size_t)1 * MS * D, (size_t)MS * 2048); }
      if (DBG_DUMP & 2) { hipLaunchKernelGGL(dbg_dump_bf16, dim3(2048), dim3(256), 0, stream, (const unsigned short*)(ws + WS_A2), out + O_VP + (size_t)1 * MP * D, (size_t)MP * 2048);
                          hipLaunchKernelGGL(dbg_dump_bf16, dim3(256), dim3(256), 0, stream, (const unsigned short*)(ws + WS_A2) + (size_t)MP * 2048, out + O_VS + (size_t)1 * MS * D, (size_t)MS * 2048); }
      if (DBG_DUMP & 8) { hipLaunchKernelGGL(dbg_dump_bf16, dim3(2048), dim3(256), 0, stream, (const unsigned short*)(ws + WS_GS), out + O_KP + (size_t)1 * MP * D, (size_t)MP * 3072); }
      if (DBG_DUMP & 16) { hipLaunchKernelGGL(dbg_dump_bf16, dim3(2048), dim3(256), 0, stream, (const unsigned short*)(ws + WS_W + W_BR), out + O_VP + (size_t)1 * MP * D, (size_t)1024 * 2048); }
      if (DBG_DUMP & 4) { hipLaunchKernelGGL(dbg_dump_bf16, dim3(2048), dim3(256), 0, stream, (const unsigned short*)(ws + WS_MG), out + O_KP + (size_t)3 * MP * D, (size_t)MP * 1024);
                          hipLaunchKernelGGL(dbg_dump_bf16, dim3(256), dim3(256), 0, stream, (const unsigned short*)(ws + WS_MG) + (size_t)MP * 1024, out + O_KS + (size_t)3 * MS * D, (size_t)MS * 1024); } }
#endif
#else
    a.ph_lo = 0; a.ph_hi = (NPH < PH_STOP ? NPH : PH_STOP);
    hipLaunchKernelGGL(enc_fwd, dim3(grid), dim3(NWAVES * 64), LDS_BYTES, stream, a);
#endif
}
```

```cpp
#include <hip/hip_runtime.h>
#include <cstdio>
#include <cstdint>

namespace pg8 {
#define PG8_LAS __attribute__((address_space(3)))
typedef unsigned short bf16_t;
typedef short bf16x8 __attribute__((ext_vector_type(8)));
typedef float f32x4 __attribute__((ext_vector_type(4)));
typedef unsigned u32x4 __attribute__((ext_vector_type(4)));
constexpr int BM = 256, BK = 64, HALF = 128, HTB = HALF * BK * 2  , STAGE_BYTES = 8 * HTB, NXCD = 8, WGM = 8;

__host__ __device__ __forceinline__ int lds_byte(int r, int c) { const int st = (r >> 4) * 2 + (c >> 5), rr = r & 15, cc = c & 31, ob = rr * 64 + cc * 2; return st * 1024 + (ob ^ (((ob >> 9) & 1) << 5)); }
__host__ __device__ __forceinline__ void stage_rc(int b, int& R, int& C) { const int st = b / 1024, sb = b % 1024, swz = sb ^ (((sb >> 9) & 1) << 5); R = (st >> 1) * 16 + swz / 64; C = (st & 1) * 32 + (swz % 64) / 2; }
__host__ __device__ __forceinline__ int perm32(int rho) { const int n = rho >> 4, i = rho & 15; return 8 * (i >> 2) + 4 * n + (i & 3); }

struct Unit { int pm, pn, seg; };
constexpr int MPROMPT_TILES = 128;
struct Gemm { const bf16_t* A; const bf16_t* Bt; int M, N, K; };

struct StaticOrder {
    int nM, nN, nwg, G, c;
    __host__ __device__ void init(int M, int N, int G_, int c_) { nM = M / BM; nN = N / BM; nwg = nM * nN; G = G_; c = c_; }
    __host__ __device__ bool next(int i, Unit& u) const {
        const long L = (long)i * G + c; if (L >= nwg) return false;
        int wgid = (int)L; { const int q = nwg / NXCD, r = nwg % NXCD, xcd = wgid % NXCD, off = wgid / NXCD; wgid = (xcd < r ? xcd * (q + 1) : r * (q + 1) + (xcd - r) * q) + off; }
        const int nig = WGM * nN, gid = wgid / nig, fm = gid * WGM, gsz = (nM - fm) < WGM ? (nM - fm) : WGM;
        u.pm = fm + ((wgid % nig) % gsz); u.pn = (wgid % nig) / gsz; u.seg = 0; return true;
    }
    __device__ __forceinline__ size_t koff_bytes(const Unit&) const { return 0; }
    __device__ __forceinline__ int ntiles(const Unit&, int K) const { return K / BK; }
    __device__ __forceinline__ void a_ready(const Unit&) const {}
    __device__ __forceinline__ void done(const Unit&) const {}
};
struct SampleOrder {
    int nN, G, c;
    __host__ __device__ void init(int N, int G_, int c_) { nN = N / BM; G = G_; c = c_; }
    __host__ __device__ bool next(int i, Unit& u) const { const int L = i * G + c; if (L >= 2 * nN) return false; u.pm = MPROMPT_TILES + L / nN; u.pn = L % nN; u.seg = 0; return true; }
    __device__ __forceinline__ size_t koff_bytes(const Unit&) const { return 0; }
    __device__ __forceinline__ int ntiles(const Unit&, int K) const { return K / BK; }
    __device__ __forceinline__ void a_ready(const Unit&) const {}
    __device__ __forceinline__ void done(const Unit&) const {}
};
struct SampleSplitOrder : SampleOrder {
    __host__ __device__ bool next(int i, Unit& u) const { const int L = i * G + c; if (L >= 32) return false; const int tile = L >> 2; u.pm = MPROMPT_TILES + (tile >> 2); u.pn = tile & 3; u.seg = L & 3; return true; }
    __device__ __forceinline__ size_t koff_bytes(const Unit& u) const { return (size_t)(u.seg == 0 ? 0 : (u.seg == 1 ? 12 : (u.seg == 2 ? 24 : 34))) * BK * 2; }
    __device__ __forceinline__ int ntiles(const Unit& u, int) const { return u.seg < 2 ? 12 : 10; }
};
struct SampleSplitQOrder : SampleOrder {
    __host__ __device__ bool next(int i, Unit& u) const { const int L = i * G + c; if (L >= 32) return false; const int tile = L >> 2; u.pm = MPROMPT_TILES + (tile >> 2); u.pn = tile & 3; u.seg = L & 3; return true; }
    __device__ __forceinline__ size_t koff_bytes(const Unit& u) const { return (size_t)u.seg * 4 * BK * 2; }
    __device__ __forceinline__ int ntiles(const Unit&, int) const { return 4; }
};
struct SampleSegOrder : SampleOrder {
    __host__ __device__ bool next(int i, Unit& u) const { const int r = i / 3; if (!SampleOrder::next(r, u)) return false; u.seg = i - 3 * r; return true; }
    __device__ __forceinline__ size_t koff_bytes(const Unit& u) const { return u.seg == 0 ? 0 : (u.seg == 1 ? 2048 : 3072); }
    __device__ __forceinline__ int ntiles(const Unit& u, int) const { return u.seg == 0 ? 16 : 8; }
};
struct SegOrder : StaticOrder {
    __host__ __device__ bool next(int i, Unit& u) const { const int r = i / 3; if (!StaticOrder::next(r, u)) return false; u.seg = i - 3 * r; return true; }
    __device__ __forceinline__ size_t koff_bytes(const Unit& u) const { return u.seg == 0 ? 0 : (u.seg == 1 ? 2048 : 3072); }
    __device__ __forceinline__ int ntiles(const Unit& u, int) const { return u.seg == 0 ? 16 : 8; }
};

typedef float cvt_f32x2_t __attribute__((ext_vector_type(2))); typedef __bf16 cvt_bf16x2_t __attribute__((ext_vector_type(2)));
__device__ __forceinline__ unsigned cvt_pk_bf16(float lo, float hi) { const cvt_f32x2_t v = {lo, hi}; const cvt_bf16x2_t b = __builtin_convertvector(v, cvt_bf16x2_t); return __builtin_bit_cast(unsigned, b); }
typedef float f32x2 __attribute__((ext_vector_type(2)));
constexpr int MPROMPT = 32768;
constexpr float QSCALE = 0.125f * 1.4426950408889634f;
__device__ __forceinline__ float sigm(float x) { return __builtin_amdgcn_rcpf(1.0f + __builtin_amdgcn_exp2f(-1.4426950408889634f * x)); }
__device__ __forceinline__ u32x4 pack8(const f32x4 a, const f32x4 b) { u32x4 w; w.x = cvt_pk_bf16(a[0], a[1]); w.y = cvt_pk_bf16(a[2], a[3]); w.z = cvt_pk_bf16(b[0], b[1]); w.w = cvt_pk_bf16(b[2], b[3]); return w; }
__device__ __forceinline__ void unpack8(const u32x4 w, f32x4& a, f32x4& b) {
    a[0] = __uint_as_float(w.x << 16); a[1] = __uint_as_float(w.x & 0xffff0000u); a[2] = __uint_as_float(w.y << 16); a[3] = __uint_as_float(w.y & 0xffff0000u);
    b[0] = __uint_as_float(w.z << 16); b[1] = __uint_as_float(w.z & 0xffff0000u); b[2] = __uint_as_float(w.w << 16); b[3] = __uint_as_float(w.w & 0xffff0000u); }

struct EpiSwiGLU {
    static constexpr bool PERM = true, AFTER_DRAIN = false;
    bf16_t* O; int ldc;
    __device__ __forceinline__ void operator()(const f32x4 (&acc)[2][2][4][2], const Unit& u, int wr, int wc, int fr, int fq) const {
        const int row0 = u.pm * BM + wr * 64 + fr, col0 = u.pn * HALF + wc * 32 + 8 * fq;
#pragma unroll
        for (int ai = 0; ai < 2; ++ai)
#pragma unroll
            for (int m = 0; m < 4; ++m) { bf16_t* p = O + (size_t)(row0 + ai * HALF + m * 16) * ldc + col0; f32x4 h[2];
#pragma unroll
                for (int n = 0; n < 2; ++n)
#pragma unroll
                    for (int j = 0; j < 4; ++j) { const float g = acc[ai][0][m][n][j]; h[n][j] = g * sigm(g) * acc[ai][1][m][n][j]; }
                *(u32x4*)p = pack8(h[0], h[1]); }
    }
};
struct EpiF32 {
    static constexpr bool PERM = false, AFTER_DRAIN = false;
    float* Y; int ldc;
    __device__ __forceinline__ void operator()(const f32x4 (&acc)[2][2][4][2], const Unit& u, int wr, int wc, int fr, int fq) const {
        float* yb = Y + (size_t)(u.pm * BM) * ldc + u.pn * BM;
        int lrow = wr * 64 + fr, lcol = wc * 32 + 4 * fq; asm volatile("" : "+v"(lrow), "+v"(lcol));
#pragma unroll
        for (int ai = 0; ai < 2; ++ai)
#pragma unroll
            for (int m = 0; m < 4; ++m) { const int o = (lrow + ai * HALF + m * 16) * ldc + lcol;
#pragma unroll
                for (int bj = 0; bj < 2; ++bj)
#pragma unroll
                    for (int n = 0; n < 2; ++n) *(f32x4*)(yb + o + bj * HALF + n * 16) = acc[ai][bj][m][n]; }
    }
};
struct EpiF32Slab {
    static constexpr bool PERM = false, AFTER_DRAIN = false;
    float* YS;
    __device__ __forceinline__ void operator()(const f32x4 (&acc)[2][2][4][2], const Unit& u, int wr, int wc, int fr, int fq) const {
        float* yb = YS + (size_t)u.seg * 512 * 1024 + (size_t)((u.pm - MPROMPT_TILES) * BM) * 1024 + u.pn * BM;
        int lrow = wr * 64 + fr, lcol = wc * 32 + 4 * fq; asm volatile("" : "+v"(lrow), "+v"(lcol));
#pragma unroll
        for (int ai = 0; ai < 2; ++ai)
#pragma unroll
            for (int m = 0; m < 4; ++m) { const int o = (lrow + ai * HALF + m * 16) * 1024 + lcol;
#pragma unroll
                for (int bj = 0; bj < 2; ++bj)
#pragma unroll
                    for (int n = 0; n < 2; ++n) *(f32x4*)(yb + o + bj * HALF + n * 16) = acc[ai][bj][m][n]; }
    }
};
struct EpiPle {
    static constexpr bool PERM = true, AFTER_DRAIN = false;
    bf16_t* Y; const bf16_t* PU; int ldc;
    __device__ __forceinline__ void operator()(const f32x4 (&acc)[2][2][4][2], const Unit& u, int wr, int wc, int fr, int fq) const {
        const size_t tb = (size_t)(u.pm * BM) * ldc + u.pn * BM;
        int lrow = wr * 64 + fr, lcol = wc * 32 + 8 * fq; asm volatile("" : "+v"(lrow), "+v"(lcol));
#pragma unroll
        for (int ai = 0; ai < 2; ++ai)
#pragma unroll
            for (int m = 0; m < 4; ++m) { const int o = (lrow + ai * HALF + m * 16) * ldc + lcol;
#pragma unroll
                for (int bj = 0; bj < 2; ++bj) { const u32x4 w = *(const u32x4*)(PU + tb + o + bj * HALF); f32x4 p0, p1; unpack8(w, p0, p1); f32x4 o0, o1;
#pragma unroll
                    for (int j = 0; j < 4; ++j) { o0[j] = p0[j] * sigm(acc[ai][bj][m][0][j]); o1[j] = p1[j] * sigm(acc[ai][bj][m][1][j]); }
                    *(u32x4*)(Y + tb + o + bj * HALF) = pack8(o0, o1); } }
    }
};
struct EpiBf {
    static constexpr bool PERM = true, AFTER_DRAIN = false;
    bf16_t* O; int ldc;
    __device__ __forceinline__ void operator()(const f32x4 (&acc)[2][2][4][2], const Unit& u, int wr, int wc, int fr, int fq) const {
        bf16_t* ob = O + (size_t)(u.pm * BM) * ldc + u.pn * BM;
        int lrow = wr * 64 + fr, lcol = wc * 32 + 8 * fq; asm volatile("" : "+v"(lrow), "+v"(lcol));
#pragma unroll
        for (int ai = 0; ai < 2; ++ai)
#pragma unroll
            for (int m = 0; m < 4; ++m) { const int o = (lrow + ai * HALF + m * 16) * ldc + lcol;
#pragma unroll
                for (int bj = 0; bj < 2; ++bj) *(u32x4*)(ob + o + bj * HALF) = pack8(acc[ai][bj][m][0], acc[ai][bj][m][1]); }
    }
};
struct EpiSeg {
    static constexpr bool PERM = true, AFTER_DRAIN = false;
    const bf16_t* S; float* T; bf16_t* O;
    __device__ __forceinline__ void operator()(const f32x4 (&acc)[2][2][4][2], const Unit& u, int wr, int wc, int fr, int fq) const {
        const int seg = u.seg;
        const bf16_t* sb = S + (size_t)(u.pm * BM) * 3072 + u.pn * BM + seg * 1024; float* tb = T + (size_t)(u.pm * BM) * 1024 + u.pn * BM; bf16_t* ob = O + (size_t)(u.pm * BM) * 1024 + u.pn * BM;
        int lrow = wr * 64 + fr, lcol = wc * 32 + 8 * fq; asm volatile("" : "+v"(lrow), "+v"(lcol));
#pragma unroll
        for (int ai = 0; ai < 2; ++ai)
#pragma unroll
            for (int m = 0; m < 4; ++m) { const int r = lrow + ai * HALF + m * 16;
#pragma unroll
                for (int bj = 0; bj < 2; ++bj) { const u32x4 ws = *(const u32x4*)(sb + r * 3072 + lcol + bj * HALF); f32x4 s0, s1; unpack8(ws, s0, s1);
                    f32x4 o0 = acc[ai][bj][m][0] * s0, o1 = acc[ai][bj][m][1] * s1; float* tp = tb + r * 1024 + lcol + bj * HALF;
                    if (seg != 0) { o0 = o0 + *(const f32x4*)tp; o1 = o1 + *(const f32x4*)(tp + 4); }
                    if (seg != 2) { *(f32x4*)tp = o0; *(f32x4*)(tp + 4) = o1; }
                    else *(u32x4*)(ob + r * 1024 + lcol + bj * HALF) = pack8(o0, o1); } }
    }
};
struct EpiWin {
    static constexpr bool PERM = true, AFTER_DRAIN = false;
    bf16_t *Q, *K, *V, *BG, *C, *ZP, *GS; const float *ropec, *ropes; float *kp, *vp, *ks, *vs;
    __device__ __forceinline__ void operator()(const f32x4 (&acc)[2][2][4][2], const Unit& u, int wr, int wc, int fr, int fq) const {
        const int pn = u.pn; const bool samp = u.pm >= MPROMPT / BM; const int row0 = u.pm * BM + wr * 64 + fr;
        if (pn < 8) {
            const bool isq = pn < 4; const int map = (pn & 3) * 4 + wc; bf16_t* dst = isq ? Q : K; const float sc = isq ? QSCALE : 1.0f;
            float* ko = samp ? ks - (size_t)MPROMPT * 1024 : kp;
#pragma unroll
            for (int ai = 0; ai < 2; ++ai)
#pragma unroll
                for (int m = 0; m < 4; ++m) { const int row = row0 + ai * HALF + m * 16; const int pos = samp ? 1024 + ((row - MPROMPT) & 31) : (row & 16383);
                    const float* cp = ropec + (size_t)pos * 32 + 8 * fq; const float* sp = ropes + (size_t)pos * 32 + 8 * fq;
                    f32x4 o1[2], o2[2];
#pragma unroll
                    for (int n = 0; n < 2; ++n) { const f32x4 c = *(const f32x4*)(cp + 4 * n), s = *(const f32x4*)(sp + 4 * n), x1 = acc[ai][0][m][n], x2 = acc[ai][1][m][n]; o1[n] = x1 * c - x2 * s; o2[n] = x2 * c + x1 * s; }
                    const size_t off = (size_t)row * 1024 + map * 64 + 8 * fq;
                    if (!isq) { float* kf = ko + off; __builtin_nontemporal_store(o1[0], (f32x4*)kf); __builtin_nontemporal_store(o1[1], (f32x4*)(kf + 4)); __builtin_nontemporal_store(o2[0], (f32x4*)(kf + 32)); __builtin_nontemporal_store(o2[1], (f32x4*)(kf + 36)); }
                    *(u32x4*)(dst + off) = pack8(o1[0] * sc, o1[1] * sc); *(u32x4*)(dst + off + 32) = pack8(o2[0] * sc, o2[1] * sc); }
        } else if (pn < 12) {
            float* vo = samp ? vs - (size_t)MPROMPT * 1024 : vp; const int col0 = (pn - 8) * BM + wc * 32 + 8 * fq;
#pragma unroll
            for (int ai = 0; ai < 2; ++ai)
#pragma unroll
                for (int m = 0; m < 4; ++m) { const size_t off = (size_t)(row0 + ai * HALF + m * 16) * 1024 + col0;
#pragma unroll
                    for (int bj = 0; bj < 2; ++bj) { float* vf = vo + off + bj * HALF; __builtin_nontemporal_store(acc[ai][bj][m][0], (f32x4*)vf); __builtin_nontemporal_store(acc[ai][bj][m][1], (f32x4*)(vf + 4)); *(u32x4*)(V + off + bj * HALF) = pack8(acc[ai][bj][m][0], acc[ai][bj][m][1]); } }
        } else if (pn < 14 || (pn >= 18 && pn < 20)) {
            bf16_t* dst = pn < 14 ? BG : ZP; const int col0 = (pn < 14 ? pn - 12 : pn - 18) * BM + wc * 32 + 8 * fq;
#pragma unroll
            for (int ai = 0; ai < 2; ++ai)
#pragma unroll
                for (int m = 0; m < 4; ++m) { bf16_t* p = dst + (size_t)(row0 + ai * HALF + m * 16) * 512 + col0;
#pragma unroll
                    for (int bj = 0; bj < 2; ++bj) *(u32x4*)(p + bj * HALF) = pack8(acc[ai][bj][m][0], acc[ai][bj][m][1]); }
        } else if (pn < 18) {
            const int col0 = (pn - 14) * HALF + wc * 32 + 8 * fq;
#pragma unroll
            for (int ai = 0; ai < 2; ++ai)
#pragma unroll
                for (int m = 0; m < 4; ++m) *(u32x4*)(C + (size_t)(row0 + ai * HALF + m * 16) * 512 + col0) = pack8(acc[ai][0][m][0] * acc[ai][1][m][0], acc[ai][0][m][1] * acc[ai][1][m][1]);
        } else {
            const int col0 = (pn - 20) * BM + wc * 32 + 8 * fq;
#pragma unroll
            for (int ai = 0; ai < 2; ++ai)
#pragma unroll
                for (int m = 0; m < 4; ++m) { bf16_t* p = GS + (size_t)(row0 + ai * HALF + m * 16) * 3072 + col0;
#pragma unroll
                    for (int bj = 0; bj < 2; ++bj) { f32x4 g0, g1;
#pragma unroll
                        for (int j = 0; j < 4; ++j) { g0[j] = sigm(acc[ai][bj][m][0][j]); g1[j] = sigm(acc[ai][bj][m][1][j]); }
                        *(u32x4*)(p + bj * HALF) = pack8(g0, g1); } }
        }
    }
};
template <class Epi, class Sched, bool ALIGN_EPI = false, bool SP2 = false>
__device__ __forceinline__ void gemm_phase(PG8_LAS unsigned char* lds, const Gemm g, const Sched& S, const Epi& E, const int wave) {
    int lane_; asm volatile("v_mbcnt_lo_u32_b32 %0, -1, 0\n\tv_mbcnt_hi_u32_b32 %0, -1, %0" : "=v"(lane_));
    const int wid = wave, lane = lane_, tid = wid * 64 + lane, wr = wid >> 2, wc = wid & 3, fr = lane & 15, fq = lane >> 4;
    const int K = g.K;
    unsigned voffA[2], voffB[2];
#pragma unroll
    for (int i = 0; i < 2; ++i) { int R, C; stage_rc(tid * 16 + i * 8192, R, C); const int Rb = Epi::PERM ? ((R & ~31) + perm32(R & 31)) : R;
        voffA[i] = (unsigned)(R * K + C) * 2u; voffB[i] = (unsigned)(Rb * K + C) * 2u; }
    const size_t kstep = (size_t)(BK * 2);
    const size_t hstep = (size_t)HALF * K * 2;
    const size_t tstep = 2 * hstep;
    const unsigned ldsw = (unsigned)wid * 1024u;
    const int aoff = lds_byte(wr * 64 + fr, fq * 8), boff = lds_byte(wc * 32 + fr, fq * 8);
#define PG8_SA(b, h) (((b) * 2 + (h)) * HTB)
#define PG8_SB(b, h) ((4 + (b) * 2 + (h)) * HTB)
#define PG8_STAGE(bufoff, gbase, voff) do { _Pragma("unroll") for (int _i = 0; _i < 2; ++_i) \
        __builtin_amdgcn_global_load_lds((const unsigned*)((const char*)(gbase) + (voff)[_i]), (PG8_LAS unsigned*)(lds + (bufoff) + ldsw + _i * 8192), 16, 0, 0); } while (0)
#define PG8_LDA(dst, b, h) do { _Pragma("unroll") for (int m = 0; m < 4; ++m) _Pragma("unroll") for (int k = 0; k < 2; ++k) dst[m][k] = *(const PG8_LAS bf16x8*)(lds + PG8_SA(b, h) + aoff + m * 2048 + k * 1024); } while (0)
#define PG8_LDB(dst, b, h) do { _Pragma("unroll") for (int n = 0; n < 2; ++n) _Pragma("unroll") for (int k = 0; k < 2; ++k) dst[n][k] = *(const PG8_LAS bf16x8*)(lds + PG8_SB(b, h) + boff + n * 2048 + k * 1024); } while (0)
#define PG8_MMA(ai, bj, At, Bt) do { __builtin_amdgcn_s_setprio(1); _Pragma("unroll") for (int m = 0; m < 4; ++m) _Pragma("unroll") for (int n = 0; n < 2; ++n) _Pragma("unroll") for (int k = 0; k < 2; ++k) \
        acc[ai][bj][m][n] = __builtin_amdgcn_mfma_f32_16x16x32_bf16(Bt[n][k], At[m][k], acc[ai][bj][m][n], 0, 0, 0); __builtin_amdgcn_s_setprio(0); } while (0)
#define PG8_WAIT_V(n) asm volatile("s_waitcnt vmcnt(" #n ")" ::: "memory")
#define PG8_WAIT_L(n) asm volatile("s_waitcnt lgkmcnt(" #n ")" ::: "memory")
#define PG8_BAR __builtin_amdgcn_s_barrier()
#define PG8_SCHED __builtin_amdgcn_sched_barrier(0)
    Unit cur, nxt; int ui = 0;
    if (!S.next(0, cur)) return;
    f32x4 acc[2][2][4][2];
#pragma unroll
    for (int a = 0; a < 2; ++a)
#pragma unroll
        for (int b = 0; b < 2; ++b)
#pragma unroll
            for (int m = 0; m < 4; ++m)
#pragma unroll
                for (int n = 0; n < 2; ++n) acc[a][b][m][n] = (f32x4){0.f, 0.f, 0.f, 0.f};
    bf16x8 At[4][2], B0[2][2], B1[2][2];
    const char* cA = (const char*)g.A + (size_t)cur.pm * tstep + S.koff_bytes(cur); const char* cB = (const char*)g.Bt + (size_t)cur.pn * tstep + S.koff_bytes(cur);
    S.a_ready(cur);
    if constexpr (SP2) {
        PG8_STAGE(PG8_SB(0, 0), cB, voffB); PG8_STAGE(PG8_SB(0, 1), cB + hstep, voffB); PG8_STAGE(PG8_SA(0, 0), cA, voffA); PG8_STAGE(PG8_SA(0, 1), cA + hstep, voffA);
        if (wr == 1) PG8_BAR;
        PG8_WAIT_V(2); PG8_BAR;
        PG8_STAGE(PG8_SB(1, 0), cB + kstep, voffB); PG8_STAGE(PG8_SA(1, 0), cA + kstep, voffA); PG8_STAGE(PG8_SB(1, 1), cB + hstep + kstep, voffB);
        PG8_WAIT_V(6); PG8_BAR;
    } else {
        PG8_STAGE(PG8_SB(0, 0), cB, voffB); PG8_STAGE(PG8_SA(0, 0), cA, voffA); PG8_STAGE(PG8_SB(0, 1), cB + hstep, voffB); PG8_STAGE(PG8_SA(0, 1), cA + hstep, voffA);
        if (wr == 1) PG8_BAR;
        PG8_WAIT_V(4); PG8_BAR;
        PG8_STAGE(PG8_SB(1, 0), cB + kstep, voffB); PG8_STAGE(PG8_SA(1, 0), cA + kstep, voffA); PG8_STAGE(PG8_SB(1, 1), cB + hstep + kstep, voffB);
        PG8_WAIT_V(6); PG8_BAR;
    }
    for (;;) {
        const bool has_next = S.next(ui + 1, nxt);
        const char* nA = has_next ? (const char*)g.A + (size_t)nxt.pm * tstep + S.koff_bytes(nxt) : cA; const char* nB = has_next ? (const char*)g.Bt + (size_t)nxt.pn * tstep + S.koff_bytes(nxt) : cB;
        const int nt = S.ntiles(cur, K);
        for (int t = 0; t < nt; t += 2) {
            const bool last = (t == nt - 2);
            const char* a1 = cA + (size_t)(t + 1) * kstep;
            const char* a2 = last ? nA : cA + (size_t)(t + 2) * kstep; const char* b2 = last ? nB : cB + (size_t)(t + 2) * kstep;
            const char* a3 = a2 + kstep; const char* b3 = b2 + kstep;
            if (last && has_next) S.a_ready(nxt);
            if constexpr (SP2) {
            PG8_LDB(B0, 0, 0); PG8_LDB(B1, 0, 1); PG8_SCHED; PG8_LDA(At, 0, 0); PG8_STAGE(PG8_SA(1, 1), a1 + hstep, voffA);
            PG8_WAIT_V(8); PG8_WAIT_L(0); PG8_BAR; PG8_MMA(0, 0, At, B0); PG8_MMA(0, 1, At, B1); PG8_BAR; PG8_SCHED;
            PG8_LDA(At, 0, 1); PG8_STAGE(PG8_SB(0, 0), b2, voffB); PG8_STAGE(PG8_SB(0, 1), b2 + hstep, voffB); PG8_STAGE(PG8_SA(0, 0), a2, voffA);
            PG8_WAIT_V(8); PG8_WAIT_L(0); PG8_BAR; PG8_MMA(1, 0, At, B0); PG8_MMA(1, 1, At, B1); PG8_BAR; PG8_SCHED;
            PG8_LDB(B0, 1, 0); PG8_LDB(B1, 1, 1); PG8_SCHED; PG8_LDA(At, 1, 0); PG8_STAGE(PG8_SA(0, 1), a2 + hstep, voffA);
            PG8_WAIT_V(8); PG8_WAIT_L(0); PG8_BAR; PG8_MMA(0, 0, At, B0); PG8_MMA(0, 1, At, B1); PG8_BAR; PG8_SCHED;
            PG8_LDA(At, 1, 1); PG8_STAGE(PG8_SB(1, 0), b3, voffB); PG8_STAGE(PG8_SB(1, 1), b3 + hstep, voffB); PG8_STAGE(PG8_SA(1, 0), a3, voffA);
            PG8_WAIT_V(8); PG8_WAIT_L(0); PG8_BAR; PG8_MMA(1, 0, At, B0); PG8_MMA(1, 1, At, B1); PG8_BAR; PG8_SCHED;
            } else {
            PG8_LDB(B0, 0, 0); PG8_SCHED; PG8_LDA(At, 0, 0); PG8_STAGE(PG8_SA(1, 1), a1 + hstep, voffA);
            PG8_WAIT_L(8); PG8_BAR; PG8_WAIT_L(0); PG8_MMA(0, 0, At, B0); PG8_BAR; PG8_SCHED;
            PG8_LDB(B1, 0, 1); PG8_STAGE(PG8_SB(0, 0), b2, voffB);
            PG8_BAR; PG8_WAIT_L(0); PG8_MMA(0, 1, At, B1); PG8_BAR;
            PG8_LDA(At, 0, 1); PG8_STAGE(PG8_SA(0, 0), a2, voffA);
            PG8_BAR; PG8_WAIT_L(0); PG8_MMA(1, 0, At, B0); PG8_BAR; PG8_SCHED;
            PG8_STAGE(PG8_SB(0, 1), b2 + hstep, voffB);
            PG8_WAIT_V(6); PG8_BAR; PG8_MMA(1, 1, At, B1); PG8_BAR;
            PG8_LDB(B0, 1, 0); PG8_SCHED; PG8_LDA(At, 1, 0); PG8_STAGE(PG8_SA(0, 1), a2 + hstep, voffA);
            PG8_WAIT_L(8); PG8_BAR; PG8_WAIT_L(0); PG8_MMA(0, 0, At, B0); PG8_BAR; PG8_SCHED;
            PG8_LDB(B1, 1, 1); PG8_STAGE(PG8_SB(1, 0), b3, voffB);
            PG8_BAR; PG8_WAIT_L(0); PG8_MMA(0, 1, At, B1); PG8_BAR;
            PG8_LDA(At, 1, 1); PG8_STAGE(PG8_SA(1, 0), a3, voffA);
            PG8_BAR; PG8_WAIT_L(0); PG8_MMA(1, 0, At, B0); PG8_BAR; PG8_SCHED;
            PG8_STAGE(PG8_SB(1, 1), b3 + hstep, voffB);
            PG8_WAIT_V(6); PG8_BAR; PG8_MMA(1, 1, At, B1); PG8_BAR;
            }
        }
        if constexpr (ALIGN_EPI) { if (wr == 0) PG8_BAR; }
        if constexpr (!Epi::AFTER_DRAIN) { E(acc, cur, wr, wc, fr, fq); S.done(cur); }
        if (!has_next) break;
#pragma unroll
        for (int a = 0; a < 2; ++a)
#pragma unroll
            for (int b = 0; b < 2; ++b)
#pragma unroll
                for (int m = 0; m < 4; ++m)
#pragma unroll
                    for (int n = 0; n < 2; ++n) acc[a][b][m][n] = (f32x4){0.f, 0.f, 0.f, 0.f};
        cur = nxt; cA = nA; cB = nB; ++ui;
        if constexpr (ALIGN_EPI) { if (wr == 1) PG8_BAR; }
    }
    PG8_WAIT_V(0);
    if constexpr (!ALIGN_EPI) { if (wr == 0) PG8_BAR; }
    PG8_BAR;
    if constexpr (Epi::AFTER_DRAIN) { E.fused(acc, cur, wr, wc, fr, fq, lds, wid, lane); S.done(cur); }
#undef PG8_SA
#undef PG8_SB
#undef PG8_STAGE
#undef PG8_LDA
#undef PG8_LDB
#undef PG8_MMA
#undef PG8_WAIT_V
#undef PG8_WAIT_L
#undef PG8_BAR
#undef PG8_SCHED
}
}
#include <hip/hip_bf16.h>
#include <cmath>
namespace attn_body {
using bf16=__hip_bfloat16;
using bf16x8=__attribute__((ext_vector_type(8)))short;
using s16x4=__attribute__((ext_vector_type(4)))short;
using f32x16=__attribute__((ext_vector_type(16)))float;
using u32x4=__attribute__((ext_vector_type(4)))unsigned;
constexpr int SEQ=16384,D=64,DM=1024,OP=2048;
constexpr int NW=8,QBLK=32,QB=QBLK*NW,KVBLK=64,NQB=SEQ/QB;
constexpr int ATTN_PITCH=DM, ATTN_UNIT_ROWS=QB;
__device__ __forceinline__ int crow(int r,int hi){return (r&3)+8*(r>>2)+4*hi;}
__device__ __forceinline__ f32x16 zero16(){ float z; asm volatile("v_mov_b32 %0, 0":"=v"(z)); f32x16 r; _Pragma("unroll") for(int i=0;i<16;++i)r[i]=z; return r; }
#define SBAR() __builtin_amdgcn_sched_barrier(0)
__device__ __forceinline__ void cmask(f32x16&p0,f32x16&p1,int jb,int qrel,int hi){
  const float NEG=-INFINITY; (void)hi;
  if(jb>(qrel>>6)){
  #pragma unroll
  for(int r=0;r<16;++r){p0[r]=NEG;p1[r]=NEG;} }
}

constexpr int NSLOT=3, SLOTB=8192;
constexpr int LDS_K=0, LDS_V=NSLOT*SLOTB, LDS_WS=3*NSLOT*SLOTB, LDS_OST=LDS_WS+NW*64*4, LDS_BYTES=LDS_OST+NW*4096;
constexpr float C2=0.125f*1.4426950408889634f;
__device__ __forceinline__ void glds16(const void*gsrc,unsigned lds_dst){unsigned keep;
  asm volatile("s_mov_b32 %0, m0\n\ts_mov_b32 m0, %2\n\ts_nop 0\n\tglobal_load_lds_dwordx4 %1, off\n\ts_mov_b32 m0, %0":"=&s"(keep):"v"(gsrc),"s"(lds_dst):"memory");}
__device__ __forceinline__ float max3f(float a,float b,float c){float r;asm("v_max3_f32 %0, %1, %2, %3":"=v"(r):"v"(a),"v"(b),"v"(c));return r;}
__device__ __forceinline__ float max2f(float a,float b){float r;asm("v_max_f32_e32 %0, %1, %2":"=v"(r):"v"(a),"v"(b));return r;}
__device__ __forceinline__ float fadd_s(float a,float b){float r;asm("v_add_f32_e32 %0, %1, %2":"=v"(r):"v"(a),"v"(b));return r;}
__device__ __forceinline__ float fsub_s(float a,float b){float r;asm("v_sub_f32_e32 %0, %1, %2":"=v"(r):"v"(a),"v"(b));return r;}
typedef float f32x2_t __attribute__((ext_vector_type(2))); typedef __bf16 bf16x2_t __attribute__((ext_vector_type(2)));
__device__ __forceinline__ unsigned cvtpk_s(float lo,float hi){f32x2_t v={lo,hi};bf16x2_t b=__builtin_convertvector(v,bf16x2_t);return __builtin_bit_cast(unsigned,b);}
#define WAIT_BAR(N) asm volatile("s_waitcnt vmcnt(" #N ") lgkmcnt(0)\n\ts_barrier":::"memory")

__device__ __forceinline__ void qkt(f32x16&p0,f32x16&p1,const char*Kslot,const bf16x8*qr,const f32x16&negm,int r32,int hi){
  const char*kb=Kslot+hi*1024+r32*16;
  #pragma unroll
  for(int d0=0;d0<4;++d0){
    const bf16x8 b0=*reinterpret_cast<const bf16x8*>(kb+d0*2048);
    const bf16x8 b1=*reinterpret_cast<const bf16x8*>(kb+d0*2048+512);
    if(d0==0){p0=__builtin_amdgcn_mfma_f32_32x32x16_bf16(b0,qr[0],negm,0,0,0);p1=__builtin_amdgcn_mfma_f32_32x32x16_bf16(b1,qr[0],negm,0,0,0);}
    else{p0=__builtin_amdgcn_mfma_f32_32x32x16_bf16(b0,qr[d0],p0,0,0,0);p1=__builtin_amdgcn_mfma_f32_32x32x16_bf16(b1,qr[d0],p1,0,0,0);}}
}
typedef __attribute__((address_space(3))) const char* lds_cptr;
typedef short v4i16_t __attribute__((ext_vector_type(4)));
__device__ __forceinline__ void kload8(bf16x8*kf,lds_cptr kp){
  kf[0]=*(const __attribute__((address_space(3))) bf16x8*)(kp);      kf[1]=*(const __attribute__((address_space(3))) bf16x8*)(kp+512);
  kf[2]=*(const __attribute__((address_space(3))) bf16x8*)(kp+2048); kf[3]=*(const __attribute__((address_space(3))) bf16x8*)(kp+2560);
  kf[4]=*(const __attribute__((address_space(3))) bf16x8*)(kp+4096); kf[5]=*(const __attribute__((address_space(3))) bf16x8*)(kp+4608);
  kf[6]=*(const __attribute__((address_space(3))) bf16x8*)(kp+6144); kf[7]=*(const __attribute__((address_space(3))) bf16x8*)(kp+6656);
}
__device__ __forceinline__ void kload2(bf16x8*kf,lds_cptr kp,int j){ kf[2*j]=*(const __attribute__((address_space(3))) bf16x8*)(kp+j*2048); kf[2*j+1]=*(const __attribute__((address_space(3))) bf16x8*)(kp+j*2048+512); }
__device__ __forceinline__ s16x4 vtr(lds_cptr p){ return __builtin_bit_cast(s16x4,__builtin_amdgcn_ds_read_tr16_b64_v4i16((__attribute__((address_space(3))) v4i16_t*)p)); }
__device__ __forceinline__ float rowmax(const f32x16&p0,const f32x16&p1){
  float a=max3f(p0[0],p0[1],p1[0]),b=max3f(p0[2],p0[3],p1[1]);a=max3f(a,p1[2],p1[3]);
  #pragma unroll
  for(int r=4;r<16;r+=4){a=max3f(a,p0[r],p0[r+1]);b=max3f(b,p0[r+2],p0[r+3]);a=max3f(a,p1[r],p1[r+1]);b=max3f(b,p1[r+2],p1[r+3]);}
  const float m=max2f(a,b);
  auto rr=__builtin_amdgcn_permlane32_swap(__float_as_uint(m),__float_as_uint(m),false,false);
  return max2f(__uint_as_float(rr[0]),__uint_as_float(rr[1]));
}
__device__ __forceinline__ void pv(f32x16*o,int vb,bf16x8 pa0,bf16x8 pa1,bf16x8 pa2,bf16x8 pa3){
  #pragma unroll
  for(int d0=0;d0<4;++d0){s16x4 lo[4],hi[4];
    #pragma unroll
    for(int ks=0;ks<4;++ks){
      asm volatile("ds_read_b64_tr_b16 %0,%1 offset:%c2":"=&v"(lo[ks]):"v"(vb),"i"(d0*4096+ks*1024):"memory");
      asm volatile("ds_read_b64_tr_b16 %0,%1 offset:%c2":"=&v"(hi[ks]):"v"(vb),"i"(d0*4096+ks*1024+512):"memory");}
    asm volatile("s_waitcnt lgkmcnt(0)":::"memory");SBAR();
    #define PK(k) (bf16x8){lo[k][0],lo[k][1],lo[k][2],lo[k][3],hi[k][0],hi[k][1],hi[k][2],hi[k][3]}
    o[d0]=__builtin_amdgcn_mfma_f32_32x32x16_bf16(pa0,PK(0),o[d0],0,0,0);
    o[d0]=__builtin_amdgcn_mfma_f32_32x32x16_bf16(pa1,PK(1),o[d0],0,0,0);
    o[d0]=__builtin_amdgcn_mfma_f32_32x32x16_bf16(pa2,PK(2),o[d0],0,0,0);
    o[d0]=__builtin_amdgcn_mfma_f32_32x32x16_bf16(pa3,PK(3),o[d0],0,0,0);
    #undef PK
  }
}

#ifndef ATTN_STORE16
#define ATTN_STORE16(p,v) (*(u32x4*)(p)=(v))
#endif
template<int THRL> __device__ __forceinline__ void attn_unit(int b,int map,int qb,const bf16*Q,const bf16*__restrict__ K,const bf16*__restrict__ V,bf16*O,char*shm,const int wave){
  int lane_; asm volatile("v_mbcnt_lo_u32_b32 %0, -1, 0\n\tv_mbcnt_hi_u32_b32 %0, -1, %0":"=v"(lane_)); const int lane=lane_,r32=lane&31,hi=lane>>5; const int wid=wave;
  const long rowbase=(long)b*SEQ; const int q0=qb*QB;
  const bf16*Qw=Q+(rowbase+q0+wid*QBLK)*DM+map*D;
  const bf16*Kh=K+rowbase*DM+map*D,*Vh=V+rowbase*DM+(map>>1)*128;
  const unsigned lds0=(unsigned)(uintptr_t)shm;
  float*wsf=(float*)(shm+LDS_WS)+wid*64;
  const bf16*ksrc=Kh+(long)lane*DM+wid*8;
  const bf16*vsrc=Vh+(long)(16*(wid&3)+(lane>>2))*DM+(wid>>2)*32+(lane&3)*8;
  const unsigned kdst=lds0+LDS_K+wid*1024, vdst=lds0+LDS_V+wid*1024;
  #define DMA_K(t,slot) glds16(ksrc+(long)(t)*KVBLK*DM,(unsigned)__builtin_amdgcn_readfirstlane(kdst+(slot)))
  #define DMA_V(t,slot) do{ glds16(vsrc+(long)(t)*KVBLK*DM,(unsigned)__builtin_amdgcn_readfirstlane(vdst+2*(slot))); glds16(vsrc+(long)(t)*KVBLK*DM+64,(unsigned)__builtin_amdgcn_readfirstlane(vdst+2*(slot)+8192)); }while(0)
  const int vb0=(int)(lds0+LDS_V)+((lane>>4)&1)*32+(lane&3)*8+(4*hi+((lane&15)>>2))*64;
  const char*Kbase=shm+LDS_K; bf16x8 kf[8];
  const lds_cptr shm3=(lds_cptr)shm; const lds_cptr kp0=shm3+LDS_K+hi*1024+r32*16; const lds_cptr vp0=shm3+LDS_V+((lane>>4)&1)*32+(lane&3)*8+(4*hi+((lane&15)>>2))*64;
  const int NT=(q0+QB)/KVBLK;
  DMA_K(0,0);DMA_V(0,0);DMA_K(1,SLOTB);
  bf16x8 qr[4];
  #pragma unroll
  for(int d0=0;d0<4;++d0)qr[d0]=*reinterpret_cast<const bf16x8*>(&Qw[(long)r32*DM+d0*16+hi*8]);
  float mhat=0.f,l_reg=0.f;f32x16 o[4];o[0]=zero16();o[1]=zero16();o[2]=zero16();o[3]=zero16();f32x16 negm=zero16();asm volatile("":"+v"(negm));
  const int qrel=wid*QBLK+r32;
  #define CMASK(P0,P1,t) do{int jb_=(t)-(NT-4); if(jb_>=0)cmask(P0,P1,jb_,qrel,hi);}while(0)
  bool resc=false;
  #define START(P0,P1) do{ const float rm=rowmax(P0,P1); resc=false; \
    { const float dl=rm; mhat=fadd_s(mhat,dl); \
      _Pragma("unroll") for(int r=0;r<16;++r){P0[r]=fsub_s(P0[r],dl);P1[r]=fsub_s(P1[r],dl);} \
      _Pragma("unroll") for(int r=0;r<16;++r)negm[r]=-mhat; asm volatile("":"+v"(negm)); } \
    _Pragma("unroll") for(int r=0;r<16;++r)P0[r]=__builtin_amdgcn_exp2f(P0[r]); }while(0)
  #define RESC() do{ if(resc){ asm volatile("s_waitcnt lgkmcnt(0)":::"memory"); \
      _Pragma("unroll") for(int d_=0;d_<4;++d_) _Pragma("unroll") for(int r=0;r<16;++r)o[d_][r]*=wsf[crow(r,hi)]; } }while(0)
  f32x16 pA0,pA1,pB0,pB1;
  int sl_prev=0,sl_cur=0,sl_next=SLOTB;
  #define ROT() do{sl_prev=sl_cur;sl_cur=sl_next;sl_next=(sl_next==(NSLOT-1)*SLOTB)?0:sl_next+SLOTB;}while(0)
  DMA_K(2,2*SLOTB);
  WAIT_BAR(3);
  qkt(pA0,pA1,Kbase,qr,negm,r32,hi);asm volatile("s_nop 15\n\ts_nop 7":"+v"(pA0),"+v"(pA1));CMASK(pA0,pA1,0);
  START(pA0,pA1);
  _Pragma("unroll") for(int r=0;r<16;++r)pA1[r]=__builtin_amdgcn_exp2f(pA1[r]);
  WAIT_BAR(0);
  DMA_K(3,0);DMA_V(1,SLOTB);
  ROT();
  kload8(kf,kp0+sl_cur);
  WAIT_BAR(3);
  s16x4 vlo[16],vhi[16]; u32x4 pw0,pw1,pw2,pw3;
  #define PKW(P,B) cvtpk_s(P[B],P[B+1])
  #define PAF(k) __builtin_bit_cast(bf16x8,pw##k)
  #define VFR(i) (bf16x8){vlo[i][0],vlo[i][1],vlo[i][2],vlo[i][3],vhi[i][0],vhi[i][1],vhi[i][2],vhi[i][3]}
  #define PIN(x) asm volatile("":"+v"(x))
  #define MX3(a,b,c) __builtin_fmaxf(__builtin_fmaxf((a),(b)),(c))
  #define GAPA(MF,A0,A1,A2,A3,W0,W1,PW) do{ MF; sacc+=A0; sacc+=A1; sacc+=A2; sacc+=A3; PIN(sacc); W0; W1; PIN(PW); SBAR(); }while(0)
  #define EX(v) __builtin_amdgcn_exp2f(v)
  #define GAPB2(MF,X,B) do{ MF; X[B]=EX(X[B]); X[B+1]=EX(X[B+1]); PIN(X); SBAR(); }while(0)
  #define GAPB(MF,X,B) do{ MF; X[B]=EX(X[B]); X[B+1]=EX(X[B+1]); X[B+2]=EX(X[B+2]); X[B+3]=EX(X[B+3]); PIN(X); SBAR(); }while(0)
  #define VRD(i) do{ vlo[i]=vtr(vp_+(((i)>>2)*4096+((i)&3)*1024)); vhi[i]=vtr(vp_+(((i)>>2)*4096+((i)&3)*1024+512)); }while(0)
  #define KRD(G,j) do{ if(G){ kload2(kf,kp0+sl_next,j); SBAR(); } }while(0)
  #define STEP(C0,C1,P0,P1,t,GK,GV,GL) do{ SBAR(); \
    const lds_cptr vp_=vp0+2*sl_prev; \
    VRD(0); SBAR(); float sacc=(P0[0]+P0[1]); \
    GAPA(C0=__builtin_amdgcn_mfma_f32_32x32x16_bf16(kf[0],qr[0],negm,0,0,0), P0[2],P0[3],P0[4],P0[5],     pw0[0]=PKW(P0,0), pw0[1]=PKW(P0,2), pw0); \
    VRD(4); SBAR(); GAPA(C1=__builtin_amdgcn_mfma_f32_32x32x16_bf16(kf[1],qr[0],negm,0,0,0), P0[6],P0[7],P0[8],P0[9],     pw0[2]=PKW(P0,4), pw0[3]=PKW(P0,6), pw0); \
    VRD(1); SBAR(); GAPA(C0=__builtin_amdgcn_mfma_f32_32x32x16_bf16(kf[2],qr[1],C0,0,0,0),   P0[10],P0[11],P0[12],P0[13], pw1[0]=PKW(P0,8), pw1[1]=PKW(P0,10), pw1); \
    VRD(5); SBAR(); GAPA(C1=__builtin_amdgcn_mfma_f32_32x32x16_bf16(kf[3],qr[1],C1,0,0,0),   P0[14],P0[15],P1[0],P1[1],   pw1[2]=PKW(P0,12),pw1[3]=PKW(P0,14), pw1); \
    VRD(2); SBAR(); GAPA(C0=__builtin_amdgcn_mfma_f32_32x32x16_bf16(kf[4],qr[2],C0,0,0,0),   P1[2],P1[3],P1[4],P1[5],     pw2[0]=PKW(P1,0), pw2[1]=PKW(P1,2), pw2); \
    VRD(6); SBAR(); GAPA(C1=__builtin_amdgcn_mfma_f32_32x32x16_bf16(kf[5],qr[2],C1,0,0,0),   P1[6],P1[7],P1[8],P1[9],     pw2[2]=PKW(P1,4), pw2[3]=PKW(P1,6), pw2); \
    VRD(3); SBAR(); GAPA(C0=__builtin_amdgcn_mfma_f32_32x32x16_bf16(kf[6],qr[3],C0,0,0,0),   P1[10],P1[11],P1[12],P1[13], pw3[0]=PKW(P1,8), pw3[1]=PKW(P1,10), pw3); \
    VRD(7); SBAR(); GAPA(C1=__builtin_amdgcn_mfma_f32_32x32x16_bf16(kf[7],qr[3],C1,0,0,0),   P1[14],P1[15],0.f,0.f,       pw3[2]=PKW(P1,12),pw3[3]=PKW(P1,14), pw3); \
    l_reg+=sacc; \
    if(GK){DMA_K((t)+3,sl_cur);} if(GV){DMA_V((t)+1,sl_next);} \
    CMASK(C0,C1,t); \
    { float a=MX3(C0[0],C0[1],C1[0]),b=MX3(C0[2],C0[3],C1[1]); a=MX3(a,C1[2],C1[3]); \
      _Pragma("unroll") for(int r=4;r<16;r+=4){a=MX3(a,C0[r],C0[r+1]);b=MX3(b,C0[r+2],C0[r+3]);a=MX3(a,C1[r],C1[r+1]);b=MX3(b,C1[r+2],C1[r+3]);} \
      float rm=__builtin_fmaxf(a,b); { auto rr=__builtin_amdgcn_permlane32_swap(__float_as_uint(rm),__float_as_uint(rm),false,false); rm=__builtin_fmaxf(__uint_as_float(rr[0]),__uint_as_float(rr[1])); } \
      resc=false; \
      if(__builtin_expect(__any(rm>(float)THRL),0)){ const float dl=__builtin_fmaxf(rm,0.f); mhat+=dl; \
        _Pragma("unroll") for(int r=0;r<16;++r){C0[r]-=dl;C1[r]-=dl;} \
        _Pragma("unroll") for(int r=0;r<16;++r)negm[r]=-mhat; asm volatile("":"+v"(negm)); \
        const float f=__builtin_amdgcn_exp2f(-dl); l_reg*=f; if(hi==0)wsf[r32]=f; resc=true; } } \
    SBAR(); \
    VRD(8); SBAR();  GAPB2(o[0]=__builtin_amdgcn_mfma_f32_32x32x16_bf16(PAF(0),VFR(0),o[0],0,0,0), C0,0); \
    VRD(12); SBAR(); GAPB2(o[1]=__builtin_amdgcn_mfma_f32_32x32x16_bf16(PAF(0),VFR(4),o[1],0,0,0), C0,2); \
    KRD(GL,0); GAPB2(o[0]=__builtin_amdgcn_mfma_f32_32x32x16_bf16(PAF(1),VFR(1),o[0],0,0,0), C0,4); \
    KRD(GL,1); GAPB2(o[1]=__builtin_amdgcn_mfma_f32_32x32x16_bf16(PAF(1),VFR(5),o[1],0,0,0), C0,6); \
    KRD(GL,2); GAPB2(o[0]=__builtin_amdgcn_mfma_f32_32x32x16_bf16(PAF(2),VFR(2),o[0],0,0,0), C0,8); \
    KRD(GL,3); GAPB2(o[1]=__builtin_amdgcn_mfma_f32_32x32x16_bf16(PAF(2),VFR(6),o[1],0,0,0), C0,10); \
    VRD(9); SBAR();  GAPB2(o[0]=__builtin_amdgcn_mfma_f32_32x32x16_bf16(PAF(3),VFR(3),o[0],0,0,0), C0,12); \
    VRD(13); SBAR(); GAPB2(o[1]=__builtin_amdgcn_mfma_f32_32x32x16_bf16(PAF(3),VFR(7),o[1],0,0,0), C0,14); \
    VRD(10); SBAR(); GAPB2(o[2]=__builtin_amdgcn_mfma_f32_32x32x16_bf16(PAF(0),VFR(8),o[2],0,0,0), C1,0); \
    VRD(14); SBAR(); GAPB2(o[3]=__builtin_amdgcn_mfma_f32_32x32x16_bf16(PAF(0),VFR(12),o[3],0,0,0), C1,2); \
    VRD(11); SBAR(); GAPB2(o[2]=__builtin_amdgcn_mfma_f32_32x32x16_bf16(PAF(1),VFR(9),o[2],0,0,0), C1,4); \
    VRD(15); SBAR(); GAPB2(o[3]=__builtin_amdgcn_mfma_f32_32x32x16_bf16(PAF(1),VFR(13),o[3],0,0,0), C1,6); \
    GAPB2(o[2]=__builtin_amdgcn_mfma_f32_32x32x16_bf16(PAF(2),VFR(10),o[2],0,0,0), C1,8); \
    GAPB2(o[3]=__builtin_amdgcn_mfma_f32_32x32x16_bf16(PAF(2),VFR(14),o[3],0,0,0), C1,10); \
    GAPB2(o[2]=__builtin_amdgcn_mfma_f32_32x32x16_bf16(PAF(3),VFR(11),o[2],0,0,0), C1,12); \
    GAPB2(o[3]=__builtin_amdgcn_mfma_f32_32x32x16_bf16(PAF(3),VFR(15),o[3],0,0,0), C1,14); \
    }while(0)
  int t=1;
  #undef CMASK
  #define CMASK(P0,P1,t) do{}while(0)
  for(;t+5<NT;t+=2){
    STEP(pB0,pB1,pA0,pA1,t,true,true,true);     WAIT_BAR(3); RESC(); ROT();
    STEP(pA0,pA1,pB0,pB1,t+1,true,true,true);   WAIT_BAR(3); RESC(); ROT();
  }
  #undef CMASK
  #define CMASK(P0,P1,t) do{int jb_=(t)-(NT-4); if(jb_>=0)cmask(P0,P1,jb_,qrel,hi);}while(0)
  #define ENDW(tt) do{ if((tt)+3<NT){WAIT_BAR(3);} else if((tt)+2<NT){WAIT_BAR(2);} else {WAIT_BAR(0);} }while(0)
  for(;t+1<NT;t+=2){
    STEP(pB0,pB1,pA0,pA1,t,(t+3<NT),(t+1<NT),(t+1<NT));       ENDW(t);   RESC(); ROT();
    STEP(pA0,pA1,pB0,pB1,t+1,(t+4<NT),(t+2<NT),(t+2<NT));     ENDW(t+1); RESC(); ROT();
  }
  STEP(pB0,pB1,pA0,pA1,NT-1,false,false,false); RESC();
  { float sacc=pB0[0]+pB0[1]; _Pragma("unroll") for(int r=2;r<16;++r)sacc+=pB0[r]; _Pragma("unroll") for(int r=0;r<16;++r)sacc+=pB1[r]; l_reg+=sacc;
    pw0=(u32x4){PKW(pB0,0),PKW(pB0,2),PKW(pB0,4),PKW(pB0,6)};pw1=(u32x4){PKW(pB0,8),PKW(pB0,10),PKW(pB0,12),PKW(pB0,14)};pw2=(u32x4){PKW(pB1,0),PKW(pB1,2),PKW(pB1,4),PKW(pB1,6)};pw3=(u32x4){PKW(pB1,8),PKW(pB1,10),PKW(pB1,12),PKW(pB1,14)};
    SBAR(); pv(o,vb0+2*sl_cur,PAF(0),PAF(1),PAF(2),PAF(3)); }
  #undef PKW
  #undef PAF
  #undef VFR
  #undef PIN
  #undef MX3
  #undef GAPA
  #undef GAPB
  #undef GAPB2
  #undef EX
  #undef VRD
  #undef KRD
  #undef STEP
  #undef ENDW
  {auto rr=__builtin_amdgcn_permlane32_swap(__float_as_uint(l_reg),__float_as_uint(l_reg),false,false);l_reg=__uint_as_float(rr[0])+__uint_as_float(rr[1]);}
  if(hi==0)wsf[32+r32]=l_reg;asm volatile("s_waitcnt lgkmcnt(0)":::"memory");
  float rli[16];
  #pragma unroll
  for(int r=0;r<16;++r)rli[r]=__builtin_amdgcn_rcpf(wsf[32+crow(r,hi)]);
  bf16*Ow=O+(rowbase+q0+wid*QBLK)*OP+map*128;
  { bf16*stg=(bf16*)(shm+LDS_OST)+wid*2048;
    #pragma unroll
    for(int hp=0;hp<2;++hp){
    #pragma unroll
    for(int r=0;r<16;++r){const int orow=crow(r,hi);
      #pragma unroll
      for(int d0=0;d0<2;++d0)stg[orow*64+d0*32+r32]=__float2bfloat16(o[2*hp+d0][r]*rli[r]);}
    asm volatile("s_waitcnt lgkmcnt(0)":::"memory");
    #pragma unroll
    for(int i=0;i<4;++i){const int row=i*8+(lane>>3),ch=lane&7; const u32x4 v=*(const u32x4*)(stg+row*64+ch*8); ATTN_STORE16(Ow+(long)row*OP+hp*64+ch*8,v);}
    asm volatile("s_waitcnt lgkmcnt(0)":::"memory"); } }
  asm volatile("s_waitcnt lgkmcnt(0)\n\ts_barrier":::"memory");
  #undef DMA_K
  #undef DMA_V
  #undef CMASK
  #undef START
  #undef RESC
  #undef ROT
}
constexpr int ATTN_LDS_BYTES=LDS_BYTES;
struct AttnTensors { const bf16* Q; const bf16* K; const bf16* V; bf16* O; };
template<int THRL=8> __device__ __forceinline__ void attn_phase(char*lds,const AttnTensors&T,int vcu,const int wave){
  const int xcd=vcu>>5, s=vcu&31, b=xcd>>2;
  for(int c=0;c<4;++c){ const int map=4*(xcd&3)+c;
    attn_unit<THRL>(b,map,s,T.Q,T.K,T.V,T.O,lds,wave); attn_unit<THRL>(b,map,63-s,T.Q,T.K,T.V,T.O,lds,wave); }
}
#undef SBAR
#undef WAIT_BAR
}
constexpr int NWAVES = 8;
constexpr int D = 1024, MP = 32768, MS = 512, M = MP + MS, SEQ = 16384, DEPTH = 4, DFF = 2816, NUP = 2 * DFF, NIN = 8192, KBR = 2048, PLE = 256;
constexpr int DSEQ = 32, PAST = 1024, DB = 16;
constexpr float RMS_EPS = 1e-6f;
constexpr int PH_PER_LAYER = 14, NPH = 1 + DEPTH * PH_PER_LAYER;
#ifndef REP_ATT
#define REP_ATT 1
#endif
#ifndef REP_PRO
#define REP_PRO 1
#endif
#ifndef REP_ROW
#define REP_ROW 1
#endif
#ifndef REP_E2
#define REP_E2 1
#endif
#ifndef REP_LB
#define REP_LB 1
#endif
#ifndef REP_BAR
#define REP_BAR 1
#endif
#ifndef REP_SG
#define REP_SG 1
#endif
#ifndef REP_SA
#define REP_SA 1
#endif
#ifndef REP_SE2
#define REP_SE2 1
#endif
#ifndef REP_GEMM_BAR
#define REP_GEMM_BAR 0
#endif
#ifndef REP_GEMM
#define REP_GEMM 1
#endif
#ifndef MK_PER_PHASE
#define MK_PER_PHASE 0
#endif

constexpr size_t MiB = 1u << 20;
constexpr size_t WS_CTL = 0, CTL_ZERO_BYTES = 1 * MiB;
constexpr size_t WS_ROPEC = 2 * MiB, WS_ROPES = 4 * MiB;
constexpr size_t WS_W = 8 * MiB, W_LAYER = 64 * MiB;
constexpr size_t W_UP1 = 0, W_UP2 = 11 * MiB, W_DN1 = 22 * MiB, W_DN2 = 22 * MiB + 5632 * 1024, W_IN = 33 * MiB, W_BR = 49 * MiB, W_OUT = 53 * MiB, W_PG = 55 * MiB, W_PU = 57 * MiB;
constexpr size_t WS_PB = 272 * MiB, PB_LAYER = 17 * MiB;
constexpr size_t WS_XN = 344 * MiB, WS_HFF = 416 * MiB, WS_Q = 600 * MiB, WS_K = 672 * MiB, WS_V = 744 * MiB, WS_BG = 816 * MiB, WS_C = 852 * MiB, WS_ZP = 888 * MiB;
constexpr size_t WS_GS = 924 * MiB, WS_O = 1120 * MiB, WS_A2 = 1256 * MiB, WS_MG = 1392 * MiB, WS_Y = 1464 * MiB, WS_PU = 1600 * MiB, WS_YS = 1672 * MiB  , WS_END = 1680 * MiB, WS_YB = 1688 * MiB  , WS_HB = 1760 * MiB  , WS_TOP = 1828 * MiB, WS_DUMMY = 1832 * MiB  ;
static_assert(WS_XN + (size_t)M * D * 2 <= WS_HFF && WS_HFF + (size_t)M * DFF * 2 <= WS_Q && WS_GS + (size_t)M * 3072 * 2 <= WS_O && WS_O + (size_t)M * 2048 * 2 <= WS_A2 && WS_Y + (size_t)M * D * 4 <= WS_PU && WS_PU + (size_t)M * D * 2 <= WS_END, "d_ws map");
static_assert(W_PU + (size_t)D * PLE * 2 <= W_LAYER && (size_t)M * PLE * 2 <= PB_LAYER && WS_W + DEPTH * W_LAYER <= WS_PB && WS_PB + DEPTH * PB_LAYER <= WS_XN, "d_ws map 2");
constexpr int CW_TMO = 0, CW_CODE = 1, CW_BAR = 4096;
constexpr size_t O_Y = 0, O_KP = (size_t)M * D, O_VP = O_KP + (size_t)DEPTH * MP * D, O_CP = O_VP + (size_t)DEPTH * MP * D, O_PP = O_CP + (size_t)DEPTH * 2 * 2 * 512, O_KS = O_PP + (size_t)DEPTH * 2 * 15 * 512,
                 O_VS = O_KS + (size_t)DEPTH * MS * D, O_CS = O_VS + (size_t)DEPTH * MS * D, O_PS = O_CS + (size_t)DEPTH * DB * 2 * 512, O_END = O_PS + (size_t)DEPTH * DB * 15 * 512;

constexpr int RING_OFF = 0, RING_BYTES = 131072;
constexpr int LDSCTL_OFF = RING_BYTES, MISC_OFF = LDSCTL_OFF + 320;
constexpr int LDS_BYTES = 147456;
static_assert(MISC_OFF + 128 <= LDS_BYTES, "LDS map");
#define GAS __attribute__((address_space(1)))
#define LAS __attribute__((address_space(3)))
typedef unsigned short bf16;
typedef unsigned v4u __attribute__((ext_vector_type(4)));
typedef float f32x4 __attribute__((ext_vector_type(4)));
typedef short bf16x8 __attribute__((ext_vector_type(8)));
typedef GAS unsigned gu32;
typedef GAS unsigned long long gu64;
#define RLX_AGENT __ATOMIC_RELAXED, __HIP_MEMORY_SCOPE_AGENT
#define LDS_WAIT() asm volatile("s_waitcnt lgkmcnt(0)" ::: "memory")
#define VM_WAIT() asm volatile("s_waitcnt vmcnt(0)" ::: "memory")
__device__ __forceinline__ unsigned long long rt() { return __builtin_amdgcn_s_memrealtime(); }
__device__ __forceinline__ unsigned f2bf(float f) { unsigned u = __builtin_bit_cast(unsigned, f); return (u + 0x7fffu + ((u >> 16) & 1u)) >> 16; }
__device__ __forceinline__ unsigned pk2(float lo, float hi) { return f2bf(lo) | (f2bf(hi) << 16); }

#define XB_TMO      128
#define XB_XCNT(j)  (256  + 64 * (j))
#define XB_XSUB(j)  (1280 + 64 * (j))
#define XB_XGEN(j)  (2304 + 64 * (j))
#define XB_TOP      3328
#define XB_TOPGEN   3392
#define XCD_BAR_WORDS 3456
#define XB_SPIN_CAP (1u << 18)

__device__ __forceinline__ unsigned xb_ld(unsigned* p)              { return __hip_atomic_load(p, __ATOMIC_RELAXED, __HIP_MEMORY_SCOPE_AGENT); }
__device__ __forceinline__ unsigned xb_add(unsigned* p, unsigned v) { return __hip_atomic_fetch_add(p, v, __ATOMIC_RELAXED, __HIP_MEMORY_SCOPE_AGENT); }
__device__ __forceinline__ unsigned xb_xcc_id() { return (unsigned)__builtin_amdgcn_s_getreg((3 << 11) | 20) & 0xFu; }
#define XB_SPIN(cond, bar) do { unsigned _sp = 0; while (cond) { __builtin_amdgcn_s_sleep(1); \
    if ((++_sp & 255u) == 0u) { if (xb_ld(&(bar)[XB_TMO])) break; if (_sp > XB_SPIN_CAP) { atomicAdd(&(bar)[XB_TMO], 1u); break; } } } } while (0)

__device__ __forceinline__ int lane_now() { int l; asm volatile("v_mbcnt_lo_u32_b32 %0, -1, 0\n\tv_mbcnt_hi_u32_b32 %0, -1, %0" : "=v"(l)); return l; }
struct XcdBarrier {
    int wave;
    unsigned* bar; unsigned x;
    volatile LAS unsigned* st;
};

__device__ __forceinline__ XcdBarrier xcd_barrier_post(unsigned* bar, volatile LAS unsigned* st) {
    XcdBarrier b; b.wave = (int)__builtin_amdgcn_readfirstlane(threadIdx.x >> 6); b.bar = bar; b.x = xb_xcc_id(); b.st = st;
    if (threadIdx.x == 0) (void)xb_add(&bar[XB_XCNT(b.x)], 1u);
    return b;
}
__device__ __forceinline__ void xcd_barrier_complete(unsigned* bar, unsigned x, unsigned& nloc, unsigned& nx) {
    const unsigned G = gridDim.x * gridDim.y * gridDim.z;
    unsigned sum, cnt, mine, sp = 0u;
    for (;;) {
        sum = 0u; cnt = 0u; mine = 0u;
#pragma unroll
        for (unsigned j = 0; j < 16; ++j) { const unsigned c = xb_ld(&bar[XB_XCNT(j)]); sum += c; cnt += (c > 0u) ? 1u : 0u; mine = (j == x) ? c : mine; }
        if (sum == G) break;
        __builtin_amdgcn_s_sleep(1);
        if ((++sp & 255u) == 0u) { if (xb_ld(&bar[XB_TMO])) break; if (sp > XB_SPIN_CAP) { atomicAdd(&bar[XB_TMO], 1u); break; } }
    }
    nloc = mine > 0u ? mine : 1u; nx = cnt > 0u ? cnt : 1u;
}

__device__ __forceinline__ void xcd_barrier(const XcdBarrier& b) {
    asm volatile("s_waitcnt vmcnt(0)" ::: "memory");
    __syncthreads();
    if (b.wave == 0 && lane_now() == 0) {
        unsigned* bar = b.bar;
        __builtin_amdgcn_s_waitcnt(0);
        unsigned nloc = b.st[0], nx = b.st[1];
        if (nloc == 0u) { xcd_barrier_complete(bar, b.x, nloc, nx); b.st[0] = nloc; b.st[1] = nx; }
        const unsigned old = xb_add(&bar[XB_XSUB(b.x)], 1u);
        const unsigned gen = old / nloc;
        if (old + 1u == (gen + 1u) * nloc) {
            __builtin_amdgcn_fence(__ATOMIC_RELEASE, "agent");
            asm volatile("s_waitcnt vmcnt(0)" ::: "memory");
            const unsigned og = xb_add(&bar[XB_TOP], 1u);
            const unsigned tg = og / nx;
            if (og + 1u == (tg + 1u) * nx) xb_add(&bar[XB_TOPGEN], 1u);
            else XB_SPIN(xb_ld(&bar[XB_TOPGEN]) == tg, bar);
            __builtin_amdgcn_fence(__ATOMIC_ACQUIRE, "agent");
            xb_add(&bar[XB_XGEN(b.x)], 1u);
            asm volatile("s_waitcnt vmcnt(0)" ::: "memory");
        } else {
            XB_SPIN(xb_ld(&bar[XB_XGEN(b.x)]) == gen, bar);
            __builtin_amdgcn_fence(__ATOMIC_ACQUIRE, "agent");
            asm volatile("s_waitcnt vmcnt(0)" ::: "memory");
        }
    }
    __syncthreads();
}
constexpr int NSG_C = 64;
struct Frame {
    LAS unsigned char* lds;
    volatile LAS unsigned* MISC;
    gu32* ctl;
    int wave;
    int vcu, G;
    unsigned lbn;
    int sidx, pidx;
    const float* in[21]; float* out; unsigned char* ws;
};
__device__ __forceinline__ float wave_sum(float v) {
#pragma unroll
    for (int o = 1; o < 64; o <<= 1) v += __shfl_xor(v, o);
    return v;
}
__device__ __forceinline__ bf16* wsb(Frame& F, size_t off) { return (bf16*)(F.ws + off); }
__device__ __forceinline__ bf16* wlayer(Frame& F, int li, size_t off) { return (bf16*)(F.ws + WS_W + (size_t)li * W_LAYER + off); }

__device__ __forceinline__ int map_row(int kind, int n0) {
    if (kind == 1) { const int bj = n0 / DFF, rem = n0 - bj * DFF; return (rem >> 7) * 256 + bj * 128 + (rem & 127); }
    if (kind == 2) {
        if (n0 < 2048) return (n0 & ~255) + ((n0 >> 5) & 1) * 128 + ((n0 >> 6) & 3) * 32;
        if (n0 >= 3584 && n0 < 4608) { const int x = n0 >= 4096, j = n0 - (x ? 4096 : 3584); return 3584 + (j >> 7) * 256 + x * 128 + (j & 127); }
        return n0; }
    return n0;
}
__device__ __forceinline__ void p0_transpose_item(const float* W, int N, bf16* WT, int ldk, int kind, LAS float* scr, int item, int lane) {
    const int nblk = N / 32, kb = item / nblk, nb = item % nblk, k0 = 64 * kb, n0 = 32 * nb;
#pragma unroll 8
    for (int i = 0; i < 32; ++i) { const int kk = 2 * i + (lane >> 5); scr[kk * 33 + (lane & 31)] = W[(size_t)(k0 + kk) * N + n0 + (lane & 31)]; }
    LDS_WAIT(); asm volatile("" ::: "memory");
    const int c = lane & 7; const int r0 = map_row(kind, n0);
#pragma unroll
    for (int j = 0; j < 4; ++j) { const int n = (lane >> 3) + 8 * j; const LAS float* s = scr + (8 * c) * 33 + n;
        v4u o; o.x = pk2(s[0 * 33], s[1 * 33]); o.y = pk2(s[2 * 33], s[3 * 33]); o.z = pk2(s[4 * 33], s[5 * 33]); o.w = pk2(s[6 * 33], s[7 * 33]);
        *(GAS v4u*)(WT + (size_t)(r0 + n) * ldk + k0 + 8 * c) = o; }
    LDS_WAIT(); asm volatile("" ::: "memory");
}
__device__ __forceinline__ void p0_weff_item(const float* pool_w, const float* pool_scale, const float* wbr, bf16* WT, int item, int lane) {
    const int kb = item >> 4, nb = item & 15, k0 = kb * 8, g = k0 >> 7, c0 = k0 & 127, n = nb * 64 + lane;
    float acc[8];
#pragma unroll
    for (int i = 0; i < 8; ++i) acc[i] = 0.f;
    const float* pw = pool_w + ((size_t)g * 128 + c0) * 128; const float* ps = pool_scale + g * 128; const float* wb = wbr + (size_t)(1536 + g * 128) * D + n;
    for (int dd = 0; dd < 128; ++dd) { const float w = wb[(size_t)dd * D] * ps[dd];
#pragma unroll
        for (int i = 0; i < 8; ++i) acc[i] += pw[i * 128 + dd] * w; }
    v4u o; o.x = pk2(acc[0], acc[1]); o.y = pk2(acc[2], acc[3]); o.z = pk2(acc[4], acc[5]); o.w = pk2(acc[6], acc[7]);
    *(GAS v4u*)(WT + (size_t)n * KBR + 1536 + k0) = o;
}
__device__ __forceinline__ void norm_row(int lane, const float* yrow, const float* hin, float coef, const float* ga, float* hout, const float* gb, bf16* xnrow) {
    const GAS f32x4* hr = (const GAS f32x4*)hin + lane;
    f32x4 h[4];
#pragma unroll
    for (int j = 0; j < 4; ++j) h[j] = hr[64 * j];
    if (yrow) {
        const GAS f32x4* yr = (const GAS f32x4*)yrow + lane; f32x4 y[4]; float s = 0.f;
#pragma unroll
        for (int j = 0; j < 4; ++j) { y[j] = yr[64 * j]; s += (y[j].x * y[j].x + y[j].y * y[j].y) + (y[j].z * y[j].z + y[j].w * y[j].w); }
        const float r = coef * __builtin_amdgcn_rsqf(wave_sum(s) * (1.f / D) + RMS_EPS);
#pragma unroll
        for (int j = 0; j < 4; ++j) { const f32x4 g = ((const GAS f32x4*)ga + lane)[64 * j]; h[j] = h[j] + y[j] * r * g; }
    }
    GAS f32x4* ho = (GAS f32x4*)hout + lane;
#pragma unroll
    for (int j = 0; j < 4; ++j) ho[64 * j] = h[j];
    if (xnrow) {
        float s2 = 0.f;
#pragma unroll
        for (int j = 0; j < 4; ++j) s2 += (h[j].x * h[j].x + h[j].y * h[j].y) + (h[j].z * h[j].z + h[j].w * h[j].w);
        const float r2 = __builtin_amdgcn_rsqf(wave_sum(s2) * (1.f / D) + RMS_EPS);
        GAS unsigned long long* o8 = (GAS unsigned long long*)xnrow + lane;
#pragma unroll
        for (int j = 0; j < 4; ++j) { const f32x4 g = ((const GAS f32x4*)gb + lane)[64 * j]; const f32x4 v = h[j] * r2 * g;
            o8[64 * j] = (unsigned long long)pk2(v.x, v.y) | ((unsigned long long)pk2(v.z, v.w) << 32); }
    }
}
__device__ __forceinline__ void rope_entry(int pos, int d, float& c, float& s) {
    double inv = 1.0; for (int i = 0; i < d; ++i) inv *= 0.7498942093324559;
    const float ang = (float)pos * (float)inv; const double a = (double)ang;
    const double q = __builtin_rint(a * 0.6366197723675814);
    double y = __builtin_fma(-q, 1.5707963267948966, a); y = __builtin_fma(-q, 6.123233995736766e-17, y);
    const double y2 = y * y;
    const double sp = y * (1.0 + y2 * (-1.0 / 6.0 + y2 * (1.0 / 120.0 + y2 * (-1.0 / 5040.0 + y2 * (1.0 / 362880.0 + y2 * (-1.0 / 39916800.0 + y2 * (1.0 / 6227020800.0)))))));
    const double cp = 1.0 + y2 * (-0.5 + y2 * (1.0 / 24.0 + y2 * (-1.0 / 720.0 + y2 * (1.0 / 40320.0 + y2 * (-1.0 / 3628800.0 + y2 * (1.0 / 479001600.0 + y2 * (-1.0 / 87178291200.0)))))));
    const int qi = ((int)q) & 3;
    const double sv = (qi == 0) ? sp : (qi == 1) ? cp : (qi == 2) ? -sp : -cp;
    const double cv = (qi == 0) ? cp : (qi == 1) ? -sp : (qi == 2) ? -cp : sp;
    c = (float)cv; s = (float)sv;
}
struct RowRegs { f32x4 y[4], h[4]; };
typedef unsigned u32x2r __attribute__((ext_vector_type(2)));
__device__ __forceinline__ f32x4 bf4_to_f32(const u32x2r w) { return (f32x4){__uint_as_float(w.x << 16), __uint_as_float(w.x & 0xffff0000u), __uint_as_float(w.y << 16), __uint_as_float(w.y & 0xffff0000u)}; }
__device__ __forceinline__ void row_load(int lane, const bf16* Y, const bf16* H, int m, RowRegs& R) {
    const GAS u32x2r* yr = (const GAS u32x2r*)(Y + (size_t)m * D) + lane; const GAS u32x2r* hr = (const GAS u32x2r*)(H + (size_t)m * D) + lane;
    u32x2r yw[4], hw[4];
#pragma unroll
    for (int j = 0; j < 4; ++j) { yw[j] = yr[64 * j]; hw[j] = hr[64 * j]; }
#pragma unroll
    for (int j = 0; j < 4; ++j) { R.y[j] = bf4_to_f32(yw[j]); R.h[j] = bf4_to_f32(hw[j]); }
}
__device__ __forceinline__ void row_finish(int lane, RowRegs& R, float coef, const f32x4 (&ga)[4], const f32x4 (&gb)[4], bf16* H, bf16* XN, int m, bool write_xn, float* fin) {
    float s = 0.f;
#pragma unroll
    for (int j = 0; j < 4; ++j) s += (R.y[j].x * R.y[j].x + R.y[j].y * R.y[j].y) + (R.y[j].z * R.y[j].z + R.y[j].w * R.y[j].w);
    const float r = coef * __builtin_amdgcn_rsqf(wave_sum(s) * (1.f / D) + RMS_EPS);
    GAS unsigned long long* hb = (GAS unsigned long long*)(H + (size_t)m * D) + lane; GAS f32x4* ho = (GAS f32x4*)(fin + (size_t)m * D) + lane; float s2 = 0.f;
#pragma unroll
    for (int j = 0; j < 4; ++j) { R.h[j] = R.h[j] + R.y[j] * r * ga[j]; if (fin) ho[64 * j] = R.h[j]; else hb[64 * j] = (unsigned long long)pk2(R.h[j].x, R.h[j].y) | ((unsigned long long)pk2(R.h[j].z, R.h[j].w) << 32); s2 += (R.h[j].x * R.h[j].x + R.h[j].y * R.h[j].y) + (R.h[j].z * R.h[j].z + R.h[j].w * R.h[j].w); }
    if (write_xn) {
        const float r2 = __builtin_amdgcn_rsqf(wave_sum(s2) * (1.f / D) + RMS_EPS);
        GAS unsigned long long* o8 = (GAS unsigned long long*)(XN + (size_t)m * D) + lane;
#pragma unroll
        for (int j = 0; j < 4; ++j) { const f32x4 v = R.h[j] * r2 * gb[j]; o8[64 * j] = (unsigned long long)pk2(v.x, v.y) | ((unsigned long long)pk2(v.z, v.w) << 32); }
    }
}
__device__ __forceinline__ void norm_phase(Frame& F, float coef, const float* ga_, const float* gb_, bool write_xn, int m0, int m1, int gw, int NGW, bool dry = false, bool final_ = false) {
    const bf16* Y = (const bf16*)(F.ws + WS_YB); bf16* XN = dry ? (bf16*)(F.ws + WS_DUMMY + 160 * MiB) : wsb(F, WS_XN); const bf16* H = wsb(F, WS_HB); bf16* HO = dry ? (bf16*)(F.ws + WS_DUMMY) : wsb(F, WS_HB);
    float* fin = (final_ && !dry) ? F.out : nullptr;
    const int lane = lane_now();
    f32x4 ga[4], gb[4];
#pragma unroll
    for (int j = 0; j < 4; ++j) { ga[j] = ((const GAS f32x4*)ga_ + lane)[64 * j]; gb[j] = write_xn ? ((const GAS f32x4*)gb_ + lane)[64 * j] : (f32x4){0.f, 0.f, 0.f, 0.f}; }
    for (int m = m0 + gw; m < m1; m += 4 * NGW) {
        const int mb = m + NGW, mc = m + 2 * NGW, md = m + 3 * NGW; const bool hasb = mb < m1, hasc = mc < m1, hasd = md < m1;
        RowRegs A, B, C, E; row_load(lane, Y, H, m, A); if (hasb) row_load(lane, Y, H, mb, B); if (hasc) row_load(lane, Y, H, mc, C); if (hasd) row_load(lane, Y, H, md, E);
        row_finish(lane, A, coef, ga, gb, HO, XN, m, write_xn, fin);
        if (hasb) row_finish(lane, B, coef, ga, gb, HO, XN, mb, write_xn, fin);
        if (hasc) row_finish(lane, C, coef, ga, gb, HO, XN, mc, write_xn, fin);
        if (hasd) row_finish(lane, E, coef, ga, gb, HO, XN, md, write_xn, fin);
    }
}
__device__ __forceinline__ void norm_phase_sample(Frame& F, float coef, const float* ga_, const float* gb_, bool write_xn, const float* ysrc, int nslab, bool final_ = false) {
    const int lane = lane_now(); bf16* XN = wsb(F, WS_XN); bf16* H = wsb(F, WS_HB); float* fin = final_ ? F.out : nullptr;
    f32x4 ga[4], gb[4];
#pragma unroll
    for (int j = 0; j < 4; ++j) { ga[j] = ((const GAS f32x4*)ga_ + lane)[64 * j]; gb[j] = write_xn ? ((const GAS f32x4*)gb_ + lane)[64 * j] : (f32x4){0.f, 0.f, 0.f, 0.f}; }
    for (int r = F.sidx * NWAVES + F.wave; r < MS; r += NSG_C * NWAVES) {
        RowRegs A; const int m = MP + r;
        const GAS u32x2r* hr = (const GAS u32x2r*)(H + (size_t)m * D) + lane;
#pragma unroll
        for (int j = 0; j < 4; ++j) { A.h[j] = bf4_to_f32(hr[64 * j]); A.y[j] = (f32x4){0.f, 0.f, 0.f, 0.f}; }
        for (int sl = 0; sl < nslab; ++sl) { const GAS f32x4* yr = (const GAS f32x4*)(ysrc + (size_t)sl * MS * D + (size_t)r * D) + lane;
#pragma unroll
            for (int j = 0; j < 4; ++j) A.y[j] = A.y[j] + yr[64 * j]; }
        if (nslab == 0) { const GAS u32x2r* yr = (const GAS u32x2r*)((const bf16*)(F.ws + WS_YB) + (size_t)m * D) + lane;
#pragma unroll
            for (int j = 0; j < 4; ++j) A.y[j] = bf4_to_f32(yr[64 * j]); }
        row_finish(lane, A, coef, ga, gb, H, XN, m, write_xn, fin);
    }
}
__device__ __forceinline__ void p0_layer(Frame& F, const int li, const int gw, const int NGW, const int parts = 31) {
    LAS float* scr = (LAS float*)(F.lds + RING_OFF + F.wave * 16384);
    const int lane = lane_now();
    for (int f = 0; f < 2; ++f) {
        if (parts & 1) { const float* wu = F.in[9] + (size_t)(li * 2 + f) * D * NUP; bf16* du = wlayer(F, li, f ? W_UP2 : W_UP1);
            for (int it = gw; it < (D / 64) * (NUP / 32); it += NGW) p0_transpose_item(wu, NUP, du, D, 1, scr, it, lane); }
        if (parts & 2) { const float* wd = F.in[10] + (size_t)(li * 2 + f) * DFF * D; bf16* dd = wlayer(F, li, f ? W_DN2 : W_DN1);
            for (int it = gw; it < (DFF / 64) * (D / 32); it += NGW) p0_transpose_item(wd, D, dd, DFF, 0, scr, it, lane); }
    }
    if (parts & 4) for (int it = gw; it < (D / 64) * (NIN / 32); it += NGW) p0_transpose_item(F.in[11] + (size_t)li * D * NIN, NIN, wlayer(F, li, W_IN), D, 2, scr, it, lane);
    if (parts & 8) {
        for (int it = gw; it < (1536 / 64) * (D / 32); it += NGW) p0_transpose_item(F.in[17] + (size_t)li * KBR * D, D, wlayer(F, li, W_BR), KBR, 0, scr, it, lane);
        for (int it = gw; it < (D / 64) * (D / 32); it += NGW) p0_transpose_item(F.in[18] + (size_t)li * D * D, D, wlayer(F, li, W_OUT), D, 0, scr, it, lane);
        for (int it = gw; it < (D / 64) * (D / 32); it += NGW) p0_transpose_item(F.in[20] + (size_t)li * D * D, D, wlayer(F, li, W_PG), D, 0, scr, it, lane);
        for (int it = gw; it < (PLE / 64) * (D / 32); it += NGW) p0_transpose_item(F.in[19] + (size_t)li * PLE * D, D, wlayer(F, li, W_PU), PLE, 0, scr, it, lane);
        for (int it = gw; it < 64 * 16; it += NGW) p0_weff_item(F.in[15] + (size_t)li * 4 * 128 * 128, F.in[16] + (size_t)li * 512, F.in[17] + (size_t)li * KBR * D, wlayer(F, li, W_BR), it, lane);
    }
    if (parts & 16) { bf16* pb = (bf16*)(F.ws + WS_PB + (size_t)li * PB_LAYER);
        for (int m = gw; m < M; m += NGW) { const float* src = m < MP ? F.in[6] + ((size_t)li * MP + m) * PLE : F.in[7] + ((size_t)li * MS + (m - MP)) * PLE;
            const f32x4 v = ((const GAS f32x4*)src)[lane]; ((GAS unsigned long long*)(pb + (size_t)m * PLE))[lane] = (unsigned long long)pk2(v.x, v.y) | ((unsigned long long)pk2(v.z, v.w) << 32); } }
}
__device__ __forceinline__ void p0_prologue(Frame& F) {
    const int gw = F.vcu * NWAVES + F.wave, NGW = F.G * NWAVES; const int lane = lane_now();
    p0_layer(F, 0, gw, NGW);
    { float* rc = (float*)(F.ws + WS_ROPEC); float* rs = (float*)(F.ws + WS_ROPES);
      for (int i = gw * 64 + lane; i < SEQ * 32; i += NGW * 64) { float c, s; rope_entry(i >> 5, i & 31, c, s); rc[i] = c; rs[i] = s; } }
    bf16* XN = wsb(F, WS_XN); bf16* HB = wsb(F, WS_HB);
    for (int m = gw; m < M; m += NGW) { const float* xr = m < MP ? F.in[0] + (size_t)m * D : F.in[1] + (size_t)(m - MP) * D;
        const GAS f32x4* xp = (const GAS f32x4*)xr + lane; f32x4 h[4]; float s2 = 0.f;
#pragma unroll
        for (int j = 0; j < 4; ++j) { h[j] = xp[64 * j]; s2 += (h[j].x * h[j].x + h[j].y * h[j].y) + (h[j].z * h[j].z + h[j].w * h[j].w); }
        const float r2 = __builtin_amdgcn_rsqf(wave_sum(s2) * (1.f / D) + RMS_EPS);
        GAS unsigned long long* hb = (GAS unsigned long long*)(HB + (size_t)m * D) + lane; GAS unsigned long long* o8 = (GAS unsigned long long*)(XN + (size_t)m * D) + lane;
#pragma unroll
        for (int j = 0; j < 4; ++j) { hb[64 * j] = (unsigned long long)pk2(h[j].x, h[j].y) | ((unsigned long long)pk2(h[j].z, h[j].w) << 32);
            const f32x4 g = ((const GAS f32x4*)F.in[8] + lane)[64 * j]; const f32x4 v = h[j] * r2 * g; o8[64 * j] = (unsigned long long)pk2(v.x, v.y) | ((unsigned long long)pk2(v.z, v.w) << 32); } }
}
__device__ __forceinline__ void unpack8f(const v4u w, float (&f)[8]) {
    f[0] = __uint_as_float(w.x << 16); f[1] = __uint_as_float(w.x & 0xffff0000u); f[2] = __uint_as_float(w.y << 16); f[3] = __uint_as_float(w.y & 0xffff0000u);
    f[4] = __uint_as_float(w.z << 16); f[5] = __uint_as_float(w.z & 0xffff0000u); f[6] = __uint_as_float(w.w << 16); f[7] = __uint_as_float(w.w & 0xffff0000u); }
__device__ __forceinline__ v4u pack8f(const float (&f)[8]) { v4u o; o.x = pk2(f[0], f[1]); o.y = pk2(f[2], f[3]); o.z = pk2(f[4], f[5]); o.w = pk2(f[6], f[7]); return o; }
__device__ __forceinline__ void e2_phase(Frame& F, int li, int m0, int m1, int gw, int NGW) {
    const int lane = lane_now();
    const float* lam = F.in[12] + li * 256;
    const float s1 = wave_sum(lam[lane] * lam[64 + lane]), s2 = wave_sum(lam[128 + lane] * lam[192 + lane]);
    const float lam_init = 0.8f - 0.6f * __expf(-0.3f * (float)li);
    const float lam_full = __expf(s1) - __expf(s2) + lam_init, osc = 1.0f - lam_init;
    const bf16* O = wsb(F, WS_O); const bf16* BG = wsb(F, WS_BG); const bf16* C = wsb(F, WS_C); const bf16* ZP = wsb(F, WS_ZP); bf16* A2 = wsb(F, WS_A2);
    const int hh = lane >> 3, e0 = (lane & 7) * 16, c0 = lane * 8, grp = lane >> 4, win = 2 << grp;
    float sg[16];
#pragma unroll
    for (int i = 0; i < 16; ++i) sg[i] = F.in[13][li * 1024 + hh * 128 + e0 + i];
    float cw[3][8];
#pragma unroll
    for (int j = 0; j < 3; ++j)
#pragma unroll
        for (int i = 0; i < 8; ++i) cw[j][i] = F.in[14][(li * 3 + j) * 512 + c0 + i];
    for (int m = m0 + gw; m < m1; m += NGW) {
        const bool samp = m >= MP; const int t = samp ? ((m - MP) & 31) : (m & (SEQ - 1)); const int b = samp ? ((m - MP) >> 5) : (m >> 14); const int T = samp ? DSEQ : SEQ;
        { const bf16* orow = O + (size_t)m * 2048 + hh * 256 + e0;
          float o1[16], o2[16]; { float t8[8]; unpack8f(*(const GAS v4u*)orow, t8); for (int i = 0; i < 8; ++i) o1[i] = t8[i]; unpack8f(*(const GAS v4u*)(orow + 8), t8); for (int i = 0; i < 8; ++i) o1[8 + i] = t8[i];
              unpack8f(*(const GAS v4u*)(orow + 128), t8); for (int i = 0; i < 8; ++i) o2[i] = t8[i]; unpack8f(*(const GAS v4u*)(orow + 136), t8); for (int i = 0; i < 8; ++i) o2[8 + i] = t8[i]; }
          float ss = 0.f;
#pragma unroll
          for (int i = 0; i < 16; ++i) { o1[i] = o1[i] - lam_full * o2[i]; ss += o1[i] * o1[i]; }
          ss += __shfl_xor(ss, 1); ss += __shfl_xor(ss, 2); ss += __shfl_xor(ss, 4);
          const float r = __builtin_amdgcn_rsqf(ss * (1.f / 128.f) + RMS_EPS) * osc;
          float a0[8], a1[8];
#pragma unroll
          for (int i = 0; i < 8; ++i) { a0[i] = o1[i] * r * sg[i]; a1[i] = o1[8 + i] * r * sg[8 + i]; }
          bf16* arow = A2 + (size_t)m * KBR + hh * 128 + e0; *(GAS v4u*)arow = pack8f(a0); *(GAS v4u*)(arow + 8) = pack8f(a1); }
        { float z0[8], z1[8], z2[8], bgv[8];
          unpack8f(*(const GAS v4u*)(C + (size_t)m * 512 + c0), z0); unpack8f(*(const GAS v4u*)(BG + (size_t)m * 512 + c0), bgv);
          const float* hist = F.in[4] + ((size_t)(li * DB + b) * 2) * 512 + c0;
          if (t >= 1) unpack8f(*(const GAS v4u*)(C + (size_t)(m - 1) * 512 + c0), z1);
          else { for (int i = 0; i < 8; ++i) z1[i] = samp ? hist[512 + i] : 0.f; }
          if (t >= 2) unpack8f(*(const GAS v4u*)(C + (size_t)(m - 2) * 512 + c0), z2);
          else { for (int i = 0; i < 8; ++i) z2[i] = samp ? hist[t * 512 + i] : 0.f; }
          float y[8];
#pragma unroll
          for (int i = 0; i < 8; ++i) y[i] = bgv[i] * (cw[0][i] * z2[i] + cw[1][i] * z1[i] + cw[2][i] * z0[i]);
          *(GAS v4u*)(A2 + (size_t)m * KBR + 1024 + c0) = pack8f(y);
          if (t >= T - 2) { float* dst = samp ? F.out + O_CS + ((size_t)(li * DB + b) * 2 + (t - (T - 2))) * 512 + c0 : F.out + O_CP + ((size_t)(li * 2 + b) * 2 + (t - (T - 2))) * 512 + c0;
              *(GAS f32x4*)dst = (f32x4){z0[0], z0[1], z0[2], z0[3]}; *(GAS f32x4*)(dst + 4) = (f32x4){z0[4], z0[5], z0[6], z0[7]}; } }
        { float zc[8], ws8[8]; unpack8f(*(const GAS v4u*)(ZP + (size_t)m * 512 + c0), zc);
#pragma unroll
          for (int i = 0; i < 8; ++i) ws8[i] = zc[i];
          if (t >= 15) {
              v4u zr[15];
#pragma unroll
              for (int j = 1; j < 16; ++j) { const int jj = j < win ? j : win - 1; zr[j - 1] = *(const GAS v4u*)(ZP + (size_t)(m - jj) * 512 + c0); }
#pragma unroll
              for (int j = 1; j < 16; ++j) { float zz[8]; unpack8f(zr[j - 1], zz); const float wj = j < win ? 1.f : 0.f;
#pragma unroll
                  for (int q = 0; q < 8; ++q) ws8[q] += wj * zz[q]; }
          } else {
          const float* phist = F.in[5] + ((size_t)(li * DB + b) * 15) * 512 + c0;
          for (int j = 1; j < 16; ++j) { if (j < win) { const int i = t - j;
                  if (i >= 0) { float zz[8]; unpack8f(*(const GAS v4u*)(ZP + (size_t)(m - j) * 512 + c0), zz);
#pragma unroll
                      for (int q = 0; q < 8; ++q) ws8[q] += zz[q]; }
                  else if (samp) { const float* hp = phist + (size_t)(15 + i) * 512;
#pragma unroll
                      for (int q = 0; q < 8; ++q) ws8[q] += hp[q]; } } }
          }
          const int cnt = min(t + 1 + (samp ? 15 : 0), win); const float rc = 1.0f / (float)cnt;
          float dv[8];
#pragma unroll
          for (int i = 0; i < 8; ++i) dv[i] = ws8[i] * rc - zc[i];
          *(GAS v4u*)(A2 + (size_t)m * KBR + 1536 + c0) = pack8f(dv);
          if (t >= T - 15) { float* dst = samp ? F.out + O_PS + ((size_t)(li * DB + b) * 15 + (t - (T - 15))) * 512 + c0 : F.out + O_PP + ((size_t)(li * 2 + b) * 15 + (t - (T - 15))) * 512 + c0;
              *(GAS f32x4*)dst = (f32x4){zc[0], zc[1], zc[2], zc[3]}; *(GAS f32x4*)(dst + 4) = (f32x4){zc[4], zc[5], zc[6], zc[7]}; } }
    }
}
typedef float f32x16 __attribute__((ext_vector_type(16)));
__device__ __forceinline__ bf16x8 cvt8(const f32x4 a, const f32x4 b) { v4u w; w.x = pk2(a.x, a.y); w.y = pk2(a.z, a.w); w.z = pk2(b.x, b.y); w.w = pk2(b.z, b.w); return __builtin_bit_cast(bf16x8, w); }
__device__ __forceinline__ int crow16(int r, int hi) { return (r & 3) + 8 * (r >> 2) + 4 * hi; }
__device__ __forceinline__ void sattn_unit(Frame& F, int li, int b, int head) {
    const int lane = lane_now(), wid = F.wave, r32 = lane & 31, hi = lane >> 5;
    LAS float* Lmx = (LAS float*)(F.lds + LDSCTL_OFF + 1024);
    LAS float* Lsum = (LAS float*)(F.lds + LDSCTL_OFF + 3072);
    const bf16* Qs = wsb(F, WS_Q) + (size_t)(MP + b * DSEQ) * D;
    const float* kc = F.in[2] + ((size_t)(li * DB + b) * PAST) * D; const float* vc = F.in[3] + ((size_t)(li * DB + b) * PAST) * D;
    const float* kn = F.out + O_KS + ((size_t)li * MS + b * DSEQ) * D; const float* vn = F.out + O_VS + ((size_t)li * MS + b * DSEQ) * D;
    bf16x8 qr[2][4];
#pragma unroll
    for (int mm = 0; mm < 2; ++mm)
#pragma unroll
        for (int d0 = 0; d0 < 4; ++d0) qr[mm][d0] = *(const GAS bf16x8*)(Qs + (size_t)r32 * D + (2 * head + mm) * 64 + d0 * 16 + hi * 8);
    const int nblk = (wid == 0) ? 5 : 4;
    f32x16 o[2][4];
#pragma unroll
    for (int mm = 0; mm < 2; ++mm)
#pragma unroll
        for (int eb = 0; eb < 4; ++eb) o[mm][eb] = (f32x16){};
    float lsum[2] = {0.f, 0.f}, mrun[2] = {-1e30f, -1e30f};
    for (int i = 0; i < nblk; ++i) { const int blk = (i < 4) ? wid + 8 * i : 32; const float* kb = (blk < 32) ? kc + (size_t)(blk * 32) * D : kn; const float* vb = (blk < 32) ? vc + (size_t)(blk * 32) * D : vn;
        f32x16 s[2];
#pragma unroll
        for (int mm = 0; mm < 2; ++mm) { s[mm] = (f32x16){};
#pragma unroll
            for (int d0 = 0; d0 < 4; ++d0) { const float* kp = kb + (size_t)r32 * D + (2 * head + mm) * 64 + d0 * 16 + hi * 8; const bf16x8 kf = cvt8(*(const GAS f32x4*)kp, *(const GAS f32x4*)(kp + 4));
                s[mm] = __builtin_amdgcn_mfma_f32_32x32x16_bf16(kf, qr[mm][d0], s[mm], 0, 0, 0); } }
        bf16x8 pf[2][2];
#pragma unroll
        for (int mm = 0; mm < 2; ++mm) {
            float mloc = s[mm][0];
#pragma unroll
            for (int r = 1; r < 16; ++r) mloc = fmaxf(mloc, s[mm][r]);
            mloc = fmaxf(mloc, __shfl_xor(mloc, 32));
            const float mnew = fmaxf(mrun[mm], mloc), sc = __builtin_amdgcn_exp2f(mrun[mm] - mnew); mrun[mm] = mnew;
            lsum[mm] *= sc;
#pragma unroll
            for (int eb = 0; eb < 4; ++eb)
#pragma unroll
                for (int r = 0; r < 16; ++r) o[mm][eb][r] *= sc;
            float acc = 0.f;
#pragma unroll
            for (int r = 0; r < 16; ++r) { s[mm][r] = __builtin_amdgcn_exp2f(s[mm][r] - mnew); acc += s[mm][r]; }
            lsum[mm] += acc;
#pragma unroll
            for (int k2 = 0; k2 < 2; ++k2) pf[mm][k2] = cvt8((f32x4){s[mm][8 * k2], s[mm][8 * k2 + 1], s[mm][8 * k2 + 2], s[mm][8 * k2 + 3]}, (f32x4){s[mm][8 * k2 + 4], s[mm][8 * k2 + 5], s[mm][8 * k2 + 6], s[mm][8 * k2 + 7]}); }
#pragma unroll
        for (int eb = 0; eb < 4; ++eb)
#pragma unroll
            for (int k2 = 0; k2 < 2; ++k2) { const float* vp = vb + (size_t)(16 * k2 + 4 * hi) * D + head * 128 + eb * 32 + r32;
                const f32x4 va = {vp[0], vp[D], vp[2 * D], vp[3 * D]}, vb4 = {vp[8 * D], vp[9 * D], vp[10 * D], vp[11 * D]}; const bf16x8 vf = cvt8(va, vb4);
                o[0][eb] = __builtin_amdgcn_mfma_f32_32x32x16_bf16(vf, pf[0][k2], o[0][eb], 0, 0, 0); o[1][eb] = __builtin_amdgcn_mfma_f32_32x32x16_bf16(vf, pf[1][k2], o[1][eb], 0, 0, 0); } }
#pragma unroll
    for (int mm = 0; mm < 2; ++mm) { lsum[mm] += __shfl_xor(lsum[mm], 32); if (hi == 0) { Lmx[(mm * 8 + wid) * 32 + r32] = mrun[mm]; Lsum[(mm * 8 + wid) * 32 + r32] = lsum[mm]; } }
    __syncthreads();
#pragma unroll
    for (int mm = 0; mm < 2; ++mm) { float M = Lmx[(mm * 8) * 32 + r32];
#pragma unroll
        for (int w = 1; w < 8; ++w) M = fmaxf(M, Lmx[(mm * 8 + w) * 32 + r32]);
        const float f = __builtin_amdgcn_exp2f(mrun[mm] - M);
#pragma unroll
        for (int eb = 0; eb < 4; ++eb)
#pragma unroll
            for (int r = 0; r < 16; ++r) o[mm][eb][r] *= f; }
    LAS float* Lw = (LAS float*)(F.lds + RING_OFF) + wid * 4096;
#pragma unroll
    for (int mm = 0; mm < 2; ++mm) {
        __syncthreads();
#pragma unroll
        for (int eb = 0; eb < 4; ++eb)
#pragma unroll
            for (int r = 0; r < 16; ++r) Lw[(eb * 32 + crow16(r, hi)) * 32 + r32] = o[mm][eb][r];
        __syncthreads();
        { const int q = lane & 31, e0 = (wid * 2 + (lane >> 5)) * 8; float L = 0.f;
          float Mq = Lmx[(mm * 8) * 32 + q];
#pragma unroll
          for (int w = 1; w < 8; ++w) Mq = fmaxf(Mq, Lmx[(mm * 8 + w) * 32 + q]);
#pragma unroll
          for (int w = 0; w < 8; ++w) L += Lsum[(mm * 8 + w) * 32 + q] * __builtin_amdgcn_exp2f(Lmx[(mm * 8 + w) * 32 + q] - Mq);
          const float inv = 1.0f / L; float v[8];
#pragma unroll
          for (int i = 0; i < 8; ++i) { float a = 0.f;
#pragma unroll
              for (int w = 0; w < 8; ++w) a += ((LAS float*)(F.lds + RING_OFF))[w * 4096 + (e0 + i) * 32 + q];
              v[i] = a * inv; }
          bf16* orow = wsb(F, WS_O) + (size_t)(MP + b * DSEQ + q) * 2048 + (2 * head + mm) * 128 + e0; *(GAS v4u*)orow = pack8f(v); }
    }
    __syncthreads();
}
#ifndef KEEP_UP
#define KEEP_UP 1
#endif
#ifndef KEEP_DOWN
#define KEEP_DOWN 1
#endif
#ifndef KEEP_N1
#define KEEP_N1 1
#endif
#ifndef KEEP_WIN
#define KEEP_WIN 1
#endif
#ifndef KEEP_ATT
#define KEEP_ATT 1
#endif
#ifndef KEEP_E2
#define KEEP_E2 1
#endif
#ifndef KEEP_BR
#define KEEP_BR 1
#endif
#ifndef KEEP_WOUT
#define KEEP_WOUT 1
#endif
#ifndef KEEP_N3
#define KEEP_N3 1
#endif
#ifndef KEEP_PG
#define KEEP_PG 1
#endif
#ifndef KEEP_N5
#define KEEP_N5 1
#endif
#ifndef KEEP_PRO
#define KEEP_PRO 1
#endif
struct Args { const float* in[21]; float* out; unsigned char* ws; int ph_lo, ph_hi; };
#if !MK_PER_PHASE
#define GRID_BAR() do { for (int rb_ = 0; rb_ < REP_BAR; ++rb_) xcd_barrier(bar); } while (0)
#else
#define GRID_BAR() do { if (F.wave == 0 && lane_now() == 0) __hip_atomic_store(F.ctl + CW_TMO, 0xBADBA0u, RLX_AGENT); } while (0)
#endif
#define IN(k) (lo <= (k) && (k) < hi)
#define SEAM(k) do { if (IN(k) && IN((k) + 1)) GRID_BAR(); } while (0)
__device__ __forceinline__ unsigned long long uni64_opaque(unsigned long long v) { unsigned lo = __builtin_amdgcn_readfirstlane((unsigned)v), hi = __builtin_amdgcn_readfirstlane((unsigned)(v >> 32)); asm volatile("" : "+s"(lo), "+s"(hi)); return ((unsigned long long)hi << 32) | lo; }
#define FRESH() do { F.ws = (unsigned char*)(GAS unsigned char*)uni64_opaque((unsigned long long)F.ws); F.out = (float*)(GAS float*)uni64_opaque((unsigned long long)F.out); } while (0)
#define RING (F.lds + RING_OFF)
constexpr int NSG = 64, NPG = 192;
constexpr int CW_GRP = 8192, CW_GRP_TMO = 8256;
constexpr int LB_PER_LAYER = 9;
__device__ __forceinline__ void group_barrier1(Frame& F, const unsigned n) {
    asm volatile("s_waitcnt vmcnt(0)" ::: "memory");
    __syncthreads();
    if (F.wave == 0 && lane_now() == 0) {
        __builtin_amdgcn_s_waitcnt(0);
        __builtin_amdgcn_fence(__ATOMIC_RELEASE, "agent");
        asm volatile("s_waitcnt vmcnt(0)" ::: "memory");
        gu32* c = F.ctl + CW_GRP; const unsigned target = (unsigned)NSG * (n + 1u);
        (void)__hip_atomic_fetch_add(c, 1u, RLX_AGENT);
        unsigned sp = 0u;
        while (__hip_atomic_load(c, RLX_AGENT) < target) { __builtin_amdgcn_s_sleep(1);
            if ((++sp & 255u) == 0u) { if (__hip_atomic_load(F.ctl + CW_GRP_TMO, RLX_AGENT)) break; if (sp > (1u << 20)) { __hip_atomic_store(F.ctl + CW_GRP_TMO, 1u, RLX_AGENT); break; } } }
        __builtin_amdgcn_fence(__ATOMIC_ACQUIRE, "agent");
        asm volatile("s_waitcnt vmcnt(0)" ::: "memory");
    }
    __syncthreads();
}
__device__ __forceinline__ void group_barrier(Frame& F) { for (unsigned r = 0; r < REP_LB; ++r) group_barrier1(F, F.lbn++); }
#define OPAQUE_K(name, val) int name = (val); asm volatile("" : "+s"(name))
#define SAMPLE (F.sidx >= 0)
template <int LI, int HALF> __device__ __forceinline__ void ffn_part(Frame& F, const XcdBarrier& bar, const int lo, const int hi) {
    constexpr int pb = 1 + LI * PH_PER_LAYER, p0 = pb + HALF * 9;
    if (KEEP_UP && IN(p0)) { FRESH(); pg8::Gemm g{wsb(F, WS_XN), wlayer(F, LI, HALF ? W_UP2 : W_UP1), MP, NUP, D}; pg8::StaticOrder S; S.init(MP, NUP, F.G, (int)blockIdx.x);
        pg8::EpiSwiGLU E{wsb(F, WS_HFF), DFF};
        for (int rep = 0; rep < REP_GEMM; ++rep) { if (rep && REP_GEMM_BAR) GRID_BAR(); pg8::gemm_phase<pg8::EpiSwiGLU, pg8::StaticOrder, true, true>(RING, g, S, E, F.wave); } SEAM(p0); }
    if (KEEP_DOWN && IN(p0 + 1)) { FRESH(); { pg8::Gemm g{wsb(F, WS_HFF), wlayer(F, LI, HALF ? W_DN2 : W_DN1), MP, D, DFF}; pg8::StaticOrder S; S.init(MP, D, F.G, (int)blockIdx.x);
        pg8::EpiBf E{wsb(F, WS_YB), D};
        for (int rep = 0; rep < REP_GEMM; ++rep) { if (rep && REP_GEMM_BAR) GRID_BAR(); pg8::gemm_phase<pg8::EpiBf, pg8::StaticOrder, true, true>(RING, g, S, E, F.wave); } } }
    if (KEEP_DOWN && IN(p0 + 1)) {
        if (HALF == 1) { FRESH(); OPAQUE_K(kple, PLE);
            pg8::Gemm g2{(const bf16*)(F.ws + WS_PB + (size_t)LI * PB_LAYER), wlayer(F, LI, W_PU), MP, D, kple}; pg8::StaticOrder S2; S2.init(MP, D, F.G, (int)blockIdx.x);
            pg8::EpiBf E2{wsb(F, WS_PU), D};
            for (int rep = 0; rep < REP_GEMM; ++rep) { if (rep && REP_GEMM_BAR) GRID_BAR(); pg8::gemm_phase<pg8::EpiBf, pg8::StaticOrder, true, true>(RING, g2, S2, E2, F.wave); } }
        SEAM(p0 + 1); }
    if (KEEP_N1 && IN(p0 + 2) && !SAMPLE) { FRESH(); const float* ng = F.in[8] + (size_t)LI * 8 * D; for (int rep = 0; rep < REP_ROW; ++rep) norm_phase(F, 0.5f, ng + (HALF ? 5 : 1) * D, ng + (HALF ? 6 : 2) * D, true, 0, MP, F.pidx * NWAVES + F.wave, NPG * NWAVES, rep + 1 < REP_ROW);
        if (HALF == 0 && LI + 1 < DEPTH) p0_layer(F, LI + 1 < DEPTH ? LI + 1 : LI, F.pidx * NWAVES + F.wave, NPG * NWAVES, 16); }
    if (KEEP_N1 && IN(p0 + 2) && SAMPLE && (HALF == 1 || LI == 0)) { FRESH(); OPAQUE_K(kd, D); pg8::Gemm g{wsb(F, WS_XN), wlayer(F, LI, HALF ? W_UP2 : W_UP1), M, NUP, kd}; pg8::SampleOrder S; S.init(NUP, NSG, F.sidx);
        pg8::EpiSwiGLU E{wsb(F, WS_HFF), DFF};
        for (int rs_ = 0; rs_ < REP_SG; ++rs_) pg8::gemm_phase<pg8::EpiSwiGLU, pg8::SampleOrder, true, true>(RING, g, S, E, F.wave); group_barrier(F); }
    if (KEEP_N1 && IN(p0 + 2) && SAMPLE) { FRESH(); OPAQUE_K(kf, DFF); pg8::Gemm g{wsb(F, WS_HFF), wlayer(F, LI, HALF ? W_DN2 : W_DN1), M, D, kf}; pg8::SampleSplitOrder S; S.init(D, NSG, F.sidx);
        pg8::EpiF32Slab E{(float*)(F.ws + WS_YS)};
        for (int rs_ = 0; rs_ < REP_SG; ++rs_) pg8::gemm_phase<pg8::EpiF32Slab, pg8::SampleSplitOrder, true, true>(RING, g, S, E, F.wave); }
    if (KEEP_N1 && IN(p0 + 2) && SAMPLE && HALF == 1) { FRESH(); OPAQUE_K(kple, PLE);
        pg8::Gemm g2{(const bf16*)(F.ws + WS_PB + (size_t)LI * PB_LAYER), wlayer(F, LI, W_PU), M, D, kple}; pg8::SampleOrder S2; S2.init(D, NSG, (F.sidx + NSG - 32) % NSG);
        pg8::EpiBf E2{wsb(F, WS_PU), D};
        for (int rs_ = 0; rs_ < REP_SG; ++rs_) pg8::gemm_phase<pg8::EpiBf, pg8::SampleOrder, true, true>(RING, g2, S2, E2, F.wave); }
    if (KEEP_N1 && IN(p0 + 2) && SAMPLE) { FRESH(); group_barrier(F); const float* ng = F.in[8] + (size_t)LI * 8 * D;
        norm_phase_sample(F, 0.5f, ng + (HALF ? 5 : 1) * D, ng + (HALF ? 6 : 2) * D, true, (const float*)(F.ws + WS_YS), 4); }
    if (KEEP_N1 && IN(p0 + 2) && SAMPLE && HALF == 0) { FRESH(); group_barrier(F); OPAQUE_K(kd, D); pg8::Gemm g{wsb(F, WS_XN), wlayer(F, LI, W_IN), M, NIN, kd}; pg8::SampleOrder S; S.init(NIN, NSG, F.sidx);
        pg8::EpiWin E{wsb(F, WS_Q), wsb(F, WS_K), wsb(F, WS_V), wsb(F, WS_BG), wsb(F, WS_C), wsb(F, WS_ZP), wsb(F, WS_GS), (const float*)(F.ws + WS_ROPEC), (const float*)(F.ws + WS_ROPES),
                      F.out + O_KP + (size_t)LI * MP * D, F.out + O_VP + (size_t)LI * MP * D, F.out + O_KS + (size_t)LI * MS * D, F.out + O_VS + (size_t)LI * MS * D};
        for (int rs_ = 0; rs_ < REP_SG; ++rs_) pg8::gemm_phase<pg8::EpiWin, pg8::SampleOrder, true, true>(RING, g, S, E, F.wave); }
    if (IN(p0 + 2)) SEAM(p0 + 2);
}
template <int LI> __device__ __forceinline__ void mixer_part(Frame& F, const XcdBarrier& bar, const int lo, const int hi) {
    constexpr int pb = 1 + LI * PH_PER_LAYER;
    if (KEEP_WIN && IN(pb + 3)) { FRESH(); pg8::Gemm g{wsb(F, WS_XN), wlayer(F, LI, W_IN), MP, NIN, D}; pg8::StaticOrder S; S.init(MP, NIN, F.G, (int)blockIdx.x);
        pg8::EpiWin E{wsb(F, WS_Q), wsb(F, WS_K), wsb(F, WS_V), wsb(F, WS_BG), wsb(F, WS_C), wsb(F, WS_ZP), wsb(F, WS_GS), (const float*)(F.ws + WS_ROPEC), (const float*)(F.ws + WS_ROPES),
                      F.out + O_KP + (size_t)LI * MP * D, F.out + O_VP + (size_t)LI * MP * D, F.out + O_KS + (size_t)LI * MS * D, F.out + O_VS + (size_t)LI * MS * D};
        for (int rep = 0; rep < REP_GEMM; ++rep) { if (rep && REP_GEMM_BAR) GRID_BAR(); pg8::gemm_phase<pg8::EpiWin, pg8::StaticOrder, true, true>(RING, g, S, E, F.wave); } SEAM(pb + 3); }
    if (KEEP_ATT && IN(pb + 4)) { FRESH();
        const attn_body::AttnTensors AT{(const attn_body::bf16*)wsb(F, WS_Q), (const attn_body::bf16*)wsb(F, WS_K), (const attn_body::bf16*)wsb(F, WS_V), (attn_body::bf16*)wsb(F, WS_O)};
        for (int rep = 0; rep < REP_ATT; ++rep)
        for (int v = F.vcu; v < 256; v += F.G) attn_body::attn_phase<8>((char*)RING, AT, v, F.wave);
        SEAM(pb + 4); }
    if (KEEP_E2 && IN(pb + 5) && !SAMPLE) { FRESH(); for (int rep = 0; rep < REP_E2; ++rep) e2_phase(F, LI, 0, MP, F.pidx * NWAVES + F.wave, NPG * NWAVES);
        if (LI + 1 < DEPTH) p0_layer(F, LI + 1 < DEPTH ? LI + 1 : LI, F.pidx * NWAVES + F.wave, NPG * NWAVES, 1); }
    if (KEEP_E2 && IN(pb + 5) && SAMPLE) { FRESH(); for (int rs_ = 0; rs_ < REP_SA; ++rs_) for (int su = F.sidx; su < DB * 8; su += NSG) sattn_unit(F, LI, su >> 3, su & 7); group_barrier(F); }
    if (KEEP_E2 && IN(pb + 5) && SAMPLE) { FRESH(); for (int rs_ = 0; rs_ < REP_SE2; ++rs_) e2_phase(F, LI, MP, M, F.sidx * NWAVES + F.wave, NSG * NWAVES); }
    if (IN(pb + 5)) SEAM(pb + 5);
    if (KEEP_BR && IN(pb + 6)) { FRESH(); pg8::Gemm g{wsb(F, WS_A2), wlayer(F, LI, W_BR), MP, D, KBR}; pg8::SegOrder S; S.init(MP, D, F.G, (int)blockIdx.x);
        pg8::EpiSeg E{wsb(F, WS_GS), (float*)(F.ws + WS_Y), wsb(F, WS_MG)};
        for (int rep = 0; rep < REP_GEMM; ++rep) { if (rep && REP_GEMM_BAR) GRID_BAR(); pg8::gemm_phase<pg8::EpiSeg, pg8::SegOrder, true, true>(RING, g, S, E, F.wave); } SEAM(pb + 6); }
    if (KEEP_WOUT && IN(pb + 7)) { FRESH(); pg8::Gemm g{wsb(F, WS_MG), wlayer(F, LI, W_OUT), MP, D, D}; pg8::StaticOrder S; S.init(MP, D, F.G, (int)blockIdx.x);
        pg8::EpiBf E{wsb(F, WS_YB), D};
        for (int rep = 0; rep < REP_GEMM; ++rep) { if (rep && REP_GEMM_BAR) GRID_BAR(); pg8::gemm_phase<pg8::EpiBf, pg8::StaticOrder, true, true>(RING, g, S, E, F.wave); } SEAM(pb + 7); }
    if (KEEP_N3 && IN(pb + 8) && !SAMPLE) { FRESH(); const float* ng = F.in[8] + (size_t)LI * 8 * D; for (int rep = 0; rep < REP_ROW; ++rep) norm_phase(F, 1.0f, ng + 3 * D, ng + 4 * D, true, 0, MP, F.pidx * NWAVES + F.wave, NPG * NWAVES, rep + 1 < REP_ROW);
        if (LI + 1 < DEPTH) p0_layer(F, LI + 1 < DEPTH ? LI + 1 : LI, F.pidx * NWAVES + F.wave, NPG * NWAVES, 4 | 8); }
    if (KEEP_N3 && IN(pb + 8) && SAMPLE) { FRESH(); pg8::Gemm g{wsb(F, WS_A2), wlayer(F, LI, W_BR), M, D, KBR}; pg8::SampleSegOrder S; S.init(D, NSG, F.sidx);
        pg8::EpiSeg E{wsb(F, WS_GS), (float*)(F.ws + WS_Y), wsb(F, WS_MG)};
        for (int rs_ = 0; rs_ < REP_SG; ++rs_) pg8::gemm_phase<pg8::EpiSeg, pg8::SampleSegOrder, true, true>(RING, g, S, E, F.wave); group_barrier(F); }
    if (KEEP_N3 && IN(pb + 8) && SAMPLE) { FRESH(); OPAQUE_K(kd, D); pg8::Gemm g{wsb(F, WS_MG), wlayer(F, LI, W_OUT), M, D, kd}; pg8::SampleSplitQOrder S; S.init(D, NSG, F.sidx);
        pg8::EpiF32Slab E{(float*)(F.ws + WS_YS)};
        for (int rs_ = 0; rs_ < REP_SG; ++rs_) pg8::gemm_phase<pg8::EpiF32Slab, pg8::SampleSplitQOrder, true, true>(RING, g, S, E, F.wave); group_barrier(F); }
    if (KEEP_N3 && IN(pb + 8) && SAMPLE) { FRESH(); const float* ng = F.in[8] + (size_t)LI * 8 * D; norm_phase_sample(F, 1.0f, ng + 3 * D, ng + 4 * D, true, (const float*)(F.ws + WS_YS), 4); }
    if (IN(pb + 8)) SEAM(pb + 8);
}
template <int LI> __device__ __forceinline__ void ple_part(Frame& F, const XcdBarrier& bar, const int lo, const int hi) {
    constexpr int pb = 1 + LI * PH_PER_LAYER;
    if (KEEP_PG && IN(pb + 12)) { FRESH(); pg8::Gemm g{wsb(F, WS_XN), wlayer(F, LI, W_PG), MP, D, D}; pg8::StaticOrder S; S.init(MP, D, F.G, (int)blockIdx.x);
        pg8::EpiPle E{wsb(F, WS_YB), wsb(F, WS_PU), D};
        for (int rep = 0; rep < REP_GEMM; ++rep) { if (rep && REP_GEMM_BAR) GRID_BAR(); pg8::gemm_phase<pg8::EpiPle, pg8::StaticOrder, true, true>(RING, g, S, E, F.wave); } SEAM(pb + 12); }
    if (KEEP_N5 && IN(pb + 13) && !SAMPLE) { FRESH(); const float* ng = F.in[8] + (size_t)LI * 8 * D; for (int rep = 0; rep < REP_ROW; ++rep) norm_phase(F, 1.0f, ng + 7 * D, ng + 8 * D, LI + 1 < DEPTH, 0, MP, F.pidx * NWAVES + F.wave, NPG * NWAVES, rep + 1 < REP_ROW, LI + 1 == DEPTH);
        if (LI + 1 < DEPTH) p0_layer(F, LI + 1 < DEPTH ? LI + 1 : LI, F.pidx * NWAVES + F.wave, NPG * NWAVES, 2); }
    if (KEEP_N5 && IN(pb + 13) && SAMPLE) { FRESH(); OPAQUE_K(kd, D); pg8::Gemm g{wsb(F, WS_XN), wlayer(F, LI, W_PG), M, D, kd}; pg8::SampleOrder S; S.init(D, NSG, F.sidx);
        pg8::EpiPle E{wsb(F, WS_YB), wsb(F, WS_PU), D};
        for (int rs_ = 0; rs_ < REP_SG; ++rs_) pg8::gemm_phase<pg8::EpiPle, pg8::SampleOrder, true, true>(RING, g, S, E, F.wave); group_barrier(F); }
    if (KEEP_N5 && IN(pb + 13) && SAMPLE) { FRESH(); const float* ng = F.in[8] + (size_t)LI * 8 * D; norm_phase_sample(F, 1.0f, ng + 7 * D, ng + 8 * D, LI + 1 < DEPTH, nullptr, 0, LI + 1 == DEPTH); }
    if (KEEP_N5 && IN(pb + 13) && SAMPLE && LI + 1 < DEPTH) { FRESH(); group_barrier(F); OPAQUE_K(kd, D); pg8::Gemm g{wsb(F, WS_XN), wlayer(F, LI + 1 < DEPTH ? LI + 1 : LI, W_UP1), M, NUP, kd}; pg8::SampleOrder S; S.init(NUP, NSG, F.sidx);
        pg8::EpiSwiGLU E{wsb(F, WS_HFF), DFF};
        for (int rs_ = 0; rs_ < REP_SG; ++rs_) pg8::gemm_phase<pg8::EpiSwiGLU, pg8::SampleOrder, true, true>(RING, g, S, E, F.wave); }
    if (IN(pb + 13)) SEAM(pb + 13);
}
template <int LI> __device__ __forceinline__ void layer_part(Frame& F, const XcdBarrier& bar, const int lo, const int hi) {
    ffn_part<LI, 0>(F, bar, lo, hi); mixer_part<LI>(F, bar, lo, hi); ffn_part<LI, 1>(F, bar, lo, hi); ple_part<LI>(F, bar, lo, hi);
}
__global__ void __launch_bounds__(NWAVES * 64, 2) enc_fwd(Args args) {
    extern __shared__ __attribute__((aligned(16))) unsigned char lds[];
    Frame F;
    F.lds = (LAS unsigned char*)lds;
    F.MISC = (volatile LAS unsigned*)(F.lds + MISC_OFF);
    F.wave = __builtin_amdgcn_readfirstlane(threadIdx.x >> 6);
    F.G = gridDim.x; { const int bx = blockIdx.x; F.vcu = (F.G % 8 == 0) ? (bx % 8) * (F.G / 8) + bx / 8 : bx; }
    { const int w = F.vcu & 31, x = F.vcu >> 5; F.sidx = (w < 8) ? x * 8 + w : -1; F.pidx = (w >= 8) ? x * 24 + (w - 8) : -1; } F.lbn = 0u;
#pragma unroll
    for (int i = 0; i < 21; ++i) F.in[i] = args.in[i];
    F.out = args.out; F.ws = args.ws;
    F.ctl = (gu32*)(F.ws + WS_CTL);
    for (int u = threadIdx.x; u < (LDS_BYTES - LDSCTL_OFF) / 4; u += NWAVES * 64) ((LAS unsigned*)(F.lds + LDSCTL_OFF))[u] = 0u;
    __syncthreads();
    XcdBarrier bar; bar.wave = F.wave; bar.bar = (unsigned*)(F.ctl + CW_BAR); bar.x = 0; bar.st = nullptr;
#if !MK_PER_PHASE
    bar = xcd_barrier_post((unsigned*)(F.ctl + CW_BAR), F.MISC + 8);
#endif
    const int lo = args.ph_lo, hi = args.ph_hi;
    if (KEEP_PRO && IN(0)) { FRESH(); for (int rep = 0; rep < REP_PRO; ++rep) p0_prologue(F); SEAM(0); }
    layer_part<0>(F, bar, lo, hi); layer_part<1>(F, bar, lo, hi); layer_part<2>(F, bar, lo, hi); layer_part<3>(F, bar, lo, hi);
}
#undef IN
#undef SEAM
#undef FRESH
#undef RING
#undef SAMPLE

#ifndef DBG_DUMP
#define DBG_DUMP 0
#endif
#if DBG_DUMP
__global__ void dbg_dump_bf16(const unsigned short* src, float* dst, size_t n) { size_t i = (size_t)blockIdx.x * blockDim.x + threadIdx.x; const size_t st = (size_t)gridDim.x * blockDim.x; for (; i < n; i += st) dst[i] = __uint_as_float((unsigned)src[i] << 16); }
#endif
#ifndef PH_STOP
#define PH_STOP 1000
#endif
extern "C" void kernel_launch(void* const* d_in, const int* in_sizes, int n_in, void* d_out, int out_size, void* d_ws, size_t ws_size, hipStream_t stream) {
    static int grid = 0;
    if (grid == 0) {
        if (n_in != 21 || (size_t)(unsigned)out_size != O_END || ws_size < WS_TOP) { fprintf(stderr, "kernel_launch: unexpected shapes (n_in %d, out %d, ws %zu); nothing launched\n", n_in, out_size, ws_size); grid = -1; return; }
        int dev = 0, cus = 0, per_cu = 0;
        if (hipGetDevice(&dev) != hipSuccess || hipDeviceGetAttribute(&cus, hipDeviceAttributeMultiprocessorCount, dev) != hipSuccess) { grid = -1; return; }
        if (hipFuncSetAttribute((const void*)enc_fwd, hipFuncAttributeMaxDynamicSharedMemorySize, LDS_BYTES) != hipSuccess) { fprintf(stderr, "kernel_launch: hipFuncSetAttribute failed\n"); grid = -1; return; }
        if (hipOccupancyMaxActiveBlocksPerMultiprocessor(&per_cu, (const void*)enc_fwd, NWAVES * 64, LDS_BYTES) != hipSuccess || per_cu < 1)
            fprintf(stderr, "kernel_launch: note: occupancy query reports %d workgroups per CU\n", per_cu);
        (void)hipGetLastError();
        grid = cus;
    }
    if (grid < 0) return;
    if (hipMemsetAsync((char*)d_ws + WS_CTL, 0, CTL_ZERO_BYTES, stream) != hipSuccess) return;
    Args a{};
    for (int i = 0; i < 21; ++i) a.in[i] = (const float*)d_in[i];
    a.out = (float*)d_out; a.ws = (unsigned char*)d_ws;
#if MK_PER_PHASE
    for (int ph = 0; ph < (NPH < PH_STOP ? NPH : PH_STOP); ++ph) { a.ph_lo = ph; a.ph_hi = ph + 1; hipLaunchKernelGGL(enc_fwd, dim3(grid), dim3(NWAVES * 64), LDS_BYTES, stream, a); }
#if DBG_DUMP
    { const unsigned char* ws = (const unsigned char*)d_ws; float* out = (float*)d_out;
      if (DBG_DUMP & 1) { hipLaunchKernelGGL(dbg_dump_bf16, dim3(2048), dim3(256), 0, stream, (const unsigned short*)(ws + WS_O), out + O_KP + (size_t)1 * MP * D, (size_t)MP * 2048);
                          hipLaunchKernelGGL(dbg_dump_bf16, dim3(256), dim3(256), 0, stream, (const unsigned short*)(ws + WS_O) + (size_t)MP * 2048, out + O_KS + (size_t)1 * MS * D, (size_t)MS * 2048); }
      if (DBG_DUMP & 2) { hipLaunchKernelGGL(dbg_dump_bf16, dim3(2048), dim3(256), 0, stream, (const unsigned short*)(ws + WS_A2), out + O_VP + (size_t)1 * MP * D, (size_t)MP * 2048);
                          hipLaunchKernelGGL(dbg_dump_bf16, dim3(256), dim3(256), 0, stream, (const unsigned short*)(ws + WS_A2) + (size_t)MP * 2048, out + O_VS + (size_t)1 * MS * D, (size_t)MS * 2048); }
      if (DBG_DUMP & 8) { hipLaunchKernelGGL(dbg_dump_bf16, dim3(2048), dim3(256), 0, stream, (const unsigned short*)(ws + WS_GS), out + O_KP + (size_t)1 * MP * D, (size_t)MP * 3072); }
      if (DBG_DUMP & 16) { hipLaunchKernelGGL(dbg_dump_bf16, dim3(2048), dim3(256), 0, stream, (const unsigned short*)(ws + WS_W + W_BR), out + O_VP + (size_t)1 * MP * D, (size_t)1024 * 2048); }
      if (DBG_DUMP & 4) { hipLaunchKernelGGL(dbg_dump_bf16, dim3(2048), dim3(256), 0, stream, (const unsigned short*)(ws + WS_MG), out + O_KP + (size_t)3 * MP * D, (size_t)MP * 1024);
                          hipLaunchKernelGGL(dbg_dump_bf16, dim3(256), dim3(256), 0, stream, (const unsigned short*)(ws + WS_MG) + (size_t)MP * 1024, out + O_KS + (size_t)3 * MS * D, (size_t)MS * 1024); } }
#endif
#else
    a.ph_lo = 0; a.ph_hi = (NPH < PH_STOP ? NPH : PH_STOP);
    hipLaunchKernelGGL(enc_fwd, dim3(grid), dim3(NWAVES * 64), LDS_BYTES, stream, a);
#endif
}
```
